# Optimizing an MI355X kernel written in HIP

```python
import jax, jax.numpy as jnp
from jax import lax
import numpy as np

D_MODEL = 1024
BATCH = 8
SEQ = 4096
DEPTH = 2

CHUNK = 64
HEAD_DIM = 64
DSA_HEADS = 8
IDX_HEADS = 8
IDX_DIM = 64
DSA_TOPK_MAX = 256
DSA_BLOCK = 64
FOX_HEADS = 8
FOX_BLOCK = 128
ROPE_THETA = 10000.0
D_FF = 3584
N_EXPERTS = 8
TOP_K = 2
MOE_BLOCK = 256
LN_EPS = 1e-5
DSA_WIDTH = DSA_HEADS * HEAD_DIM
FOX_WIDTH = FOX_HEADS * HEAD_DIM
PROJ_SIZES = (DSA_WIDTH, DSA_WIDTH, DSA_WIDTH, IDX_HEADS * IDX_DIM, IDX_DIM, IDX_HEADS,
              FOX_WIDTH, FOX_WIDTH, FOX_WIDTH, FOX_HEADS, D_MODEL, D_MODEL)
PROJ_TOTAL = sum(PROJ_SIZES)

kernel_name = "hybrid_dsa_fox_gated_moe_deepnorm"


def layer_norm(x, g, b):
    xf = x.astype(jnp.float32)
    mu = jnp.mean(xf, axis=-1, keepdims=True)
    xc = xf - mu
    var = jnp.mean(xc * xc, axis=-1, keepdims=True)
    y = xc * lax.rsqrt(var + LN_EPS)
    return (y * g.astype(jnp.float32) + b.astype(jnp.float32)).astype(x.dtype)


def rotary_tables(positions, dim):
    inv_freq = ROPE_THETA ** (-jnp.arange(0, dim, 2, dtype=jnp.float32) / dim)
    ang = positions.astype(jnp.float32)[..., None] * inv_freq
    return jnp.cos(ang), jnp.sin(ang)


def apply_rotary(x, cos, sin):
    c = cos[:, :, None, :].astype(x.dtype)
    s = sin[:, :, None, :].astype(x.dtype)
    x1, x2 = jnp.split(x, 2, axis=-1)
    return jnp.concatenate([x1 * c - x2 * s, x2 * c + x1 * s], axis=-1)


def split_projection(proj):
    points = [int(p) for p in np.cumsum(PROJ_SIZES)[:-1]]
    return jnp.split(proj, points, axis=-1)


def to_blocks(a, block):
    B, T = a.shape[0], a.shape[1]
    return a.reshape((B, T // block, block) + a.shape[2:]).swapaxes(0, 1)


def from_blocks(a):
    a = a.swapaxes(0, 1)
    return a.reshape((a.shape[0], a.shape[1] * a.shape[2]) + a.shape[3:])


def dsa_attention(q, k, v, iq, ik, iw, top_k):
    B, T, H, dh = q.shape
    nb = T // DSA_BLOCK
    key_pos = jnp.arange(T)
    ik_f = ik.astype(jnp.float32)

    def body(args):
        qb, iqb, iwb, blk = args
        t = blk * DSA_BLOCK + jnp.arange(DSA_BLOCK)
        limit = (t // CHUNK + 1) * CHUNK
        admissible = key_pos[None, :] < limit[:, None]
        head_sc = jnp.einsum('bqhd,bsd->bqhs', iqb.astype(jnp.float32), ik_f) * (IDX_DIM ** -0.5)
        score = jnp.einsum('bqhs,bqh->bqs', jax.nn.relu(head_sc), iwb.astype(jnp.float32))
        score = jnp.where(admissible[None], score, -jnp.inf)
        _, sel = lax.top_k(score, top_k)
        valid = sel < limit[None, :, None]
        k_sel = jax.vmap(lambda kb, ib: kb[ib])(k, sel)
        v_sel = jax.vmap(lambda vb, ib: vb[ib])(v, sel)
        logits = jnp.einsum('bqhd,bqkhd->bhqk', qb, k_sel).astype(jnp.float32) * (dh ** -0.5)
        logits = jnp.where(valid[:, None], logits, -jnp.inf)
        p = jax.nn.softmax(logits, axis=-1).astype(v.dtype)
        return jnp.einsum('bhqk,bqkhd->bqhd', p, v_sel)

    out = lax.map(body, (to_blocks(q, DSA_BLOCK), to_blocks(iq, DSA_BLOCK),
                         to_blocks(iw, DSA_BLOCK), jnp.arange(nb)))
    return from_blocks(out).reshape(B, T, H * dh)


def forgetting_attention(q, k, v, log_f):
    B, T, H, dh = q.shape
    nb = T // FOX_BLOCK
    key_pos = jnp.arange(T)
    c = jnp.cumsum(log_f, axis=1)
    c_k = c.transpose(0, 2, 1)

    def body(args):
        qb, cqb, blk = args
        t = blk * FOX_BLOCK + jnp.arange(FOX_BLOCK)
        causal = key_pos[None, :] <= t[:, None]
        decay = cqb.transpose(0, 2, 1)[..., None] - c_k[:, :, None, :]
        logits = jnp.einsum('bqhd,bshd->bhqs', qb, k).astype(jnp.float32) * (dh ** -0.5) + decay
        logits = jnp.where(causal, logits, -jnp.inf)
        p = jax.nn.softmax(logits, axis=-1).astype(v.dtype)
        return jnp.einsum('bhqs,bshd->bqhd', p, v)

    out = lax.map(body, (to_blocks(q, FOX_BLOCK), to_blocks(c, FOX_BLOCK), jnp.arange(nb)))
    return from_blocks(out).reshape(B, T, H * dh)


def hybrid_mixer(h, cos, sin, w_in, b_forget, w_branch_a, w_branch_b, w_out, top_k):
    B, T, _ = h.shape
    proj = h @ w_in
    dq, dk, dv, iq, ik, iw, fq, fk, fv, fl, ga, gb = split_projection(proj)
    dq = apply_rotary(dq.reshape(B, T, DSA_HEADS, HEAD_DIM), cos, sin)
    dk = apply_rotary(dk.reshape(B, T, DSA_HEADS, HEAD_DIM), cos, sin)
    dv = dv.reshape(B, T, DSA_HEADS, HEAD_DIM)
    iq = apply_rotary(iq.reshape(B, T, IDX_HEADS, IDX_DIM), cos, sin)
    ik = apply_rotary(ik.reshape(B, T, 1, IDX_DIM), cos, sin)[:, :, 0, :]
    iw = iw * (IDX_HEADS ** -0.5)
    o_a = dsa_attention(dq, dk, dv, iq, ik, iw, top_k)

    fq = fq.reshape(B, T, FOX_HEADS, HEAD_DIM)
    fk = fk.reshape(B, T, FOX_HEADS, HEAD_DIM)
    fv = fv.reshape(B, T, FOX_HEADS, HEAD_DIM)
    log_f = jax.nn.log_sigmoid((fl + b_forget).astype(jnp.float32))
    o_b = forgetting_attention(fq, fk, fv, log_f)

    merged = jax.nn.sigmoid(ga) * (o_a @ w_branch_a) + jax.nn.sigmoid(gb) * (o_b @ w_branch_b)
    return merged @ w_out


def dense_swiglu(h, w_gate, w_up, w_down):
    return (jax.nn.silu(h @ w_gate) * (h @ w_up)) @ w_down


def moe_swiglu(h, router, w_gate, w_up, w_down):
    B, T, D = h.shape
    N = B * T
    hf = h.reshape(N, D)
    logits = (hf @ router).astype(jnp.float32)
    top_vals, top_idx = lax.top_k(logits, TOP_K)
    gates = jax.nn.softmax(top_vals, axis=-1).astype(h.dtype)
    A = N * TOP_K
    e_flat = top_idx.reshape(A)
    tok_flat = jnp.repeat(jnp.arange(N, dtype=jnp.int32), TOP_K)
    g_flat = gates.reshape(A)
    order = jnp.argsort(e_flat)
    e_sorted = e_flat[order]
    tok_sorted = tok_flat[order]
    g_sorted = g_flat[order]
    counts = jnp.bincount(e_flat, length=N_EXPERTS).astype(jnp.int32)
    start = jnp.cumsum(counts) - counts
    padded = ((counts + MOE_BLOCK - 1) // MOE_BLOCK) * MOE_BLOCK
    pad_end = jnp.cumsum(padded)
    pad_start = pad_end - padded
    rank = jnp.arange(A, dtype=jnp.int32) - start[e_sorted]
    slot = pad_start[e_sorted] + rank
    P = A + N_EXPERTS * MOE_BLOCK
    slot_tok = jnp.zeros((P,), jnp.int32).at[slot].set(tok_sorted)
    slot_gate = jnp.zeros((P,), h.dtype).at[slot].set(g_sorted)
    n_blocks = P // MOE_BLOCK
    block_expert = jnp.clip(
        jnp.searchsorted(pad_end, jnp.arange(n_blocks, dtype=jnp.int32) * MOE_BLOCK, side='right'),
        0, N_EXPERTS - 1)

    def run_block(args):
        toks, gts, e = args
        xb = hf[toks]
        hid = jax.nn.silu(xb @ w_gate[e]) * (xb @ w_up[e])
        return (hid @ w_down[e]) * gts[:, None]

    yb = lax.map(run_block, (slot_tok.reshape(n_blocks, MOE_BLOCK),
                             slot_gate.reshape(n_blocks, MOE_BLOCK), block_expert))
    out = jnp.zeros((N, D), h.dtype).at[slot_tok].add(yb.reshape(P, D))
    return out.reshape(B, T, D)


def setup_inputs(seed: int = 0) -> dict:
    key = jax.random.key(seed)
    ks = jax.random.split(key, 20)
    n_dense = (DEPTH + 1) // 2
    n_moe = DEPTH // 2
    beta = (8.0 * DEPTH) ** -0.25
    nrm = jax.random.normal
    x = nrm(ks[0], (BATCH, SEQ, D_MODEL), jnp.float32)
    positions = jnp.tile(jnp.arange(SEQ, dtype=jnp.int32)[None, :], (BATCH, 1))
    w_in = nrm(ks[1], (DEPTH, D_MODEL, PROJ_TOTAL), jnp.float32) * D_MODEL ** -0.5
    b_forget = 3.0 + 0.5 * nrm(ks[2], (DEPTH, FOX_HEADS), jnp.float32)
    w_branch_a = nrm(ks[3], (DEPTH, DSA_WIDTH, D_MODEL), jnp.float32) * DSA_WIDTH ** -0.5
    w_branch_b = nrm(ks[4], (DEPTH, FOX_WIDTH, D_MODEL), jnp.float32) * FOX_WIDTH ** -0.5
    w_out = nrm(ks[5], (DEPTH, D_MODEL, D_MODEL), jnp.float32) * (D_MODEL ** -0.5) * beta
    ln_mix_g = 1.0 + 0.02 * nrm(ks[6], (DEPTH, D_MODEL), jnp.float32)
    ln_mix_b = 0.02 * nrm(ks[7], (DEPTH, D_MODEL), jnp.float32)
    ln_ffn_g = 1.0 + 0.02 * nrm(ks[8], (DEPTH, D_MODEL), jnp.float32)
    ln_ffn_b = 0.02 * nrm(ks[9], (DEPTH, D_MODEL), jnp.float32)
    ffn_w_gate = nrm(ks[10], (n_dense, D_MODEL, D_FF), jnp.float32) * D_MODEL ** -0.5
    ffn_w_up = nrm(ks[11], (n_dense, D_MODEL, D_FF), jnp.float32) * D_MODEL ** -0.5
    ffn_w_down = nrm(ks[12], (n_dense, D_FF, D_MODEL), jnp.float32) * (D_FF ** -0.5) * beta
    moe_router = nrm(ks[13], (n_moe, D_MODEL, N_EXPERTS), jnp.float32) * D_MODEL ** -0.5
    moe_w_gate = nrm(ks[14], (n_moe, N_EXPERTS, D_MODEL, D_FF), jnp.float32) * D_MODEL ** -0.5
    moe_w_up = nrm(ks[15], (n_moe, N_EXPERTS, D_MODEL, D_FF), jnp.float32) * D_MODEL ** -0.5
    moe_w_down = nrm(ks[16], (n_moe, N_EXPERTS, D_FF, D_MODEL), jnp.float32) * (D_FF ** -0.5) * beta
    return {"x": x, "positions": positions, "w_in": w_in, "b_forget": b_forget,
            "w_branch_a": w_branch_a, "w_branch_b": w_branch_b, "w_out": w_out,
            "ln_mix_g": ln_mix_g, "ln_mix_b": ln_mix_b, "ln_ffn_g": ln_ffn_g, "ln_ffn_b": ln_ffn_b,
            "ffn_w_gate": ffn_w_gate, "ffn_w_up": ffn_w_up, "ffn_w_down": ffn_w_down,
            "moe_router": moe_router, "moe_w_gate": moe_w_gate, "moe_w_up": moe_w_up,
            "moe_w_down": moe_w_down}


def reference(x, positions, w_in, b_forget, w_branch_a, w_branch_b, w_out,
              ln_mix_g, ln_mix_b, ln_ffn_g, ln_ffn_b, ffn_w_gate, ffn_w_up, ffn_w_down,
              moe_router, moe_w_gate, moe_w_up, moe_w_down):
    T = x.shape[1]
    top_k = min(DSA_TOPK_MAX, T // 4)
    alpha = (2.0 * DEPTH) ** 0.25
    cos, sin = rotary_tables(positions, HEAD_DIM)
    for layer in range(DEPTH):
        mix = hybrid_mixer(x, cos, sin, w_in[layer], b_forget[layer], w_branch_a[layer],
                           w_branch_b[layer], w_out[layer], top_k)
        x = layer_norm(alpha * x + mix, ln_mix_g[layer], ln_mix_b[layer])
        j = layer // 2
        if layer % 2 == 0:
            ff = dense_swiglu(x, ffn_w_gate[j], ffn_w_up[j], ffn_w_down[j])
        else:
            ff = moe_swiglu(x, moe_router[j], moe_w_gate[j], moe_w_up[j], moe_w_down[j])
        x = layer_norm(alpha * x + ff, ln_ffn_g[layer], ln_ffn_b[layer])
    return x
```

```cpp
#include <hip/hip_runtime.h>
#include <hip/hip_bf16.h>
#include <cstdio>
#include <cstdint>
#include <cmath>

#ifndef MK_MULTI
#define MK_MULTI 0
#endif

constexpr int BATCH = 8, SEQ = 4096, DM = 1024, NTOK = BATCH * SEQ, AW = 512, NH = 8;
constexpr int PROJ_TOTAL = 5712, PROJ_PAD = 5888, DFF = 3584, NEXP = 8;
constexpr float LN_EPS = 1e-5f;
constexpr float ALPHA = 1.4142135623730951f;
constexpr float LOG2E = 1.4426950408889634f;
constexpr float C2 = 0.125f * LOG2E;
constexpr int DSA_TOPK = 256;
constexpr int MOE_RT = 132;
constexpr int MOE_NT_MAX = 264;

constexpr int NWAVES = 8;
constexpr size_t MiB = 1u << 20;
constexpr size_t WS_CTL = 0, CTL_ZERO_BYTES = 1 * MiB;
constexpr size_t WS_WIN = 1 * MiB;
constexpr size_t WIN_STRIDE = (size_t)PROJ_PAD * DM * 2;
constexpr size_t WS_WA = 24 * MiB, WS_WB = 26 * MiB, WS_WOUT = 28 * MiB;
constexpr size_t WS_FGU = 32 * MiB, WS_FD = 46 * MiB;
constexpr size_t WS_CS = 53 * MiB;
constexpr size_t WS_IW = 61 * MiB, WS_LOGF = 62 * MiB, WS_CB = 63 * MiB;
constexpr size_t WS_MOE = 64 * MiB;
constexpr size_t MOE_TOPE = WS_MOE, MOE_TOPG = WS_MOE + 128 * 1024, MOE_TOKSLOT = WS_MOE + 384 * 1024, MOE_SLOTTOK = WS_MOE + 640 * 1024,
                 MOE_SLOTGATE = WS_MOE + 1024 * 1024, MOE_CNT = WS_MOE + 1408 * 1024, MOE_TOT = MOE_CNT + 16 * 1024;
constexpr size_t WS_XS = 66 * MiB;
constexpr size_t WS_DQ = 130 * MiB, WS_DK = 162 * MiB, WS_DV = 194 * MiB, WS_IQ = 226 * MiB, WS_FQ = 258 * MiB, WS_FK = 290 * MiB, WS_FV = 322 * MiB;
constexpr size_t WS_GA = 354 * MiB, WS_GB = 418 * MiB;
constexpr size_t WS_IK = 482 * MiB, WS_MASK = 486 * MiB;
constexpr size_t WS_MERGED = WS_DK;
constexpr size_t WS_H = 130 * MiB;
constexpr size_t WS_H2 = 130 * MiB;
constexpr size_t WS_YB = 361 * MiB;
constexpr size_t WS_MWD = 493 * MiB;
constexpr size_t WS_END = 549 * MiB;
static_assert(WS_MASK + (size_t)NTOK * 128 * 4 <= WS_END && WS_H2 + (size_t)MOE_RT * 256 * DFF * 2 <= WS_YB && WS_YB + (size_t)MOE_NT_MAX * 256 * DM * 2 <= WS_MWD && WS_MWD + (size_t)NEXP * DM * DFF * 2 <= WS_END, "ws map");
static_assert(WS_WIN + 2 * WIN_STRIDE <= WS_WA && WS_FD + (size_t)DM * DFF * 2 <= WS_CS && WS_H + (size_t)NTOK * DFF * 2 <= WS_GA, "ws map 2");
constexpr int CW_TMO = 0, CW_CODE = 1, CW_BAR = 4096;

constexpr int RING_OFF = 0, RING_BYTES = 131072;
constexpr int IDX_ROWB = 8200;
constexpr int IDX_HIST_OFF = 16 * IDX_ROWB;
constexpr int MISC_OFF = 146432;
constexpr int LDS_BYTES = 147456;
static_assert(IDX_HIST_OFF + 8 * 1024 <= MISC_OFF && MISC_OFF + 128 <= LDS_BYTES, "LDS map");

#define GAS __attribute__((address_space(1)))
#define LAS __attribute__((address_space(3)))
typedef unsigned short bf16;
typedef unsigned v4u __attribute__((ext_vector_type(4)));
typedef unsigned v2u __attribute__((ext_vector_type(2)));
typedef float f32x4 __attribute__((ext_vector_type(4)));
typedef short bf16x8 __attribute__((ext_vector_type(8)));
typedef GAS unsigned gu32;
#define RLX_AGENT __ATOMIC_RELAXED, __HIP_MEMORY_SCOPE_AGENT
__device__ __forceinline__ unsigned f2bf(float f) { unsigned u = __builtin_bit_cast(unsigned, f); return (u + 0x7fffu + ((u >> 16) & 1u)) >> 16; }
__device__ __forceinline__ unsigned pk2(float lo, float hi) { return f2bf(lo) | (f2bf(hi) << 16); }

namespace pg8 {
#define PG8_LAS __attribute__((address_space(3)))
typedef unsigned short bf16_t;
typedef short bf16x8 __attribute__((ext_vector_type(8)));
typedef float f32x4 __attribute__((ext_vector_type(4)));
typedef unsigned u32x4 __attribute__((ext_vector_type(4)));
constexpr int BM = 256, BK = 64, HALF = 128, HTB = HALF * BK * 2  , STAGE_BYTES = 8 * HTB, NXCD = 8, WGM = 8;

__host__ __device__ __forceinline__ int lds_byte(int r, int c) { const int st = (r >> 4) * 2 + (c >> 5), rr = r & 15, cc = c & 31, ob = rr * 64 + cc * 2; return st * 1024 + (ob ^ (((ob >> 9) & 1) << 5)); }
__host__ __device__ __forceinline__ void stage_rc(int b, int& R, int& C) { const int st = b / 1024, sb = b % 1024, swz = sb ^ (((sb >> 9) & 1) << 5); R = (st >> 1) * 16 + swz / 64; C = (st & 1) * 32 + (swz % 64) / 2; }
__host__ __device__ __forceinline__ int perm32(int rho) { const int n = rho >> 4, i = rho & 15; return 8 * (i >> 2) + 4 * n + (i & 3); }

struct Unit { int pm, pn; };
struct Gemm { const bf16_t* A; const bf16_t* Bt; int M, N, K; };

struct StaticOrder {
    int nM, nN, nwg, G, c;
    __host__ __device__ void init(int M, int N, int G_, int c_) { nM = M / BM; nN = N / BM; nwg = nM * nN; G = G_; c = c_; }
    __host__ __device__ bool next(int i, Unit& u) const {
        const long L = (long)i * G + c; if (L >= nwg) return false;
        int wgid = (int)L; { const int q = nwg / NXCD, r = nwg % NXCD, xcd = wgid % NXCD, off = wgid / NXCD; wgid = (xcd < r ? xcd * (q + 1) : r * (q + 1) + (xcd - r) * q) + off; }
        const int nig = WGM * nN, gid = wgid / nig, fm = gid * WGM, gsz = (nM - fm) < WGM ? (nM - fm) : WGM;
        u.pm = fm + ((wgid % nig) % gsz); u.pn = (wgid % nig) / gsz; return true;
    }
    __device__ __forceinline__ void a_ready(const Unit&) const {}
    __device__ __forceinline__ void done(const Unit&) const {}
};
__device__ __forceinline__ unsigned cvt_pk_bf16(float lo, float hi) { unsigned r; asm volatile("v_cvt_pk_bf16_f32 %0, %1, %2" : "=v"(r) : "v"(lo), "v"(hi)); return r; }
typedef float f32x2 __attribute__((ext_vector_type(2)));
template <class Epi, class Sched, bool ALIGN_EPI = false, bool SP2 = false, bool GATHER = false>
__device__ __forceinline__ void gemm_phase(PG8_LAS unsigned char* lds, const Gemm g, const Sched& S, const Epi& E) {
    int tid_ = threadIdx.x; asm volatile("" : "+v"(tid_));
    const int tid = tid_, wid = __builtin_amdgcn_readfirstlane(tid >> 6), lane = tid & 63, wr = wid >> 2, wc = wid & 3, fr = lane & 15, fq = lane >> 4;
    const int K = g.K, nt = K / BK;
    unsigned voffA[2], voffB[2]; int gR[2]; unsigned gC[2];
#pragma unroll
    for (int i = 0; i < 2; ++i) { int R, C; stage_rc(tid * 16 + i * 8192, R, C); const int Rb = Epi::PERM ? ((R & ~31) + perm32(R & 31)) : R;
        voffA[i] = (unsigned)(R * K + C) * 2u; voffB[i] = (unsigned)(Rb * K + C) * 2u; gR[i] = R; gC[i] = (unsigned)C * 2u; }
    static_assert(!GATHER || SP2, "gather mode is written for the SP2 loop only");
    unsigned cv[2][2] = {{0u, 0u}, {0u, 0u}}, nv[2][2] = {{0u, 0u}, {0u, 0u}};
    const size_t kstep = (size_t)(BK * 2);
    const size_t hstep = (size_t)HALF * K * 2;
    const size_t tstep = 2 * hstep;
    const unsigned ldsw = (unsigned)wid * 1024u;
    const int aoff = lds_byte(wr * 64 + fr, fq * 8), boff = lds_byte(wc * 32 + fr, fq * 8);
#define PG8_SA(b, h) (((b) * 2 + (h)) * HTB)
#define PG8_SB(b, h) ((4 + (b) * 2 + (h)) * HTB)
#define PG8_STAGE(bufoff, gbase, voff) do { _Pragma("unroll") for (int _i = 0; _i < 2; ++_i) \
        __builtin_amdgcn_global_load_lds((const unsigned*)((const char*)(gbase) + (voff)[_i]), (PG8_LAS unsigned*)(lds + (bufoff) + ldsw + _i * 8192), 16, 0, 0); } while (0)
#define PG8_STAGE_A(b, h, gbase, VO) do { if constexpr (GATHER) { PG8_STAGE(PG8_SA(b, h), gbase, VO[h]); } else { PG8_STAGE(PG8_SA(b, h), (gbase) + (h) * hstep, voffA); } } while (0)
#define PG8_LDA(dst, b, h) do { _Pragma("unroll") for (int m = 0; m < 4; ++m) _Pragma("unroll") for (int k = 0; k < 2; ++k) dst[m][k] = *(const PG8_LAS bf16x8*)(lds + PG8_SA(b, h) + aoff + m * 2048 + k * 1024); } while (0)
#define PG8_LDB(dst, b, h) do { _Pragma("unroll") for (int n = 0; n < 2; ++n) _Pragma("unroll") for (int k = 0; k < 2; ++k) dst[n][k] = *(const PG8_LAS bf16x8*)(lds + PG8_SB(b, h) + boff + n * 2048 + k * 1024); } while (0)
#define PG8_MMA(ai, bj, At, Bt) do { __builtin_amdgcn_s_setprio(1); _Pragma("unroll") for (int m = 0; m < 4; ++m) _Pragma("unroll") for (int n = 0; n < 2; ++n) _Pragma("unroll") for (int k = 0; k < 2; ++k) \
        acc[ai][bj][m][n] = __builtin_amdgcn_mfma_f32_16x16x32_bf16(Bt[n][k], At[m][k], acc[ai][bj][m][n], 0, 0, 0); __builtin_amdgcn_s_setprio(0); } while (0)
#define PG8_WAIT_V(n) asm volatile("s_waitcnt vmcnt(" #n ")" ::: "memory")
#define PG8_WAIT_L(n) asm volatile("s_waitcnt lgkmcnt(" #n ")" ::: "memory")
#define PG8_BAR __builtin_amdgcn_s_barrier()
#define PG8_SCHED __builtin_amdgcn_sched_barrier(0)
    Unit cur, nxt; int ui = 0;
    if (!S.next(0, cur)) return;
    f32x4 acc[2][2][4][2];
#pragma unroll
    for (int a = 0; a < 2; ++a)
#pragma unroll
        for (int b = 0; b < 2; ++b)
#pragma unroll
            for (int m = 0; m < 4; ++m)
#pragma unroll
                for (int n = 0; n < 2; ++n) acc[a][b][m][n] = (f32x4){0.f, 0.f, 0.f, 0.f};
    bf16x8 At[4][2], B0[2][2], B1[2][2];
    const char* cA = (const char*)g.A + (GATHER ? (size_t)0 : (size_t)cur.pm * tstep);
    if constexpr (GATHER) {
#pragma unroll
        for (int h = 0; h < 2; ++h)
#pragma unroll
            for (int i = 0; i < 2; ++i) { cv[h][i] = (unsigned)S.arow(cur, h * HALF + gR[i]) * (unsigned)(K * 2) + gC[i]; nv[h][i] = cv[h][i]; } } const char* cB = (const char*)g.Bt + (size_t)cur.pn * tstep;
    S.a_ready(cur);
    if constexpr (SP2) {
        PG8_STAGE(PG8_SB(0, 0), cB, voffB); PG8_STAGE(PG8_SB(0, 1), cB + hstep, voffB); PG8_STAGE_A(0, 0, cA, cv); PG8_STAGE_A(0, 1, cA, cv);
        if (wr == 1) PG8_BAR;
        PG8_WAIT_V(2); PG8_BAR;
        PG8_STAGE(PG8_SB(1, 0), cB + kstep, voffB); PG8_STAGE_A(1, 0, cA + kstep, cv); PG8_STAGE(PG8_SB(1, 1), cB + hstep + kstep, voffB);
        PG8_WAIT_V(6); PG8_BAR;
    } else {
        PG8_STAGE(PG8_SB(0, 0), cB, voffB); PG8_STAGE(PG8_SA(0, 0), cA, voffA); PG8_STAGE(PG8_SB(0, 1), cB + hstep, voffB); PG8_STAGE(PG8_SA(0, 1), cA + hstep, voffA);
        if (wr == 1) PG8_BAR;
        PG8_WAIT_V(4); PG8_BAR;
        PG8_STAGE(PG8_SB(1, 0), cB + kstep, voffB); PG8_STAGE_A(1, 0, cA + kstep, cv); PG8_STAGE(PG8_SB(1, 1), cB + hstep + kstep, voffB);
        PG8_WAIT_V(6); PG8_BAR;
    }
    for (;;) {
        const bool has_next = S.next(ui + 1, nxt);
        const char* nA = (has_next && !GATHER) ? (const char*)g.A + (size_t)nxt.pm * tstep : cA;
        if constexpr (GATHER) { if (has_next) {
#pragma unroll
            for (int h = 0; h < 2; ++h)
#pragma unroll
                for (int i = 0; i < 2; ++i) nv[h][i] = (unsigned)S.arow(nxt, h * HALF + gR[i]) * (unsigned)(K * 2) + gC[i]; } } const char* nB = has_next ? (const char*)g.Bt + (size_t)nxt.pn * tstep : cB;
        for (int t = 0; t < nt; t += 2) {
            const bool last = (t == nt - 2);
            const char* a1 = cA + (size_t)(t + 1) * kstep;
            const char* a2 = last ? nA : cA + (size_t)(t + 2) * kstep; const char* b2 = last ? nB : cB + (size_t)(t + 2) * kstep;
            const char* a3 = a2 + kstep; const char* b3 = b2 + kstep;
            if (last && has_next) S.a_ready(nxt);
            unsigned v2[2][2];
#pragma unroll
            for (int h = 0; h < 2; ++h)
#pragma unroll
                for (int i = 0; i < 2; ++i) v2[h][i] = last ? nv[h][i] : cv[h][i];
            if constexpr (SP2) {
            PG8_LDB(B0, 0, 0); PG8_LDB(B1, 0, 1); PG8_SCHED; PG8_LDA(At, 0, 0); PG8_STAGE_A(1, 1, a1, cv);
            PG8_WAIT_V(8); PG8_WAIT_L(0); PG8_BAR; PG8_MMA(0, 0, At, B0); PG8_MMA(0, 1, At, B1); PG8_BAR; PG8_SCHED;
            PG8_LDA(At, 0, 1); PG8_STAGE(PG8_SB(0, 0), b2, voffB); PG8_STAGE(PG8_SB(0, 1), b2 + hstep, voffB); PG8_STAGE_A(0, 0, a2, v2);
            PG8_WAIT_V(8); PG8_WAIT_L(0); PG8_BAR; PG8_MMA(1, 0, At, B0); PG8_MMA(1, 1, At, B1); PG8_BAR; PG8_SCHED;
            PG8_LDB(B0, 1, 0); PG8_LDB(B1, 1, 1); PG8_SCHED; PG8_LDA(At, 1, 0); PG8_STAGE_A(0, 1, a2, v2);
            PG8_WAIT_V(8); PG8_WAIT_L(0); PG8_BAR; PG8_MMA(0, 0, At, B0); PG8_MMA(0, 1, At, B1); PG8_BAR; PG8_SCHED;
            PG8_LDA(At, 1, 1); PG8_STAGE(PG8_SB(1, 0), b3, voffB); PG8_STAGE(PG8_SB(1, 1), b3 + hstep, voffB); PG8_STAGE_A(1, 0, a3, v2);
            PG8_WAIT_V(8); PG8_WAIT_L(0); PG8_BAR; PG8_MMA(1, 0, At, B0); PG8_MMA(1, 1, At, B1); PG8_BAR; PG8_SCHED;
            } else {
            PG8_LDB(B0, 0, 0); PG8_SCHED; PG8_LDA(At, 0, 0); PG8_STAGE(PG8_SA(1, 1), a1 + hstep, voffA);
            PG8_WAIT_L(8); PG8_BAR; PG8_WAIT_L(0); PG8_MMA(0, 0, At, B0); PG8_BAR; PG8_SCHED;
            PG8_LDB(B1, 0, 1); PG8_STAGE(PG8_SB(0, 0), b2, voffB);
            PG8_BAR; PG8_WAIT_L(0); PG8_MMA(0, 1, At, B1); PG8_BAR;
            PG8_LDA(At, 0, 1); PG8_STAGE(PG8_SA(0, 0), a2, voffA);
            PG8_BAR; PG8_WAIT_L(0); PG8_MMA(1, 0, At, B0); PG8_BAR; PG8_SCHED;
            PG8_STAGE(PG8_SB(0, 1), b2 + hstep, voffB);
            PG8_WAIT_V(6); PG8_BAR; PG8_MMA(1, 1, At, B1); PG8_BAR;
            PG8_LDB(B0, 1, 0); PG8_SCHED; PG8_LDA(At, 1, 0); PG8_STAGE(PG8_SA(0, 1), a2 + hstep, voffA);
            PG8_WAIT_L(8); PG8_BAR; PG8_WAIT_L(0); PG8_MMA(0, 0, At, B0); PG8_BAR; PG8_SCHED;
            PG8_LDB(B1, 1, 1); PG8_STAGE(PG8_SB(1, 0), b3, voffB);
            PG8_BAR; PG8_WAIT_L(0); PG8_MMA(0, 1, At, B1); PG8_BAR;
            PG8_LDA(At, 1, 1); PG8_STAGE(PG8_SA(1, 0), a3, voffA);
            PG8_BAR; PG8_WAIT_L(0); PG8_MMA(1, 0, At, B0); PG8_BAR; PG8_SCHED;
            PG8_STAGE(PG8_SB(1, 1), b3 + hstep, voffB);
            PG8_WAIT_V(6); PG8_BAR; PG8_MMA(1, 1, At, B1); PG8_BAR;
            }
        }
        if constexpr (ALIGN_EPI) { if (wr == 0) PG8_BAR; }
        if constexpr (!Epi::AFTER_DRAIN) { E(acc, cur, wr, wc, fr, fq); S.done(cur); }
        if (!has_next) break;
#pragma unroll
        for (int a = 0; a < 2; ++a)
#pragma unroll
            for (int b = 0; b < 2; ++b)
#pragma unroll
                for (int m = 0; m < 4; ++m)
#pragma unroll
                    for (int n = 0; n < 2; ++n) acc[a][b][m][n] = (f32x4){0.f, 0.f, 0.f, 0.f};
        cur = nxt; cA = nA; cB = nB; ++ui;
        if constexpr (GATHER) {
#pragma unroll
            for (int h = 0; h < 2; ++h)
#pragma unroll
                for (int i = 0; i < 2; ++i) cv[h][i] = nv[h][i]; }
        if constexpr (ALIGN_EPI) { if (wr == 1) PG8_BAR; }
    }
    PG8_WAIT_V(0);
    if constexpr (!ALIGN_EPI) { if (wr == 0) PG8_BAR; }
    PG8_BAR;
    if constexpr (Epi::AFTER_DRAIN) { E.fused(acc, cur, wr, wc, fr, fq, lds, wid, lane); S.done(cur); }
#undef PG8_SA
#undef PG8_SB
#undef PG8_STAGE
#undef PG8_STAGE_A
#undef PG8_LDA
#undef PG8_LDB
#undef PG8_MMA
#undef PG8_WAIT_V
#undef PG8_WAIT_L
#undef PG8_BAR
#undef PG8_SCHED
}
}
namespace pg8 {
typedef unsigned u32x2 __attribute__((ext_vector_type(2)));
__device__ __forceinline__ float bf2f(unsigned h16) { return __uint_as_float(h16 << 16); }
__device__ __forceinline__ float sigmoidf_fast(float x) { return __builtin_amdgcn_rcpf(1.0f + __builtin_amdgcn_exp2f(-x * 1.4426950408889634f)); }
typedef float f32x2c __attribute__((ext_vector_type(2))); typedef __bf16 bf16x2c __attribute__((ext_vector_type(2)));
__device__ __forceinline__ unsigned cvt2(float lo, float hi) { f32x2c v = {lo, hi}; bf16x2c b = __builtin_convertvector(v, bf16x2c); return __builtin_bit_cast(unsigned, b); }
__device__ __forceinline__ u32x4 pack8(const f32x4& a, const f32x4& b) { u32x4 w; w.x = cvt2(a[0], a[1]); w.y = cvt2(a[2], a[3]); w.z = cvt2(b[0], b[1]); w.w = cvt2(b[2], b[3]); return w; }
__device__ __forceinline__ void unpack8(const u32x4& w, f32x4& a, f32x4& b) {
    a[0] = bf2f(w.x & 0xffffu); a[1] = __uint_as_float(w.x & 0xffff0000u); a[2] = bf2f(w.y & 0xffffu); a[3] = __uint_as_float(w.y & 0xffff0000u);
    b[0] = bf2f(w.z & 0xffffu); b[1] = __uint_as_float(w.z & 0xffff0000u); b[2] = bf2f(w.w & 0xffffu); b[3] = __uint_as_float(w.w & 0xffff0000u); }

#ifdef DBG_NOSIG
#define SIGF(x) (x)
#else
#define SIGF(x) sigmoidf_fast(x)
#endif
struct EpiProj {
    static constexpr bool PERM = true, AFTER_DRAIN = false;
    unsigned char* ws; const float* bforget;
    __device__ __forceinline__ void operator()(const f32x4 (&acc)[2][2][4][2], const Unit& u, int wr, int wc, int fr, int fq) const {
        const int pn = u.pn; const int row0 = u.pm * BM + wr * 64 + fr;
        bf16_t *DQ = (bf16_t*)(ws + WS_DQ), *DK = (bf16_t*)(ws + WS_DK), *DV = (bf16_t*)(ws + WS_DV), *IQ = (bf16_t*)(ws + WS_IQ), *FQ = (bf16_t*)(ws + WS_FQ), *FK = (bf16_t*)(ws + WS_FK), *FV = (bf16_t*)(ws + WS_FV);
        bf16_t *GA = (bf16_t*)(ws + WS_GA), *GB = (bf16_t*)(ws + WS_GB), *IK = (bf16_t*)(ws + WS_IK); float *IW = (float*)(ws + WS_IW), *LOGF = (float*)(ws + WS_LOGF); const float* CS = (const float*)(ws + WS_CS);
        const bool rot = (pn < 4) || pn == 6 || pn == 7 || (pn == 22 && wc == 0);
        if (rot) {
            bf16_t* dst; int pitch, col1; float sc = 1.f;
            if (pn == 22) { dst = IK; pitch = 64; col1 = 8 * fq; }
            else { dst = pn < 2 ? DQ : (pn < 4 ? DK : IQ); pitch = AW; col1 = (4 * (pn & 1) + wc) * 64 + 8 * fq; if (pn < 2) sc = C2; }
#pragma unroll
            for (int ai = 0; ai < 2; ++ai)
#pragma unroll
                for (int m = 0; m < 4; ++m) {
                    const int row = row0 + ai * HALF + m * 16;
                    const float* cs = CS + (size_t)row * 64 + 16 * fq;
                    const f32x4 t0 = *(const f32x4*)(cs), t1 = *(const f32x4*)(cs + 4), t2 = *(const f32x4*)(cs + 8), t3 = *(const f32x4*)(cs + 12);
                    const f32x4 xa = acc[ai][0][m][0], xb = acc[ai][0][m][1], ya = acc[ai][1][m][0], yb = acc[ai][1][m][1];
                    f32x4 o1a, o1b, o2a, o2b;
                    o1a[0] = (xa[0] * t0[0] - ya[0] * t0[1]) * sc; o2a[0] = (ya[0] * t0[0] + xa[0] * t0[1]) * sc;
                    o1a[1] = (xa[1] * t0[2] - ya[1] * t0[3]) * sc; o2a[1] = (ya[1] * t0[2] + xa[1] * t0[3]) * sc;
                    o1a[2] = (xa[2] * t1[0] - ya[2] * t1[1]) * sc; o2a[2] = (ya[2] * t1[0] + xa[2] * t1[1]) * sc;
                    o1a[3] = (xa[3] * t1[2] - ya[3] * t1[3]) * sc; o2a[3] = (ya[3] * t1[2] + xa[3] * t1[3]) * sc;
                    o1b[0] = (xb[0] * t2[0] - yb[0] * t2[1]) * sc; o2b[0] = (yb[0] * t2[0] + xb[0] * t2[1]) * sc;
                    o1b[1] = (xb[1] * t2[2] - yb[1] * t2[3]) * sc; o2b[1] = (yb[1] * t2[2] + xb[1] * t2[3]) * sc;
                    o1b[2] = (xb[2] * t3[0] - yb[2] * t3[1]) * sc; o2b[2] = (yb[2] * t3[0] + xb[2] * t3[1]) * sc;
                    o1b[3] = (xb[3] * t3[2] - yb[3] * t3[3]) * sc; o2b[3] = (yb[3] * t3[2] + xb[3] * t3[3]) * sc;
                    bf16_t* rp = dst + (size_t)row * pitch + col1;
                    *(u32x4*)(rp) = pack8(o1a, o1b); *(u32x4*)(rp + 32) = pack8(o2a, o2b);
                }
        } else if (pn == 22) {
            if (fq == 0 && (wc == 1 || wc == 2)) {
                f32x4 b0 = {0.f, 0.f, 0.f, 0.f}, b1 = {0.f, 0.f, 0.f, 0.f};
                if (wc == 2) { b0 = *(const f32x4*)(bforget); b1 = *(const f32x4*)(bforget + 4); }
#pragma unroll
                for (int ai = 0; ai < 2; ++ai)
#pragma unroll
                    for (int m = 0; m < 4; ++m) {
                        const int row = row0 + ai * HALF + m * 16;
                        f32x4 va = acc[ai][0][m][0], vb = acc[ai][0][m][1];
                        if (wc == 1) { va = va * 0.04419417382415922f; vb = vb * 0.04419417382415922f;
                            *(f32x4*)(IW + (size_t)row * 8) = va; *(f32x4*)(IW + (size_t)row * 8 + 4) = vb; }
                        else { va = va + b0; vb = vb + b1; f32x4 la, lb;
#pragma unroll
                            for (int i = 0; i < 4; ++i) { const float za = va[i], zb = vb[i];
                                la[i] = fminf(za, 0.f) - log1pf(__expf(-fabsf(za))); lb[i] = fminf(zb, 0.f) - log1pf(__expf(-fabsf(zb))); }
                            *(f32x4*)(LOGF + (size_t)row * 8) = la; *(f32x4*)(LOGF + (size_t)row * 8 + 4) = lb; }
                    }
            }
        } else if (pn < 14) {
            bf16_t* dst = pn < 6 ? DV : (pn < 10 ? FQ : (pn < 12 ? FK : FV)); const float sc = (pn == 8 || pn == 9) ? C2 : 1.f;
            const int col0 = 256 * (pn & 1) + wc * 32 + 8 * fq;
#pragma unroll
            for (int ai = 0; ai < 2; ++ai)
#pragma unroll
                for (int m = 0; m < 4; ++m) { bf16_t* rp = dst + (size_t)(row0 + ai * HALF + m * 16) * AW + col0;
#pragma unroll
                    for (int bj = 0; bj < 2; ++bj) *(u32x4*)(rp + bj * HALF) = pack8(acc[ai][bj][m][0] * sc, acc[ai][bj][m][1] * sc); }
        } else {
            bf16_t* dst = pn < 18 ? GA : GB; const int col0 = 256 * ((pn - 14) & 3) + wc * 32 + 8 * fq;
#pragma unroll
            for (int ai = 0; ai < 2; ++ai)
#pragma unroll
                for (int m = 0; m < 4; ++m) { bf16_t* rp = dst + (size_t)(row0 + ai * HALF + m * 16) * DM + col0;
#pragma unroll
                    for (int bj = 0; bj < 2; ++bj) { f32x4 a = acc[ai][bj][m][0], b = acc[ai][bj][m][1];
#pragma unroll
                        for (int i = 0; i < 4; ++i) { a[i] = SIGF(a[i]); b[i] = SIGF(b[i]); }
                        *(u32x4*)(rp + bj * HALF) = pack8(a, b); } }
        }
    }
};

struct EpiGate {
    static constexpr bool PERM = true, AFTER_DRAIN = false;
    bf16_t* O; const bf16_t* G; const bf16_t* Prev;
    __device__ __forceinline__ void operator()(const f32x4 (&acc)[2][2][4][2], const Unit& u, int wr, int wc, int fr, int fq) const {
        const int row0 = u.pm * BM + wr * 64 + fr, col0 = u.pn * BM + wc * 32 + 8 * fq;
#pragma unroll
        for (int ai = 0; ai < 2; ++ai)
#pragma unroll
            for (int m = 0; m < 4; ++m) { const size_t ro = (size_t)(row0 + ai * HALF + m * 16) * DM + col0;
#pragma unroll
                for (int bj = 0; bj < 2; ++bj) { const size_t off = ro + bj * HALF;
                    f32x4 ga, gb; unpack8(*(const u32x4*)(G + off), ga, gb);
                    f32x4 a = ga * acc[ai][bj][m][0], b = gb * acc[ai][bj][m][1];
                    if (Prev) { f32x4 pa, pb; unpack8(*(const u32x4*)(Prev + off), pa, pb); a = a + pa; b = b + pb; }
                    *(u32x4*)(O + off) = pack8(a, b); } }
    }
};

struct EpiY {
    static constexpr bool PERM = false, AFTER_DRAIN = false;
    float* Y; const bf16_t* R;
    __device__ __forceinline__ void operator()(const f32x4 (&acc)[2][2][4][2], const Unit& u, int wr, int wc, int fr, int fq) const {
        const int row0 = u.pm * BM + wr * 64 + fr, col0 = u.pn * BM + wc * 32 + 4 * fq;
#pragma unroll
        for (int ai = 0; ai < 2; ++ai)
#pragma unroll
            for (int m = 0; m < 4; ++m) { const size_t ro = (size_t)(row0 + ai * HALF + m * 16) * DM + col0;
#pragma unroll
                for (int bj = 0; bj < 2; ++bj)
#pragma unroll
                    for (int n = 0; n < 2; ++n) { const size_t off = ro + bj * HALF + n * 16;
                        const u32x2 w = *(const u32x2*)(R + off); f32x4 r;
                        r[0] = bf2f(w.x & 0xffffu); r[1] = __uint_as_float(w.x & 0xffff0000u); r[2] = bf2f(w.y & 0xffffu); r[3] = __uint_as_float(w.y & 0xffff0000u);
                        *(f32x4*)(Y + off) = r * ALPHA + acc[ai][bj][m][n]; } }
    }
};

struct EpiSwiglu {
    static constexpr bool PERM = true, AFTER_DRAIN = false;
    bf16_t* H; int nc;
    __device__ __forceinline__ void operator()(const f32x4 (&acc)[2][2][4][2], const Unit& u, int wr, int wc, int fr, int fq) const {
        const int row0 = u.pm * BM + wr * 64 + fr, col0 = (u.pn % nc) * HALF + wc * 32 + 8 * fq;
#pragma unroll
        for (int ai = 0; ai < 2; ++ai)
#pragma unroll
            for (int m = 0; m < 4; ++m) { f32x4 a, b;
#pragma unroll
                for (int i = 0; i < 4; ++i) { const float g0 = acc[ai][0][m][0][i], g1 = acc[ai][0][m][1][i];
                    a[i] = g0 * sigmoidf_fast(g0) * acc[ai][1][m][0][i]; b[i] = g1 * sigmoidf_fast(g1) * acc[ai][1][m][1][i]; }
                *(u32x4*)(H + (size_t)(row0 + ai * HALF + m * 16) * DFF + col0) = pack8(a, b); }
    }
};

struct EpiDownMoe {
    static constexpr bool PERM = true, AFTER_DRAIN = false;
    bf16_t* YB; const float* gate; int t_lo;
    __device__ __forceinline__ void operator()(const f32x4 (&acc)[2][2][4][2], const Unit& u, int wr, int wc, int fr, int fq) const {
        const int row0 = (t_lo + u.pm) * BM + wr * 64 + fr, col0 = (u.pn & 3) * BM + wc * 32 + 8 * fq;
#pragma unroll
        for (int ai = 0; ai < 2; ++ai)
#pragma unroll
            for (int m = 0; m < 4; ++m) { const int row = row0 + ai * HALF + m * 16; const float gt = gate[row]; bf16_t* rp = YB + (size_t)row * DM + col0;
#pragma unroll
                for (int bj = 0; bj < 2; ++bj) *(u32x4*)(rp + bj * HALF) = pack8(acc[ai][bj][m][0] * gt, acc[ai][bj][m][1] * gt); }
    }
};

struct MoeOrder {
    int cum[8]; int t_lo, t_hi, nc, G, c; const int* slot_tok;
    __device__ __forceinline__ bool next(int i, Unit& u) const {
        const long L = (long)i * G + c; const int nt = t_hi - t_lo; if (L >= (long)nt * nc) return false;
        const int pml = (int)(L / nc), pnl = (int)(L % nc), tg = t_lo + pml; int e = 0;
#pragma unroll
        for (int j = 0; j < 7; ++j) e += (tg >= cum[j]) ? 1 : 0;
        u.pm = pml; u.pn = e * nc + pnl; return true;
    }
    __device__ __forceinline__ int arow(const Unit& u, int r) const { return slot_tok[(t_lo + u.pm) * BM + r]; }
    __device__ __forceinline__ void a_ready(const Unit&) const {}
    __device__ __forceinline__ void done(const Unit&) const {}
};
}

namespace attn_body {
using bf16 = unsigned short;
using bf16x8 = __attribute__((ext_vector_type(8))) short;
using s16x4 = __attribute__((ext_vector_type(4))) short;
using f32x16 = __attribute__((ext_vector_type(16))) float;
using u32x4 = __attribute__((ext_vector_type(4))) unsigned;
using u32x2 = __attribute__((ext_vector_type(2))) unsigned;
#define ALAS __attribute__((address_space(3)))
constexpr int NW = 8, QBLK = 32, QB = QBLK * NW, KVBLK = 64;
constexpr int NSLOT = 3, SLOTB = 8192;
constexpr int LDS_K = 0, LDS_V = NSLOT * SLOTB, LDS_WS = 2 * NSLOT * SLOTB, LDS_OST = LDS_WS + NW * 64 * 4, LDS_BIAS = LDS_OST + NW * 4096, LDS_BYTES = LDS_BIAS + 1024;
__device__ __forceinline__ int crow(int r, int hi) { return (r & 3) + 8 * (r >> 2) + 4 * hi; }
typedef float f32x2_t __attribute__((ext_vector_type(2))); typedef __bf16 bf16x2_t __attribute__((ext_vector_type(2)));
__device__ __forceinline__ unsigned cvtpk_s(float lo, float hi) { f32x2_t v = {lo, hi}; bf16x2_t b = __builtin_convertvector(v, bf16x2_t); return __builtin_bit_cast(unsigned, b); }
__device__ __forceinline__ void cmask(f32x16& p0, f32x16& p1, int jb, int qrel, int hi) {
    const float NEG = -INFINITY; const int kb = 64 * jb + 4 * hi;
#pragma unroll
    for (int r = 0; r < 16; ++r) { const int kv = kb + (r & 3) + 8 * (r >> 2); if (kv > qrel) p0[r] = NEG; if (kv + 32 > qrel) p1[r] = NEG; }
}
__device__ __forceinline__ void pv(f32x16* o, int vb, bf16x8 pa0, bf16x8 pa1, bf16x8 pa2, bf16x8 pa3) {
#pragma unroll
    for (int d0 = 0; d0 < 2; ++d0) { s16x4 lo[4], hi[4];
#pragma unroll
        for (int ks = 0; ks < 4; ++ks) {
            asm volatile("ds_read_b64_tr_b16 %0,%1 offset:%c2" : "=&v"(lo[ks]) : "v"(vb), "i"(d0 * 4096 + ks * 1024) : "memory");
            asm volatile("ds_read_b64_tr_b16 %0,%1 offset:%c2" : "=&v"(hi[ks]) : "v"(vb), "i"(d0 * 4096 + ks * 1024 + 512) : "memory"); }
        asm volatile("s_waitcnt lgkmcnt(0)" ::: "memory"); __builtin_amdgcn_sched_barrier(0);
#define PK(k) (bf16x8){lo[k][0], lo[k][1], lo[k][2], lo[k][3], hi[k][0], hi[k][1], hi[k][2], hi[k][3]}
        o[d0] = __builtin_amdgcn_mfma_f32_32x32x16_bf16(pa0, PK(0), o[d0], 0, 0, 0);
        o[d0] = __builtin_amdgcn_mfma_f32_32x32x16_bf16(pa1, PK(1), o[d0], 0, 0, 0);
        o[d0] = __builtin_amdgcn_mfma_f32_32x32x16_bf16(pa2, PK(2), o[d0], 0, 0, 0);
        o[d0] = __builtin_amdgcn_mfma_f32_32x32x16_bf16(pa3, PK(3), o[d0], 0, 0, 0);
#undef PK
    }
}

template <int KIND>
__device__ __forceinline__ void attn_unit(int b, int h, int qb, const bf16* Q, const bf16* __restrict__ K, const bf16* __restrict__ V, bf16* O,
                                          const unsigned* __restrict__ MASK, const float* __restrict__ CB, ALAS char* shm) {
    int tid_ = threadIdx.x; asm volatile("" : "+v"(tid_));
    const int tid = tid_, lane = tid & 63, r32 = lane & 31, hi = lane >> 5; const int wid = __builtin_amdgcn_readfirstlane(tid >> 6);
    const long rowbase = (long)b * SEQ; const int q0 = qb * QB;
    const bf16* Qw = Q + (rowbase + q0 + wid * QBLK) * AW + h * 64;
    const bf16* Kh = K + rowbase * AW + h * 64, *Vh = V + rowbase * AW + h * 64;
    const unsigned lds0 = (unsigned)(uintptr_t)shm;
    ALAS float* wsf = (ALAS float*)(shm + LDS_WS) + wid * 64;
    ALAS float* bl = (ALAS float*)(shm + LDS_BIAS);
    const bf16* ksrc = Kh + (long)lane * AW + wid * 8;
    const bf16* vsrc = Vh + (long)(16 * (wid & 3) + (lane >> 2)) * AW + (wid >> 2) * 32 + (lane & 3) * 8;
    ALAS u32x4* kdst = (ALAS u32x4*)(shm + LDS_K + wid * 1024 + lane * 16);
    ALAS u32x4* vdst = (ALAS u32x4*)(shm + LDS_V + wid * 1024 + lane * 16);
    const int vb0 = (int)(lds0 + LDS_V) + ((lane >> 4) & 1) * 32 + (lane & 3) * 8 + (4 * hi + ((lane & 15) >> 2)) * 64;
    const ALAS char* kbase = shm + LDS_K + hi * 1024 + r32 * 16;
    const int NT = (q0 + QB) / KVBLK;
    bf16x8 qr[4];
#pragma unroll
    for (int d0 = 0; d0 < 4; ++d0) qr[d0] = *reinterpret_cast<const bf16x8*>(&Qw[(long)r32 * AW + d0 * 16 + hi * 8]);
    float m = -INFINITY, l_reg = 0.f; f32x16 o[2]; o[0] = f32x16{}; o[1] = f32x16{};
    const int qrel = wid * QBLK + r32;
    const unsigned* mrow = MASK + (size_t)(rowbase + q0 + qrel) * 128;
    const float* cbh = CB + (size_t)(b * NH + h) * SEQ;
    u32x4 kreg = *(const u32x4*)ksrc, vreg = *(const u32x4*)vsrc; float breg = 0.f; u32x2 mreg = {0u, 0u};
    if (KIND == 1) { if (tid < 64) breg = cbh[tid]; } else mreg = *(const u32x2*)(mrow);
    for (int t = 0; t < NT; ++t) {
        __syncthreads();
        *kdst = kreg; *vdst = vreg; if (KIND == 1) { if (tid < 64) bl[tid] = breg; }
        const u32x2 mcur = mreg;
        __syncthreads();
        if (t + 1 < NT) { kreg = *(const u32x4*)(ksrc + (long)(t + 1) * KVBLK * AW); vreg = *(const u32x4*)(vsrc + (long)(t + 1) * KVBLK * AW);
            if (KIND == 1) { if (tid < 64) breg = cbh[(t + 1) * KVBLK + tid]; } else mreg = *(const u32x2*)(mrow + 2 * (t + 1)); }
        f32x16 p0, p1;
        if (KIND == 1) {
#pragma unroll
            for (int r = 0; r < 16; ++r) { p0[r] = bl[crow(r, hi)]; p1[r] = bl[32 + crow(r, hi)]; }
        } else { p0 = f32x16{}; p1 = f32x16{}; }
#pragma unroll
        for (int d0 = 0; d0 < 4; ++d0) {
            const bf16x8 b0 = *(const ALAS bf16x8*)(kbase + d0 * 2048);
            const bf16x8 b1 = *(const ALAS bf16x8*)(kbase + d0 * 2048 + 512);
            p0 = __builtin_amdgcn_mfma_f32_32x32x16_bf16(b0, qr[d0], p0, 0, 0, 0);
            p1 = __builtin_amdgcn_mfma_f32_32x32x16_bf16(b1, qr[d0], p1, 0, 0, 0);
        }
        if (KIND == 0) {
            const unsigned w0 = mcur.x >> (4 * hi), w1 = mcur.y >> (4 * hi);
#pragma unroll
            for (int r = 0; r < 16; ++r) { const int sh = (r & 3) + 8 * (r >> 2);
                if (!((w0 >> sh) & 1u)) p0[r] = -INFINITY; if (!((w1 >> sh) & 1u)) p1[r] = -INFINITY; }
        } else { const int jb = t - (NT - 4); if (jb >= 0) cmask(p0, p1, jb, qrel, hi); }
        float rm = __builtin_fmaxf(p0[0], p1[0]);
#pragma unroll
        for (int r = 1; r < 16; ++r) rm = __builtin_fmaxf(rm, __builtin_fmaxf(p0[r], p1[r]));
        { auto rr = __builtin_amdgcn_permlane32_swap(__float_as_uint(rm), __float_as_uint(rm), false, false); rm = __builtin_fmaxf(__uint_as_float(rr[0]), __uint_as_float(rr[1])); }
        const float mref = __builtin_fmaxf(__builtin_fmaxf(m, rm), -1e30f);
        const float alpha = __builtin_amdgcn_exp2f(m - mref);
        m = mref;
        float sum = 0.f;
#pragma unroll
        for (int r = 0; r < 16; ++r) { p0[r] = __builtin_amdgcn_exp2f(p0[r] - mref); p1[r] = __builtin_amdgcn_exp2f(p1[r] - mref); sum += p0[r] + p1[r]; }
        l_reg = l_reg * alpha + sum;
        if (hi == 0) wsf[r32] = alpha;
        asm volatile("s_waitcnt lgkmcnt(0)" ::: "memory");
#pragma unroll
        for (int r = 0; r < 16; ++r) { const float a = wsf[crow(r, hi)]; o[0][r] *= a; o[1][r] *= a; }
        u32x4 pw0, pw1, pw2, pw3;
        pw0 = (u32x4){cvtpk_s(p0[0], p0[1]), cvtpk_s(p0[2], p0[3]), cvtpk_s(p0[4], p0[5]), cvtpk_s(p0[6], p0[7])};
        pw1 = (u32x4){cvtpk_s(p0[8], p0[9]), cvtpk_s(p0[10], p0[11]), cvtpk_s(p0[12], p0[13]), cvtpk_s(p0[14], p0[15])};
        pw2 = (u32x4){cvtpk_s(p1[0], p1[1]), cvtpk_s(p1[2], p1[3]), cvtpk_s(p1[4], p1[5]), cvtpk_s(p1[6], p1[7])};
        pw3 = (u32x4){cvtpk_s(p1[8], p1[9]), cvtpk_s(p1[10], p1[11]), cvtpk_s(p1[12], p1[13]), cvtpk_s(p1[14], p1[15])};
        __builtin_amdgcn_sched_barrier(0);
        pv(o, vb0, __builtin_bit_cast(bf16x8, pw0), __builtin_bit_cast(bf16x8, pw1), __builtin_bit_cast(bf16x8, pw2), __builtin_bit_cast(bf16x8, pw3));
    }
    { auto rr = __builtin_amdgcn_permlane32_swap(__float_as_uint(l_reg), __float_as_uint(l_reg), false, false); l_reg = __uint_as_float(rr[0]) + __uint_as_float(rr[1]); }
    if (hi == 0) wsf[32 + r32] = l_reg;
    asm volatile("s_waitcnt lgkmcnt(0)" ::: "memory");
    float rli[16];
#pragma unroll
    for (int r = 0; r < 16; ++r) rli[r] = __builtin_amdgcn_rcpf(wsf[32 + crow(r, hi)]);
    bf16* Ow = O + (rowbase + q0 + wid * QBLK) * AW + h * 64;
    { ALAS bf16* stg = (ALAS bf16*)(shm + LDS_OST) + wid * 2048;
#pragma unroll
        for (int r = 0; r < 16; ++r) { const int orow = crow(r, hi);
#pragma unroll
            for (int d0 = 0; d0 < 2; ++d0) stg[orow * 64 + d0 * 32 + r32] = (bf16)(cvtpk_s(o[d0][r] * rli[r], 0.f) & 0xffffu); }
        asm volatile("s_waitcnt lgkmcnt(0)" ::: "memory");
#pragma unroll
        for (int i = 0; i < 4; ++i) { const int row = i * 8 + (lane >> 3), ch = lane & 7; const u32x4 v = *(const ALAS u32x4*)(stg + row * 64 + ch * 8); *(u32x4*)(Ow + (long)row * AW + ch * 8) = v; } }
    asm volatile("s_waitcnt lgkmcnt(0)" ::: "memory");
}
#undef ALAS
}

static_assert(attn_body::LDS_BYTES <= RING_BYTES, "attention LDS");
#define XB_TMO      128
#define XB_XCNT(j)  (256  + 64 * (j))
#define XB_XSUB(j)  (1280 + 64 * (j))
#define XB_XGEN(j)  (2304 + 64 * (j))
#define XB_TOP      3328
#define XB_TOPGEN   3392
#define XCD_BAR_WORDS 3456
#define XB_SPIN_CAP (1u << 18)

__device__ __forceinline__ unsigned xb_ld(unsigned* p)              { return __hip_atomic_load(p, __ATOMIC_RELAXED, __HIP_MEMORY_SCOPE_AGENT); }
__device__ __forceinline__ unsigned xb_add(unsigned* p, unsigned v) { return __hip_atomic_fetch_add(p, v, __ATOMIC_RELAXED, __HIP_MEMORY_SCOPE_AGENT); }
__device__ __forceinline__ unsigned xb_xcc_id() { return (unsigned)__builtin_amdgcn_s_getreg((3 << 11) | 20) & 0xFu; }
#define XB_SPIN(cond, bar) do { unsigned _sp = 0; while (cond) { __builtin_amdgcn_s_sleep(1); \
    if ((++_sp & 255u) == 0u) { if (xb_ld(&(bar)[XB_TMO])) break; if (_sp > XB_SPIN_CAP) { atomicAdd(&(bar)[XB_TMO], 1u); break; } } } } while (0)

struct XcdBarrier {
    unsigned* bar; unsigned x;
    volatile LAS unsigned* st;
};

__device__ __forceinline__ XcdBarrier xcd_barrier_post(unsigned* bar, volatile LAS unsigned* st) {
    XcdBarrier b; b.bar = bar; b.x = xb_xcc_id(); b.st = st;
    if (threadIdx.x == 0) (void)xb_add(&bar[XB_XCNT(b.x)], 1u);
    return b;
}
__device__ __forceinline__ void xcd_barrier_complete(unsigned* bar, unsigned x, unsigned& nloc, unsigned& nx) {
    const unsigned G = gridDim.x * gridDim.y * gridDim.z;
    unsigned sum, cnt, mine, sp = 0u;
    for (;;) {
        sum = 0u; cnt = 0u; mine = 0u;
#pragma unroll
        for (unsigned j = 0; j < 16; ++j) { const unsigned c = xb_ld(&bar[XB_XCNT(j)]); sum += c; cnt += (c > 0u) ? 1u : 0u; mine = (j == x) ? c : mine; }
        if (sum == G) break;
        __builtin_amdgcn_s_sleep(1);
        if ((++sp & 255u) == 0u) { if (xb_ld(&bar[XB_TMO])) break; if (sp > XB_SPIN_CAP) { atomicAdd(&bar[XB_TMO], 1u); break; } }
    }
    nloc = mine > 0u ? mine : 1u; nx = cnt > 0u ? cnt : 1u;
}

__device__ __forceinline__ void xcd_barrier(const XcdBarrier& b) {
    asm volatile("s_waitcnt vmcnt(0)" ::: "memory");
    __syncthreads();
    if (threadIdx.x == 0) {
        unsigned* bar = b.bar;
        __builtin_amdgcn_s_waitcnt(0);
        unsigned nloc = b.st[0], nx = b.st[1];
        if (nloc == 0u) { xcd_barrier_complete(bar, b.x, nloc, nx); b.st[0] = nloc; b.st[1] = nx; }
        const unsigned old = xb_add(&bar[XB_XSUB(b.x)], 1u);
        const unsigned gen = old / nloc;
        if (old + 1u == (gen + 1u) * nloc) {
            __builtin_amdgcn_fence(__ATOMIC_RELEASE, "agent");
            asm volatile("s_waitcnt vmcnt(0)" ::: "memory");
            const unsigned og = xb_add(&bar[XB_TOP], 1u);
            const unsigned tg = og / nx;
            if (og + 1u == (tg + 1u) * nx) xb_add(&bar[XB_TOPGEN], 1u);
            else XB_SPIN(xb_ld(&bar[XB_TOPGEN]) == tg, bar);
            __builtin_amdgcn_fence(__ATOMIC_ACQUIRE, "agent");
            xb_add(&bar[XB_XGEN(b.x)], 1u);
            asm volatile("s_waitcnt vmcnt(0)" ::: "memory");
        } else {
            XB_SPIN(xb_ld(&bar[XB_XGEN(b.x)]) == gen, bar);
            __builtin_amdgcn_fence(__ATOMIC_ACQUIRE, "agent");
            asm volatile("s_waitcnt vmcnt(0)" ::: "memory");
        }
    }
    __syncthreads();
}
struct Frame {
    LAS unsigned char* lds;
    volatile LAS unsigned* MISC;
    gu32* ctl;
    int tid, lane, wave, G, bid;
    unsigned char* ws; float* out;
};
__device__ __forceinline__ float wave_sum(float v) {
#pragma unroll
    for (int o = 1; o < 64; o <<= 1) v += __shfl_xor(v, o);
    return v;
}

__device__ __forceinline__ int win_colmap(int dr) {
    const int tile = dr >> 8, j = dr & 255;
    if (tile < 4 || tile == 6 || tile == 7) { const int base = (tile < 2) ? 0 : (tile < 4 ? 512 : 1536); return base + 256 * (tile & 1) + 64 * ((j & 127) >> 5) + 32 * (j >> 7) + (j & 31); }
    if (tile < 6) return 1024 + 256 * (tile - 4) + j;
    if (tile < 14) return 2120 + 256 * (tile - 8) + j;
    if (tile < 22) return 3664 + 256 * (tile - 14) + j;
    if (j < 32) return 2048 + j;
    if (j < 40) return 2112 + (j - 32);
    if (j >= 64 && j < 72) return 3656 + (j - 64);
    if (j >= 128 && j < 160) return 2080 + (j - 128);
    return -1;
}
template <int KIND>
__device__ __forceinline__ void conv_item(const float* s0, const float* s1, int K, int Nsrc, int ndst, bf16* dst, int item, LAS unsigned char* scr, int lane) {
    const int nb = ndst >> 6, kb = item / nb, dg = item - kb * nb, k0 = kb << 6, d0 = dg << 6;
    const int nq = lane & 15, dr = d0 + 4 * nq;
    const float* sp = s0; int col;
    if (KIND == 0) col = dr;
    else if (KIND == 1) col = win_colmap(dr);
    else { const int tile = dr >> 8, j = dr & 255; col = 128 * tile + (j & 127); if (j >= 128) sp = s1; }
#pragma unroll 4
    for (int i = 0; i < 16; ++i) {
        const int k = 4 * i + (lane >> 4);
        f32x4 v = {0.f, 0.f, 0.f, 0.f};
        if (col >= 0) v = *(const f32x4*)(sp + (size_t)(k0 + k) * Nsrc + col);
        LAS unsigned short* w = (LAS unsigned short*)(scr + (4 * nq) * 144 + k * 2);
        w[0] = (unsigned short)f2bf(v[0]); w[72] = (unsigned short)f2bf(v[1]); w[144] = (unsigned short)f2bf(v[2]); w[216] = (unsigned short)f2bf(v[3]);
    }
    asm volatile("s_waitcnt lgkmcnt(0)" ::: "memory");
#pragma unroll
    for (int i = 0; i < 8; ++i) { const int n = 8 * i + (lane >> 3), ch = lane & 7;
        const v4u o = *(const LAS v4u*)(scr + n * 144 + ch * 16);
        *(v4u*)(dst + (size_t)(d0 + n) * K + k0 + 8 * ch) = o; }
    asm volatile("s_waitcnt lgkmcnt(0)" ::: "memory");
}
template <int KIND>
__device__ __forceinline__ void conv_matrix(Frame& F, const float* s0, const float* s1, int K, int Nsrc, int ndst, bf16* dst) {
    LAS unsigned char* scr = F.lds + RING_OFF + F.wave * 9216;
    const int gw = F.bid * NWAVES + F.wave, NGW = F.G * NWAVES, nitems = (K >> 6) * (ndst >> 6);
    for (int it = gw; it < nitems; it += NGW) conv_item<KIND>(s0, s1, K, Nsrc, ndst, dst, it, scr, F.lane);
}
__device__ __forceinline__ void sincos_rev(double r, float& s, float& c) {
    const double k = rint(4.0 * r);
    const double y = (r - 0.25 * k) * 6.283185307179586;
    const double y2 = y * y;
    const double sy = y * (1.0 + y2 * (-1.0 / 6 + y2 * (1.0 / 120 + y2 * (-1.0 / 5040 + y2 * (1.0 / 362880 + y2 * (-1.0 / 39916800 + y2 * (1.0 / 6227020800.0)))))));
    const double cy = 1.0 + y2 * (-0.5 + y2 * (1.0 / 24 + y2 * (-1.0 / 720 + y2 * (1.0 / 40320 + y2 * (-1.0 / 3628800 + y2 * (1.0 / 479001600.0))))));
    const int q = ((int)k) & 3;
    const double sv = (q == 0) ? sy : (q == 1) ? cy : (q == 2) ? -sy : -cy;
    const double cv = (q == 0) ? cy : (q == 1) ? -sy : (q == 2) ? -cy : sy;
    s = (float)sv; c = (float)cv;
}
__device__ __forceinline__ void p0_prologue(Frame& F, const float* x_in, const int* pos, const float* w_in, const float* w_a, const float* w_b, const float* w_o, const float* f_g, const float* f_u, const float* f_d) {
    unsigned char* ws = F.ws;
    for (int l = 0; l < 2; ++l) {
        conv_matrix<1>(F, w_in + (size_t)l * DM * PROJ_TOTAL, nullptr, DM, PROJ_TOTAL, PROJ_PAD, (bf16*)(ws + WS_WIN + l * WIN_STRIDE));
        conv_matrix<0>(F, w_a + (size_t)l * AW * DM, nullptr, AW, DM, DM, (bf16*)(ws + WS_WA) + (size_t)l * DM * AW);
        conv_matrix<0>(F, w_b + (size_t)l * AW * DM, nullptr, AW, DM, DM, (bf16*)(ws + WS_WB) + (size_t)l * DM * AW);
        conv_matrix<0>(F, w_o + (size_t)l * DM * DM, nullptr, DM, DM, DM, (bf16*)(ws + WS_WOUT) + (size_t)l * DM * DM);
    }
    conv_matrix<2>(F, f_g, f_u, DM, DFF, 2 * DFF, (bf16*)(ws + WS_FGU));
    conv_matrix<0>(F, f_d, nullptr, DFF, DM, DM, (bf16*)(ws + WS_FD));
    const int gt = F.bid * (NWAVES * 64) + F.tid, NGT = F.G * NWAVES * 64;
    { const f32x4* x4 = (const f32x4*)x_in; v2u* o2 = (v2u*)(ws + WS_XS);
      for (int i = gt; i < NTOK * DM / 4; i += NGT) { const f32x4 v = x4[i]; v2u o; o.x = pk2(v[0], v[1]); o.y = pk2(v[2], v[3]); o2[i] = o; } }
    { float* cs = (float*)(ws + WS_CS);
      for (int i = gt; i < NTOK * 32; i += NGT) { const int tok = i >> 5, fi = i & 31;
          const float invf = (float)exp2(-(double)fi * (13.287712379549449 / 32.0));
          const float ang = (float)pos[tok] * invf;
          double rev = (double)ang * 0.15915494309189535; rev -= floor(rev);
          float s, c; sincos_rev(rev, s, c); cs[2 * i] = c; cs[2 * i + 1] = s; } }
}
__device__ __forceinline__ void moe_convert(Frame& F, const float* wg, const float* wu, const float* wd) {
    bf16* gu = (bf16*)F.out; bf16* dn = (bf16*)(F.ws + WS_MWD);
    LAS unsigned char* scr = F.lds + RING_OFF + F.wave * 9216;
    const int gw = F.bid * NWAVES + F.wave, NGW = F.G * NWAVES;
    constexpr int IGU = (DM >> 6) * (2 * DFF >> 6), IDN = (DFF >> 6) * (DM >> 6);
    for (int it = gw; it < NEXP * (IGU + IDN); it += NGW) {
        const int e = it / (IGU + IDN), r = it - e * (IGU + IDN);
        if (r < IGU) conv_item<2>(wg + (size_t)e * DM * DFF, wu + (size_t)e * DM * DFF, DM, DFF, 2 * DFF, gu + (size_t)e * 2 * DFF * DM, r, scr, F.lane);
        else conv_item<0>(wd + (size_t)e * DFF * DM, nullptr, DFF, DM, DM, dn + (size_t)e * DM * DFF, r - IGU, scr, F.lane);
    }
}

typedef float f32x4i __attribute__((ext_vector_type(4)));
__device__ __forceinline__ unsigned sortkey16(float f) { const unsigned u = __float_as_uint(f); return (u ^ ((u >> 31) ? 0xffffffffu : 0x80000000u)) >> 16; }
__device__ __forceinline__ int wave_suffix_sum(int x, int lane) {
#pragma unroll
    for (int o = 1; o < 64; o <<= 1) { const int t = __shfl_down(x, o); if (lane + o < 64) x += t; }
    return x;
}
__device__ __forceinline__ int hist_select(const LAS unsigned* hist, int K, int lane, int& gt) {
    const v4u c = *(const LAS v4u*)(hist + 4 * lane);
    const int s = (int)(c.x + c.y + c.z + c.w);
    const int above = wave_suffix_sum(s, lane) - s;
    int bin = -1, g = 0;
    int a3 = above, a2 = above + (int)c.w, a1 = a2 + (int)c.z, a0 = a1 + (int)c.y;
    if (a3 < K && K <= a3 + (int)c.w) { bin = 4 * lane + 3; g = a3; }
    else if (a2 < K && K <= a2 + (int)c.z) { bin = 4 * lane + 2; g = a2; }
    else if (a1 < K && K <= a1 + (int)c.y) { bin = 4 * lane + 1; g = a1; }
    else if (a0 < K && K <= a0 + (int)c.x) { bin = 4 * lane + 0; g = a0; }
    const unsigned long long bal = __ballot(bin >= 0);
    const int src = bal ? (int)__builtin_ctzll(bal) : 0;
    gt = __shfl(g, src); return __shfl(bin, src);
}
__device__ __forceinline__ void idx_unit(Frame& F, int b, int qg, const bf16* IQ, const bf16* IK, const float* IW, unsigned* MASK) {
    const int lane = F.lane, wave = F.wave;
    const int t0 = 16 * qg, limit = 64 * (t0 / 64 + 1); const size_t row0 = (size_t)b * SEQ + t0;
    const int nwords = ((limit + 255) >> 8) << 3;
    if (limit <= 256) {
        for (int qq = 0; qq < 2; ++qq) { const int q = 2 * wave + qq; if (lane < nwords) MASK[(row0 + q) * 128 + lane] = (lane < (limit >> 5)) ? 0xffffffffu : 0u; }
        return;
    }
    LAS unsigned char* keys = F.lds;
    LAS unsigned* hist = (LAS unsigned*)(F.lds + IDX_HIST_OFF) + wave * 256;
    {
        const int qc = lane & 15, kq = lane >> 4;
        bf16x8 bq[8][2]; float w[8];
#pragma unroll
        for (int h = 0; h < 8; ++h) { const bf16* p = IQ + (row0 + qc) * AW + h * 64 + 8 * kq; bq[h][0] = *(const bf16x8*)p; bq[h][1] = *(const bf16x8*)(p + 32); }
        { const f32x4 w0 = *(const f32x4*)(IW + (row0 + qc) * 8), w1 = *(const f32x4*)(IW + (row0 + qc) * 8 + 4);
          w[0] = w0[0]; w[1] = w0[1]; w[2] = w0[2]; w[3] = w0[3]; w[4] = w1[0]; w[5] = w1[1]; w[6] = w1[2]; w[7] = w1[3]; }
        const bf16* ikb = IK + ((size_t)b * SEQ + qc) * 64 + 8 * kq;
        const int nkb = limit >> 4;
        for (int kb = wave; kb < nkb; kb += 8) {
            const bf16* p = ikb + (size_t)kb * 16 * 64;
            const bf16x8 a0 = *(const bf16x8*)p, a1 = *(const bf16x8*)(p + 32);
            f32x4i sc = {0.f, 0.f, 0.f, 0.f};
#pragma unroll
            for (int h = 0; h < 8; ++h) {
                f32x4i acc = {0.f, 0.f, 0.f, 0.f};
                acc = __builtin_amdgcn_mfma_f32_16x16x32_bf16(a0, bq[h][0], acc, 0, 0, 0);
                acc = __builtin_amdgcn_mfma_f32_16x16x32_bf16(a1, bq[h][1], acc, 0, 0, 0);
#pragma unroll
                for (int r = 0; r < 4; ++r) sc[r] += w[h] * fmaxf(acc[r], 0.f);
            }
            v2u pk; pk.x = sortkey16(sc[0]) | (sortkey16(sc[1]) << 16); pk.y = sortkey16(sc[2]) | (sortkey16(sc[3]) << 16);
            *(LAS v2u*)(keys + qc * IDX_ROWB + (kb * 16 + 4 * kq) * 2) = pk;
        }
    }
    __syncthreads();
    for (int qq = 0; qq < 2; ++qq) {
        const int q = 2 * wave + qq; const LAS unsigned char* rowk = keys + q * IDX_ROWB;
        *(LAS v4u*)(hist + 4 * lane) = (v4u){0u, 0u, 0u, 0u};
        for (int i = 0; i < (limit >> 8); ++i) { const v2u k4 = *(const LAS v2u*)(rowk + (256 * i + 4 * lane) * 2);
            __hip_atomic_fetch_add(hist + ((k4.x >> 8) & 255u), 1u, __ATOMIC_RELAXED, __HIP_MEMORY_SCOPE_WORKGROUP); __hip_atomic_fetch_add(hist + (k4.x >> 24), 1u, __ATOMIC_RELAXED, __HIP_MEMORY_SCOPE_WORKGROUP);
            __hip_atomic_fetch_add(hist + ((k4.y >> 8) & 255u), 1u, __ATOMIC_RELAXED, __HIP_MEMORY_SCOPE_WORKGROUP); __hip_atomic_fetch_add(hist + (k4.y >> 24), 1u, __ATOMIC_RELAXED, __HIP_MEMORY_SCOPE_WORKGROUP); }
        asm volatile("s_waitcnt lgkmcnt(0)" ::: "memory");
        int gt1; const int b1 = hist_select(hist, DSA_TOPK, lane, gt1);
        *(LAS v4u*)(hist + 4 * lane) = (v4u){0u, 0u, 0u, 0u};
        for (int i = 0; i < (limit >> 8); ++i) { const v2u k4 = *(const LAS v2u*)(rowk + (256 * i + 4 * lane) * 2);
            const unsigned e0 = k4.x & 0xffffu, e1 = k4.x >> 16, e2 = k4.y & 0xffffu, e3 = k4.y >> 16;
            if ((int)(e0 >> 8) == b1) __hip_atomic_fetch_add(hist + (e0 & 255u), 1u, __ATOMIC_RELAXED, __HIP_MEMORY_SCOPE_WORKGROUP);
            if ((int)(e1 >> 8) == b1) __hip_atomic_fetch_add(hist + (e1 & 255u), 1u, __ATOMIC_RELAXED, __HIP_MEMORY_SCOPE_WORKGROUP);
            if ((int)(e2 >> 8) == b1) __hip_atomic_fetch_add(hist + (e2 & 255u), 1u, __ATOMIC_RELAXED, __HIP_MEMORY_SCOPE_WORKGROUP);
            if ((int)(e3 >> 8) == b1) __hip_atomic_fetch_add(hist + (e3 & 255u), 1u, __ATOMIC_RELAXED, __HIP_MEMORY_SCOPE_WORKGROUP); }
        asm volatile("s_waitcnt lgkmcnt(0)" ::: "memory");
        int gt2; const int b2 = hist_select(hist, DSA_TOPK - gt1, lane, gt2);
        const unsigned thr = ((unsigned)b1 << 8) | (unsigned)b2; const int need = DSA_TOPK - gt1 - gt2;
        unsigned long long mine = 0ull; int running = 0;
        for (int i = 0; i < (limit >> 6); ++i) {
            const unsigned k = *(const LAS unsigned short*)(rowk + (64 * i + lane) * 2);
            const bool eq = (k == thr);
            const unsigned long long eqm = __ballot(eq);
            const int rank = running + __popcll(eqm & ((1ull << lane) - 1ull));
            const bool sel = (k > thr) || (eq && rank < need);
            const unsigned long long m = __ballot(sel);
            running += __popcll(eqm);
            if (lane == i) mine = m;
        }
        if (lane < (nwords >> 1)) *(unsigned long long*)(MASK + (row0 + q) * 128 + 2 * lane) = mine;
    }
    __syncthreads();
}
__device__ __forceinline__ void idx_phase(Frame& F, const bf16* IQ, const bf16* IK, const float* IW, const float* LOGF, float* CB, unsigned* MASK) {
    const int gw = F.bid * NWAVES + F.wave;
    if (gw < BATCH * NH) {
        const int b = gw >> 3, h = gw & 7; float carry = 0.f;
        for (int i = 0; i < SEQ / 64; ++i) {
            const int t = 64 * i + F.lane;
            float v = LOGF[((size_t)b * SEQ + t) * 8 + h];
#pragma unroll
            for (int o = 1; o < 64; o <<= 1) { const float u = __shfl_up(v, o); if (F.lane >= o) v += u; }
            const float c = carry + v;
            CB[(size_t)(b * NH + h) * SEQ + t] = -c * LOG2E;
            carry = __shfl(c, 63);
        }
    }
    for (int k = F.bid; k < BATCH * (SEQ / 16); k += F.G) {
        const int round = k >> 8, pos = k & 255, i = (round << 8) + ((round & 1) ? 255 - pos : pos);
        idx_unit(F, i & 7, 255 - (i >> 3), IQ, IK, IW, MASK);
    }
}

__device__ __forceinline__ void attn_phase(Frame& F, const bf16* DQ, const bf16* DK, const bf16* DV, const bf16* FQ, const bf16* FK, const bf16* FV, const unsigned* MASK, const float* CB) {
    for (int k = F.bid; k < 2 * BATCH * NH * (SEQ / 256); k += F.G) {
        const int round = k >> 8, pos = k & 255, i = (round << 8) + ((round & 1) ? 255 - pos : pos);
        const int qb = 15 - (i >> 7), r = i & 127, kind = r >> 6, b = (r >> 3) & 7, h = r & 7;
        if (kind == 0) attn_body::attn_unit<0>(b, h, qb, DQ, DK, DV, (bf16*)DQ, MASK, CB, (LAS char*)F.lds);
        else attn_body::attn_unit<1>(b, h, qb, FQ, FK, FV, (bf16*)FQ, MASK, CB, (LAS char*)F.lds);
    }
}

template <int MODE>
__device__ __forceinline__ void ln_phase(Frame& F, const float* gam, const float* bet, const float* router) {
    const float* Y = F.out; bf16* XS = (bf16*)(F.ws + WS_XS);
    const int tpb = NTOK / F.G, r_lo = F.bid * tpb;
    LAS unsigned* cnt = (LAS unsigned*)(F.lds + RING_OFF);
    if (MODE == 1) { if (F.tid < 8) cnt[F.tid] = 0u; __syncthreads(); }
    f32x4 g4[4], b4[4];
#pragma unroll
    for (int j = 0; j < 4; ++j) { g4[j] = *(const f32x4*)(gam + 4 * F.lane + 256 * j); b4[j] = *(const f32x4*)(bet + 4 * F.lane + 256 * j); }
    for (int rr = F.wave; rr < tpb; rr += NWAVES) {
        const int row = r_lo + rr;
        f32x4 v[4]; float s = 0.f;
        if (MODE == 3) {
            const int* ts = (const int*)(F.ws + MOE_TOKSLOT) + 2 * row; const int s0 = ts[0], s1 = ts[1];
            const bf16* yb = (const bf16*)(F.ws + WS_YB);
#pragma unroll
            for (int j = 0; j < 4; ++j) { const int c = 4 * F.lane + 256 * j;
                const v2u xr = *(const v2u*)(XS + (size_t)row * DM + c), y0 = *(const v2u*)(yb + (size_t)s0 * DM + c), y1 = *(const v2u*)(yb + (size_t)s1 * DM + c);
                v[j][0] = ALPHA * pg8::bf2f(xr.x & 0xffffu) + (pg8::bf2f(y0.x & 0xffffu) + pg8::bf2f(y1.x & 0xffffu));
                v[j][1] = ALPHA * __uint_as_float(xr.x & 0xffff0000u) + (__uint_as_float(y0.x & 0xffff0000u) + __uint_as_float(y1.x & 0xffff0000u));
                v[j][2] = ALPHA * pg8::bf2f(xr.y & 0xffffu) + (pg8::bf2f(y0.y & 0xffffu) + pg8::bf2f(y1.y & 0xffffu));
                v[j][3] = ALPHA * __uint_as_float(xr.y & 0xffff0000u) + (__uint_as_float(y0.y & 0xffff0000u) + __uint_as_float(y1.y & 0xffff0000u)); }
        } else {
#pragma unroll
            for (int j = 0; j < 4; ++j) v[j] = *(const f32x4*)(Y + (size_t)row * DM + 4 * F.lane + 256 * j);
        }
#pragma unroll
        for (int j = 0; j < 4; ++j) s += (v[j][0] + v[j][1]) + (v[j][2] + v[j][3]);
        const float mean = wave_sum(s) * (1.f / DM); float s2 = 0.f;
#pragma unroll
        for (int j = 0; j < 4; ++j) { v[j] = v[j] - mean; s2 += (v[j][0] * v[j][0] + v[j][1] * v[j][1]) + (v[j][2] * v[j][2] + v[j][3] * v[j][3]); }
        const float rstd = 1.f / sqrtf(wave_sum(s2) * (1.f / DM) + LN_EPS);
#pragma unroll
        for (int j = 0; j < 4; ++j) v[j] = v[j] * rstd * g4[j] + b4[j];
        if (MODE == 2 || MODE == 3) {
#pragma unroll
            for (int j = 0; j < 4; ++j) *(f32x4*)(F.out + (size_t)row * DM + 4 * F.lane + 256 * j) = v[j];
        } else {
#pragma unroll
            for (int j = 0; j < 4; ++j) { v2u o; o.x = pk2(v[j][0], v[j][1]); o.y = pk2(v[j][2], v[j][3]); *(v2u*)(XS + (size_t)row * DM + 4 * F.lane + 256 * j) = o; }
        }
        if (MODE == 1) {
            float lg[8];
#pragma unroll
            for (int e = 0; e < 8; ++e) lg[e] = 0.f;
#pragma unroll
            for (int j = 0; j < 4; ++j)
#pragma unroll
                for (int c = 0; c < 4; ++c) { const float* rp = router + (size_t)(4 * F.lane + 256 * j + c) * 8; const f32x4 r0 = *(const f32x4*)rp, r1 = *(const f32x4*)(rp + 4); const float x = v[j][c];
                    lg[0] += x * r0[0]; lg[1] += x * r0[1]; lg[2] += x * r0[2]; lg[3] += x * r0[3]; lg[4] += x * r1[0]; lg[5] += x * r1[1]; lg[6] += x * r1[2]; lg[7] += x * r1[3]; }
#pragma unroll
            for (int e = 0; e < 8; ++e) lg[e] = wave_sum(lg[e]);
            float bv = lg[0]; int bi = 0;
#pragma unroll
            for (int e = 1; e < 8; ++e) if (lg[e] > bv) { bv = lg[e]; bi = e; }
            float sv = -INFINITY; int si = 0;
#pragma unroll
            for (int e = 0; e < 8; ++e) if (e != bi && lg[e] > sv) { sv = lg[e]; si = e; }
            if (F.lane == 0) {
                const float g0 = 1.f / (1.f + __expf(sv - bv));
                ((unsigned*)(F.ws + MOE_TOPE))[row] = (unsigned)bi | ((unsigned)si << 8);
                float* tg = (float*)(F.ws + MOE_TOPG) + 2 * row; tg[0] = g0; tg[1] = 1.f - g0;
                __hip_atomic_fetch_add(cnt + bi, 1u, __ATOMIC_RELAXED, __HIP_MEMORY_SCOPE_WORKGROUP); __hip_atomic_fetch_add(cnt + si, 1u, __ATOMIC_RELAXED, __HIP_MEMORY_SCOPE_WORKGROUP);
            }
        }
    }
    if (MODE == 1) { __syncthreads(); if (F.tid < 8) ((unsigned*)(F.ws + MOE_CNT))[F.bid * 8 + F.tid] = cnt[F.tid]; }
}

__device__ __forceinline__ void moe_assign(Frame& F) {
    const unsigned* CNT = (const unsigned*)(F.ws + MOE_CNT);
    LAS int* part = (LAS int*)(F.lds + RING_OFF);
    LAS int* tot = part + 512;
    LAS int* base = tot + 8; LAS int* pst = tot + 16; LAS int* wcnt = tot + 24;
    const int G = F.G, tpb = NTOK / G, j = F.bid;
    __syncthreads();
    { const int e = F.tid & 7, grp = F.tid >> 3; int s = 0;
      const int gsz = (G + 63) / 64;
      for (int jj = grp * gsz; jj < (grp + 1) * gsz && jj < G; ++jj) s += (int)CNT[jj * 8 + e];
      part[grp * 8 + e] = s; }
    __syncthreads();
    if (F.tid < 8) { const int e = F.tid, gsz = (G + 63) / 64, myg = j / gsz; int t = 0, bs = 0;
        for (int g = 0; g < 64; ++g) { const int s = part[g * 8 + e]; if (g < myg) bs += s; t += s; }
        for (int jj = myg * gsz; jj < j; ++jj) bs += (int)CNT[jj * 8 + e];
        tot[e] = t; base[e] = bs; if (j == 0) ((int*)(F.ws + MOE_TOT))[e] = t; }
    __syncthreads();
    if (F.tid == 0) { int ps = 0; for (int e = 0; e < 8; ++e) { pst[e] = ps; ps += ((tot[e] + 255) >> 8) << 8; } }
    const unsigned* TOPE = (const unsigned*)(F.ws + MOE_TOPE); const float* TOPG = (const float*)(F.ws + MOE_TOPG);
    int* SLOTTOK = (int*)(F.ws + MOE_SLOTTOK); float* SLOTGATE = (float*)(F.ws + MOE_SLOTGATE); int* TOKSLOT = (int*)(F.ws + MOE_TOKSLOT);
    const int na = 2 * tpb;
    int done_before[8];
#pragma unroll
    for (int e = 0; e < 8; ++e) done_before[e] = 0;
    for (int a0 = 0; a0 < na; a0 += NWAVES * 64) {
        const int a = a0 + F.tid; const bool valid = a < na;
        const int tok = j * tpb + (a >> 1), k = a & 1;
        int e = -1; if (valid) { const unsigned te = TOPE[tok]; e = (int)((te >> (8 * k)) & 255u); }
        int rank = 0;
#pragma unroll
        for (int x = 0; x < 8; ++x) { const unsigned long long bm = __ballot(e == x); if (e == x) rank = __popcll(bm & ((1ull << F.lane) - 1ull)); if (F.lane == 0) wcnt[F.wave * 8 + x] = __popcll(bm); }
        __syncthreads();
        if (valid) { int pre = 0, all = 0;
#pragma unroll
            for (int x = 0; x < 8; ++x) { int ps = 0, al = 0;
#pragma unroll
                for (int w = 0; w < NWAVES; ++w) { const int c = wcnt[w * 8 + x]; if (w < F.wave) ps += c; al += c; }
                if (e == x) { pre = ps + done_before[x]; } all = al; done_before[x] += all; }
            const int slot = pst[e] + base[e] + pre + rank;
            SLOTTOK[slot] = tok; SLOTGATE[slot] = TOPG[2 * tok + k]; TOKSLOT[2 * tok + k] = slot;
        } else {
#pragma unroll
            for (int x = 0; x < 8; ++x) { int al = 0;
#pragma unroll
                for (int w = 0; w < NWAVES; ++w) al += wcnt[w * 8 + x];
                done_before[x] += al; }
        }
        __syncthreads();
    }
    if (j < 8) { const int e = j, t = tot[e], padded = ((t + 255) >> 8) << 8; for (int s = t + F.tid; s < padded; s += NWAVES * 64) { SLOTTOK[pst[e] + s] = 0; SLOTGATE[pst[e] + s] = 0.f; } }
    __syncthreads();
}

constexpr int NPHASE = 27;
__device__ __forceinline__ const void* kin_load(const __attribute__((address_space(4))) char* ka, int i) {
    int z; asm volatile("s_mov_b32 %0, 0" : "=s"(z));
    return *(const void* const __attribute__((address_space(4)))*)(ka + 8 * (i + z));
}
struct Args { const void* in[18]; float* out; unsigned char* ws; int ph_lo, ph_hi; };
__global__ void __launch_bounds__(NWAVES * 64, 2) mk_fwd(Args args) {
    extern __shared__ __attribute__((aligned(16))) unsigned char lds[];
    Frame F;
    F.lds = (LAS unsigned char*)lds;
    F.MISC = (volatile LAS unsigned*)(F.lds + MISC_OFF);
    F.tid = threadIdx.x; F.lane = F.tid & 63; F.wave = __builtin_amdgcn_readfirstlane(F.tid >> 6);
    F.G = gridDim.x; F.bid = blockIdx.x;
    F.ws = args.ws; F.out = args.out; F.ctl = (gu32*)(args.ws + WS_CTL);
    const __attribute__((address_space(4))) char* KA = (const __attribute__((address_space(4))) char*)__builtin_amdgcn_kernarg_segment_ptr();
#define KIN(T, i) ((T)kin_load(KA, (i)))
    for (int u = F.tid; u < (LDS_BYTES - MISC_OFF) / 4; u += NWAVES * 64) ((LAS unsigned*)(F.lds + MISC_OFF))[u] = 0u;
    __syncthreads();
    const int lo = args.ph_lo, hi = args.ph_hi;
    XcdBarrier bar; bar.bar = (unsigned*)(F.ctl + CW_BAR); bar.x = 0; bar.st = nullptr;
    if (hi - lo > 1) bar = xcd_barrier_post((unsigned*)(F.ctl + CW_BAR), F.MISC + 8);
#ifndef PHS
#define PHS(s) 1
#endif
#define IN(k) (lo <= (k) && (k) < hi)
#define PHASE_BEGIN() do { int t_ = threadIdx.x; asm volatile("" : "+v"(t_)); F.tid = t_; F.lane = t_ & 63; F.wave = __builtin_amdgcn_readfirstlane(t_ >> 6); } while (0)
#define INS(s) (PHS(s) && IN(pb + (s)))
#define INM(s) (PHS((s) + 20) && IN(pb + (s)))
#define SEAM(k) do { if (IN((k) + 1)) xcd_barrier(bar); } while (0)
    unsigned char* ws = args.ws;
#define XS ((bf16*)(ws + WS_XS))
#define DQ ((bf16*)(ws + WS_DQ))
#define DK ((bf16*)(ws + WS_DK))
#define DV ((bf16*)(ws + WS_DV))
#define IQ ((bf16*)(ws + WS_IQ))
#define FQ ((bf16*)(ws + WS_FQ))
#define FK ((bf16*)(ws + WS_FK))
#define FV ((bf16*)(ws + WS_FV))
#define GA ((bf16*)(ws + WS_GA))
#define GB ((bf16*)(ws + WS_GB))
#define IK ((bf16*)(ws + WS_IK))
#define MERGED ((bf16*)(ws + WS_MERGED))
#define IW ((float*)(ws + WS_IW))
#define LOGF ((float*)(ws + WS_LOGF))
#define CB ((float*)(ws + WS_CB))
#define MASK ((unsigned*)(ws + WS_MASK))

    if (PHS(100) && IN(0)) { PHASE_BEGIN(); p0_prologue(F, KIN(const float*, 0), KIN(const int*, 1), KIN(const float*, 2), KIN(const float*, 4), KIN(const float*, 5), KIN(const float*, 6), KIN(const float*, 11), KIN(const float*, 12), KIN(const float*, 13)); SEAM(0); }

    for (int layer = 0; layer < 2; ++layer) {
        const int pb = 1 + 13 * layer; const bool moe = (layer & 1) != 0;
        if (INS(0)) { PHASE_BEGIN();
            pg8::Gemm g{XS, (const bf16*)(ws + WS_WIN + layer * WIN_STRIDE), NTOK, PROJ_PAD, DM}; pg8::StaticOrder S; S.init(NTOK, PROJ_PAD, F.G, F.bid);
            pg8::EpiProj E{ws, KIN(const float*, 3) + layer * NH};
            pg8::gemm_phase<pg8::EpiProj, pg8::StaticOrder, true, true>(F.lds + RING_OFF, g, S, E);
            SEAM(pb + 0);
        }
        if (INS(1)) { PHASE_BEGIN(); idx_phase(F, IQ, IK, IW, LOGF, CB, MASK); SEAM(pb + 1); }
        if (INS(2)) { PHASE_BEGIN(); attn_phase(F, DQ, DK, DV, FQ, FK, FV, MASK, CB); SEAM(pb + 2); }
        if (INS(3)) { PHASE_BEGIN();
            pg8::Gemm g{DQ, (const bf16*)(ws + WS_WA) + (size_t)layer * DM * AW, NTOK, DM, AW}; pg8::StaticOrder S; S.init(NTOK, DM, F.G, F.bid);
            pg8::EpiGate E{MERGED, GA, nullptr};
            pg8::gemm_phase<pg8::EpiGate, pg8::StaticOrder, true, true>(F.lds + RING_OFF, g, S, E);
            SEAM(pb + 3);
        }
        if (INS(4)) { PHASE_BEGIN();
            pg8::Gemm g{FQ, (const bf16*)(ws + WS_WB) + (size_t)layer * DM * AW, NTOK, DM, AW}; pg8::StaticOrder S; S.init(NTOK, DM, F.G, F.bid);
            pg8::EpiGate E{MERGED, GB, MERGED};
            pg8::gemm_phase<pg8::EpiGate, pg8::StaticOrder, true, true>(F.lds + RING_OFF, g, S, E);
            SEAM(pb + 4);
        }
        if (INS(5)) { PHASE_BEGIN();
            pg8::Gemm g{MERGED, (const bf16*)(ws + WS_WOUT) + (size_t)layer * DM * DM, NTOK, DM, DM}; pg8::StaticOrder S; S.init(NTOK, DM, F.G, F.bid);
            pg8::EpiY E{F.out, XS};
            pg8::gemm_phase<pg8::EpiY, pg8::StaticOrder, true, true>(F.lds + RING_OFF, g, S, E);
            SEAM(pb + 5);
        }
        if (INS(6)) { PHASE_BEGIN();
            if (moe) ln_phase<1>(F, KIN(const float*, 7) + layer * DM, KIN(const float*, 8) + layer * DM, KIN(const float*, 14) + (size_t)(layer >> 1) * DM * NEXP);
            else ln_phase<0>(F, KIN(const float*, 7) + layer * DM, KIN(const float*, 8) + layer * DM, nullptr);
            SEAM(pb + 6);
        }
        if (!moe) {
            if (INS(8)) { PHASE_BEGIN();
                pg8::Gemm g{XS, (const bf16*)(ws + WS_FGU), NTOK, 2 * DFF, DM}; pg8::StaticOrder S; S.init(NTOK, 2 * DFF, F.G, F.bid);
                pg8::EpiSwiglu E{(bf16*)(ws + WS_H), 28};
                pg8::gemm_phase<pg8::EpiSwiglu, pg8::StaticOrder, true, true>(F.lds + RING_OFF, g, S, E);
                SEAM(pb + 8);
            }
            if (INS(9)) { PHASE_BEGIN();
                pg8::Gemm g{(const bf16*)(ws + WS_H), (const bf16*)(ws + WS_FD), NTOK, DM, DFF}; pg8::StaticOrder S; S.init(NTOK, DM, F.G, F.bid);
                pg8::EpiY E{F.out, XS};
                pg8::gemm_phase<pg8::EpiY, pg8::StaticOrder, true, true>(F.lds + RING_OFF, g, S, E);
                SEAM(pb + 9);
            }
            if (INS(12)) { PHASE_BEGIN();
                ln_phase<0>(F, KIN(const float*, 9) + layer * DM, KIN(const float*, 10) + layer * DM, nullptr);
                SEAM(pb + 12);
            }
        } else {
            if (INS(7)) { PHASE_BEGIN(); moe_convert(F, KIN(const float*, 15), KIN(const float*, 16), KIN(const float*, 17)); moe_assign(F); SEAM(pb + 7); }
            pg8::MoeOrder MO; MO.G = F.G; MO.c = F.bid; MO.slot_tok = (const int*)(ws + MOE_SLOTTOK);
            if (INM(8) || INM(9) || INM(10) || INM(11)) {
                const int* tot = (const int*)(ws + MOE_TOT); int cs = 0;
#pragma unroll
                for (int e = 0; e < 8; ++e) { cs += (tot[e] + 255) >> 8; MO.cum[e] = cs; }
            } else {
#pragma unroll
                for (int e = 0; e < 8; ++e) MO.cum[e] = 0;
            }
#pragma unroll
            for (int pass = 0; pass < 2; ++pass) {
                const int t_lo = pass * MOE_RT, t_hi = (MO.cum[7] < (pass + 1) * MOE_RT) ? MO.cum[7] : (pass + 1) * MOE_RT;
                if (INM(8 + 2 * pass)) { PHASE_BEGIN();
                    MO.t_lo = t_lo; MO.t_hi = t_hi > t_lo ? t_hi : t_lo; MO.nc = 28;
                    pg8::Gemm g{XS, (const bf16*)F.out, NTOK, NEXP * 2 * DFF, DM};
                    pg8::EpiSwiglu E{(bf16*)(ws + WS_H2), 28};
                    pg8::gemm_phase<pg8::EpiSwiglu, pg8::MoeOrder, true, true, true>(F.lds + RING_OFF, g, MO, E);
                    SEAM(pb + 8 + 2 * pass);
                }
                if (INM(9 + 2 * pass)) { PHASE_BEGIN();
                    MO.t_lo = t_lo; MO.t_hi = t_hi > t_lo ? t_hi : t_lo; MO.nc = 4;
                    pg8::Gemm g{(const bf16*)(ws + WS_H2), (const bf16*)(ws + WS_MWD), MOE_RT * 256, NEXP * DM, DFF};
                    pg8::EpiDownMoe E{(bf16*)(ws + WS_YB), (const float*)(ws + MOE_SLOTGATE), t_lo};
                    pg8::gemm_phase<pg8::EpiDownMoe, pg8::MoeOrder, true, true>(F.lds + RING_OFF, g, MO, E);
                    SEAM(pb + 9 + 2 * pass);
                }
            }
            if (INS(12)) { PHASE_BEGIN(); ln_phase<3>(F, KIN(const float*, 9) + layer * DM, KIN(const float*, 10) + layer * DM, nullptr); SEAM(pb + 12); }
        }
    }
#undef IN
#undef INS
#undef SEAM
}


#if MK_MULTI && defined(MK_DUMP)
__global__ void dump_kernel(unsigned char* ws, float* out, int mode) {
    const size_t n = (size_t)NTOK * DM;
    for (size_t i = (size_t)blockIdx.x * blockDim.x + threadIdx.x; i < n; i += (size_t)gridDim.x * blockDim.x) {
        const size_t row = i >> 10; const int c = (int)(i & 1023);
        float v = 0.f;
        auto B = [&](size_t off, int pitch, int col) { return pg8::bf2f(((const bf16*)(ws + off))[row * pitch + col]); };
        if (mode == 1) { if (c < 512) v = B(WS_DQ, 512, c) + 2.f * B(WS_DK, 512, c) + 4.f * B(WS_DV, 512, c) + 8.f * B(WS_IQ, 512, c);
                         else v = B(WS_FQ, 512, c - 512) + 2.f * B(WS_FK, 512, c - 512) + 4.f * B(WS_FV, 512, c - 512) + 8.f * B(WS_IK, 64, c & 63) + ((const float*)(ws + WS_IW))[row * 8 + (c & 7)] + ((const float*)(ws + WS_LOGF))[row * 8 + (c & 7)]; }
        else if (mode == 2) v = B(WS_GA, 1024, c) + 2.f * B(WS_GB, 1024, c);
        else if (mode == 3) { const unsigned w = ((const unsigned*)(ws + WS_MASK))[row * 128 + (c & 127)]; const int qb = (int)((row & 4095) >> 8); v = ((c & 127) < 8 * (qb + 1)) ? (float)((w >> (4 * (c >> 7))) & 0xffffu) : 0.f; }
        else if (mode == 4) v = ((const float*)(ws + WS_CB))[(row >> 12) * 8 * 4096 + (size_t)(c & 7) * 4096 + (row & 4095)];
        else if (mode == 5) v = c < 512 ? B(WS_DQ, 512, c) : B(WS_FQ, 512, c - 512);
        else if (mode == 6) v = B(WS_MERGED, 1024, c);
        else if (mode == 7) v = B(WS_XS, 1024, c);
        out[i] = v;
    }
}
#endif
extern "C" void kernel_launch(void* const* d_in, const int* in_sizes, int n_in, void* d_out, int out_size, void* d_ws, size_t ws_size, hipStream_t stream) {
    static int grid = 0;
    if (grid == 0) {
        if (n_in != 18 || in_sizes[0] != NTOK * DM || out_size != NTOK * DM || ws_size < WS_END) {
            fprintf(stderr, "kernel_launch: unexpected shapes: n_in %d in0 %d out %d ws %zu (need %zu); nothing launched\n", n_in, n_in > 0 ? in_sizes[0] : -1, out_size, ws_size, (size_t)WS_END); grid = -1; return; }
        int dev = 0, cus = 0, per_cu = 0;
        if (hipGetDevice(&dev) != hipSuccess || hipDeviceGetAttribute(&cus, hipDeviceAttributeMultiprocessorCount, dev) != hipSuccess) { fprintf(stderr, "kernel_launch: device query failed\n"); grid = -1; return; }
        if (hipFuncSetAttribute((const void*)mk_fwd, hipFuncAttributeMaxDynamicSharedMemorySize, LDS_BYTES) != hipSuccess) { fprintf(stderr, "kernel_launch: hipFuncSetAttribute failed\n"); grid = -1; return; }
        if (hipOccupancyMaxActiveBlocksPerMultiprocessor(&per_cu, (const void*)mk_fwd, NWAVES * 64, LDS_BYTES) != hipSuccess || per_cu < 1)
            fprintf(stderr, "kernel_launch: note: occupancy query reports %d workgroups per CU\n", per_cu);
        (void)hipGetLastError();
        grid = cus;
        if (grid != 256) fprintf(stderr, "kernel_launch: note: %d CUs (built for 256)\n", grid);
    }
    if (grid < 0) return;
    if (hipMemsetAsync((char*)d_ws + WS_CTL, 0, CTL_ZERO_BYTES, stream) != hipSuccess) { fprintf(stderr, "kernel_launch: memset failed\n"); return; }
    Args a{};
    for (int i = 0; i < 18; ++i) a.in[i] = d_in[i];
    a.out = (float*)d_out; a.ws = (unsigned char*)d_ws;
#if MK_MULTI
#ifndef MK_MAXPH
#define MK_MAXPH NPHASE
#endif
    for (int k = 0; k < MK_MAXPH; ++k) {
        if (k >= 1) { const int layer = (k - 1) / 13, s = (k - 1) % 13; const bool moe = layer & 1;
            if (!moe && (s == 7 || s == 10 || s == 11)) continue; }
        a.ph_lo = k; a.ph_hi = k + 1;
        hipLaunchKernelGGL(mk_fwd, dim3(grid), dim3(NWAVES * 64), LDS_BYTES, stream, a);
    }
#ifdef MK_DUMP
    hipLaunchKernelGGL(dump_kernel, dim3(2048), dim3(256), 0, stream, (unsigned char*)d_ws, (float*)d_out, MK_DUMP);
#endif
#else
    a.ph_lo = 0; a.ph_hi = NPHASE;
    hipLaunchKernelGGL(mk_fwd, dim3(grid), dim3(NWAVES * 64), LDS_BYTES, stream, a);
#endif
    const hipError_t le = hipPeekAtLastError();
    if (le != hipSuccess) fprintf(stderr, "kernel_launch: launch failed: %s\n", hipGetErrorName(le));
}
```

```cpp
#include <hip/hip_runtime.h>
#include <hip/hip_bf16.h>
#include <cstdio>
#include <cstdint>
#include <cmath>

#ifndef MK_MULTI
#define MK_MULTI 0
#endif

constexpr int BATCH = 8, SEQ = 4096, DM = 1024, NTOK = BATCH * SEQ, AW = 512, NH = 8;
constexpr int PROJ_TOTAL = 5712, PROJ_PAD = 5888, DFF = 3584, NEXP = 8;
constexpr float LN_EPS = 1e-5f;
constexpr float ALPHA = 1.4142135623730951f;
constexpr float LOG2E = 1.4426950408889634f;
constexpr float C2 = 0.125f * LOG2E;
constexpr int DSA_TOPK = 256;
constexpr int MOE_RT = 132;
constexpr int MOE_NT_MAX = 264;

constexpr int NWAVES = 8;
constexpr size_t MiB = 1u << 20;
constexpr size_t WS_CTL = 0, CTL_ZERO_BYTES = 1 * MiB;
constexpr size_t WS_WIN = 1 * MiB;
constexpr size_t WIN_STRIDE = (size_t)PROJ_PAD * DM * 2;
constexpr size_t WS_WA = 24 * MiB, WS_WB = 26 * MiB, WS_WOUT = 28 * MiB;
constexpr size_t WS_FGU = 32 * MiB, WS_FD = 46 * MiB;
constexpr size_t WS_CS = 53 * MiB;
constexpr size_t WS_IW = 61 * MiB, WS_LOGF = 62 * MiB, WS_CB = 63 * MiB;
constexpr size_t WS_MOE = 64 * MiB;
constexpr size_t MOE_TOPE = WS_MOE, MOE_TOPG = WS_MOE + 128 * 1024, MOE_TOKSLOT = WS_MOE + 384 * 1024, MOE_SLOTTOK = WS_MOE + 640 * 1024,
                 MOE_SLOTGATE = WS_MOE + 1024 * 1024, MOE_CNT = WS_MOE + 1408 * 1024, MOE_TOT = MOE_CNT + 16 * 1024;
constexpr size_t WS_XS = 66 * MiB;
constexpr size_t WS_DQ = 130 * MiB, WS_DK = 162 * MiB, WS_DV = 194 * MiB, WS_IQ = 226 * MiB, WS_FQ = 258 * MiB, WS_FK = 290 * MiB, WS_FV = 322 * MiB;
constexpr size_t WS_GA = 354 * MiB, WS_GB = 418 * MiB;
constexpr size_t WS_IK = 482 * MiB, WS_MASK = 486 * MiB;
constexpr size_t WS_MERGED = WS_DK;
constexpr size_t WS_H = 130 * MiB;
constexpr size_t WS_H2 = 130 * MiB;
constexpr size_t WS_YB = 361 * MiB;
constexpr size_t WS_MWD = 493 * MiB;
constexpr size_t WS_END = 549 * MiB;
static_assert(WS_MASK + (size_t)NTOK * 128 * 4 <= WS_END && WS_H2 + (size_t)MOE_RT * 256 * DFF * 2 <= WS_YB && WS_YB + (size_t)MOE_NT_MAX * 256 * DM * 2 <= WS_MWD && WS_MWD + (size_t)NEXP * DM * DFF * 2 <= WS_END, "ws map");
static_assert(WS_WIN + 2 * WIN_STRIDE <= WS_WA && WS_FD + (size_t)DM * DFF * 2 <= WS_CS && WS_H + (size_t)NTOK * DFF * 2 <= WS_GA, "ws map 2");
constexpr int CW_TMO = 0, CW_CODE = 1, CW_BAR = 4096;

constexpr int RING_OFF = 0, RING_BYTES = 131072;
constexpr int IDX_ROWB = 8200;
constexpr int IDX_HIST_OFF = 16 * IDX_ROWB;
constexpr int MISC_OFF = 146432;
constexpr int LDS_BYTES = 147456;
static_assert(IDX_HIST_OFF + 8 * 1024 <= MISC_OFF && MISC_OFF + 128 <= LDS_BYTES, "LDS map");

#define GAS __attribute__((address_space(1)))
#define LAS __attribute__((address_space(3)))
typedef unsigned short bf16;
typedef unsigned v4u __attribute__((ext_vector_type(4)));
typedef unsigned v2u __attribute__((ext_vector_type(2)));
typedef float f32x4 __attribute__((ext_vector_type(4)));
typedef short bf16x8 __attribute__((ext_vector_type(8)));
typedef GAS unsigned gu32;
#define RLX_AGENT __ATOMIC_RELAXED, __HIP_MEMORY_SCOPE_AGENT
__device__ __forceinline__ unsigned f2bf(float f) { unsigned u = __builtin_bit_cast(unsigned, f); return (u + 0x7fffu + ((u >> 16) & 1u)) >> 16; }
__device__ __forceinline__ unsigned pk2(float lo, float hi) { return f2bf(lo) | (f2bf(hi) << 16); }

namespace pg8 {
#define PG8_LAS __attribute__((address_space(3)))
typedef unsigned short bf16_t;
typedef short bf16x8 __attribute__((ext_vector_type(8)));
typedef float f32x4 __attribute__((ext_vector_type(4)));
typedef unsigned u32x4 __attribute__((ext_vector_type(4)));
constexpr int BM = 256, BK = 64, HALF = 128, HTB = HALF * BK * 2  , STAGE_BYTES = 8 * HTB, NXCD = 8, WGM = 8;

__host__ __device__ __forceinline__ int lds_byte(int r, int c) { const int st = (r >> 4) * 2 + (c >> 5), rr = r & 15, cc = c & 31, ob = rr * 64 + cc * 2; return st * 1024 + (ob ^ (((ob >> 9) & 1) << 5)); }
__host__ __device__ __forceinline__ void stage_rc(int b, int& R, int& C) { const int st = b / 1024, sb = b % 1024, swz = sb ^ (((sb >> 9) & 1) << 5); R = (st >> 1) * 16 + swz / 64; C = (st & 1) * 32 + (swz % 64) / 2; }
__host__ __device__ __forceinline__ int perm32(int rho) { const int n = rho >> 4, i = rho & 15; return 8 * (i >> 2) + 4 * n + (i & 3); }

struct Unit { int pm, pn; };
struct Gemm { const bf16_t* A; const bf16_t* Bt; int M, N, K; };

struct StaticOrder {
    int nM, nN, nwg, G, c;
    __host__ __device__ void init(int M, int N, int G_, int c_) { nM = M / BM; nN = N / BM; nwg = nM * nN; G = G_; c = c_; }
    __host__ __device__ bool next(int i, Unit& u) const {
        const long L = (long)i * G + c; if (L >= nwg) return false;
        int wgid = (int)L; { const int q = nwg / NXCD, r = nwg % NXCD, xcd = wgid % NXCD, off = wgid / NXCD; wgid = (xcd < r ? xcd * (q + 1) : r * (q + 1) + (xcd - r) * q) + off; }
        const int nig = WGM * nN, gid = wgid / nig, fm = gid * WGM, gsz = (nM - fm) < WGM ? (nM - fm) : WGM;
        u.pm = fm + ((wgid % nig) % gsz); u.pn = (wgid % nig) / gsz; return true;
    }
    __device__ __forceinline__ void a_ready(const Unit&) const {}
    __device__ __forceinline__ void done(const Unit&) const {}
};
__device__ __forceinline__ unsigned cvt_pk_bf16(float lo, float hi) { unsigned r; asm volatile("v_cvt_pk_bf16_f32 %0, %1, %2" : "=v"(r) : "v"(lo), "v"(hi)); return r; }
typedef float f32x2 __attribute__((ext_vector_type(2)));
template <class Epi, class Sched, bool ALIGN_EPI = false, bool SP2 = false, bool GATHER = false>
__device__ __forceinline__ void gemm_phase(PG8_LAS unsigned char* lds, const Gemm g, const Sched& S, const Epi& E) {
    int tid_ = threadIdx.x; asm volatile("" : "+v"(tid_));
    const int tid = tid_, wid = __builtin_amdgcn_readfirstlane(tid >> 6), lane = tid & 63, wr = wid >> 2, wc = wid & 3, fr = lane & 15, fq = lane >> 4;
    const int K = g.K, nt = K / BK;
    unsigned voffA[2], voffB[2]; int gR[2]; unsigned gC[2];
#pragma unroll
    for (int i = 0; i < 2; ++i) { int R, C; stage_rc(tid * 16 + i * 8192, R, C); const int Rb = Epi::PERM ? ((R & ~31) + perm32(R & 31)) : R;
        voffA[i] = (unsigned)(R * K + C) * 2u; voffB[i] = (unsigned)(Rb * K + C) * 2u; gR[i] = R; gC[i] = (unsigned)C * 2u; }
    static_assert(!GATHER || SP2, "gather mode is written for the SP2 loop only");
    unsigned cv[2][2] = {{0u, 0u}, {0u, 0u}}, nv[2][2] = {{0u, 0u}, {0u, 0u}};
    const size_t kstep = (size_t)(BK * 2);
    const size_t hstep = (size_t)HALF * K * 2;
    const size_t tstep = 2 * hstep;
    const unsigned ldsw = (unsigned)wid * 1024u;
    const int aoff = lds_byte(wr * 64 + fr, fq * 8), boff = lds_byte(wc * 32 + fr, fq * 8);
#define PG8_SA(b, h) (((b) * 2 + (h)) * HTB)
#define PG8_SB(b, h) ((4 + (b) * 2 + (h)) * HTB)
#define PG8_STAGE(bufoff, gbase, voff) do { _Pragma("unroll") for (int _i = 0; _i < 2; ++_i) \
        __builtin_amdgcn_global_load_lds((const unsigned*)((const char*)(gbase) + (voff)[_i]), (PG8_LAS unsigned*)(lds + (bufoff) + ldsw + _i * 8192), 16, 0, 0); } while (0)
#define PG8_STAGE_A(b, h, gbase, VO) do { if constexpr (GATHER) { PG8_STAGE(PG8_SA(b, h), gbase, VO[h]); } else { PG8_STAGE(PG8_SA(b, h), (gbase) + (h) * hstep, voffA); } } while (0)
#define PG8_LDA(dst, b, h) do { _Pragma("unroll") for (int m = 0; m < 4; ++m) _Pragma("unroll") for (int k = 0; k < 2; ++k) dst[m][k] = *(const PG8_LAS bf16x8*)(lds + PG8_SA(b, h) + aoff + m * 2048 + k * 1024); } while (0)
#define PG8_LDB(dst, b, h) do { _Pragma("unroll") for (int n = 0; n < 2; ++n) _Pragma("unroll") for (int k = 0; k < 2; ++k) dst[n][k] = *(const PG8_LAS bf16x8*)(lds + PG8_SB(b, h) + boff + n * 2048 + k * 1024); } while (0)
#define PG8_MMA(ai, bj, At, Bt) do { __builtin_amdgcn_s_setprio(1); _Pragma("unroll") for (int m = 0; m < 4; ++m) _Pragma("unroll") for (int n = 0; n < 2; ++n) _Pragma("unroll") for (int k = 0; k < 2; ++k) \
        acc[ai][bj][m][n] = __builtin_amdgcn_mfma_f32_16x16x32_bf16(Bt[n][k], At[m][k], acc[ai][bj][m][n], 0, 0, 0); __builtin_amdgcn_s_setprio(0); } while (0)
#define PG8_WAIT_V(n) asm volatile("s_waitcnt vmcnt(" #n ")" ::: "memory")
#define PG8_WAIT_L(n) asm volatile("s_waitcnt lgkmcnt(" #n ")" ::: "memory")
#define PG8_BAR __builtin_amdgcn_s_barrier()
#define PG8_SCHED __builtin_amdgcn_sched_barrier(0)
    Unit cur, nxt; int ui = 0;
    if (!S.next(0, cur)) return;
    f32x4 acc[2][2][4][2];
#pragma unroll
    for (int a = 0; a < 2; ++a)
#pragma unroll
        for (int b = 0; b < 2; ++b)
#pragma unroll
            for (int m = 0; m < 4; ++m)
#pragma unroll
                for (int n = 0; n < 2; ++n) acc[a][b][m][n] = (f32x4){0.f, 0.f, 0.f, 0.f};
    bf16x8 At[4][2], B0[2][2], B1[2][2];
    const char* cA = (const char*)g.A + (GATHER ? (size_t)0 : (size_t)cur.pm * tstep);
    if constexpr (GATHER) {
#pragma unroll
        for (int h = 0; h < 2; ++h)
#pragma unroll
            for (int i = 0; i < 2; ++i) { cv[h][i] = (unsigned)S.arow(cur, h * HALF + gR[i]) * (unsigned)(K * 2) + gC[i]; nv[h][i] = cv[h][i]; } } const char* cB = (const char*)g.Bt + (size_t)cur.pn * tstep;
    S.a_ready(cur);
    if constexpr (SP2) {
        PG8_STAGE(PG8_SB(0, 0), cB, voffB); PG8_STAGE(PG8_SB(0, 1), cB + hstep, voffB); PG8_STAGE_A(0, 0, cA, cv); PG8_STAGE_A(0, 1, cA, cv);
        if (wr == 1) PG8_BAR;
        PG8_WAIT_V(2); PG8_BAR;
        PG8_STAGE(PG8_SB(1, 0), cB + kstep, voffB); PG8_STAGE_A(1, 0, cA + kstep, cv); PG8_STAGE(PG8_SB(1, 1), cB + hstep + kstep, voffB);
        PG8_WAIT_V(6); PG8_BAR;
    } else {
        PG8_STAGE(PG8_SB(0, 0), cB, voffB); PG8_STAGE(PG8_SA(0, 0), cA, voffA); PG8_STAGE(PG8_SB(0, 1), cB + hstep, voffB); PG8_STAGE(PG8_SA(0, 1), cA + hstep, voffA);
        if (wr == 1) PG8_BAR;
        PG8_WAIT_V(4); PG8_BAR;
        PG8_STAGE(PG8_SB(1, 0), cB + kstep, voffB); PG8_STAGE_A(1, 0, cA + kstep, cv); PG8_STAGE(PG8_SB(1, 1), cB + hstep + kstep, voffB);
        PG8_WAIT_V(6); PG8_BAR;
    }
    for (;;) {
        const bool has_next = S.next(ui + 1, nxt);
        const char* nA = (has_next && !GATHER) ? (const char*)g.A + (size_t)nxt.pm * tstep : cA;
        if constexpr (GATHER) { if (has_next) {
#pragma unroll
            for (int h = 0; h < 2; ++h)
#pragma unroll
                for (int i = 0; i < 2; ++i) nv[h][i] = (unsigned)S.arow(nxt, h * HALF + gR[i]) * (unsigned)(K * 2) + gC[i]; } } const char* nB = has_next ? (const char*)g.Bt + (size_t)nxt.pn * tstep : cB;
        for (int t = 0; t < nt; t += 2) {
            const bool last = (t == nt - 2);
            const char* a1 = cA + (size_t)(t + 1) * kstep;
            const char* a2 = last ? nA : cA + (size_t)(t + 2) * kstep; const char* b2 = last ? nB : cB + (size_t)(t + 2) * kstep;
            const char* a3 = a2 + kstep; const char* b3 = b2 + kstep;
            if (last && has_next) S.a_ready(nxt);
            unsigned v2[2][2];
#pragma unroll
            for (int h = 0; h < 2; ++h)
#pragma unroll
                for (int i = 0; i < 2; ++i) v2[h][i] = last ? nv[h][i] : cv[h][i];
            if constexpr (SP2) {
            PG8_LDB(B0, 0, 0); PG8_LDB(B1, 0, 1); PG8_SCHED; PG8_LDA(At, 0, 0); PG8_STAGE_A(1, 1, a1, cv);
            PG8_WAIT_V(8); PG8_WAIT_L(0); PG8_BAR; PG8_MMA(0, 0, At, B0); PG8_MMA(0, 1, At, B1); PG8_BAR; PG8_SCHED;
            PG8_LDA(At, 0, 1); PG8_STAGE(PG8_SB(0, 0), b2, voffB); PG8_STAGE(PG8_SB(0, 1), b2 + hstep, voffB); PG8_STAGE_A(0, 0, a2, v2);
            PG8_WAIT_V(8); PG8_WAIT_L(0); PG8_BAR; PG8_MMA(1, 0, At, B0); PG8_MMA(1, 1, At, B1); PG8_BAR; PG8_SCHED;
            PG8_LDB(B0, 1, 0); PG8_LDB(B1, 1, 1); PG8_SCHED; PG8_LDA(At, 1, 0); PG8_STAGE_A(0, 1, a2, v2);
            PG8_WAIT_V(8); PG8_WAIT_L(0); PG8_BAR; PG8_MMA(0, 0, At, B0); PG8_MMA(0, 1, At, B1); PG8_BAR; PG8_SCHED;
            PG8_LDA(At, 1, 1); PG8_STAGE(PG8_SB(1, 0), b3, voffB); PG8_STAGE(PG8_SB(1, 1), b3 + hstep, voffB); PG8_STAGE_A(1, 0, a3, v2);
            PG8_WAIT_V(8); PG8_WAIT_L(0); PG8_BAR; PG8_MMA(1, 0, At, B0); PG8_MMA(1, 1, At, B1); PG8_BAR; PG8_SCHED;
            } else {
            PG8_LDB(B0, 0, 0); PG8_SCHED; PG8_LDA(At, 0, 0); PG8_STAGE(PG8_SA(1, 1), a1 + hstep, voffA);
            PG8_WAIT_L(8); PG8_BAR; PG8_WAIT_L(0); PG8_MMA(0, 0, At, B0); PG8_BAR; PG8_SCHED;
            PG8_LDB(B1, 0, 1); PG8_STAGE(PG8_SB(0, 0), b2, voffB);
            PG8_BAR; PG8_WAIT_L(0); PG8_MMA(0, 1, At, B1); PG8_BAR;
            PG8_LDA(At, 0, 1); PG8_STAGE(PG8_SA(0, 0), a2, voffA);
            PG8_BAR; PG8_WAIT_L(0); PG8_MMA(1, 0, At, B0); PG8_BAR; PG8_SCHED;
            PG8_STAGE(PG8_SB(0, 1), b2 + hstep, voffB);
            PG8_WAIT_V(6); PG8_BAR; PG8_MMA(1, 1, At, B1); PG8_BAR;
            PG8_LDB(B0, 1, 0); PG8_SCHED; PG8_LDA(At, 1, 0); PG8_STAGE(PG8_SA(0, 1), a2 + hstep, voffA);
            PG8_WAIT_L(8); PG8_BAR; PG8_WAIT_L(0); PG8_MMA(0, 0, At, B0); PG8_BAR; PG8_SCHED;
            PG8_LDB(B1, 1, 1); PG8_STAGE(PG8_SB(1, 0), b3, voffB);
            PG8_BAR; PG8_WAIT_L(0); PG8_MMA(0, 1, At, B1); PG8_BAR;
            PG8_LDA(At, 1, 1); PG8_STAGE(PG8_SA(1, 0), a3, voffA);
            PG8_BAR; PG8_WAIT_L(0); PG8_MMA(1, 0, At, B0); PG8_BAR; PG8_SCHED;
            PG8_STAGE(PG8_SB(1, 1), b3 + hstep, voffB);
            PG8_WAIT_V(6); PG8_BAR; PG8_MMA(1, 1, At, B1); PG8_BAR;
            }
        }
        if constexpr (ALIGN_EPI) { if (wr == 0) PG8_BAR; }
        if constexpr (!Epi::AFTER_DRAIN) { E(acc, cur, wr, wc, fr, fq); S.done(cur); }
        if (!has_next) break;
#pragma unroll
        for (int a = 0; a < 2; ++a)
#pragma unroll
            for (int b = 0; b < 2; ++b)
#pragma unroll
                for (int m = 0; m < 4; ++m)
#pragma unroll
                    for (int n = 0; n < 2; ++n) acc[a][b][m][n] = (f32x4){0.f, 0.f, 0.f, 0.f};
        cur = nxt; cA = nA; cB = nB; ++ui;
        if constexpr (GATHER) {
#pragma unroll
            for (int h = 0; h < 2; ++h)
#pragma unroll
                for (int i = 0; i < 2; ++i) cv[h][i] = nv[h][i]; }
        if constexpr (ALIGN_EPI) { if (wr == 1) PG8_BAR; }
    }
    PG8_WAIT_V(0);
    if constexpr (!ALIGN_EPI) { if (wr == 0) PG8_BAR; }
    PG8_BAR;
    if constexpr (Epi::AFTER_DRAIN) { E.fused(acc, cur, wr, wc, fr, fq, lds, wid, lane); S.done(cur); }
#undef PG8_SA
#undef PG8_SB
#undef PG8_STAGE
#undef PG8_STAGE_A
#undef PG8_LDA
#undef PG8_LDB
#undef PG8_MMA
#undef PG8_WAIT_V
#undef PG8_WAIT_L
#undef PG8_BAR
#undef PG8_SCHED
}
}
namespace pg8 {
typedef unsigned u32x2 __attribute__((ext_vector_type(2)));
__device__ __forceinline__ float bf2f(unsigned h16) { return __uint_as_float(h16 << 16); }
__device__ __forceinline__ float sigmoidf_fast(float x) { return __builtin_amdgcn_rcpf(1.0f + __builtin_amdgcn_exp2f(-x * 1.4426950408889634f)); }
typedef float f32x2c __attribute__((ext_vector_type(2))); typedef __bf16 bf16x2c __attribute__((ext_vector_type(2)));
__device__ __forceinline__ unsigned cvt2(float lo, float hi) { f32x2c v = {lo, hi}; bf16x2c b = __builtin_convertvector(v, bf16x2c); return __builtin_bit_cast(unsigned, b); }
__device__ __forceinline__ u32x4 pack8(const f32x4& a, const f32x4& b) { u32x4 w; w.x = cvt2(a[0], a[1]); w.y = cvt2(a[2], a[3]); w.z = cvt2(b[0], b[1]); w.w = cvt2(b[2], b[3]); return w; }
__device__ __forceinline__ void unpack8(const u32x4& w, f32x4& a, f32x4& b) {
    a[0] = bf2f(w.x & 0xffffu); a[1] = __uint_as_float(w.x & 0xffff0000u); a[2] = bf2f(w.y & 0xffffu); a[3] = __uint_as_float(w.y & 0xffff0000u);
    b[0] = bf2f(w.z & 0xffffu); b[1] = __uint_as_float(w.z & 0xffff0000u); b[2] = bf2f(w.w & 0xffffu); b[3] = __uint_as_float(w.w & 0xffff0000u); }

#ifdef DBG_NOSIG
#define SIGF(x) (x)
#else
#define SIGF(x) sigmoidf_fast(x)
#endif
struct EpiProj {
    static constexpr bool PERM = true, AFTER_DRAIN = false;
    unsigned char* ws; const float* bforget;
    __device__ __forceinline__ void operator()(const f32x4 (&acc)[2][2][4][2], const Unit& u, int wr, int wc, int fr, int fq) const {
        const int pn = u.pn; const int row0 = u.pm * BM + wr * 64 + fr;
        bf16_t *DQ = (bf16_t*)(ws + WS_DQ), *DK = (bf16_t*)(ws + WS_DK), *DV = (bf16_t*)(ws + WS_DV), *IQ = (bf16_t*)(ws + WS_IQ), *FQ = (bf16_t*)(ws + WS_FQ), *FK = (bf16_t*)(ws + WS_FK), *FV = (bf16_t*)(ws + WS_FV);
        bf16_t *GA = (bf16_t*)(ws + WS_GA), *GB = (bf16_t*)(ws + WS_GB), *IK = (bf16_t*)(ws + WS_IK); float *IW = (float*)(ws + WS_IW), *LOGF = (float*)(ws + WS_LOGF); const float* CS = (const float*)(ws + WS_CS);
        const bool rot = (pn < 4) || pn == 6 || pn == 7 || (pn == 22 && wc == 0);
        if (rot) {
            bf16_t* dst; int pitch, col1; float sc = 1.f;
            if (pn == 22) { dst = IK; pitch = 64; col1 = 8 * fq; }
            else { dst = pn < 2 ? DQ : (pn < 4 ? DK : IQ); pitch = AW; col1 = (4 * (pn & 1) + wc) * 64 + 8 * fq; if (pn < 2) sc = C2; }
#pragma unroll
            for (int ai = 0; ai < 2; ++ai)
#pragma unroll
                for (int m = 0; m < 4; ++m) {
                    const int row = row0 + ai * HALF + m * 16;
                    const float* cs = CS + (size_t)row * 64 + 16 * fq;
                    const f32x4 t0 = *(const f32x4*)(cs), t1 = *(const f32x4*)(cs + 4), t2 = *(const f32x4*)(cs + 8), t3 = *(const f32x4*)(cs + 12);
                    const f32x4 xa = acc[ai][0][m][0], xb = acc[ai][0][m][1], ya = acc[ai][1][m][0], yb = acc[ai][1][m][1];
                    f32x4 o1a, o1b, o2a, o2b;
                    o1a[0] = (xa[0] * t0[0] - ya[0] * t0[1]) * sc; o2a[0] = (ya[0] * t0[0] + xa[0] * t0[1]) * sc;
                    o1a[1] = (xa[1] * t0[2] - ya[1] * t0[3]) * sc; o2a[1] = (ya[1] * t0[2] + xa[1] * t0[3]) * sc;
                    o1a[2] = (xa[2] * t1[0] - ya[2] * t1[1]) * sc; o2a[2] = (ya[2] * t1[0] + xa[2] * t1[1]) * sc;
                    o1a[3] = (xa[3] * t1[2] - ya[3] * t1[3]) * sc; o2a[3] = (ya[3] * t1[2] + xa[3] * t1[3]) * sc;
                    o1b[0] = (xb[0] * t2[0] - yb[0] * t2[1]) * sc; o2b[0] = (yb[0] * t2[0] + xb[0] * t2[1]) * sc;
                    o1b[1] = (xb[1] * t2[2] - yb[1] * t2[3]) * sc; o2b[1] = (yb[1] * t2[2] + xb[1] * t2[3]) * sc;
                    o1b[2] = (xb[2] * t3[0] - yb[2] * t3[1]) * sc; o2b[2] = (yb[2] * t3[0] + xb[2] * t3[1]) * sc;
                    o1b[3] = (xb[3] * t3[2] - yb[3] * t3[3]) * sc; o2b[3] = (yb[3] * t3[2] + xb[3] * t3[3]) * sc;
                    bf16_t* rp = dst + (size_t)row * pitch + col1;
                    *(u32x4*)(rp) = pack8(o1a, o1b); *(u32x4*)(rp + 32) = pack8(o2a, o2b);
                }
        } else if (pn == 22) {
            if (fq == 0 && (wc == 1 || wc == 2)) {
                f32x4 b0 = {0.f, 0.f, 0.f, 0.f}, b1 = {0.f, 0.f, 0.f, 0.f};
                if (wc == 2) { b0 = *(const f32x4*)(bforget); b1 = *(const f32x4*)(bforget + 4); }
#pragma unroll
                for (int ai = 0; ai < 2; ++ai)
#pragma unroll
                    for (int m = 0; m < 4; ++m) {
                        const int row = row0 + ai * HALF + m * 16;
                        f32x4 va = acc[ai][0][m][0], vb = acc[ai][0][m][1];
                        if (wc == 1) { va = va * 0.04419417382415922f; vb = vb * 0.04419417382415922f;
                            *(f32x4*)(IW + (size_t)row * 8) = va; *(f32x4*)(IW + (size_t)row * 8 + 4) = vb; }
                        else { va = va + b0; vb = vb + b1; f32x4 la, lb;
#pragma unroll
                            for (int i = 0; i < 4; ++i) { const float za = va[i], zb = vb[i];
                                la[i] = fminf(za, 0.f) - log1pf(__expf(-fabsf(za))); lb[i] = fminf(zb, 0.f) - log1pf(__expf(-fabsf(zb))); }
                            *(f32x4*)(LOGF + (size_t)row * 8) = la; *(f32x4*)(LOGF + (size_t)row * 8 + 4) = lb; }
                    }
            }
        } else if (pn < 14) {
            bf16_t* dst = pn < 6 ? DV : (pn < 10 ? FQ : (pn < 12 ? FK : FV)); const float sc = (pn == 8 || pn == 9) ? C2 : 1.f;
            const int col0 = 256 * (pn & 1) + wc * 32 + 8 * fq;
#pragma unroll
            for (int ai = 0; ai < 2; ++ai)
#pragma unroll
                for (int m = 0; m < 4; ++m) { bf16_t* rp = dst + (size_t)(row0 + ai * HALF + m * 16) * AW + col0;
#pragma unroll
                    for (int bj = 0; bj < 2; ++bj) *(u32x4*)(rp + bj * HALF) = pack8(acc[ai][bj][m][0] * sc, acc[ai][bj][m][1] * sc); }
        } else {
            bf16_t* dst = pn < 18 ? GA : GB; const int col0 = 256 * ((pn - 14) & 3) + wc * 32 + 8 * fq;
#pragma unroll
            for (int ai = 0; ai < 2; ++ai)
#pragma unroll
                for (int m = 0; m < 4; ++m) { bf16_t* rp = dst + (size_t)(row0 + ai * HALF + m * 16) * DM + col0;
#pragma unroll
                    for (int bj = 0; bj < 2; ++bj) { f32x4 a = acc[ai][bj][m][0], b = acc[ai][bj][m][1];
#pragma unroll
                        for (int i = 0; i < 4; ++i) { a[i] = SIGF(a[i]); b[i] = SIGF(b[i]); }
                        *(u32x4*)(rp + bj * HALF) = pack8(a, b); } }
        }
    }
};

struct EpiGate2 {
    static constexpr bool PERM = true, AFTER_DRAIN = false;
    bf16_t* O; const bf16_t* GAp; const bf16_t* GBp;
    __device__ __forceinline__ void operator()(const f32x4 (&acc)[2][2][4][2], const Unit& u, int wr, int wc, int fr, int fq) const {
        const int br = u.pm >> 9; const bf16_t* G = br ? GBp : GAp;
        const int row0 = (u.pm & 511) * BM + wr * 64 + fr, col0 = (u.pn & 7) * BM + wc * 32 + 8 * fq;
#pragma unroll
        for (int ai = 0; ai < 2; ++ai)
#pragma unroll
            for (int m = 0; m < 4; ++m) { const size_t ro = (size_t)(row0 + ai * HALF + m * 16) * DM + col0;
#pragma unroll
                for (int bj = 0; bj < 2; ++bj) { const size_t off = ro + bj * HALF;
                    f32x4 ga, gb; unpack8(*(const u32x4*)(G + off), ga, gb);
                    f32x4 a = ga * acc[ai][bj][m][0], b = gb * acc[ai][bj][m][1];
                    if (br) { f32x4 pa, pb; unpack8(*(const u32x4*)(O + off), pa, pb); a = a + pa; b = b + pb; }
                    *(u32x4*)(O + off) = pack8(a, b); } }
    }
};
struct D1Order {
    StaticOrder S; int n;
    __device__ __forceinline__ void init(int M, int N, int G, int c) { S.init(M, N, G, c); n = (S.nwg - c + G - 1) / G; if (n < 0) n = 0; }
    __device__ __forceinline__ bool next(int i, Unit& u) const { if (i >= 2 * n) return false; const int br = (i >= n) ? 1 : 0; S.next(i - br * n, u); u.pm += 512 * br; u.pn += 8 * br; return true; }
    __device__ __forceinline__ void a_ready(const Unit&) const {}
    __device__ __forceinline__ void done(const Unit&) const {}
};

struct EpiY {
    static constexpr bool PERM = false, AFTER_DRAIN = false;
    float* Y; const float* R;
    __device__ __forceinline__ void operator()(const f32x4 (&acc)[2][2][4][2], const Unit& u, int wr, int wc, int fr, int fq) const {
        const int row0 = u.pm * BM + wr * 64 + fr, col0 = u.pn * BM + wc * 32 + 4 * fq;
#pragma unroll
        for (int ai = 0; ai < 2; ++ai)
#pragma unroll
            for (int m = 0; m < 4; ++m) { const size_t ro = (size_t)(row0 + ai * HALF + m * 16) * DM + col0;
#pragma unroll
                for (int bj = 0; bj < 2; ++bj)
#pragma unroll
                    for (int n = 0; n < 2; ++n) { const size_t off = ro + bj * HALF + n * 16;
                        const f32x4 r = *(const f32x4*)(R + off);
                        *(f32x4*)(Y + off) = r * ALPHA + acc[ai][bj][m][n]; } }
    }
};

struct EpiSwiglu {
    static constexpr bool PERM = true, AFTER_DRAIN = false;
    bf16_t* H; int nc;
    __device__ __forceinline__ void operator()(const f32x4 (&acc)[2][2][4][2], const Unit& u, int wr, int wc, int fr, int fq) const {
        const int row0 = u.pm * BM + wr * 64 + fr, col0 = (u.pn % nc) * HALF + wc * 32 + 8 * fq;
#pragma unroll
        for (int ai = 0; ai < 2; ++ai)
#pragma unroll
            for (int m = 0; m < 4; ++m) { f32x4 a, b;
#pragma unroll
                for (int i = 0; i < 4; ++i) { const float g0 = acc[ai][0][m][0][i], g1 = acc[ai][0][m][1][i];
                    a[i] = g0 * sigmoidf_fast(g0) * acc[ai][1][m][0][i]; b[i] = g1 * sigmoidf_fast(g1) * acc[ai][1][m][1][i]; }
                *(u32x4*)(H + (size_t)(row0 + ai * HALF + m * 16) * DFF + col0) = pack8(a, b); }
    }
};

struct EpiDownMoe {
    static constexpr bool PERM = true, AFTER_DRAIN = false;
    bf16_t* YB; const float* gate; int t_lo;
    __device__ __forceinline__ void operator()(const f32x4 (&acc)[2][2][4][2], const Unit& u, int wr, int wc, int fr, int fq) const {
        const int row0 = (t_lo + u.pm) * BM + wr * 64 + fr, col0 = (u.pn & 3) * BM + wc * 32 + 8 * fq;
#pragma unroll
        for (int ai = 0; ai < 2; ++ai)
#pragma unroll
            for (int m = 0; m < 4; ++m) { const int row = row0 + ai * HALF + m * 16; const float gt = gate[row]; bf16_t* rp = YB + (size_t)row * DM + col0;
#pragma unroll
                for (int bj = 0; bj < 2; ++bj) *(u32x4*)(rp + bj * HALF) = pack8(acc[ai][bj][m][0] * gt, acc[ai][bj][m][1] * gt); }
    }
};

struct MoeOrder {
    int cum[8]; int t_lo, t_hi, nc, G, c; const int* slot_tok;
    __device__ __forceinline__ bool next(int i, Unit& u) const {
        const long L = (long)i * G + c; const int nt = t_hi - t_lo; if (L >= (long)nt * nc) return false;
        const int pml = (int)(L / nc), pnl = (int)(L % nc), tg = t_lo + pml; int e = 0;
#pragma unroll
        for (int j = 0; j < 7; ++j) e += (tg >= cum[j]) ? 1 : 0;
        u.pm = pml; u.pn = e * nc + pnl; return true;
    }
    __device__ __forceinline__ int arow(const Unit& u, int r) const { return slot_tok[(t_lo + u.pm) * BM + r]; }
    __device__ __forceinline__ void a_ready(const Unit&) const {}
    __device__ __forceinline__ void done(const Unit&) const {}
};
}

namespace attn_body {
using bf16 = unsigned short;
using bf16x8 = __attribute__((ext_vector_type(8))) short;
using s16x4 = __attribute__((ext_vector_type(4))) short;
using f32x16 = __attribute__((ext_vector_type(16))) float;
using f32x4a = __attribute__((ext_vector_type(4))) float;
using u32x4 = __attribute__((ext_vector_type(4))) unsigned;
using u32x2 = __attribute__((ext_vector_type(2))) unsigned;
#define ALAS __attribute__((address_space(3)))
constexpr int NW = 8, QBLK = 32, QB = QBLK * NW, KVBLK = 64;
constexpr int NSLOT = 3, SLOTB = 8192;
constexpr int LDS_K = 0, LDS_V = NSLOT * SLOTB, LDS_WS = 2 * NSLOT * SLOTB, LDS_OST = LDS_WS + NW * 64 * 4, LDS_BIAS = LDS_OST + NW * 4096, LDS_M = LDS_BIAS + 16384, LDS_BYTES = LDS_M + NW * 512;
__device__ __forceinline__ int crow(int r, int hi) { return (r & 3) + 8 * (r >> 2) + 4 * hi; }
#define SBAR() __builtin_amdgcn_sched_barrier(0)
__device__ __forceinline__ void cmask(f32x16& p0, f32x16& p1, int jb, int qrel, int hi) {
    const float NEG = -INFINITY; const int kb = 64 * jb + 4 * hi;
#pragma unroll
    for (int r = 0; r < 16; ++r) { const int kv = kb + (r & 3) + 8 * (r >> 2); if (kv > qrel) p0[r] = NEG; if (kv + 32 > qrel) p1[r] = NEG; }
}
__device__ __forceinline__ void glds16(const void* gsrc, unsigned lds_dst) { unsigned keep;
    asm volatile("s_mov_b32 %0, m0\n\ts_mov_b32 m0, %2\n\ts_nop 0\n\tglobal_load_lds_dwordx4 %1, off\n\ts_mov_b32 m0, %0" : "=&s"(keep) : "v"(gsrc), "s"(lds_dst) : "memory"); }
__device__ __forceinline__ void glds4(const void* gsrc, unsigned lds_dst) { unsigned keep;
    asm volatile("s_mov_b32 %0, m0\n\ts_mov_b32 m0, %2\n\ts_nop 0\n\tglobal_load_lds_dword %1, off\n\ts_mov_b32 m0, %0" : "=&s"(keep) : "v"(gsrc), "s"(lds_dst) : "memory"); }
typedef float f32x2_t __attribute__((ext_vector_type(2))); typedef __bf16 bf16x2_t __attribute__((ext_vector_type(2)));
__device__ __forceinline__ unsigned cvtpk_s(float lo, float hi) { f32x2_t v = {lo, hi}; bf16x2_t b = __builtin_convertvector(v, bf16x2_t); return __builtin_bit_cast(unsigned, b); }
template <int N> __device__ __forceinline__ void wait_bar() {
    static_assert(N >= 0 && N <= 4, "wait_bar");
    if constexpr (N == 0) asm volatile("s_waitcnt vmcnt(0) lgkmcnt(0)\n\ts_barrier" ::: "memory");
    else if constexpr (N == 1) asm volatile("s_waitcnt vmcnt(1) lgkmcnt(0)\n\ts_barrier" ::: "memory");
    else if constexpr (N == 2) asm volatile("s_waitcnt vmcnt(2) lgkmcnt(0)\n\ts_barrier" ::: "memory");
    else if constexpr (N == 3) asm volatile("s_waitcnt vmcnt(3) lgkmcnt(0)\n\ts_barrier" ::: "memory");
    else asm volatile("s_waitcnt vmcnt(4) lgkmcnt(0)\n\ts_barrier" ::: "memory");
}
typedef __attribute__((address_space(3))) const char* lds_cptr;
typedef short v4i16_t __attribute__((ext_vector_type(4)));
__device__ __forceinline__ void kload8(bf16x8* kf, lds_cptr kp) {
    kf[0] = *(const ALAS bf16x8*)(kp);        kf[1] = *(const ALAS bf16x8*)(kp + 512);
    kf[2] = *(const ALAS bf16x8*)(kp + 2048); kf[3] = *(const ALAS bf16x8*)(kp + 2560);
    kf[4] = *(const ALAS bf16x8*)(kp + 4096); kf[5] = *(const ALAS bf16x8*)(kp + 4608);
    kf[6] = *(const ALAS bf16x8*)(kp + 6144); kf[7] = *(const ALAS bf16x8*)(kp + 6656);
}
__device__ __forceinline__ void kload2(bf16x8* kf, lds_cptr kp, int j) { kf[2 * j] = *(const ALAS bf16x8*)(kp + j * 2048); kf[2 * j + 1] = *(const ALAS bf16x8*)(kp + j * 2048 + 512); }
__device__ __forceinline__ s16x4 vtr(lds_cptr p) { return __builtin_bit_cast(s16x4, __builtin_amdgcn_ds_read_tr16_b64_v4i16((ALAS v4i16_t*)p)); }
__device__ __forceinline__ void pv(f32x16* o, int vb, bf16x8 pa0, bf16x8 pa1, bf16x8 pa2, bf16x8 pa3) {
#pragma unroll
    for (int d0 = 0; d0 < 2; ++d0) { s16x4 lo[4], hi[4];
#pragma unroll
        for (int ks = 0; ks < 4; ++ks) {
            asm volatile("ds_read_b64_tr_b16 %0,%1 offset:%c2" : "=&v"(lo[ks]) : "v"(vb), "i"(d0 * 4096 + ks * 1024) : "memory");
            asm volatile("ds_read_b64_tr_b16 %0,%1 offset:%c2" : "=&v"(hi[ks]) : "v"(vb), "i"(d0 * 4096 + ks * 1024 + 512) : "memory"); }
        asm volatile("s_waitcnt lgkmcnt(0)" ::: "memory"); SBAR();
#define PK(k) (bf16x8){lo[k][0], lo[k][1], lo[k][2], lo[k][3], hi[k][0], hi[k][1], hi[k][2], hi[k][3]}
        o[d0] = __builtin_amdgcn_mfma_f32_32x32x16_bf16(pa0, PK(0), o[d0], 0, 0, 0);
        o[d0] = __builtin_amdgcn_mfma_f32_32x32x16_bf16(pa1, PK(1), o[d0], 0, 0, 0);
        o[d0] = __builtin_amdgcn_mfma_f32_32x32x16_bf16(pa2, PK(2), o[d0], 0, 0, 0);
        o[d0] = __builtin_amdgcn_mfma_f32_32x32x16_bf16(pa3, PK(3), o[d0], 0, 0, 0);
#undef PK
    }
}
template <int KIND>
__device__ __forceinline__ void cinit(f32x16& C0, f32x16& C1, const ALAS float* bl_t  , const ALAS unsigned* mw  , int hi, float negmh) {
    if constexpr (KIND == 1) {
#pragma unroll
        for (int g = 0; g < 4; ++g) { const f32x4a a = *(const ALAS f32x4a*)(bl_t + 8 * g), b = *(const ALAS f32x4a*)(bl_t + 32 + 8 * g);
            C0[4 * g] = a[0] + negmh; C0[4 * g + 1] = a[1] + negmh; C0[4 * g + 2] = a[2] + negmh; C0[4 * g + 3] = a[3] + negmh;
            C1[4 * g] = b[0] + negmh; C1[4 * g + 1] = b[1] + negmh; C1[4 * g + 2] = b[2] + negmh; C1[4 * g + 3] = b[3] + negmh; }
    } else {
        const unsigned w0 = mw[0] >> (4 * hi), w1 = mw[32] >> (4 * hi); const unsigned ninf = 0xff800000u, nm = __float_as_uint(negmh);
#pragma unroll
        for (int r = 0; r < 16; ++r) { const int sh = (r & 3) + 8 * (r >> 2);
            const unsigned m0 = (unsigned)__builtin_amdgcn_sbfe((int)w0, sh, 1), m1 = (unsigned)__builtin_amdgcn_sbfe((int)w1, sh, 1);
            C0[r] = __uint_as_float((m0 & nm) | (~m0 & ninf)); C1[r] = __uint_as_float((m1 & nm) | (~m1 & ninf)); }
    }
}

template <int KIND, int THRL>
__device__ __forceinline__ void attn_unit(int b, int h, int qb, const bf16* Q, const bf16* __restrict__ K, const bf16* __restrict__ V, bf16* O,
                                          const unsigned* __restrict__ MASK, const float* __restrict__ CB, ALAS char* shm) {
    int tid_ = threadIdx.x; asm volatile("" : "+v"(tid_));
    const int tid = tid_, lane = tid & 63, r32 = lane & 31, hi = lane >> 5; const int wid = __builtin_amdgcn_readfirstlane(tid >> 6);
    constexpr int MX = (KIND == 0) ? 1 : 0;
    const long rowbase = (long)b * SEQ; const int q0 = qb * QB;
    const bf16* Qw = Q + (rowbase + q0 + wid * QBLK) * AW + h * 64;
    const bf16* Kh = K + rowbase * AW + h * 64, *Vh = V + rowbase * AW + h * 64;
    const unsigned lds0 = (unsigned)(uintptr_t)shm;
    ALAS float* wsf = (ALAS float*)(shm + LDS_WS) + wid * 64;
    const bf16* ksrc = Kh + (long)lane * AW + wid * 8;
    const bf16* vsrc = Vh + (long)(16 * (wid & 3) + (lane >> 2)) * AW + (wid >> 2) * 32 + (lane & 3) * 8;
    const unsigned kdst = lds0 + LDS_K + wid * 1024, vdst = lds0 + LDS_V + wid * 1024;
#define DMA_K(t, slot) glds16(ksrc + (long)(t) * KVBLK * AW, (unsigned)__builtin_amdgcn_readfirstlane(kdst + (slot)))
#define DMA_V(t, slot) glds16(vsrc + (long)(t) * KVBLK * AW, (unsigned)__builtin_amdgcn_readfirstlane(vdst + (slot)))
    const int qrel = wid * QBLK + r32;
    const unsigned* msrc = MASK + (size_t)(rowbase + q0 + qrel) * 128 + hi;
    const unsigned mdst = lds0 + LDS_M + wid * 512;
#define DMA_M(t) glds4(msrc + 2 * (t), (unsigned)__builtin_amdgcn_readfirstlane(mdst + (((t) & 1) << 8)))
    const ALAS unsigned* mwb = (const ALAS unsigned*)(shm + LDS_M + wid * 512) + r32;
    const ALAS float* blb = (const ALAS float*)(shm + LDS_BIAS) + 4 * hi;
    const float* cbh = CB + (size_t)(b * NH + h) * SEQ;
    const int vb0 = (int)(lds0 + LDS_V) + ((lane >> 4) & 1) * 32 + (lane & 3) * 8 + (4 * hi + ((lane & 15) >> 2)) * 64;
    bf16x8 kf[8];
    const lds_cptr shm3 = (lds_cptr)shm; const lds_cptr kp0 = shm3 + LDS_K + hi * 1024 + r32 * 16; const lds_cptr vp0 = shm3 + LDS_V + ((lane >> 4) & 1) * 32 + (lane & 3) * 8 + (4 * hi + ((lane & 15) >> 2)) * 64;
    const int NT = (q0 + QB) / KVBLK;
    if constexpr (KIND == 1) {
#pragma unroll
        for (int j = 0; j < 2; ++j) { const int piece = 2 * wid + j; if (piece * 256 < q0 + QB) glds16(cbh + piece * 256 + lane * 4, (unsigned)__builtin_amdgcn_readfirstlane(lds0 + LDS_BIAS + piece * 1024)); }
    } else { DMA_M(0); DMA_M(1); }
    DMA_K(0, 0); DMA_V(0, 0); DMA_K(1, SLOTB);
    bf16x8 qr[4];
#pragma unroll
    for (int d0 = 0; d0 < 4; ++d0) qr[d0] = *reinterpret_cast<const bf16x8*>(&Qw[(long)r32 * AW + d0 * 16 + hi * 8]);
    float mhat = 0.f; if constexpr (KIND == 1) mhat = cbh[q0 + qrel];
    float l_reg = 0.f; f32x16 o[2]; o[0] = f32x16{}; o[1] = f32x16{};
#define CMASK(P0, P1, t) do { if constexpr (KIND == 1) { int jb_ = (t) - (NT - 4); if (jb_ >= 0) cmask(P0, P1, jb_, qrel, hi); } } while (0)
    bool resc = false;
#define RESC() do { if (resc) { asm volatile("s_waitcnt lgkmcnt(0)" ::: "memory"); \
      _Pragma("unroll") for (int d_ = 0; d_ < 2; ++d_) _Pragma("unroll") for (int r = 0; r < 16; ++r) o[d_][r] *= wsf[crow(r, hi)]; } } while (0)
    f32x16 pA0, pA1, pB0, pB1;
    int sl_prev = 0, sl_cur = 0, sl_next = SLOTB;
#define ROT() do { sl_prev = sl_cur; sl_cur = sl_next; sl_next = (sl_next == (NSLOT - 1) * SLOTB) ? 0 : sl_next + SLOTB; } while (0)
    DMA_K(2, 2 * SLOTB);
    wait_bar<3>();
    cinit<KIND>(pA0, pA1, blb, mwb, hi, -mhat);
    { const lds_cptr kb = kp0;
#pragma unroll
      for (int d0 = 0; d0 < 4; ++d0) { const bf16x8 b0 = *(const ALAS bf16x8*)(kb + d0 * 2048), b1 = *(const ALAS bf16x8*)(kb + d0 * 2048 + 512);
          pA0 = __builtin_amdgcn_mfma_f32_32x32x16_bf16(b0, qr[d0], pA0, 0, 0, 0); pA1 = __builtin_amdgcn_mfma_f32_32x32x16_bf16(b1, qr[d0], pA1, 0, 0, 0); } }
    asm volatile("s_nop 15\n\ts_nop 7" : "+v"(pA0), "+v"(pA1)); CMASK(pA0, pA1, 0);
    { float rm = __builtin_fmaxf(pA0[0], pA1[0]);
#pragma unroll
      for (int r = 1; r < 16; ++r) rm = __builtin_fmaxf(rm, __builtin_fmaxf(pA0[r], pA1[r]));
      { auto rr = __builtin_amdgcn_permlane32_swap(__float_as_uint(rm), __float_as_uint(rm), false, false); rm = __builtin_fmaxf(__uint_as_float(rr[0]), __uint_as_float(rr[1])); }
      if (__any(rm > (float)THRL)) { const float dl = __builtin_fmaxf(rm, 0.f); mhat += dl;
#pragma unroll
          for (int r = 0; r < 16; ++r) { pA0[r] -= dl; pA1[r] -= dl; } } }
#pragma unroll
    for (int r = 0; r < 16; ++r) { pA0[r] = __builtin_amdgcn_exp2f(pA0[r]); pA1[r] = __builtin_amdgcn_exp2f(pA1[r]); }
    wait_bar<0>();
    DMA_K(3, 0); DMA_V(1, SLOTB); if constexpr (MX) DMA_M(2);
    ROT();
    kload8(kf, kp0 + sl_cur);
    wait_bar<2 + MX>();
    s16x4 vlo[8], vhi[8]; u32x4 pw0, pw1, pw2, pw3;
#define PKW(P, B) cvtpk_s(P[B], P[B + 1])
#define PAF(k) __builtin_bit_cast(bf16x8, pw##k)
#define VFR(i) (bf16x8){vlo[i][0], vlo[i][1], vlo[i][2], vlo[i][3], vhi[i][0], vhi[i][1], vhi[i][2], vhi[i][3]}
#define PIN(x) asm volatile("" : "+v"(x))
#define MX3(a, b, c) __builtin_fmaxf(__builtin_fmaxf((a), (b)), (c))
#define GAPA(MF, A0, A1, A2, A3, W0, W1, PW) do { MF; sacc += A0; sacc += A1; sacc += A2; sacc += A3; PIN(sacc); W0; W1; PIN(PW); SBAR(); } while (0)
#define EX(v) __builtin_amdgcn_exp2f(v)
#define GAPB(MF, X, B) do { MF; X[B] = EX(X[B]); X[B + 1] = EX(X[B + 1]); X[B + 2] = EX(X[B + 2]); X[B + 3] = EX(X[B + 3]); PIN(X); SBAR(); } while (0)
#define VRD(i) do { vlo[i] = vtr(vp_ + (((i) >> 2) * 4096 + ((i) & 3) * 1024)); vhi[i] = vtr(vp_ + (((i) >> 2) * 4096 + ((i) & 3) * 1024 + 512)); } while (0)
#define KRD(G, j) do { if (G) { kload2(kf, kp0 + sl_next, j); SBAR(); } } while (0)
#define STEP(C0, C1, P0, P1, t, GK, GV, GL, GM) do { SBAR(); \
    cinit<KIND>(C0, C1, blb + 64 * (t), mwb + (((t) & 1) << 6), hi, -mhat); PIN(C0); PIN(C1); SBAR(); \
    const lds_cptr vp_ = vp0 + sl_prev; \
    VRD(0); SBAR(); float sacc = (P0[0] + P0[1]); \
    GAPA(C0 = __builtin_amdgcn_mfma_f32_32x32x16_bf16(kf[0], qr[0], C0, 0, 0, 0), P0[2], P0[3], P0[4], P0[5],     pw0[0] = PKW(P0, 0), pw0[1] = PKW(P0, 2), pw0); \
    VRD(4); SBAR(); GAPA(C1 = __builtin_amdgcn_mfma_f32_32x32x16_bf16(kf[1], qr[0], C1, 0, 0, 0), P0[6], P0[7], P0[8], P0[9],     pw0[2] = PKW(P0, 4), pw0[3] = PKW(P0, 6), pw0); \
    VRD(1); SBAR(); GAPA(C0 = __builtin_amdgcn_mfma_f32_32x32x16_bf16(kf[2], qr[1], C0, 0, 0, 0),   P0[10], P0[11], P0[12], P0[13], pw1[0] = PKW(P0, 8), pw1[1] = PKW(P0, 10), pw1); \
    VRD(5); SBAR(); GAPA(C1 = __builtin_amdgcn_mfma_f32_32x32x16_bf16(kf[3], qr[1], C1, 0, 0, 0),   P0[14], P0[15], P1[0], P1[1],   pw1[2] = PKW(P0, 12), pw1[3] = PKW(P0, 14), pw1); \
    VRD(2); SBAR(); GAPA(C0 = __builtin_amdgcn_mfma_f32_32x32x16_bf16(kf[4], qr[2], C0, 0, 0, 0),   P1[2], P1[3], P1[4], P1[5],     pw2[0] = PKW(P1, 0), pw2[1] = PKW(P1, 2), pw2); \
    VRD(6); SBAR(); GAPA(C1 = __builtin_amdgcn_mfma_f32_32x32x16_bf16(kf[5], qr[2], C1, 0, 0, 0),   P1[6], P1[7], P1[8], P1[9],     pw2[2] = PKW(P1, 4), pw2[3] = PKW(P1, 6), pw2); \
    VRD(3); SBAR(); GAPA(C0 = __builtin_amdgcn_mfma_f32_32x32x16_bf16(kf[6], qr[3], C0, 0, 0, 0),   P1[10], P1[11], P1[12], P1[13], pw3[0] = PKW(P1, 8), pw3[1] = PKW(P1, 10), pw3); \
    VRD(7); SBAR(); GAPA(C1 = __builtin_amdgcn_mfma_f32_32x32x16_bf16(kf[7], qr[3], C1, 0, 0, 0),   P1[14], P1[15], 0.f, 0.f,       pw3[2] = PKW(P1, 12), pw3[3] = PKW(P1, 14), pw3); \
    l_reg += sacc; \
    if (GK) { DMA_K((t) + 3, sl_cur); } if (GV) { DMA_V((t) + 1, sl_next); } if constexpr (MX) { if (GM) { DMA_M((t) + 2); } } \
    CMASK(C0, C1, t); \
    { float a = MX3(C0[0], C0[1], C1[0]), b = MX3(C0[2], C0[3], C1[1]); a = MX3(a, C1[2], C1[3]); \
      _Pragma("unroll") for (int r = 4; r < 16; r += 4) { a = MX3(a, C0[r], C0[r + 1]); b = MX3(b, C0[r + 2], C0[r + 3]); a = MX3(a, C1[r], C1[r + 1]); b = MX3(b, C1[r + 2], C1[r + 3]); } \
      float rm = __builtin_fmaxf(a, b); { auto rr = __builtin_amdgcn_permlane32_swap(__float_as_uint(rm), __float_as_uint(rm), false, false); rm = __builtin_fmaxf(__uint_as_float(rr[0]), __uint_as_float(rr[1])); } \
      resc = false; \
      if (__builtin_expect(__any(rm > (float)THRL), 0)) { const float dl = __builtin_fmaxf(rm, 0.f); mhat += dl; \
        _Pragma("unroll") for (int r = 0; r < 16; ++r) { C0[r] -= dl; C1[r] -= dl; } \
        const float f = __builtin_amdgcn_exp2f(-dl); l_reg *= f; if (hi == 0) wsf[r32] = f; resc = true; } } \
    SBAR(); \
    GAPB(o[0] = __builtin_amdgcn_mfma_f32_32x32x16_bf16(PAF(0), VFR(0), o[0], 0, 0, 0), C0, 0); \
    GAPB(o[1] = __builtin_amdgcn_mfma_f32_32x32x16_bf16(PAF(0), VFR(4), o[1], 0, 0, 0), C0, 4); \
    KRD(GL, 0); GAPB(o[0] = __builtin_amdgcn_mfma_f32_32x32x16_bf16(PAF(1), VFR(1), o[0], 0, 0, 0), C0, 8); \
    KRD(GL, 1); GAPB(o[1] = __builtin_amdgcn_mfma_f32_32x32x16_bf16(PAF(1), VFR(5), o[1], 0, 0, 0), C0, 12); \
    KRD(GL, 2); GAPB(o[0] = __builtin_amdgcn_mfma_f32_32x32x16_bf16(PAF(2), VFR(2), o[0], 0, 0, 0), C1, 0); \
    KRD(GL, 3); GAPB(o[1] = __builtin_amdgcn_mfma_f32_32x32x16_bf16(PAF(2), VFR(6), o[1], 0, 0, 0), C1, 4); \
    GAPB(o[0] = __builtin_amdgcn_mfma_f32_32x32x16_bf16(PAF(3), VFR(3), o[0], 0, 0, 0), C1, 8); \
    GAPB(o[1] = __builtin_amdgcn_mfma_f32_32x32x16_bf16(PAF(3), VFR(7), o[1], 0, 0, 0), C1, 12); \
    } while (0)
    int t = 1;
#undef CMASK
#define CMASK(P0, P1, t) do { } while (0)
    for (; t + 5 < NT; t += 2) {
        STEP(pB0, pB1, pA0, pA1, t, true, true, true, true);     wait_bar<2 + MX>(); RESC(); ROT();
        STEP(pA0, pA1, pB0, pB1, t + 1, true, true, true, true); wait_bar<2 + MX>(); RESC(); ROT();
    }
#undef CMASK
#define CMASK(P0, P1, t) do { if constexpr (KIND == 1) { int jb_ = (t) - (NT - 4); if (jb_ >= 0) cmask(P0, P1, jb_, qrel, hi); } } while (0)
#define ENDW(tt) do { if ((tt) + 3 < NT) { wait_bar<2 + MX>(); } else if ((tt) + 2 < NT) { wait_bar<1 + MX>(); } else { wait_bar<0>(); } } while (0)
    for (; t + 1 < NT; t += 2) {
        STEP(pB0, pB1, pA0, pA1, t, (t + 3 < NT), (t + 1 < NT), (t + 1 < NT), (t + 2 < NT));       ENDW(t);     RESC(); ROT();
        STEP(pA0, pA1, pB0, pB1, t + 1, (t + 4 < NT), (t + 2 < NT), (t + 2 < NT), (t + 3 < NT));   ENDW(t + 1); RESC(); ROT();
    }
    STEP(pB0, pB1, pA0, pA1, NT - 1, false, false, false, false); RESC();
    { float sacc = pB0[0] + pB0[1];
#pragma unroll
      for (int r = 2; r < 16; ++r) sacc += pB0[r];
#pragma unroll
      for (int r = 0; r < 16; ++r) sacc += pB1[r];
      l_reg += sacc;
      pw0 = (u32x4){PKW(pB0, 0), PKW(pB0, 2), PKW(pB0, 4), PKW(pB0, 6)}; pw1 = (u32x4){PKW(pB0, 8), PKW(pB0, 10), PKW(pB0, 12), PKW(pB0, 14)};
      pw2 = (u32x4){PKW(pB1, 0), PKW(pB1, 2), PKW(pB1, 4), PKW(pB1, 6)}; pw3 = (u32x4){PKW(pB1, 8), PKW(pB1, 10), PKW(pB1, 12), PKW(pB1, 14)};
      SBAR(); pv(o, vb0 + sl_cur, PAF(0), PAF(1), PAF(2), PAF(3)); }
#undef PKW
#undef PAF
#undef VFR
#undef PIN
#undef MX3
#undef GAPA
#undef GAPB
#undef EX
#undef VRD
#undef KRD
#undef STEP
#undef ENDW
    { auto rr = __builtin_amdgcn_permlane32_swap(__float_as_uint(l_reg), __float_as_uint(l_reg), false, false); l_reg = __uint_as_float(rr[0]) + __uint_as_float(rr[1]); }
    if (hi == 0) wsf[32 + r32] = l_reg;
    asm volatile("s_waitcnt lgkmcnt(0)" ::: "memory");
    float rli[16];
#pragma unroll
    for (int r = 0; r < 16; ++r) rli[r] = __builtin_amdgcn_rcpf(wsf[32 + crow(r, hi)]);
    bf16* Ow = O + (rowbase + q0 + wid * QBLK) * AW + h * 64;
    { ALAS bf16* stg = (ALAS bf16*)(shm + LDS_OST) + wid * 2048;
#pragma unroll
      for (int r = 0; r < 16; ++r) { const int orow = crow(r, hi);
#pragma unroll
          for (int d0 = 0; d0 < 2; ++d0) stg[orow * 64 + d0 * 32 + r32] = (bf16)(cvtpk_s(o[d0][r] * rli[r], 0.f) & 0xffffu); }
      asm volatile("s_waitcnt lgkmcnt(0)" ::: "memory");
#pragma unroll
      for (int i = 0; i < 4; ++i) { const int row = i * 8 + (lane >> 3), ch = lane & 7; const u32x4 v = *(const ALAS u32x4*)(stg + row * 64 + ch * 8); *(u32x4*)(Ow + (long)row * AW + ch * 8) = v; } }
    asm volatile("s_waitcnt lgkmcnt(0)\n\ts_barrier" ::: "memory");
#undef DMA_K
#undef DMA_V
#undef DMA_M
#undef CMASK
#undef RESC
#undef ROT
}
#undef SBAR
#undef ALAS
}

static_assert(attn_body::LDS_BYTES <= RING_BYTES, "attention LDS");
#define XB_TMO      128
#define XB_XCNT(j)  (256  + 64 * (j))
#define XB_XSUB(j)  (1280 + 64 * (j))
#define XB_XGEN(j)  (2304 + 64 * (j))
#define XB_TOP      3328
#define XB_TOPGEN   3392
#define XCD_BAR_WORDS 3456
#define XB_SPIN_CAP (1u << 18)

__device__ __forceinline__ unsigned xb_ld(unsigned* p)              { return __hip_atomic_load(p, __ATOMIC_RELAXED, __HIP_MEMORY_SCOPE_AGENT); }
__device__ __forceinline__ unsigned xb_add(unsigned* p, unsigned v) { return __hip_atomic_fetch_add(p, v, __ATOMIC_RELAXED, __HIP_MEMORY_SCOPE_AGENT); }
__device__ __forceinline__ unsigned xb_xcc_id() { return (unsigned)__builtin_amdgcn_s_getreg((3 << 11) | 20) & 0xFu; }
#define XB_SPIN(cond, bar) do { unsigned _sp = 0; while (cond) { __builtin_amdgcn_s_sleep(1); \
    if ((++_sp & 255u) == 0u) { if (xb_ld(&(bar)[XB_TMO])) break; if (_sp > XB_SPIN_CAP) { atomicAdd(&(bar)[XB_TMO], 1u); break; } } } } while (0)

struct XcdBarrier {
    unsigned* bar; unsigned x;
    volatile LAS unsigned* st;
};

__device__ __forceinline__ XcdBarrier xcd_barrier_post(unsigned* bar, volatile LAS unsigned* st) {
    XcdBarrier b; b.bar = bar; b.x = xb_xcc_id(); b.st = st;
    if (threadIdx.x == 0) (void)xb_add(&bar[XB_XCNT(b.x)], 1u);
    return b;
}
__device__ __forceinline__ void xcd_barrier_complete(unsigned* bar, unsigned x, unsigned& nloc, unsigned& nx) {
    const unsigned G = gridDim.x * gridDim.y * gridDim.z;
    unsigned sum, cnt, mine, sp = 0u;
    for (;;) {
        sum = 0u; cnt = 0u; mine = 0u;
#pragma unroll
        for (unsigned j = 0; j < 16; ++j) { const unsigned c = xb_ld(&bar[XB_XCNT(j)]); sum += c; cnt += (c > 0u) ? 1u : 0u; mine = (j == x) ? c : mine; }
        if (sum == G) break;
        __builtin_amdgcn_s_sleep(1);
        if ((++sp & 255u) == 0u) { if (xb_ld(&bar[XB_TMO])) break; if (sp > XB_SPIN_CAP) { atomicAdd(&bar[XB_TMO], 1u); break; } }
    }
    nloc = mine > 0u ? mine : 1u; nx = cnt > 0u ? cnt : 1u;
}

__device__ __forceinline__ void xcd_barrier(const XcdBarrier& b) {
    asm volatile("s_waitcnt vmcnt(0)" ::: "memory");
    __syncthreads();
    if (threadIdx.x == 0) {
        unsigned* bar = b.bar; unsigned bx = b.x;
        asm volatile("" : "+s"(bar), "+s"(bx));
        __builtin_amdgcn_s_waitcnt(0);
        unsigned nloc = b.st[0], nx = b.st[1];
        if (nloc == 0u) { xcd_barrier_complete(bar, bx, nloc, nx); b.st[0] = nloc; b.st[1] = nx; }
        const unsigned old = xb_add(&bar[XB_XSUB(bx)], 1u);
        const unsigned gen = old / nloc;
        if (old + 1u == (gen + 1u) * nloc) {
            __builtin_amdgcn_fence(__ATOMIC_RELEASE, "agent");
            asm volatile("s_waitcnt vmcnt(0)" ::: "memory");
            const unsigned og = xb_add(&bar[XB_TOP], 1u);
            const unsigned tg = og / nx;
            if (og + 1u == (tg + 1u) * nx) xb_add(&bar[XB_TOPGEN], 1u);
            else XB_SPIN(xb_ld(&bar[XB_TOPGEN]) == tg, bar);
            __builtin_amdgcn_fence(__ATOMIC_ACQUIRE, "agent");
            xb_add(&bar[XB_XGEN(bx)], 1u);
            asm volatile("s_waitcnt vmcnt(0)" ::: "memory");
        } else {
            XB_SPIN(xb_ld(&bar[XB_XGEN(bx)]) == gen, bar);
            __builtin_amdgcn_fence(__ATOMIC_ACQUIRE, "agent");
            asm volatile("s_waitcnt vmcnt(0)" ::: "memory");
        }
    }
    __syncthreads();
}
struct Frame {
    LAS unsigned char* lds;
    volatile LAS unsigned* MISC;
    gu32* ctl;
    int tid, lane, wave, G, bid;
    unsigned char* ws; float* out;
};
__device__ __forceinline__ float wave_sum(float v) {
#pragma unroll
    for (int o = 1; o < 64; o <<= 1) v += __shfl_xor(v, o);
    return v;
}

__device__ __forceinline__ int win_colmap(int dr) {
    const int tile = dr >> 8, j = dr & 255;
    if (tile < 4 || tile == 6 || tile == 7) { const int base = (tile < 2) ? 0 : (tile < 4 ? 512 : 1536); return base + 256 * (tile & 1) + 64 * ((j & 127) >> 5) + 32 * (j >> 7) + (j & 31); }
    if (tile < 6) return 1024 + 256 * (tile - 4) + j;
    if (tile < 14) return 2120 + 256 * (tile - 8) + j;
    if (tile < 22) return 3664 + 256 * (tile - 14) + j;
    if (j < 32) return 2048 + j;
    if (j < 40) return 2112 + (j - 32);
    if (j >= 64 && j < 72) return 3656 + (j - 64);
    if (j >= 128 && j < 160) return 2080 + (j - 128);
    return -1;
}
template <int KIND>
__device__ __forceinline__ void conv_item(const float* s0, const float* s1, int K, int Nsrc, int ndst, bf16* dst, int item, LAS unsigned char* scr, int lane) {
    const int nb = ndst >> 6, kb = item / nb, dg = item - kb * nb, k0 = kb << 6, d0 = dg << 6;
    const int nq = lane & 15, dr = d0 + 4 * nq;
    const float* sp = s0; int col;
    if (KIND == 0) col = dr;
    else if (KIND == 1) col = win_colmap(dr);
    else { const int tile = dr >> 8, j = dr & 255; col = 128 * tile + (j & 127); if (j >= 128) sp = s1; }
    f32x4 vv[16];
#pragma unroll
    for (int i = 0; i < 16; ++i) { const int k = 4 * i + (lane >> 4); vv[i] = (f32x4){0.f, 0.f, 0.f, 0.f}; if (col >= 0) vv[i] = *(const f32x4*)(sp + (size_t)(k0 + k) * Nsrc + col); }
#pragma unroll
    for (int i = 0; i < 16; ++i) {
        const int k = 4 * i + (lane >> 4); const f32x4 v = vv[i];
        LAS unsigned short* w = (LAS unsigned short*)(scr + (4 * nq) * 144 + k * 2);
        w[0] = (unsigned short)f2bf(v[0]); w[72] = (unsigned short)f2bf(v[1]); w[144] = (unsigned short)f2bf(v[2]); w[216] = (unsigned short)f2bf(v[3]);
    }
    asm volatile("s_waitcnt lgkmcnt(0)" ::: "memory");
#pragma unroll
    for (int i = 0; i < 8; ++i) { const int n = 8 * i + (lane >> 3), ch = lane & 7;
        const v4u o = *(const LAS v4u*)(scr + n * 144 + ch * 16);
        *(v4u*)(dst + (size_t)(d0 + n) * K + k0 + 8 * ch) = o; }
    asm volatile("s_waitcnt lgkmcnt(0)" ::: "memory");
}
template <int KIND>
__device__ __forceinline__ void conv_matrix(Frame& F, const float* s0, const float* s1, int K, int Nsrc, int ndst, bf16* dst) {
    LAS unsigned char* scr = F.lds + RING_OFF + F.wave * 9216;
    const int gw = F.bid * NWAVES + F.wave, NGW = F.G * NWAVES, nitems = (K >> 6) * (ndst >> 6);
    for (int it = gw; it < nitems; it += NGW) conv_item<KIND>(s0, s1, K, Nsrc, ndst, dst, it, scr, F.lane);
}
__device__ __forceinline__ void sincos_rev(double r, float& s, float& c) {
    const double k = rint(4.0 * r);
    const double y = (r - 0.25 * k) * 6.283185307179586;
    const double y2 = y * y;
    const double sy = y * (1.0 + y2 * (-1.0 / 6 + y2 * (1.0 / 120 + y2 * (-1.0 / 5040 + y2 * (1.0 / 362880 + y2 * (-1.0 / 39916800 + y2 * (1.0 / 6227020800.0)))))));
    const double cy = 1.0 + y2 * (-0.5 + y2 * (1.0 / 24 + y2 * (-1.0 / 720 + y2 * (1.0 / 40320 + y2 * (-1.0 / 3628800 + y2 * (1.0 / 479001600.0))))));
    const int q = ((int)k) & 3;
    const double sv = (q == 0) ? sy : (q == 1) ? cy : (q == 2) ? -sy : -cy;
    const double cv = (q == 0) ? cy : (q == 1) ? -sy : (q == 2) ? -cy : sy;
    s = (float)sv; c = (float)cv;
}
__device__ __forceinline__ void p0_prologue(Frame& F, const float* x_in, const int* pos, const float* w_in, const float* w_a, const float* w_b, const float* w_o, const float* f_g, const float* f_u, const float* f_d) {
    unsigned char* ws = F.ws;
    for (int l = 0; l < 2; ++l) {
        conv_matrix<1>(F, w_in + (size_t)l * DM * PROJ_TOTAL, nullptr, DM, PROJ_TOTAL, PROJ_PAD, (bf16*)(ws + WS_WIN + l * WIN_STRIDE));
        conv_matrix<0>(F, w_a + (size_t)l * AW * DM, nullptr, AW, DM, DM, (bf16*)(ws + WS_WA) + (size_t)l * DM * AW);
        conv_matrix<0>(F, w_b + (size_t)l * AW * DM, nullptr, AW, DM, DM, (bf16*)(ws + WS_WB) + (size_t)l * DM * AW);
        conv_matrix<0>(F, w_o + (size_t)l * DM * DM, nullptr, DM, DM, DM, (bf16*)(ws + WS_WOUT) + (size_t)l * DM * DM);
    }
    conv_matrix<2>(F, f_g, f_u, DM, DFF, 2 * DFF, (bf16*)(ws + WS_FGU));
    conv_matrix<0>(F, f_d, nullptr, DFF, DM, DM, (bf16*)(ws + WS_FD));
    const int gt = F.bid * (NWAVES * 64) + F.tid, NGT = F.G * NWAVES * 64;
    { const f32x4* x4 = (const f32x4*)x_in; v2u* o2 = (v2u*)(ws + WS_XS);
      for (int i = gt; i < NTOK * DM / 4; i += NGT) { const f32x4 v = x4[i]; v2u o; o.x = pk2(v[0], v[1]); o.y = pk2(v[2], v[3]); o2[i] = o; } }
    { float* cs = (float*)(ws + WS_CS);
      for (int i = gt; i < NTOK * 32; i += NGT) { const int tok = i >> 5, fi = i & 31;
          const float invf = (float)exp2(-(double)fi * (13.287712379549449 / 32.0));
          const float ang = (float)pos[tok] * invf;
          double rev = (double)ang * 0.15915494309189535; rev -= floor(rev);
          float s, c; sincos_rev(rev, s, c); cs[2 * i] = c; cs[2 * i + 1] = s; } }
}
__device__ __forceinline__ void moe_convert(Frame& F, const float* wg, const float* wu, const float* wd) {
    bf16* gu = (bf16*)F.out; bf16* dn = (bf16*)(F.ws + WS_MWD);
    LAS unsigned char* scr = F.lds + RING_OFF + F.wave * 9216;
    const int gw = F.bid * NWAVES + F.wave, NGW = F.G * NWAVES;
    constexpr int IGU = (DM >> 6) * (2 * DFF >> 6), IDN = (DFF >> 6) * (DM >> 6);
    for (int it = gw; it < NEXP * (IGU + IDN); it += NGW) {
        const int e = it / (IGU + IDN), r = it - e * (IGU + IDN);
        if (r < IGU) conv_item<2>(wg + (size_t)e * DM * DFF, wu + (size_t)e * DM * DFF, DM, DFF, 2 * DFF, gu + (size_t)e * 2 * DFF * DM, r, scr, F.lane);
        else conv_item<0>(wd + (size_t)e * DFF * DM, nullptr, DFF, DM, DM, dn + (size_t)e * DM * DFF, r - IGU, scr, F.lane);
    }
}

typedef float f32x4i __attribute__((ext_vector_type(4)));
__device__ __forceinline__ unsigned sortkey16(float f) { const unsigned u = __float_as_uint(f); return (u ^ ((u >> 31) ? 0xffffffffu : 0x80000000u)) >> 16; }
__device__ __forceinline__ int wave_suffix_sum(int x, int lane) {
#pragma unroll
    for (int o = 1; o < 64; o <<= 1) { const int t = __shfl_down(x, o); if (lane + o < 64) x += t; }
    return x;
}
__device__ __forceinline__ int hist_select(const LAS unsigned* hist, int K, int lane, int& gt) {
    const v4u c = *(const LAS v4u*)(hist + 4 * lane);
    const int s = (int)(c.x + c.y + c.z + c.w);
    const int above = wave_suffix_sum(s, lane) - s;
    int bin = -1, g = 0;
    int a3 = above, a2 = above + (int)c.w, a1 = a2 + (int)c.z, a0 = a1 + (int)c.y;
    if (a3 < K && K <= a3 + (int)c.w) { bin = 4 * lane + 3; g = a3; }
    else if (a2 < K && K <= a2 + (int)c.z) { bin = 4 * lane + 2; g = a2; }
    else if (a1 < K && K <= a1 + (int)c.y) { bin = 4 * lane + 1; g = a1; }
    else if (a0 < K && K <= a0 + (int)c.x) { bin = 4 * lane + 0; g = a0; }
    const unsigned long long bal = __ballot(bin >= 0);
    const int src = bal ? (int)__builtin_ctzll(bal) : 0;
    gt = __shfl(g, src); return __shfl(bin, src);
}
__device__ __forceinline__ void idx_unit(Frame& F, int b, int qg, const bf16* IQ, const bf16* IK, const float* IW, unsigned* MASK) {
    const int lane = F.lane, wave = F.wave;
    const int t0 = 16 * qg, limit = 64 * (t0 / 64 + 1); const size_t row0 = (size_t)b * SEQ + t0;
    const int nwords = ((limit + 255) >> 8) << 3;
    if (limit <= 256) {
        for (int qq = 0; qq < 2; ++qq) { const int q = 2 * wave + qq; if (lane < nwords) MASK[(row0 + q) * 128 + lane] = (lane < (limit >> 5)) ? 0xffffffffu : 0u; }
        return;
    }
    LAS unsigned char* keys = F.lds;
    LAS unsigned* hist = (LAS unsigned*)(F.lds + IDX_HIST_OFF) + wave * 256;
    {
        const int qc = lane & 15, kq = lane >> 4;
        bf16x8 bq[8][2]; float w[8];
#pragma unroll
        for (int h = 0; h < 8; ++h) { const bf16* p = IQ + (row0 + qc) * AW + h * 64 + 8 * kq; bq[h][0] = *(const bf16x8*)p; bq[h][1] = *(const bf16x8*)(p + 32); }
        { const f32x4 w0 = *(const f32x4*)(IW + (row0 + qc) * 8), w1 = *(const f32x4*)(IW + (row0 + qc) * 8 + 4);
          w[0] = w0[0]; w[1] = w0[1]; w[2] = w0[2]; w[3] = w0[3]; w[4] = w1[0]; w[5] = w1[1]; w[6] = w1[2]; w[7] = w1[3]; }
        const bf16* ikb = IK + ((size_t)b * SEQ + qc) * 64 + 8 * kq;
        const int nkb = limit >> 4;
        bf16x8 a0 = *(const bf16x8*)(ikb + (size_t)wave * 16 * 64), a1 = *(const bf16x8*)(ikb + (size_t)wave * 16 * 64 + 32);
        for (int kb = wave; kb < nkb; kb += 8) {
            const int kn = (kb + 8 < nkb) ? kb + 8 : kb;
            const bf16* pn = ikb + (size_t)kn * 16 * 64;
            const bf16x8 n0 = *(const bf16x8*)pn, n1 = *(const bf16x8*)(pn + 32);
            f32x4i sc = {0.f, 0.f, 0.f, 0.f};
#pragma unroll
            for (int h = 0; h < 8; ++h) {
                f32x4i acc = {0.f, 0.f, 0.f, 0.f};
                acc = __builtin_amdgcn_mfma_f32_16x16x32_bf16(a0, bq[h][0], acc, 0, 0, 0);
                acc = __builtin_amdgcn_mfma_f32_16x16x32_bf16(a1, bq[h][1], acc, 0, 0, 0);
#pragma unroll
                for (int r = 0; r < 4; ++r) sc[r] += w[h] * fmaxf(acc[r], 0.f);
            }
            v2u pk; pk.x = sortkey16(sc[0]) | (sortkey16(sc[1]) << 16); pk.y = sortkey16(sc[2]) | (sortkey16(sc[3]) << 16);
            *(LAS v2u*)(keys + qc * IDX_ROWB + (kb * 16 + 4 * kq) * 2) = pk;
            a0 = n0; a1 = n1;
        }
    }
    __syncthreads();
    for (int qq = 0; qq < 2; ++qq) {
        const int q = 2 * wave + qq; const LAS unsigned char* rowk = keys + q * IDX_ROWB;
        { unsigned z_ = 0u; asm volatile("" : "+v"(z_)); *(LAS v4u*)(hist + 4 * lane) = (v4u){z_, z_, z_, z_}; }
        for (int i = 0; i < (limit >> 8); ++i) { const v2u k4 = *(const LAS v2u*)(rowk + (256 * i + 4 * lane) * 2);
            __hip_atomic_fetch_add(hist + ((k4.x >> 8) & 255u), 1u, __ATOMIC_RELAXED, __HIP_MEMORY_SCOPE_WORKGROUP); __hip_atomic_fetch_add(hist + (k4.x >> 24), 1u, __ATOMIC_RELAXED, __HIP_MEMORY_SCOPE_WORKGROUP);
            __hip_atomic_fetch_add(hist + ((k4.y >> 8) & 255u), 1u, __ATOMIC_RELAXED, __HIP_MEMORY_SCOPE_WORKGROUP); __hip_atomic_fetch_add(hist + (k4.y >> 24), 1u, __ATOMIC_RELAXED, __HIP_MEMORY_SCOPE_WORKGROUP); }
        asm volatile("s_waitcnt lgkmcnt(0)" ::: "memory");
        int gt1; const int b1 = hist_select(hist, DSA_TOPK, lane, gt1);
        { unsigned z_ = 0u; asm volatile("" : "+v"(z_)); *(LAS v4u*)(hist + 4 * lane) = (v4u){z_, z_, z_, z_}; }
        for (int i = 0; i < (limit >> 8); ++i) { const v2u k4 = *(const LAS v2u*)(rowk + (256 * i + 4 * lane) * 2);
            const unsigned e0 = k4.x & 0xffffu, e1 = k4.x >> 16, e2 = k4.y & 0xffffu, e3 = k4.y >> 16;
            if ((int)(e0 >> 8) == b1) __hip_atomic_fetch_add(hist + (e0 & 255u), 1u, __ATOMIC_RELAXED, __HIP_MEMORY_SCOPE_WORKGROUP);
            if ((int)(e1 >> 8) == b1) __hip_atomic_fetch_add(hist + (e1 & 255u), 1u, __ATOMIC_RELAXED, __HIP_MEMORY_SCOPE_WORKGROUP);
            if ((int)(e2 >> 8) == b1) __hip_atomic_fetch_add(hist + (e2 & 255u), 1u, __ATOMIC_RELAXED, __HIP_MEMORY_SCOPE_WORKGROUP);
            if ((int)(e3 >> 8) == b1) __hip_atomic_fetch_add(hist + (e3 & 255u), 1u, __ATOMIC_RELAXED, __HIP_MEMORY_SCOPE_WORKGROUP); }
        asm volatile("s_waitcnt lgkmcnt(0)" ::: "memory");
        int gt2; const int b2 = hist_select(hist, DSA_TOPK - gt1, lane, gt2);
        const unsigned thr = ((unsigned)b1 << 8) | (unsigned)b2; const int need = DSA_TOPK - gt1 - gt2;
        unsigned long long mine = 0ull; int running = 0;
        for (int i = 0; i < (limit >> 6); ++i) {
            const unsigned k = *(const LAS unsigned short*)(rowk + (64 * i + lane) * 2);
            const bool eq = (k == thr);
            const unsigned long long eqm = __ballot(eq);
            const int rank = running + __popcll(eqm & ((1ull << lane) - 1ull));
            const bool sel = (k > thr) || (eq && rank < need);
            const unsigned long long m = __ballot(sel);
            running += __popcll(eqm);
            if (lane == i) mine = m;
        }
        if (lane < (nwords >> 1)) *(unsigned long long*)(MASK + (row0 + q) * 128 + 2 * lane) = mine;
    }
    __syncthreads();
}
__device__ __forceinline__ void idx_phase(Frame& F, const bf16* IQ, const bf16* IK, const float* IW, const float* LOGF, float* CB, unsigned* MASK) {
    const int gw = F.bid * NWAVES + F.wave;
    if (gw < BATCH * NH) {
        const int b = gw >> 3, h = gw & 7; float carry = 0.f;
        for (int i = 0; i < SEQ / 64; ++i) {
            const int t = 64 * i + F.lane;
            float v = LOGF[((size_t)b * SEQ + t) * 8 + h];
#pragma unroll
            for (int o = 1; o < 64; o <<= 1) { const float u = __shfl_up(v, o); if (F.lane >= o) v += u; }
            const float c = carry + v;
            CB[(size_t)(b * NH + h) * SEQ + t] = -c * LOG2E;
            carry = __shfl(c, 63);
        }
    }
    for (int k = F.bid; k < BATCH * (SEQ / 16); k += F.G) {
        const int round = k >> 8, pos = k & 255, i = (round << 8) + ((round & 1) ? 255 - pos : pos);
        idx_unit(F, i & 7, 255 - (i >> 3), IQ, IK, IW, MASK);
    }
}

__device__ __forceinline__ void attn_phase(Frame& F, const bf16* DQ, const bf16* DK, const bf16* DV, const bf16* FQ, const bf16* FK, const bf16* FV, const unsigned* MASK, const float* CB) {
    for (int k = F.bid; k < 2 * BATCH * NH * (SEQ / 256); k += F.G) {
        const int round = k >> 8, pos = k & 255, i = (round << 8) + ((round & 1) ? 255 - pos : pos);
        const int qb = 15 - (i >> 7), r = i & 127, kind = r >> 6, b = (r >> 3) & 7, h = r & 7;
        if (kind == 0) attn_body::attn_unit<0, 8>(b, h, qb, DQ, DK, DV, (bf16*)DQ, MASK, CB, (LAS char*)F.lds);
        else attn_body::attn_unit<1, 8>(b, h, qb, FQ, FK, FV, (bf16*)FQ, MASK, CB, (LAS char*)F.lds);
    }
}

template <int MODE>
__device__ __forceinline__ void ln_phase(Frame& F, const float* gam, const float* bet, const float* router) {
    const float* Y = F.out; bf16* XS = (bf16*)(F.ws + WS_XS);
    const int tpb = NTOK / F.G, r_lo = F.bid * tpb;
    LAS unsigned* cnt = (LAS unsigned*)(F.lds + RING_OFF);
    if (MODE == 1) { if (F.tid < 8) cnt[F.tid] = 0u; __syncthreads(); }
    f32x4 g4[4], b4[4];
#pragma unroll
    for (int j = 0; j < 4; ++j) { g4[j] = *(const f32x4*)(gam + 4 * F.lane + 256 * j); b4[j] = *(const f32x4*)(bet + 4 * F.lane + 256 * j); }
    f32x4 vn[4];
    if (MODE != 3) {
#pragma unroll
        for (int j = 0; j < 4; ++j) vn[j] = *(const f32x4*)(Y + (size_t)(r_lo + F.wave) * DM + 4 * F.lane + 256 * j);
    }
    for (int rr = F.wave; rr < tpb; rr += NWAVES) {
        const int row = r_lo + rr;
        f32x4 v[4]; float s = 0.f;
        if (MODE == 3) {
            const int* ts = (const int*)(F.ws + MOE_TOKSLOT) + 2 * row; const int s0 = ts[0], s1 = ts[1];
            const bf16* yb = (const bf16*)(F.ws + WS_YB);
#pragma unroll
            for (int j = 0; j < 4; ++j) { const int c = 4 * F.lane + 256 * j;
                const v2u xr = *(const v2u*)(XS + (size_t)row * DM + c), y0 = *(const v2u*)(yb + (size_t)s0 * DM + c), y1 = *(const v2u*)(yb + (size_t)s1 * DM + c);
                v[j][0] = ALPHA * pg8::bf2f(xr.x & 0xffffu) + (pg8::bf2f(y0.x & 0xffffu) + pg8::bf2f(y1.x & 0xffffu));
                v[j][1] = ALPHA * __uint_as_float(xr.x & 0xffff0000u) + (__uint_as_float(y0.x & 0xffff0000u) + __uint_as_float(y1.x & 0xffff0000u));
                v[j][2] = ALPHA * pg8::bf2f(xr.y & 0xffffu) + (pg8::bf2f(y0.y & 0xffffu) + pg8::bf2f(y1.y & 0xffffu));
                v[j][3] = ALPHA * __uint_as_float(xr.y & 0xffff0000u) + (__uint_as_float(y0.y & 0xffff0000u) + __uint_as_float(y1.y & 0xffff0000u)); }
        } else {
#pragma unroll
            for (int j = 0; j < 4; ++j) v[j] = vn[j];
            const int rn = (rr + NWAVES < tpb) ? row + NWAVES : row;
#pragma unroll
            for (int j = 0; j < 4; ++j) vn[j] = *(const f32x4*)(Y + (size_t)rn * DM + 4 * F.lane + 256 * j);
        }
#pragma unroll
        for (int j = 0; j < 4; ++j) s += (v[j][0] + v[j][1]) + (v[j][2] + v[j][3]);
        const float mean = wave_sum(s) * (1.f / DM); float s2 = 0.f;
#pragma unroll
        for (int j = 0; j < 4; ++j) { v[j] = v[j] - mean; s2 += (v[j][0] * v[j][0] + v[j][1] * v[j][1]) + (v[j][2] * v[j][2] + v[j][3] * v[j][3]); }
        const float rstd = 1.f / sqrtf(wave_sum(s2) * (1.f / DM) + LN_EPS);
#pragma unroll
        for (int j = 0; j < 4; ++j) v[j] = v[j] * rstd * g4[j] + b4[j];
        if (MODE == 0 || MODE == 2 || MODE == 3) {
#pragma unroll
            for (int j = 0; j < 4; ++j) *(f32x4*)(F.out + (size_t)row * DM + 4 * F.lane + 256 * j) = v[j];
        }
        if (MODE == 0 || MODE == 1) {
#pragma unroll
            for (int j = 0; j < 4; ++j) { v2u o; o.x = pk2(v[j][0], v[j][1]); o.y = pk2(v[j][2], v[j][3]); *(v2u*)(XS + (size_t)row * DM + 4 * F.lane + 256 * j) = o; }
        }
        if (MODE == 1) {
            float lg[8];
#pragma unroll
            for (int e = 0; e < 8; ++e) lg[e] = 0.f;
#pragma unroll
            for (int j = 0; j < 4; ++j)
#pragma unroll
                for (int c = 0; c < 4; ++c) { const float* rp = router + (size_t)(4 * F.lane + 256 * j + c) * 8; const f32x4 r0 = *(const f32x4*)rp, r1 = *(const f32x4*)(rp + 4); const float x = v[j][c];
                    lg[0] += x * r0[0]; lg[1] += x * r0[1]; lg[2] += x * r0[2]; lg[3] += x * r0[3]; lg[4] += x * r1[0]; lg[5] += x * r1[1]; lg[6] += x * r1[2]; lg[7] += x * r1[3]; }
#pragma unroll
            for (int e = 0; e < 8; ++e) lg[e] = wave_sum(lg[e]);
            float bv = lg[0]; int bi = 0;
#pragma unroll
            for (int e = 1; e < 8; ++e) if (lg[e] > bv) { bv = lg[e]; bi = e; }
            float sv = -INFINITY; int si = 0;
#pragma unroll
            for (int e = 0; e < 8; ++e) if (e != bi && lg[e] > sv) { sv = lg[e]; si = e; }
            if (F.lane == 0) {
                const float g0 = 1.f / (1.f + __expf(sv - bv));
                ((unsigned*)(F.ws + MOE_TOPE))[row] = (unsigned)bi | ((unsigned)si << 8);
                float* tg = (float*)(F.ws + MOE_TOPG) + 2 * row; tg[0] = g0; tg[1] = 1.f - g0;
                __hip_atomic_fetch_add(cnt + bi, 1u, __ATOMIC_RELAXED, __HIP_MEMORY_SCOPE_WORKGROUP); __hip_atomic_fetch_add(cnt + si, 1u, __ATOMIC_RELAXED, __HIP_MEMORY_SCOPE_WORKGROUP);
            }
        }
    }
    if (MODE == 1) { __syncthreads(); if (F.tid < 8) ((unsigned*)(F.ws + MOE_CNT))[F.bid * 8 + F.tid] = cnt[F.tid]; }
}

__device__ __forceinline__ void moe_assign(Frame& F) {
    const unsigned* CNT = (const unsigned*)(F.ws + MOE_CNT);
    LAS int* part = (LAS int*)(F.lds + RING_OFF);
    LAS int* tot = part + 512;
    LAS int* base = tot + 8; LAS int* pst = tot + 16; LAS int* wcnt = tot + 24;
    const int G = F.G, tpb = NTOK / G, j = F.bid;
    __syncthreads();
    { const int e = F.tid & 7, grp = F.tid >> 3; int s = 0;
      const int gsz = (G + 63) / 64;
      for (int jj = grp * gsz; jj < (grp + 1) * gsz && jj < G; ++jj) s += (int)CNT[jj * 8 + e];
      part[grp * 8 + e] = s; }
    __syncthreads();
    if (F.tid < 8) { const int e = F.tid, gsz = (G + 63) / 64, myg = j / gsz; int t = 0, bs = 0;
        for (int g = 0; g < 64; ++g) { const int s = part[g * 8 + e]; if (g < myg) bs += s; t += s; }
        for (int jj = myg * gsz; jj < j; ++jj) bs += (int)CNT[jj * 8 + e];
        tot[e] = t; base[e] = bs; if (j == 0) ((int*)(F.ws + MOE_TOT))[e] = t; }
    __syncthreads();
    if (F.tid == 0) { int ps = 0; for (int e = 0; e < 8; ++e) { pst[e] = ps; ps += ((tot[e] + 255) >> 8) << 8; } }
    const unsigned* TOPE = (const unsigned*)(F.ws + MOE_TOPE); const float* TOPG = (const float*)(F.ws + MOE_TOPG);
    int* SLOTTOK = (int*)(F.ws + MOE_SLOTTOK); float* SLOTGATE = (float*)(F.ws + MOE_SLOTGATE); int* TOKSLOT = (int*)(F.ws + MOE_TOKSLOT);
    const int na = 2 * tpb;
    int done_before[8];
#pragma unroll
    for (int e = 0; e < 8; ++e) done_before[e] = 0;
    for (int a0 = 0; a0 < na; a0 += NWAVES * 64) {
        const int a = a0 + F.tid; const bool valid = a < na;
        const int tok = j * tpb + (a >> 1), k = a & 1;
        int e = -1; if (valid) { const unsigned te = TOPE[tok]; e = (int)((te >> (8 * k)) & 255u); }
        int rank = 0;
#pragma unroll
        for (int x = 0; x < 8; ++x) { const unsigned long long bm = __ballot(e == x); if (e == x) rank = __popcll(bm & ((1ull << F.lane) - 1ull)); if (F.lane == 0) wcnt[F.wave * 8 + x] = __popcll(bm); }
        __syncthreads();
        if (valid) { int pre = 0, all = 0;
#pragma unroll
            for (int x = 0; x < 8; ++x) { int ps = 0, al = 0;
#pragma unroll
                for (int w = 0; w < NWAVES; ++w) { const int c = wcnt[w * 8 + x]; if (w < F.wave) ps += c; al += c; }
                if (e == x) { pre = ps + done_before[x]; } all = al; done_before[x] += all; }
            const int slot = pst[e] + base[e] + pre + rank;
            SLOTTOK[slot] = tok; SLOTGATE[slot] = TOPG[2 * tok + k]; TOKSLOT[2 * tok + k] = slot;
        } else {
#pragma unroll
            for (int x = 0; x < 8; ++x) { int al = 0;
#pragma unroll
                for (int w = 0; w < NWAVES; ++w) al += wcnt[w * 8 + x];
                done_before[x] += al; }
        }
        __syncthreads();
    }
    if (j < 8) { const int e = j, t = tot[e], padded = ((t + 255) >> 8) << 8; for (int s = t + F.tid; s < padded; s += NWAVES * 64) { SLOTTOK[pst[e] + s] = 0; SLOTGATE[pst[e] + s] = 0.f; } }
    __syncthreads();
}

constexpr int NPHASE = 27;
__device__ __forceinline__ const void* kin_load(const __attribute__((address_space(4))) char* ka, int i) {
    int z; asm volatile("s_mov_b32 %0, 0" : "=s"(z));
    return *(const void* const __attribute__((address_space(4)))*)(ka + 8 * (i + z));
}
struct Args { const void* in[18]; float* out; unsigned char* ws; int ph_lo, ph_hi; };
__global__ void __launch_bounds__(NWAVES * 64, 2) mk_fwd(Args args) {
    extern __shared__ __attribute__((aligned(16))) unsigned char lds[];
    Frame F;
    F.lds = (LAS unsigned char*)lds;
    F.MISC = (volatile LAS unsigned*)(F.lds + MISC_OFF);
    F.tid = threadIdx.x; F.lane = F.tid & 63; F.wave = __builtin_amdgcn_readfirstlane(F.tid >> 6);
    F.G = gridDim.x; F.bid = blockIdx.x;
    F.ws = args.ws; F.out = args.out; F.ctl = (gu32*)(args.ws + WS_CTL);
    const __attribute__((address_space(4))) char* KA = (const __attribute__((address_space(4))) char*)__builtin_amdgcn_kernarg_segment_ptr();
#define KIN(T, i) ((T)kin_load(KA, (i)))
    for (int u = F.tid; u < (LDS_BYTES - MISC_OFF) / 4; u += NWAVES * 64) ((LAS unsigned*)(F.lds + MISC_OFF))[u] = 0u;
    __syncthreads();
    const int lo = args.ph_lo, hi = args.ph_hi;
    XcdBarrier bar; bar.bar = (unsigned*)(F.ctl + CW_BAR); bar.x = 0; bar.st = nullptr;
    if (hi - lo > 1) bar = xcd_barrier_post((unsigned*)(F.ctl + CW_BAR), F.MISC + 8);
#ifndef PHS
#define PHS(s) 1
#endif
#ifndef DUP_SLOT
#define DUP_SLOT -1
#endif
#define NREP(s) (((s) == (DUP_SLOT)) ? 2 : 1)
#define IN(k) (lo <= (k) && (k) < hi)
#define PHASE_BEGIN() do { int t_ = threadIdx.x; asm volatile("" : "+v"(t_)); F.tid = t_; F.lane = t_ & 63; F.wave = __builtin_amdgcn_readfirstlane(t_ >> 6); } while (0)
#define INS(s) (PHS(s) && IN(pb + (s)))
#define INM(s) (PHS((s) + 20) && IN(pb + (s)))
#define SEAM(k) do { if (IN((k) + 1)) xcd_barrier(bar); } while (0)
    unsigned char* ws = args.ws;
#define XS ((bf16*)(ws + WS_XS))
#define DQ ((bf16*)(ws + WS_DQ))
#define DK ((bf16*)(ws + WS_DK))
#define DV ((bf16*)(ws + WS_DV))
#define IQ ((bf16*)(ws + WS_IQ))
#define FQ ((bf16*)(ws + WS_FQ))
#define FK ((bf16*)(ws + WS_FK))
#define FV ((bf16*)(ws + WS_FV))
#define GA ((bf16*)(ws + WS_GA))
#define GB ((bf16*)(ws + WS_GB))
#define IK ((bf16*)(ws + WS_IK))
#define MERGED ((bf16*)(ws + WS_MERGED))
#define IW ((float*)(ws + WS_IW))
#define LOGF ((float*)(ws + WS_LOGF))
#define CB ((float*)(ws + WS_CB))
#define MASK ((unsigned*)(ws + WS_MASK))

    if (PHS(100) && IN(0)) { for (int rep_ = 0; rep_ < NREP(100); ++rep_) { PHASE_BEGIN(); p0_prologue(F, KIN(const float*, 0), KIN(const int*, 1), KIN(const float*, 2), KIN(const float*, 4), KIN(const float*, 5), KIN(const float*, 6), KIN(const float*, 11), KIN(const float*, 12), KIN(const float*, 13)); if (rep_ + 1 < NREP(100)) xcd_barrier(bar); } SEAM(0); }

    for (int layer = 0; layer < 2; ++layer) {
        const int pb = 1 + 13 * layer; const bool moe = (layer & 1) != 0;
        if (INS(0)) { for (int rep_ = 0; rep_ < NREP(0); ++rep_) { PHASE_BEGIN();
            pg8::Gemm g{XS, (const bf16*)(ws + WS_WIN + layer * WIN_STRIDE), NTOK, PROJ_PAD, DM}; pg8::StaticOrder S; S.init(NTOK, PROJ_PAD, F.G, F.bid);
            pg8::EpiProj E{ws, KIN(const float*, 3) + layer * NH};
            pg8::gemm_phase<pg8::EpiProj, pg8::StaticOrder, true, true>(F.lds + RING_OFF, g, S, E);
            if (rep_ + 1 < NREP(0)) xcd_barrier(bar); } SEAM(pb + 0);
        }
        if (INS(1)) { for (int rep_ = 0; rep_ < NREP(1); ++rep_) { PHASE_BEGIN(); idx_phase(F, IQ, IK, IW, LOGF, CB, MASK); if (rep_ + 1 < NREP(1)) xcd_barrier(bar); } SEAM(pb + 1); }
        if (INS(2)) { for (int rep_ = 0; rep_ < NREP(2); ++rep_) { PHASE_BEGIN(); attn_phase(F, DQ, DK, DV, FQ, FK, FV, MASK, CB); if (rep_ + 1 < NREP(2)) xcd_barrier(bar); } SEAM(pb + 2); }
        if (INS(3)) { for (int rep_ = 0; rep_ < NREP(3); ++rep_) { PHASE_BEGIN();
            static_assert((WS_FQ - WS_DQ) == (size_t)512 * 256 * AW * 2 && (WS_WB - WS_WA) == (size_t)8 * 256 * AW * 2, "branch B = branch A + 512 row tiles / + 8 column tiles");
            pg8::Gemm g{DQ, (const bf16*)(ws + WS_WA) + (size_t)layer * DM * AW, NTOK, DM, AW}; pg8::D1Order S; S.init(NTOK, DM, F.G, F.bid);
            pg8::EpiGate2 E{MERGED, GA, GB};
            pg8::gemm_phase<pg8::EpiGate2, pg8::D1Order, true, true>(F.lds + RING_OFF, g, S, E);
            if (rep_ + 1 < NREP(3)) xcd_barrier(bar); } SEAM(pb + 3);
        }
        if (INS(5)) { for (int rep_ = 0; rep_ < NREP(5); ++rep_) { PHASE_BEGIN();
            pg8::Gemm g{MERGED, (const bf16*)(ws + WS_WOUT) + (size_t)layer * DM * DM, NTOK, DM, DM}; pg8::StaticOrder S; S.init(NTOK, DM, F.G, F.bid);
            pg8::EpiY E{F.out, layer == 0 ? KIN(const float*, 0) : (const float*)F.out};
            pg8::gemm_phase<pg8::EpiY, pg8::StaticOrder, true, true>(F.lds + RING_OFF, g, S, E);
            if (rep_ + 1 < NREP(5)) xcd_barrier(bar); } SEAM(pb + 5);
        }
        if (INS(6)) { for (int rep_ = 0; rep_ < NREP(6); ++rep_) { PHASE_BEGIN();
            if (moe) ln_phase<1>(F, KIN(const float*, 7) + layer * DM, KIN(const float*, 8) + layer * DM, KIN(const float*, 14) + (size_t)(layer >> 1) * DM * NEXP);
            else ln_phase<0>(F, KIN(const float*, 7) + layer * DM, KIN(const float*, 8) + layer * DM, nullptr);
            if (rep_ + 1 < NREP(6)) xcd_barrier(bar); } SEAM(pb + 6);
        }
        if (!moe) {
            if (INS(8)) { for (int rep_ = 0; rep_ < NREP(8); ++rep_) { PHASE_BEGIN();
                pg8::Gemm g{XS, (const bf16*)(ws + WS_FGU), NTOK, 2 * DFF, DM}; pg8::StaticOrder S; S.init(NTOK, 2 * DFF, F.G, F.bid);
                pg8::EpiSwiglu E{(bf16*)(ws + WS_H), 28};
                pg8::gemm_phase<pg8::EpiSwiglu, pg8::StaticOrder, true, true>(F.lds + RING_OFF, g, S, E);
                if (rep_ + 1 < NREP(8)) xcd_barrier(bar); } SEAM(pb + 8);
            }
            if (INS(9)) { for (int rep_ = 0; rep_ < NREP(9); ++rep_) { PHASE_BEGIN();
                pg8::Gemm g{(const bf16*)(ws + WS_H), (const bf16*)(ws + WS_FD), NTOK, DM, DFF}; pg8::StaticOrder S; S.init(NTOK, DM, F.G, F.bid);
                pg8::EpiY E{F.out, F.out};
                pg8::gemm_phase<pg8::EpiY, pg8::StaticOrder, true, true>(F.lds + RING_OFF, g, S, E);
                if (rep_ + 1 < NREP(9)) xcd_barrier(bar); } SEAM(pb + 9);
            }
            if (INS(12)) { for (int rep_ = 0; rep_ < NREP(12); ++rep_) { PHASE_BEGIN();
                ln_phase<0>(F, KIN(const float*, 9) + layer * DM, KIN(const float*, 10) + layer * DM, nullptr);
                if (rep_ + 1 < NREP(12)) xcd_barrier(bar); } SEAM(pb + 12);
            }
        } else {
            if (INS(7)) { for (int rep_ = 0; rep_ < NREP(7); ++rep_) { PHASE_BEGIN(); moe_convert(F, KIN(const float*, 15), KIN(const float*, 16), KIN(const float*, 17)); moe_assign(F); if (rep_ + 1 < NREP(7)) xcd_barrier(bar); } SEAM(pb + 7); }
            pg8::MoeOrder MO; MO.G = F.G; MO.c = F.bid; MO.slot_tok = (const int*)(ws + MOE_SLOTTOK);
            if (INM(8) || INM(9) || INM(10) || INM(11)) {
                const int* tot = (const int*)(ws + MOE_TOT); int cs = 0;
#pragma unroll
                for (int e = 0; e < 8; ++e) { cs += (tot[e] + 255) >> 8; MO.cum[e] = cs; }
            } else {
#pragma unroll
                for (int e = 0; e < 8; ++e) MO.cum[e] = 0;
            }
#pragma unroll
            for (int pass = 0; pass < 2; ++pass) {
                const int t_lo = pass * MOE_RT, t_hi = (MO.cum[7] < (pass + 1) * MOE_RT) ? MO.cum[7] : (pass + 1) * MOE_RT;
                if (INM(8 + 2 * pass)) { for (int rep_ = 0; rep_ < NREP(8 + 2 * pass); ++rep_) { PHASE_BEGIN();
                    MO.t_lo = t_lo; MO.t_hi = t_hi > t_lo ? t_hi : t_lo; MO.nc = 28;
                    pg8::Gemm g{XS, (const bf16*)F.out, NTOK, NEXP * 2 * DFF, DM};
                    pg8::EpiSwiglu E{(bf16*)(ws + WS_H2), 28};
                    pg8::gemm_phase<pg8::EpiSwiglu, pg8::MoeOrder, true, true, true>(F.lds + RING_OFF, g, MO, E);
                    if (rep_ + 1 < NREP(8 + 2 * pass)) xcd_barrier(bar); } SEAM(pb + 8 + 2 * pass);
                }
                if (INM(9 + 2 * pass)) { for (int rep_ = 0; rep_ < NREP(9 + 2 * pass); ++rep_) { PHASE_BEGIN();
                    MO.t_lo = t_lo; MO.t_hi = t_hi > t_lo ? t_hi : t_lo; MO.nc = 4;
                    pg8::Gemm g{(const bf16*)(ws + WS_H2), (const bf16*)(ws + WS_MWD), MOE_RT * 256, NEXP * DM, DFF};
                    pg8::EpiDownMoe E{(bf16*)(ws + WS_YB), (const float*)(ws + MOE_SLOTGATE), t_lo};
                    pg8::gemm_phase<pg8::EpiDownMoe, pg8::MoeOrder, true, true>(F.lds + RING_OFF, g, MO, E);
                    if (rep_ + 1 < NREP(9 + 2 * pass)) xcd_barrier(bar); } SEAM(pb + 9 + 2 * pass);
                }
            }
            if (INS(12)) { for (int rep_ = 0; rep_ < NREP(12); ++rep_) { PHASE_BEGIN(); ln_phase<3>(F, KIN(const float*, 9) + layer * DM, KIN(const float*, 10) + layer * DM, nullptr); if (rep_ + 1 < NREP(12)) xcd_barrier(bar); } SEAM(pb + 12); }
        }
    }
#undef IN
#undef INS
#undef SEAM
}


#if MK_MULTI && defined(MK_DUMP)
__global__ void dump_kernel(unsigned char* ws, float* out, int mode) {
    const size_t n = (size_t)NTOK * DM;
    for (size_t i = (size_t)blockIdx.x * blockDim.x + threadIdx.x; i < n; i += (size_t)gridDim.x * blockDim.x) {
        const size_t row = i >> 10; const int c = (int)(i & 1023);
        float v = 0.f;
        auto B = [&](size_t off, int pitch, int col) { return pg8::bf2f(((const bf16*)(ws + off))[row * pitch + col]); };
        if (mode == 1) { if (c < 512) v = B(WS_DQ, 512, c) + 2.f * B(WS_DK, 512, c) + 4.f * B(WS_DV, 512, c) + 8.f * B(WS_IQ, 512, c);
                         else v = B(WS_FQ, 512, c - 512) + 2.f * B(WS_FK, 512, c - 512) + 4.f * B(WS_FV, 512, c - 512) + 8.f * B(WS_IK, 64, c & 63) + ((const float*)(ws + WS_IW))[row * 8 + (c & 7)] + ((const float*)(ws + WS_LOGF))[row * 8 + (c & 7)]; }
        else if (mode == 2) v = B(WS_GA, 1024, c) + 2.f * B(WS_GB, 1024, c);
        else if (mode == 3) { const unsigned w = ((const unsigned*)(ws + WS_MASK))[row * 128 + (c & 127)]; const int qb = (int)((row & 4095) >> 8); v = ((c & 127) < 8 * (qb + 1)) ? (float)((w >> (4 * (c >> 7))) & 0xffffu) : 0.f; }
        else if (mode == 4) v = ((const float*)(ws + WS_CB))[(row >> 12) * 8 * 4096 + (size_t)(c & 7) * 4096 + (row & 4095)];
        else if (mode == 5) v = c < 512 ? B(WS_DQ, 512, c) : B(WS_FQ, 512, c - 512);
        else if (mode == 6) v = B(WS_MERGED, 1024, c);
        else if (mode == 7) v = B(WS_XS, 1024, c);
        out[i] = v;
    }
}
#endif
extern "C" void kernel_launch(void* const* d_in, const int* in_sizes, int n_in, void* d_out, int out_size, void* d_ws, size_t ws_size, hipStream_t stream) {
    static int grid = 0;
    if (grid == 0) {
        if (n_in != 18 || in_sizes[0] != NTOK * DM || out_size != NTOK * DM || ws_size < WS_END) {
            fprintf(stderr, "kernel_launch: unexpected shapes: n_in %d in0 %d out %d ws %zu (need %zu); nothing launched\n", n_in, n_in > 0 ? in_sizes[0] : -1, out_size, ws_size, (size_t)WS_END); grid = -1; return; }
        int dev = 0, cus = 0, per_cu = 0;
        if (hipGetDevice(&dev) != hipSuccess || hipDeviceGetAttribute(&cus, hipDeviceAttributeMultiprocessorCount, dev) != hipSuccess) { fprintf(stderr, "kernel_launch: device query failed\n"); grid = -1; return; }
        if (hipFuncSetAttribute((const void*)mk_fwd, hipFuncAttributeMaxDynamicSharedMemorySize, LDS_BYTES) != hipSuccess) { fprintf(stderr, "kernel_launch: hipFuncSetAttribute failed\n"); grid = -1; return; }
        if (hipOccupancyMaxActiveBlocksPerMultiprocessor(&per_cu, (const void*)mk_fwd, NWAVES * 64, LDS_BYTES) != hipSuccess || per_cu < 1)
            fprintf(stderr, "kernel_launch: note: occupancy query reports %d workgroups per CU\n", per_cu);
        (void)hipGetLastError();
        grid = cus;
        if (grid != 256) fprintf(stderr, "kernel_launch: note: %d CUs (built for 256)\n", grid);
    }
    if (grid < 0) return;
    if (hipMemsetAsync((char*)d_ws + WS_CTL, 0, CTL_ZERO_BYTES, stream) != hipSuccess) { fprintf(stderr, "kernel_launch: memset failed\n"); return; }
    Args a{};
    for (int i = 0; i < 18; ++i) a.in[i] = d_in[i];
    a.out = (float*)d_out; a.ws = (unsigned char*)d_ws;
#if MK_MULTI
#ifndef MK_MAXPH
#define MK_MAXPH NPHASE
#endif
    for (int k = 0; k < MK_MAXPH; ++k) {
        if (k >= 1) { const int layer = (k - 1) / 13, s = (k - 1) % 13; const bool moe = layer & 1;
            if (s == 4 || (!moe && (s == 7 || s == 10 || s == 11))) continue; }
        a.ph_lo = k; a.ph_hi = k + 1;
        hipLaunchKernelGGL(mk_fwd, dim3(grid), dim3(NWAVES * 64), LDS_BYTES, stream, a);
    }
#ifdef MK_DUMP
    hipLaunchKernelGGL(dump_kernel, dim3(2048), dim3(256), 0, stream, (unsigned char*)d_ws, (float*)d_out, MK_DUMP);
#endif
#else
    a.ph_lo = 0; a.ph_hi = NPHASE;
    hipLaunchKernelGGL(mk_fwd, dim3(grid), dim3(NWAVES * 64), LDS_BYTES, stream, a);
#endif
    const hipError_t le = hipPeekAtLastError();
    if (le != hipSuccess) fprintf(stderr, "kernel_launch: launch failed: %s\n", hipGetErrorName(le));
}
```

```cpp
#include <hip/hip_runtime.h>
#include <hip/hip_bf16.h>
#include <cstdio>
#include <cstdint>
#include <cmath>

#ifndef MK_MULTI
#define MK_MULTI 0
#endif

constexpr int BATCH = 8, SEQ = 4096, DM = 1024, NTOK = BATCH * SEQ, AW = 512, NH = 8;
constexpr int PROJ_TOTAL = 5712, PROJ_PAD = 5888, DFF = 3584, NEXP = 8;
constexpr float LN_EPS = 1e-5f;
constexpr float ALPHA = 1.4142135623730951f;
constexpr float LOG2E = 1.4426950408889634f;
constexpr float C2 = 0.125f * LOG2E;
constexpr int DSA_TOPK = 256;
constexpr int MOE_RT = 132;
constexpr int MOE_NT_MAX = 264;

constexpr int NWAVES = 8;
constexpr size_t MiB = 1u << 20;
constexpr size_t WS_CTL = 0, CTL_ZERO_BYTES = 1 * MiB;
constexpr size_t WS_WIN = 1 * MiB;
constexpr size_t WIN_STRIDE = (size_t)PROJ_PAD * DM * 2;
constexpr size_t WS_WA = 24 * MiB, WS_WB = 26 * MiB, WS_WOUT = 28 * MiB;
constexpr size_t WS_FGU = 32 * MiB, WS_FD = 46 * MiB;
constexpr size_t WS_CS = 53 * MiB;
constexpr size_t WS_IW = 61 * MiB, WS_LOGF = 62 * MiB, WS_CB = 63 * MiB;
constexpr size_t WS_MOE = 64 * MiB;
constexpr size_t MOE_TOPE = WS_MOE, MOE_TOPG = WS_MOE + 128 * 1024, MOE_TOKSLOT = WS_MOE + 384 * 1024, MOE_SLOTTOK = WS_MOE + 640 * 1024,
                 MOE_SLOTGATE = WS_MOE + 1024 * 1024, MOE_CNT = WS_MOE + 1408 * 1024, MOE_TOT = MOE_CNT + 16 * 1024;
constexpr size_t WS_XS = 66 * MiB;
constexpr size_t WS_DQ = 130 * MiB, WS_DK = 162 * MiB, WS_DV = 194 * MiB, WS_IQ = 226 * MiB, WS_FQ = 258 * MiB, WS_FK = 290 * MiB, WS_FV = 322 * MiB;
constexpr size_t WS_GA = 354 * MiB, WS_GB = 418 * MiB;
constexpr size_t WS_IK = 482 * MiB, WS_MASK = 486 * MiB;
constexpr size_t WS_MERGED = WS_DK;
constexpr size_t WS_H = 130 * MiB;
constexpr size_t WS_H2 = 130 * MiB;
constexpr size_t WS_YB = 361 * MiB;
constexpr size_t WS_MWD = 493 * MiB;
constexpr size_t WS_END = 549 * MiB;
static_assert(WS_MASK + (size_t)NTOK * 128 * 4 <= WS_END && WS_H2 + (size_t)MOE_RT * 256 * DFF * 2 <= WS_YB && WS_YB + (size_t)MOE_NT_MAX * 256 * DM * 2 <= WS_MWD && WS_MWD + (size_t)NEXP * DM * DFF * 2 <= WS_END, "ws map");
static_assert(WS_WIN + 2 * WIN_STRIDE <= WS_WA && WS_FD + (size_t)DM * DFF * 2 <= WS_CS && WS_H + (size_t)NTOK * DFF * 2 <= WS_GA, "ws map 2");
constexpr int CW_TMO = 0, CW_CODE = 1, CW_BAR = 4096;

constexpr int RING_OFF = 0, RING_BYTES = 131072;
constexpr int IDX_ROWB = 8200;
constexpr int IDX_HIST_OFF = 16 * IDX_ROWB;
constexpr int MISC_OFF = 146432;
constexpr int LDS_BYTES = 147456;
static_assert(IDX_HIST_OFF + 8 * 1024 <= MISC_OFF && MISC_OFF + 128 <= LDS_BYTES, "LDS map");

#define GAS __attribute__((address_space(1)))
#define LAS __attribute__((address_space(3)))
typedef unsigned short bf16;
typedef unsigned v4u __attribute__((ext_vector_type(4)));
typedef unsigned v2u __attribute__((ext_vector_type(2)));
typedef float f32x4 __attribute__((ext_vector_type(4)));
typedef short bf16x8 __attribute__((ext_vector_type(8)));
typedef GAS unsigned gu32;
#define RLX_AGENT __ATOMIC_RELAXED, __HIP_MEMORY_SCOPE_AGENT
__device__ __forceinline__ unsigned f2bf(float f) { unsigned u = __builtin_bit_cast(unsigned, f); return (u + 0x7fffu + ((u >> 16) & 1u)) >> 16; }
__device__ __forceinline__ unsigned pk2(float lo, float hi) { return f2bf(lo) | (f2bf(hi) << 16); }

namespace pg8 {
#define PG8_LAS __attribute__((address_space(3)))
typedef unsigned short bf16_t;
typedef short bf16x8 __attribute__((ext_vector_type(8)));
typedef float f32x4 __attribute__((ext_vector_type(4)));
typedef unsigned u32x4 __attribute__((ext_vector_type(4)));
constexpr int BM = 256, BK = 64, HALF = 128, HTB = HALF * BK * 2  , STAGE_BYTES = 8 * HTB, NXCD = 8, WGM = 8;

__host__ __device__ __forceinline__ int lds_byte(int r, int c) { const int st = (r >> 4) * 2 + (c >> 5), rr = r & 15, cc = c & 31, ob = rr * 64 + cc * 2; return st * 1024 + (ob ^ (((ob >> 9) & 1) << 5)); }
__host__ __device__ __forceinline__ void stage_rc(int b, int& R, int& C) { const int st = b / 1024, sb = b % 1024, swz = sb ^ (((sb >> 9) & 1) << 5); R = (st >> 1) * 16 + swz / 64; C = (st & 1) * 32 + (swz % 64) / 2; }
__host__ __device__ __forceinline__ int perm32(int rho) { const int n = rho >> 4, i = rho & 15; return 8 * (i >> 2) + 4 * n + (i & 3); }

struct Unit { int pm, pn; };
struct Gemm { const bf16_t* A; const bf16_t* Bt; int M, N, K; };

struct StaticOrder {
    int nM, nN, nwg, G, c;
    __host__ __device__ void init(int M, int N, int G_, int c_) { nM = M / BM; nN = N / BM; nwg = nM * nN; G = G_; c = c_; }
    __host__ __device__ bool next(int i, Unit& u) const {
        const long L = (long)i * G + c; if (L >= nwg) return false;
        int wgid = (int)L; { const int q = nwg / NXCD, r = nwg % NXCD, xcd = wgid % NXCD, off = wgid / NXCD; wgid = (xcd < r ? xcd * (q + 1) : r * (q + 1) + (xcd - r) * q) + off; }
        const int nig = WGM * nN, gid = wgid / nig, fm = gid * WGM, gsz = (nM - fm) < WGM ? (nM - fm) : WGM;
        u.pm = fm + ((wgid % nig) % gsz); u.pn = (wgid % nig) / gsz; return true;
    }
    __device__ __forceinline__ void a_ready(const Unit&) const {}
    __device__ __forceinline__ void done(const Unit&) const {}
};
__device__ __forceinline__ unsigned cvt_pk_bf16(float lo, float hi) { unsigned r; asm volatile("v_cvt_pk_bf16_f32 %0, %1, %2" : "=v"(r) : "v"(lo), "v"(hi)); return r; }
typedef float f32x2 __attribute__((ext_vector_type(2)));
template <class Epi, class Sched, bool ALIGN_EPI = false, bool SP2 = false, bool GATHER = false>
__device__ __forceinline__ void gemm_phase(PG8_LAS unsigned char* lds, const Gemm g, const Sched& S, const Epi& E) {
    int tid_ = threadIdx.x; asm volatile("" : "+v"(tid_));
    const int tid = tid_, wid = __builtin_amdgcn_readfirstlane(tid >> 6), lane = tid & 63, wr = wid >> 2, wc = wid & 3, fr = lane & 15, fq = lane >> 4;
    const int K = g.K, nt = K / BK;
    unsigned voffA[2], voffB[2]; int gR[2]; unsigned gC[2];
#pragma unroll
    for (int i = 0; i < 2; ++i) { int R, C; stage_rc(tid * 16 + i * 8192, R, C); const int Rb = Epi::PERM ? ((R & ~31) + perm32(R & 31)) : R;
        voffA[i] = (unsigned)(R * K + C) * 2u; voffB[i] = (unsigned)(Rb * K + C) * 2u; gR[i] = R; gC[i] = (unsigned)C * 2u; }
    static_assert(!GATHER || SP2, "gather mode is written for the SP2 loop only");
    unsigned cv[2][2] = {{0u, 0u}, {0u, 0u}}, nv[2][2] = {{0u, 0u}, {0u, 0u}};
    const size_t kstep = (size_t)(BK * 2);
    const size_t hstep = (size_t)HALF * K * 2;
    const size_t tstep = 2 * hstep;
    const unsigned ldsw = (unsigned)wid * 1024u;
    const int aoff = lds_byte(wr * 64 + fr, fq * 8), boff = lds_byte(wc * 32 + fr, fq * 8);
#define PG8_SA(b, h) (((b) * 2 + (h)) * HTB)
#define PG8_SB(b, h) ((4 + (b) * 2 + (h)) * HTB)
#define PG8_STAGE(bufoff, gbase, voff) do { _Pragma("unroll") for (int _i = 0; _i < 2; ++_i) \
        __builtin_amdgcn_global_load_lds((const unsigned*)((const char*)(gbase) + (voff)[_i]), (PG8_LAS unsigned*)(lds + (bufoff) + ldsw + _i * 8192), 16, 0, 0); } while (0)
#define PG8_STAGE_A(b, h, gbase, VO) do { if constexpr (GATHER) { PG8_STAGE(PG8_SA(b, h), gbase, VO[h]); } else { PG8_STAGE(PG8_SA(b, h), (gbase) + (h) * hstep, voffA); } } while (0)
#define PG8_LDA(dst, b, h) do { _Pragma("unroll") for (int m = 0; m < 4; ++m) _Pragma("unroll") for (int k = 0; k < 2; ++k) dst[m][k] = *(const PG8_LAS bf16x8*)(lds + PG8_SA(b, h) + aoff + m * 2048 + k * 1024); } while (0)
#define PG8_LDB(dst, b, h) do { _Pragma("unroll") for (int n = 0; n < 2; ++n) _Pragma("unroll") for (int k = 0; k < 2; ++k) dst[n][k] = *(const PG8_LAS bf16x8*)(lds + PG8_SB(b, h) + boff + n * 2048 + k * 1024); } while (0)
#define PG8_MMA(ai, bj, At, Bt) do { __builtin_amdgcn_s_setprio(1); _Pragma("unroll") for (int m = 0; m < 4; ++m) _Pragma("unroll") for (int n = 0; n < 2; ++n) _Pragma("unroll") for (int k = 0; k < 2; ++k) \
        acc[ai][bj][m][n] = __builtin_amdgcn_mfma_f32_16x16x32_bf16(Bt[n][k], At[m][k], acc[ai][bj][m][n], 0, 0, 0); __builtin_amdgcn_s_setprio(0); } while (0)
#define PG8_WAIT_V(n) asm volatile("s_waitcnt vmcnt(" #n ")" ::: "memory")
#define PG8_WAIT_L(n) asm volatile("s_waitcnt lgkmcnt(" #n ")" ::: "memory")
#define PG8_BAR __builtin_amdgcn_s_barrier()
#define PG8_SCHED __builtin_amdgcn_sched_barrier(0)
    Unit cur, nxt; int ui = 0;
    if (!S.next(0, cur)) return;
    f32x4 acc[2][2][4][2];
#pragma unroll
    for (int a = 0; a < 2; ++a)
#pragma unroll
        for (int b = 0; b < 2; ++b)
#pragma unroll
            for (int m = 0; m < 4; ++m)
#pragma unroll
                for (int n = 0; n < 2; ++n) acc[a][b][m][n] = (f32x4){0.f, 0.f, 0.f, 0.f};
    bf16x8 At[4][2], B0[2][2], B1[2][2];
    const char* cA = (const char*)g.A + (GATHER ? (size_t)0 : (size_t)cur.pm * tstep);
    if constexpr (GATHER) {
#pragma unroll
        for (int h = 0; h < 2; ++h)
#pragma unroll
            for (int i = 0; i < 2; ++i) { cv[h][i] = (unsigned)S.arow(cur, h * HALF + gR[i]) * (unsigned)(K * 2) + gC[i]; nv[h][i] = cv[h][i]; } } const char* cB = (const char*)g.Bt + (size_t)cur.pn * tstep;
    S.a_ready(cur);
    if constexpr (SP2) {
        PG8_STAGE(PG8_SB(0, 0), cB, voffB); PG8_STAGE(PG8_SB(0, 1), cB + hstep, voffB); PG8_STAGE_A(0, 0, cA, cv); PG8_STAGE_A(0, 1, cA, cv);
        if (wr == 1) PG8_BAR;
        PG8_WAIT_V(2); PG8_BAR;
        PG8_STAGE(PG8_SB(1, 0), cB + kstep, voffB); PG8_STAGE_A(1, 0, cA + kstep, cv); PG8_STAGE(PG8_SB(1, 1), cB + hstep + kstep, voffB);
        PG8_WAIT_V(6); PG8_BAR;
    } else {
        PG8_STAGE(PG8_SB(0, 0), cB, voffB); PG8_STAGE(PG8_SA(0, 0), cA, voffA); PG8_STAGE(PG8_SB(0, 1), cB + hstep, voffB); PG8_STAGE(PG8_SA(0, 1), cA + hstep, voffA);
        if (wr == 1) PG8_BAR;
        PG8_WAIT_V(4); PG8_BAR;
        PG8_STAGE(PG8_SB(1, 0), cB + kstep, voffB); PG8_STAGE_A(1, 0, cA + kstep, cv); PG8_STAGE(PG8_SB(1, 1), cB + hstep + kstep, voffB);
        PG8_WAIT_V(6); PG8_BAR;
    }
    for (;;) {
        const bool has_next = S.next(ui + 1, nxt);
        const char* nA = (has_next && !GATHER) ? (const char*)g.A + (size_t)nxt.pm * tstep : cA;
        if constexpr (GATHER) { if (has_next) {
#pragma unroll
            for (int h = 0; h < 2; ++h)
#pragma unroll
                for (int i = 0; i < 2; ++i) nv[h][i] = (unsigned)S.arow(nxt, h * HALF + gR[i]) * (unsigned)(K * 2) + gC[i]; } } const char* nB = has_next ? (const char*)g.Bt + (size_t)nxt.pn * tstep : cB;
        for (int t = 0; t < nt; t += 2) {
            const bool last = (t == nt - 2);
            const char* a1 = cA + (size_t)(t + 1) * kstep;
            const char* a2 = last ? nA : cA + (size_t)(t + 2) * kstep; const char* b2 = last ? nB : cB + (size_t)(t + 2) * kstep;
            const char* a3 = a2 + kstep; const char* b3 = b2 + kstep;
            if (last && has_next) S.a_ready(nxt);
            unsigned v2[2][2];
#pragma unroll
            for (int h = 0; h < 2; ++h)
#pragma unroll
                for (int i = 0; i < 2; ++i) v2[h][i] = last ? nv[h][i] : cv[h][i];
            if constexpr (SP2) {
            PG8_LDB(B0, 0, 0); PG8_LDB(B1, 0, 1); PG8_SCHED; PG8_LDA(At, 0, 0); PG8_STAGE_A(1, 1, a1, cv);
            PG8_WAIT_V(8); PG8_WAIT_L(0); PG8_BAR; PG8_MMA(0, 0, At, B0); PG8_MMA(0, 1, At, B1); PG8_BAR; PG8_SCHED;
            PG8_LDA(At, 0, 1); PG8_STAGE(PG8_SB(0, 0), b2, voffB); PG8_STAGE(PG8_SB(0, 1), b2 + hstep, voffB); PG8_STAGE_A(0, 0, a2, v2);
            PG8_WAIT_V(8); PG8_WAIT_L(0); PG8_BAR; PG8_MMA(1, 0, At, B0); PG8_MMA(1, 1, At, B1); PG8_BAR; PG8_SCHED;
            PG8_LDB(B0, 1, 0); PG8_LDB(B1, 1, 1); PG8_SCHED; PG8_LDA(At, 1, 0); PG8_STAGE_A(0, 1, a2, v2);
            PG8_WAIT_V(8); PG8_WAIT_L(0); PG8_BAR; PG8_MMA(0, 0, At, B0); PG8_MMA(0, 1, At, B1); PG8_BAR; PG8_SCHED;
            PG8_LDA(At, 1, 1); PG8_STAGE(PG8_SB(1, 0), b3, voffB); PG8_STAGE(PG8_SB(1, 1), b3 + hstep, voffB); PG8_STAGE_A(1, 0, a3, v2);
            PG8_WAIT_V(8); PG8_WAIT_L(0); PG8_BAR; PG8_MMA(1, 0, At, B0); PG8_MMA(1, 1, At, B1); PG8_BAR; PG8_SCHED;
            } else {
            PG8_LDB(B0, 0, 0); PG8_SCHED; PG8_LDA(At, 0, 0); PG8_STAGE(PG8_SA(1, 1), a1 + hstep, voffA);
            PG8_WAIT_L(8); PG8_BAR; PG8_WAIT_L(0); PG8_MMA(0, 0, At, B0); PG8_BAR; PG8_SCHED;
            PG8_LDB(B1, 0, 1); PG8_STAGE(PG8_SB(0, 0), b2, voffB);
            PG8_BAR; PG8_WAIT_L(0); PG8_MMA(0, 1, At, B1); PG8_BAR;
            PG8_LDA(At, 0, 1); PG8_STAGE(PG8_SA(0, 0), a2, voffA);
            PG8_BAR; PG8_WAIT_L(0); PG8_MMA(1, 0, At, B0); PG8_BAR; PG8_SCHED;
            PG8_STAGE(PG8_SB(0, 1), b2 + hstep, voffB);
            PG8_WAIT_V(6); PG8_BAR; PG8_MMA(1, 1, At, B1); PG8_BAR;
            PG8_LDB(B0, 1, 0); PG8_SCHED; PG8_LDA(At, 1, 0); PG8_STAGE(PG8_SA(0, 1), a2 + hstep, voffA);
            PG8_WAIT_L(8); PG8_BAR; PG8_WAIT_L(0); PG8_MMA(0, 0, At, B0); PG8_BAR; PG8_SCHED;
            PG8_LDB(B1, 1, 1); PG8_STAGE(PG8_SB(1, 0), b3, voffB);
            PG8_BAR; PG8_WAIT_L(0); PG8_MMA(0, 1, At, B1); PG8_BAR;
            PG8_LDA(At, 1, 1); PG8_STAGE(PG8_SA(1, 0), a3, voffA);
            PG8_BAR; PG8_WAIT_L(0); PG8_MMA(1, 0, At, B0); PG8_BAR; PG8_SCHED;
            PG8_STAGE(PG8_SB(1, 1), b3 + hstep, voffB);
            PG8_WAIT_V(6); PG8_BAR; PG8_MMA(1, 1, At, B1); PG8_BAR;
            }
        }
        if constexpr (ALIGN_EPI) { if (wr == 0) PG8_BAR; }
        if constexpr (!Epi::AFTER_DRAIN) { E(acc, cur, wr, wc, fr, fq); S.done(cur); }
        if (!has_next) break;
#pragma unroll
        for (int a = 0; a < 2; ++a)
#pragma unroll
            for (int b = 0; b < 2; ++b)
#pragma unroll
                for (int m = 0; m < 4; ++m)
#pragma unroll
                    for (int n = 0; n < 2; ++n) acc[a][b][m][n] = (f32x4){0.f, 0.f, 0.f, 0.f};
        cur = nxt; cA = nA; cB = nB; ++ui;
        if constexpr (GATHER) {
#pragma unroll
            for (int h = 0; h < 2; ++h)
#pragma unroll
                for (int i = 0; i < 2; ++i) cv[h][i] = nv[h][i]; }
        if constexpr (ALIGN_EPI) { if (wr == 1) PG8_BAR; }
    }
    PG8_WAIT_V(0);
    if constexpr (!ALIGN_EPI) { if (wr == 0) PG8_BAR; }
    PG8_BAR;
    if constexpr (Epi::AFTER_DRAIN) { E.fused(acc, cur, wr, wc, fr, fq, lds, wid, lane); S.done(cur); }
#undef PG8_SA
#undef PG8_SB
#undef PG8_STAGE
#undef PG8_STAGE_A
#undef PG8_LDA
#undef PG8_LDB
#undef PG8_MMA
#undef PG8_WAIT_V
#undef PG8_WAIT_L
#undef PG8_BAR
#undef PG8_SCHED
}
}
namespace pg8 {
typedef unsigned u32x2 __attribute__((ext_vector_type(2)));
__device__ __forceinline__ float bf2f(unsigned h16) { return __uint_as_float(h16 << 16); }
__device__ __forceinline__ float sigmoidf_fast(float x) { return __builtin_amdgcn_rcpf(1.0f + __builtin_amdgcn_exp2f(-x * 1.4426950408889634f)); }
typedef float f32x2c __attribute__((ext_vector_type(2))); typedef __bf16 bf16x2c __attribute__((ext_vector_type(2)));
__device__ __forceinline__ unsigned cvt2(float lo, float hi) { f32x2c v = {lo, hi}; bf16x2c b = __builtin_convertvector(v, bf16x2c); return __builtin_bit_cast(unsigned, b); }
__device__ __forceinline__ u32x4 pack8(const f32x4& a, const f32x4& b) { u32x4 w; w.x = cvt2(a[0], a[1]); w.y = cvt2(a[2], a[3]); w.z = cvt2(b[0], b[1]); w.w = cvt2(b[2], b[3]); return w; }
__device__ __forceinline__ void unpack8(const u32x4& w, f32x4& a, f32x4& b) {
    a[0] = bf2f(w.x & 0xffffu); a[1] = __uint_as_float(w.x & 0xffff0000u); a[2] = bf2f(w.y & 0xffffu); a[3] = __uint_as_float(w.y & 0xffff0000u);
    b[0] = bf2f(w.z & 0xffffu); b[1] = __uint_as_float(w.z & 0xffff0000u); b[2] = bf2f(w.w & 0xffffu); b[3] = __uint_as_float(w.w & 0xffff0000u); }

#ifdef DBG_NOSIG
#define SIGF(x) (x)
#else
#define SIGF(x) sigmoidf_fast(x)
#endif
struct EpiProj {
    static constexpr bool PERM = true, AFTER_DRAIN = false;
    unsigned char* ws; const float* bforget;
    __device__ __forceinline__ void operator()(const f32x4 (&acc)[2][2][4][2], const Unit& u, int wr, int wc, int fr, int fq) const {
        const int pn = u.pn; const int row0 = u.pm * BM + wr * 64 + fr;
        bf16_t *DQ = (bf16_t*)(ws + WS_DQ), *DK = (bf16_t*)(ws + WS_DK), *DV = (bf16_t*)(ws + WS_DV), *IQ = (bf16_t*)(ws + WS_IQ), *FQ = (bf16_t*)(ws + WS_FQ), *FK = (bf16_t*)(ws + WS_FK), *FV = (bf16_t*)(ws + WS_FV);
        bf16_t *GA = (bf16_t*)(ws + WS_GA), *GB = (bf16_t*)(ws + WS_GB), *IK = (bf16_t*)(ws + WS_IK); float *IW = (float*)(ws + WS_IW), *LOGF = (float*)(ws + WS_LOGF); const float* CS = (const float*)(ws + WS_CS);
        const bool rot = (pn < 4) || pn == 6 || pn == 7 || (pn == 22 && wc == 0);
        if (rot) {
            bf16_t* dst; int pitch, col1; float sc = 1.f;
            if (pn == 22) { dst = IK; pitch = 64; col1 = 8 * fq; }
            else { dst = pn < 2 ? DQ : (pn < 4 ? DK : IQ); pitch = AW; col1 = (4 * (pn & 1) + wc) * 64 + 8 * fq; if (pn < 2) sc = C2; }
#pragma unroll
            for (int ai = 0; ai < 2; ++ai)
#pragma unroll
                for (int m = 0; m < 4; ++m) {
                    const int row = row0 + ai * HALF + m * 16;
                    const float* cs = CS + (size_t)row * 64 + 16 * fq;
                    const f32x4 t0 = *(const f32x4*)(cs), t1 = *(const f32x4*)(cs + 4), t2 = *(const f32x4*)(cs + 8), t3 = *(const f32x4*)(cs + 12);
                    const f32x4 xa = acc[ai][0][m][0], xb = acc[ai][0][m][1], ya = acc[ai][1][m][0], yb = acc[ai][1][m][1];
                    f32x4 o1a, o1b, o2a, o2b;
                    o1a[0] = (xa[0] * t0[0] - ya[0] * t0[1]) * sc; o2a[0] = (ya[0] * t0[0] + xa[0] * t0[1]) * sc;
                    o1a[1] = (xa[1] * t0[2] - ya[1] * t0[3]) * sc; o2a[1] = (ya[1] * t0[2] + xa[1] * t0[3]) * sc;
                    o1a[2] = (xa[2] * t1[0] - ya[2] * t1[1]) * sc; o2a[2] = (ya[2] * t1[0] + xa[2] * t1[1]) * sc;
                    o1a[3] = (xa[3] * t1[2] - ya[3] * t1[3]) * sc; o2a[3] = (ya[3] * t1[2] + xa[3] * t1[3]) * sc;
                    o1b[0] = (xb[0] * t2[0] - yb[0] * t2[1]) * sc; o2b[0] = (yb[0] * t2[0] + xb[0] * t2[1]) * sc;
                    o1b[1] = (xb[1] * t2[2] - yb[1] * t2[3]) * sc; o2b[1] = (yb[1] * t2[2] + xb[1] * t2[3]) * sc;
                    o1b[2] = (xb[2] * t3[0] - yb[2] * t3[1]) * sc; o2b[2] = (yb[2] * t3[0] + xb[2] * t3[1]) * sc;
                    o1b[3] = (xb[3] * t3[2] - yb[3] * t3[3]) * sc; o2b[3] = (yb[3] * t3[2] + xb[3] * t3[3]) * sc;
                    bf16_t* rp = dst + (size_t)row * pitch + col1;
                    *(u32x4*)(rp) = pack8(o1a, o1b); *(u32x4*)(rp + 32) = pack8(o2a, o2b);
                }
        } else if (pn == 22) {
            if (fq == 0 && (wc == 1 || wc == 2)) {
                f32x4 b0 = {0.f, 0.f, 0.f, 0.f}, b1 = {0.f, 0.f, 0.f, 0.f};
                if (wc == 2) { b0 = *(const f32x4*)(bforget); b1 = *(const f32x4*)(bforget + 4); }
#pragma unroll
                for (int ai = 0; ai < 2; ++ai)
#pragma unroll
                    for (int m = 0; m < 4; ++m) {
                        const int row = row0 + ai * HALF + m * 16;
                        f32x4 va = acc[ai][0][m][0], vb = acc[ai][0][m][1];
                        if (wc == 1) { va = va * 0.04419417382415922f; vb = vb * 0.04419417382415922f;
                            *(f32x4*)(IW + (size_t)row * 8) = va; *(f32x4*)(IW + (size_t)row * 8 + 4) = vb; }
                        else { va = va + b0; vb = vb + b1; f32x4 la, lb;
#pragma unroll
                            for (int i = 0; i < 4; ++i) { const float za = va[i], zb = vb[i];
                                la[i] = fminf(za, 0.f) - log1pf(__expf(-fabsf(za))); lb[i] = fminf(zb, 0.f) - log1pf(__expf(-fabsf(zb))); }
                            float* lp = LOGF + (size_t)(row >> 12) * (NH * SEQ) + (row & (SEQ - 1));
                            lp[0] = la[0]; lp[SEQ] = la[1]; lp[2 * SEQ] = la[2]; lp[3 * SEQ] = la[3]; lp[4 * SEQ] = lb[0]; lp[5 * SEQ] = lb[1]; lp[6 * SEQ] = lb[2]; lp[7 * SEQ] = lb[3]; }
                    }
            }
        } else if (pn < 14) {
            bf16_t* dst = pn < 6 ? DV : (pn < 10 ? FQ : (pn < 12 ? FK : FV)); const float sc = (pn == 8 || pn == 9) ? C2 : 1.f;
            const int col0 = 256 * (pn & 1) + wc * 32 + 8 * fq;
#pragma unroll
            for (int ai = 0; ai < 2; ++ai)
#pragma unroll
                for (int m = 0; m < 4; ++m) { bf16_t* rp = dst + (size_t)(row0 + ai * HALF + m * 16) * AW + col0;
#pragma unroll
                    for (int bj = 0; bj < 2; ++bj) *(u32x4*)(rp + bj * HALF) = pack8(acc[ai][bj][m][0] * sc, acc[ai][bj][m][1] * sc); }
        } else {
            bf16_t* dst = pn < 18 ? GA : GB; const int col0 = 256 * ((pn - 14) & 3) + wc * 32 + 8 * fq;
#pragma unroll
            for (int ai = 0; ai < 2; ++ai)
#pragma unroll
                for (int m = 0; m < 4; ++m) { bf16_t* rp = dst + (size_t)(row0 + ai * HALF + m * 16) * DM + col0;
#pragma unroll
                    for (int bj = 0; bj < 2; ++bj) { f32x4 a = acc[ai][bj][m][0], b = acc[ai][bj][m][1];
#pragma unroll
                        for (int i = 0; i < 4; ++i) { a[i] = SIGF(a[i]); b[i] = SIGF(b[i]); }
                        *(u32x4*)(rp + bj * HALF) = pack8(a, b); } }
        }
    }
};

struct EpiGate2 {
    static constexpr bool PERM = true, AFTER_DRAIN = false;
    bf16_t* O; const bf16_t* GAp; const bf16_t* GBp;
    __device__ __forceinline__ void operator()(const f32x4 (&acc)[2][2][4][2], const Unit& u, int wr, int wc, int fr, int fq) const {
        const int br = u.pm >> 9; const bf16_t* G = br ? GBp : GAp;
        const int row0 = (u.pm & 511) * BM + wr * 64 + fr, col0 = (u.pn & 7) * BM + wc * 32 + 8 * fq;
#pragma unroll
        for (int ai = 0; ai < 2; ++ai) {
            u32x4 gv[4][2], pv_[4][2];
#pragma unroll
            for (int m = 0; m < 4; ++m)
#pragma unroll
                for (int bj = 0; bj < 2; ++bj) { const size_t off = (size_t)(row0 + ai * HALF + m * 16) * DM + col0 + bj * HALF;
                    gv[m][bj] = *(const u32x4*)(G + off); pv_[m][bj] = br ? *(const u32x4*)(O + off) : (u32x4){0u, 0u, 0u, 0u}; }
#pragma unroll
            for (int m = 0; m < 4; ++m)
#pragma unroll
                for (int bj = 0; bj < 2; ++bj) { const size_t off = (size_t)(row0 + ai * HALF + m * 16) * DM + col0 + bj * HALF;
                    f32x4 ga, gb, pa, pb; unpack8(gv[m][bj], ga, gb); unpack8(pv_[m][bj], pa, pb);
                    *(u32x4*)(O + off) = pack8(ga * acc[ai][bj][m][0] + pa, gb * acc[ai][bj][m][1] + pb); }
        }
    }
};
struct D1Order {
    StaticOrder S; int n;
    __device__ __forceinline__ void init(int M, int N, int G, int c) { S.init(M, N, G, c); n = (S.nwg - c + G - 1) / G; if (n < 0) n = 0; }
    __device__ __forceinline__ bool next(int i, Unit& u) const { if (i >= 2 * n) return false; const int br = (i >= n) ? 1 : 0; S.next(i - br * n, u); u.pm += 512 * br; u.pn += 8 * br; return true; }
    __device__ __forceinline__ void a_ready(const Unit&) const {}
    __device__ __forceinline__ void done(const Unit&) const {}
};

struct EpiY {
    static constexpr bool PERM = false, AFTER_DRAIN = false;
    float* Y; const float* R;
    __device__ __forceinline__ void operator()(const f32x4 (&acc)[2][2][4][2], const Unit& u, int wr, int wc, int fr, int fq) const {
        const int row0 = u.pm * BM + wr * 64 + fr, col0 = u.pn * BM + wc * 32 + 4 * fq;
#pragma unroll
        for (int ai = 0; ai < 2; ++ai)
#pragma unroll
            for (int mp = 0; mp < 2; ++mp) {
                f32x4 r[2][2][2];
#pragma unroll
                for (int mm = 0; mm < 2; ++mm)
#pragma unroll
                    for (int bj = 0; bj < 2; ++bj)
#pragma unroll
                        for (int n = 0; n < 2; ++n) r[mm][bj][n] = *(const f32x4*)(R + (size_t)(row0 + ai * HALF + (2 * mp + mm) * 16) * DM + col0 + bj * HALF + n * 16);
#pragma unroll
                for (int mm = 0; mm < 2; ++mm)
#pragma unroll
                    for (int bj = 0; bj < 2; ++bj)
#pragma unroll
                        for (int n = 0; n < 2; ++n) *(f32x4*)(Y + (size_t)(row0 + ai * HALF + (2 * mp + mm) * 16) * DM + col0 + bj * HALF + n * 16) = r[mm][bj][n] * ALPHA + acc[ai][bj][2 * mp + mm][n];
            }
    }
};

struct EpiSwiglu {
    static constexpr bool PERM = true, AFTER_DRAIN = false;
    bf16_t* H; int nc;
    __device__ __forceinline__ void operator()(const f32x4 (&acc)[2][2][4][2], const Unit& u, int wr, int wc, int fr, int fq) const {
        const int row0 = u.pm * BM + wr * 64 + fr, col0 = (u.pn % nc) * HALF + wc * 32 + 8 * fq;
#pragma unroll
        for (int ai = 0; ai < 2; ++ai)
#pragma unroll
            for (int m = 0; m < 4; ++m) { f32x4 a, b;
#pragma unroll
                for (int i = 0; i < 4; ++i) { const float g0 = acc[ai][0][m][0][i], g1 = acc[ai][0][m][1][i];
                    a[i] = g0 * sigmoidf_fast(g0) * acc[ai][1][m][0][i]; b[i] = g1 * sigmoidf_fast(g1) * acc[ai][1][m][1][i]; }
                *(u32x4*)(H + (size_t)(row0 + ai * HALF + m * 16) * DFF + col0) = pack8(a, b); }
    }
};

struct EpiDownMoe {
    static constexpr bool PERM = true, AFTER_DRAIN = false;
    bf16_t* YB; const float* gate; int t_lo;
    __device__ __forceinline__ void operator()(const f32x4 (&acc)[2][2][4][2], const Unit& u, int wr, int wc, int fr, int fq) const {
        const int row0 = (t_lo + u.pm) * BM + wr * 64 + fr, col0 = (u.pn & 3) * BM + wc * 32 + 8 * fq;
#pragma unroll
        for (int ai = 0; ai < 2; ++ai)
#pragma unroll
            for (int m = 0; m < 4; ++m) { const int row = row0 + ai * HALF + m * 16; const float gt = gate[row]; bf16_t* rp = YB + (size_t)row * DM + col0;
#pragma unroll
                for (int bj = 0; bj < 2; ++bj) *(u32x4*)(rp + bj * HALF) = pack8(acc[ai][bj][m][0] * gt, acc[ai][bj][m][1] * gt); }
    }
};

struct MoeOrder {
    int cum[8]; int t_lo, t_hi, nc, G, c; const int* slot_tok;
    __device__ __forceinline__ bool next(int i, Unit& u) const {
        const long L = (long)i * G + c; const int nt = t_hi - t_lo; if (L >= (long)nt * nc) return false;
        const int pml = (int)(L / nc), pnl = (int)(L % nc), tg = t_lo + pml; int e = 0;
#pragma unroll
        for (int j = 0; j < 7; ++j) e += (tg >= cum[j]) ? 1 : 0;
        u.pm = pml; u.pn = e * nc + pnl; return true;
    }
    __device__ __forceinline__ int arow(const Unit& u, int r) const { return slot_tok[(t_lo + u.pm) * BM + r]; }
    __device__ __forceinline__ void a_ready(const Unit&) const {}
    __device__ __forceinline__ void done(const Unit&) const {}
};
}

namespace attn_body {
using bf16 = unsigned short;
using bf16x8 = __attribute__((ext_vector_type(8))) short;
using s16x4 = __attribute__((ext_vector_type(4))) short;
using f32x16 = __attribute__((ext_vector_type(16))) float;
using f32x4a = __attribute__((ext_vector_type(4))) float;
using u32x4 = __attribute__((ext_vector_type(4))) unsigned;
using u32x2 = __attribute__((ext_vector_type(2))) unsigned;
#define ALAS __attribute__((address_space(3)))
constexpr int NW = 8, QBLK = 32, QB = QBLK * NW, KVBLK = 64;
constexpr int NSLOT = 3, SLOTB = 8192;
constexpr int LDS_K = 0, LDS_V = NSLOT * SLOTB, LDS_WS = 2 * NSLOT * SLOTB, LDS_OST = LDS_WS + NW * 64 * 4, LDS_BIAS = LDS_OST + NW * 4096, LDS_M = LDS_BIAS + 16384, LDS_BYTES = LDS_M + NW * 512;
__device__ __forceinline__ int crow(int r, int hi) { return (r & 3) + 8 * (r >> 2) + 4 * hi; }
#define SBAR() __builtin_amdgcn_sched_barrier(0)
__device__ __forceinline__ void cmask(f32x16& p0, f32x16& p1, int jb, int qrel, int hi) {
    const float NEG = -INFINITY; const int kb = 64 * jb + 4 * hi;
#pragma unroll
    for (int r = 0; r < 16; ++r) { const int kv = kb + (r & 3) + 8 * (r >> 2); if (kv > qrel) p0[r] = NEG; if (kv + 32 > qrel) p1[r] = NEG; }
}
__device__ __forceinline__ void glds16(const void* gsrc, unsigned lds_dst) { unsigned keep;
    asm volatile("s_mov_b32 %0, m0\n\ts_mov_b32 m0, %2\n\ts_nop 0\n\tglobal_load_lds_dwordx4 %1, off\n\ts_mov_b32 m0, %0" : "=&s"(keep) : "v"(gsrc), "s"(lds_dst) : "memory"); }
__device__ __forceinline__ void glds4(const void* gsrc, unsigned lds_dst) { unsigned keep;
    asm volatile("s_mov_b32 %0, m0\n\ts_mov_b32 m0, %2\n\ts_nop 0\n\tglobal_load_lds_dword %1, off\n\ts_mov_b32 m0, %0" : "=&s"(keep) : "v"(gsrc), "s"(lds_dst) : "memory"); }
typedef float f32x2_t __attribute__((ext_vector_type(2))); typedef __bf16 bf16x2_t __attribute__((ext_vector_type(2)));
__device__ __forceinline__ unsigned cvtpk_s(float lo, float hi) { f32x2_t v = {lo, hi}; bf16x2_t b = __builtin_convertvector(v, bf16x2_t); return __builtin_bit_cast(unsigned, b); }
template <int N> __device__ __forceinline__ void wait_bar() {
    static_assert(N >= 0 && N <= 4, "wait_bar");
    if constexpr (N == 0) asm volatile("s_waitcnt vmcnt(0) lgkmcnt(0)\n\ts_barrier" ::: "memory");
    else if constexpr (N == 1) asm volatile("s_waitcnt vmcnt(1) lgkmcnt(0)\n\ts_barrier" ::: "memory");
    else if constexpr (N == 2) asm volatile("s_waitcnt vmcnt(2) lgkmcnt(0)\n\ts_barrier" ::: "memory");
    else if constexpr (N == 3) asm volatile("s_waitcnt vmcnt(3) lgkmcnt(0)\n\ts_barrier" ::: "memory");
    else asm volatile("s_waitcnt vmcnt(4) lgkmcnt(0)\n\ts_barrier" ::: "memory");
}
typedef __attribute__((address_space(3))) const char* lds_cptr;
typedef short v4i16_t __attribute__((ext_vector_type(4)));
__device__ __forceinline__ void kload8(bf16x8* kf, lds_cptr kp) {
    kf[0] = *(const ALAS bf16x8*)(kp);        kf[1] = *(const ALAS bf16x8*)(kp + 512);
    kf[2] = *(const ALAS bf16x8*)(kp + 2048); kf[3] = *(const ALAS bf16x8*)(kp + 2560);
    kf[4] = *(const ALAS bf16x8*)(kp + 4096); kf[5] = *(const ALAS bf16x8*)(kp + 4608);
    kf[6] = *(const ALAS bf16x8*)(kp + 6144); kf[7] = *(const ALAS bf16x8*)(kp + 6656);
}
__device__ __forceinline__ void kload2(bf16x8* kf, lds_cptr kp, int j) { kf[2 * j] = *(const ALAS bf16x8*)(kp + j * 2048); kf[2 * j + 1] = *(const ALAS bf16x8*)(kp + j * 2048 + 512); }
__device__ __forceinline__ s16x4 vtr(lds_cptr p) { return __builtin_bit_cast(s16x4, __builtin_amdgcn_ds_read_tr16_b64_v4i16((ALAS v4i16_t*)p)); }
__device__ __forceinline__ void pv(f32x16* o, int vb, bf16x8 pa0, bf16x8 pa1, bf16x8 pa2, bf16x8 pa3) {
#pragma unroll
    for (int d0 = 0; d0 < 2; ++d0) { s16x4 lo[4], hi[4];
#pragma unroll
        for (int ks = 0; ks < 4; ++ks) {
            asm volatile("ds_read_b64_tr_b16 %0,%1 offset:%c2" : "=&v"(lo[ks]) : "v"(vb), "i"(d0 * 4096 + ks * 1024) : "memory");
            asm volatile("ds_read_b64_tr_b16 %0,%1 offset:%c2" : "=&v"(hi[ks]) : "v"(vb), "i"(d0 * 4096 + ks * 1024 + 512) : "memory"); }
        asm volatile("s_waitcnt lgkmcnt(0)" ::: "memory"); SBAR();
#define PK(k) (bf16x8){lo[k][0], lo[k][1], lo[k][2], lo[k][3], hi[k][0], hi[k][1], hi[k][2], hi[k][3]}
        o[d0] = __builtin_amdgcn_mfma_f32_32x32x16_bf16(pa0, PK(0), o[d0], 0, 0, 0);
        o[d0] = __builtin_amdgcn_mfma_f32_32x32x16_bf16(pa1, PK(1), o[d0], 0, 0, 0);
        o[d0] = __builtin_amdgcn_mfma_f32_32x32x16_bf16(pa2, PK(2), o[d0], 0, 0, 0);
        o[d0] = __builtin_amdgcn_mfma_f32_32x32x16_bf16(pa3, PK(3), o[d0], 0, 0, 0);
#undef PK
    }
}
template <int KIND>
__device__ __forceinline__ void cinit(f32x16& C0, f32x16& C1, const ALAS float* bl_t  , const ALAS unsigned* mw  , int hi, float negmh) {
    if constexpr (KIND == 1) {
#pragma unroll
        for (int g = 0; g < 4; ++g) { const f32x4a a = *(const ALAS f32x4a*)(bl_t + 8 * g), b = *(const ALAS f32x4a*)(bl_t + 32 + 8 * g);
            C0[4 * g] = a[0] + negmh; C0[4 * g + 1] = a[1] + negmh; C0[4 * g + 2] = a[2] + negmh; C0[4 * g + 3] = a[3] + negmh;
            C1[4 * g] = b[0] + negmh; C1[4 * g + 1] = b[1] + negmh; C1[4 * g + 2] = b[2] + negmh; C1[4 * g + 3] = b[3] + negmh; }
    } else {
        const unsigned w0 = mw[0] >> (4 * hi), w1 = mw[32] >> (4 * hi); const unsigned ninf = 0xff800000u, nm = __float_as_uint(negmh);
#pragma unroll
        for (int r = 0; r < 16; ++r) { const int sh = (r & 3) + 8 * (r >> 2);
            const unsigned m0 = (unsigned)__builtin_amdgcn_sbfe((int)w0, sh, 1), m1 = (unsigned)__builtin_amdgcn_sbfe((int)w1, sh, 1);
            C0[r] = __uint_as_float((m0 & nm) | (~m0 & ninf)); C1[r] = __uint_as_float((m1 & nm) | (~m1 & ninf)); }
    }
}

template <int KIND, int THRL>
__device__ __forceinline__ void attn_unit(int b, int h, int qb, const bf16* Q, const bf16* __restrict__ K, const bf16* __restrict__ V, bf16* O,
                                          const unsigned* __restrict__ MASK, const float* __restrict__ CB, ALAS char* shm) {
    int tid_ = threadIdx.x; asm volatile("" : "+v"(tid_));
    const int tid = tid_, lane = tid & 63, r32 = lane & 31, hi = lane >> 5; const int wid = __builtin_amdgcn_readfirstlane(tid >> 6);
    constexpr int MX = (KIND == 0) ? 1 : 0;
    const long rowbase = (long)b * SEQ; const int q0 = qb * QB;
    const bf16* Qw = Q + (rowbase + q0 + wid * QBLK) * AW + h * 64;
    const bf16* Kh = K + rowbase * AW + h * 64, *Vh = V + rowbase * AW + h * 64;
    const unsigned lds0 = (unsigned)(uintptr_t)shm;
    ALAS float* wsf = (ALAS float*)(shm + LDS_WS) + wid * 64;
    const bf16* ksrc = Kh + (long)lane * AW + wid * 8;
    const bf16* vsrc = Vh + (long)(16 * (wid & 3) + (lane >> 2)) * AW + (wid >> 2) * 32 + (lane & 3) * 8;
    const unsigned kdst = lds0 + LDS_K + wid * 1024, vdst = lds0 + LDS_V + wid * 1024;
#define DMA_K(t, slot) glds16(ksrc + (long)(t) * KVBLK * AW, (unsigned)__builtin_amdgcn_readfirstlane(kdst + (slot)))
#define DMA_V(t, slot) glds16(vsrc + (long)(t) * KVBLK * AW, (unsigned)__builtin_amdgcn_readfirstlane(vdst + (slot)))
    const int qrel = wid * QBLK + r32;
    const unsigned* msrc = MASK + (size_t)(rowbase + q0 + qrel) * 128 + hi;
    const unsigned mdst = lds0 + LDS_M + wid * 512;
#define DMA_M(t) glds4(msrc + 2 * (t), (unsigned)__builtin_amdgcn_readfirstlane(mdst + (((t) & 1) << 8)))
    const ALAS unsigned* mwb = (const ALAS unsigned*)(shm + LDS_M + wid * 512) + r32;
    const ALAS float* blb = (const ALAS float*)(shm + LDS_BIAS) + 4 * hi;
    const float* cbh = CB + (size_t)(b * NH + h) * SEQ;
    const int vb0 = (int)(lds0 + LDS_V) + ((lane >> 4) & 1) * 32 + (lane & 3) * 8 + (4 * hi + ((lane & 15) >> 2)) * 64;
    bf16x8 kf[8];
    const lds_cptr shm3 = (lds_cptr)shm; const lds_cptr kp0 = shm3 + LDS_K + hi * 1024 + r32 * 16; const lds_cptr vp0 = shm3 + LDS_V + ((lane >> 4) & 1) * 32 + (lane & 3) * 8 + (4 * hi + ((lane & 15) >> 2)) * 64;
    const int NT = (q0 + QB) / KVBLK;
    if constexpr (KIND == 1) {
#pragma unroll
        for (int j = 0; j < 2; ++j) { const int piece = 2 * wid + j; if (piece * 256 < q0 + QB) glds16(cbh + piece * 256 + lane * 4, (unsigned)__builtin_amdgcn_readfirstlane(lds0 + LDS_BIAS + piece * 1024)); }
    } else { DMA_M(0); DMA_M(1); }
    DMA_K(0, 0); DMA_V(0, 0); DMA_K(1, SLOTB);
    bf16x8 qr[4];
#pragma unroll
    for (int d0 = 0; d0 < 4; ++d0) qr[d0] = *reinterpret_cast<const bf16x8*>(&Qw[(long)r32 * AW + d0 * 16 + hi * 8]);
    float mhat = 0.f; if constexpr (KIND == 1) mhat = cbh[q0 + qrel];
    float l_reg = 0.f; f32x16 o[2]; o[0] = f32x16{}; o[1] = f32x16{};
#define CMASK(P0, P1, t) do { if constexpr (KIND == 1) { int jb_ = (t) - (NT - 4); if (jb_ >= 0) cmask(P0, P1, jb_, qrel, hi); } } while (0)
    bool resc = false;
#define RESC() do { if (resc) { asm volatile("s_waitcnt lgkmcnt(0)" ::: "memory"); \
      _Pragma("unroll") for (int d_ = 0; d_ < 2; ++d_) _Pragma("unroll") for (int r = 0; r < 16; ++r) o[d_][r] *= wsf[crow(r, hi)]; } } while (0)
    f32x16 pA0, pA1, pB0, pB1;
    int sl_prev = 0, sl_cur = 0, sl_next = SLOTB;
#define ROT() do { sl_prev = sl_cur; sl_cur = sl_next; sl_next = (sl_next == (NSLOT - 1) * SLOTB) ? 0 : sl_next + SLOTB; } while (0)
    DMA_K(2, 2 * SLOTB);
    wait_bar<3>();
    cinit<KIND>(pA0, pA1, blb, mwb, hi, -mhat);
    { const lds_cptr kb = kp0;
#pragma unroll
      for (int d0 = 0; d0 < 4; ++d0) { const bf16x8 b0 = *(const ALAS bf16x8*)(kb + d0 * 2048), b1 = *(const ALAS bf16x8*)(kb + d0 * 2048 + 512);
          pA0 = __builtin_amdgcn_mfma_f32_32x32x16_bf16(b0, qr[d0], pA0, 0, 0, 0); pA1 = __builtin_amdgcn_mfma_f32_32x32x16_bf16(b1, qr[d0], pA1, 0, 0, 0); } }
    asm volatile("s_nop 15\n\ts_nop 7" : "+v"(pA0), "+v"(pA1)); CMASK(pA0, pA1, 0);
    { float rm = __builtin_fmaxf(pA0[0], pA1[0]);
#pragma unroll
      for (int r = 1; r < 16; ++r) rm = __builtin_fmaxf(rm, __builtin_fmaxf(pA0[r], pA1[r]));
      { auto rr = __builtin_amdgcn_permlane32_swap(__float_as_uint(rm), __float_as_uint(rm), false, false); rm = __builtin_fmaxf(__uint_as_float(rr[0]), __uint_as_float(rr[1])); }
      if (__any(rm > (float)THRL)) { const float dl = __builtin_fmaxf(rm, 0.f); mhat += dl;
#pragma unroll
          for (int r = 0; r < 16; ++r) { pA0[r] -= dl; pA1[r] -= dl; } } }
#pragma unroll
    for (int r = 0; r < 16; ++r) { pA0[r] = __builtin_amdgcn_exp2f(pA0[r]); pA1[r] = __builtin_amdgcn_exp2f(pA1[r]); }
    wait_bar<0>();
    DMA_K(3, 0); DMA_V(1, SLOTB); if constexpr (MX) DMA_M(2);
    ROT();
    kload8(kf, kp0 + sl_cur);
    wait_bar<2 + MX>();
    s16x4 vlo[8], vhi[8]; u32x4 pw0, pw1, pw2, pw3;
#define PKW(P, B) cvtpk_s(P[B], P[B + 1])
#define PAF(k) __builtin_bit_cast(bf16x8, pw##k)
#define VFR(i) (bf16x8){vlo[i][0], vlo[i][1], vlo[i][2], vlo[i][3], vhi[i][0], vhi[i][1], vhi[i][2], vhi[i][3]}
#define PIN(x) asm volatile("" : "+v"(x))
#define MX3(a, b, c) __builtin_fmaxf(__builtin_fmaxf((a), (b)), (c))
#define GAPA(MF, A0, A1, A2, A3, W0, W1, PW) do { MF; sacc += A0; sacc += A1; sacc += A2; sacc += A3; PIN(sacc); W0; W1; PIN(PW); SBAR(); } while (0)
#define EX(v) __builtin_amdgcn_exp2f(v)
#define GAPB(MF, X, B) do { MF; X[B] = EX(X[B]); X[B + 1] = EX(X[B + 1]); X[B + 2] = EX(X[B + 2]); X[B + 3] = EX(X[B + 3]); PIN(X); SBAR(); } while (0)
#define VRD(i) do { vlo[i] = vtr(vp_ + (((i) >> 2) * 4096 + ((i) & 3) * 1024)); vhi[i] = vtr(vp_ + (((i) >> 2) * 4096 + ((i) & 3) * 1024 + 512)); } while (0)
#define KRD(G, j) do { if (G) { kload2(kf, kp0 + sl_next, j); SBAR(); } } while (0)
#define STEP(C0, C1, P0, P1, t, GK, GV, GL, GM) do { SBAR(); \
    cinit<KIND>(C0, C1, blb + 64 * (t), mwb + (((t) & 1) << 6), hi, -mhat); PIN(C0); PIN(C1); SBAR(); \
    const lds_cptr vp_ = vp0 + sl_prev; \
    VRD(0); SBAR(); float sacc = (P0[0] + P0[1]); \
    GAPA(C0 = __builtin_amdgcn_mfma_f32_32x32x16_bf16(kf[0], qr[0], C0, 0, 0, 0), P0[2], P0[3], P0[4], P0[5],     pw0[0] = PKW(P0, 0), pw0[1] = PKW(P0, 2), pw0); \
    VRD(4); SBAR(); GAPA(C1 = __builtin_amdgcn_mfma_f32_32x32x16_bf16(kf[1], qr[0], C1, 0, 0, 0), P0[6], P0[7], P0[8], P0[9],     pw0[2] = PKW(P0, 4), pw0[3] = PKW(P0, 6), pw0); \
    VRD(1); SBAR(); GAPA(C0 = __builtin_amdgcn_mfma_f32_32x32x16_bf16(kf[2], qr[1], C0, 0, 0, 0),   P0[10], P0[11], P0[12], P0[13], pw1[0] = PKW(P0, 8), pw1[1] = PKW(P0, 10), pw1); \
    VRD(5); SBAR(); GAPA(C1 = __builtin_amdgcn_mfma_f32_32x32x16_bf16(kf[3], qr[1], C1, 0, 0, 0),   P0[14], P0[15], P1[0], P1[1],   pw1[2] = PKW(P0, 12), pw1[3] = PKW(P0, 14), pw1); \
    VRD(2); SBAR(); GAPA(C0 = __builtin_amdgcn_mfma_f32_32x32x16_bf16(kf[4], qr[2], C0, 0, 0, 0),   P1[2], P1[3], P1[4], P1[5],     pw2[0] = PKW(P1, 0), pw2[1] = PKW(P1, 2), pw2); \
    VRD(6); SBAR(); GAPA(C1 = __builtin_amdgcn_mfma_f32_32x32x16_bf16(kf[5], qr[2], C1, 0, 0, 0),   P1[6], P1[7], P1[8], P1[9],     pw2[2] = PKW(P1, 4), pw2[3] = PKW(P1, 6), pw2); \
    VRD(3); SBAR(); GAPA(C0 = __builtin_amdgcn_mfma_f32_32x32x16_bf16(kf[6], qr[3], C0, 0, 0, 0),   P1[10], P1[11], P1[12], P1[13], pw3[0] = PKW(P1, 8), pw3[1] = PKW(P1, 10), pw3); \
    VRD(7); SBAR(); GAPA(C1 = __builtin_amdgcn_mfma_f32_32x32x16_bf16(kf[7], qr[3], C1, 0, 0, 0),   P1[14], P1[15], 0.f, 0.f,       pw3[2] = PKW(P1, 12), pw3[3] = PKW(P1, 14), pw3); \
    l_reg += sacc; \
    if (GK) { DMA_K((t) + 3, sl_cur); } if (GV) { DMA_V((t) + 1, sl_next); } if constexpr (MX) { if (GM) { DMA_M((t) + 2); } } \
    CMASK(C0, C1, t); \
    { float a = MX3(C0[0], C0[1], C1[0]), b = MX3(C0[2], C0[3], C1[1]); a = MX3(a, C1[2], C1[3]); \
      _Pragma("unroll") for (int r = 4; r < 16; r += 4) { a = MX3(a, C0[r], C0[r + 1]); b = MX3(b, C0[r + 2], C0[r + 3]); a = MX3(a, C1[r], C1[r + 1]); b = MX3(b, C1[r + 2], C1[r + 3]); } \
      float rm = __builtin_fmaxf(a, b); { auto rr = __builtin_amdgcn_permlane32_swap(__float_as_uint(rm), __float_as_uint(rm), false, false); rm = __builtin_fmaxf(__uint_as_float(rr[0]), __uint_as_float(rr[1])); } \
      resc = false; \
      if (__builtin_expect(__any(rm > (float)THRL), 0)) { const float dl = __builtin_fmaxf(rm, 0.f); mhat += dl; \
        _Pragma("unroll") for (int r = 0; r < 16; ++r) { C0[r] -= dl; C1[r] -= dl; } \
        const float f = __builtin_amdgcn_exp2f(-dl); l_reg *= f; if (hi == 0) wsf[r32] = f; resc = true; } } \
    SBAR(); \
    GAPB(o[0] = __builtin_amdgcn_mfma_f32_32x32x16_bf16(PAF(0), VFR(0), o[0], 0, 0, 0), C0, 0); \
    GAPB(o[1] = __builtin_amdgcn_mfma_f32_32x32x16_bf16(PAF(0), VFR(4), o[1], 0, 0, 0), C0, 4); \
    KRD(GL, 0); GAPB(o[0] = __builtin_amdgcn_mfma_f32_32x32x16_bf16(PAF(1), VFR(1), o[0], 0, 0, 0), C0, 8); \
    KRD(GL, 1); GAPB(o[1] = __builtin_amdgcn_mfma_f32_32x32x16_bf16(PAF(1), VFR(5), o[1], 0, 0, 0), C0, 12); \
    KRD(GL, 2); GAPB(o[0] = __builtin_amdgcn_mfma_f32_32x32x16_bf16(PAF(2), VFR(2), o[0], 0, 0, 0), C1, 0); \
    KRD(GL, 3); GAPB(o[1] = __builtin_amdgcn_mfma_f32_32x32x16_bf16(PAF(2), VFR(6), o[1], 0, 0, 0), C1, 4); \
    GAPB(o[0] = __builtin_amdgcn_mfma_f32_32x32x16_bf16(PAF(3), VFR(3), o[0], 0, 0, 0), C1, 8); \
    GAPB(o[1] = __builtin_amdgcn_mfma_f32_32x32x16_bf16(PAF(3), VFR(7), o[1], 0, 0, 0), C1, 12); \
    } while (0)
    int t = 1;
#undef CMASK
#define CMASK(P0, P1, t) do { } while (0)
    for (; t + 5 < NT; t += 2) {
        STEP(pB0, pB1, pA0, pA1, t, true, true, true, true);     wait_bar<2 + MX>(); RESC(); ROT();
        STEP(pA0, pA1, pB0, pB1, t + 1, true, true, true, true); wait_bar<2 + MX>(); RESC(); ROT();
    }
#undef CMASK
#define CMASK(P0, P1, t) do { if constexpr (KIND == 1) { int jb_ = (t) - (NT - 4); if (jb_ >= 0) cmask(P0, P1, jb_, qrel, hi); } } while (0)
#define ENDW(tt) do { if ((tt) + 3 < NT) { wait_bar<2 + MX>(); } else if ((tt) + 2 < NT) { wait_bar<1 + MX>(); } else { wait_bar<0>(); } } while (0)
    for (; t + 1 < NT; t += 2) {
        STEP(pB0, pB1, pA0, pA1, t, (t + 3 < NT), (t + 1 < NT), (t + 1 < NT), (t + 2 < NT));       ENDW(t);     RESC(); ROT();
        STEP(pA0, pA1, pB0, pB1, t + 1, (t + 4 < NT), (t + 2 < NT), (t + 2 < NT), (t + 3 < NT));   ENDW(t + 1); RESC(); ROT();
    }
    STEP(pB0, pB1, pA0, pA1, NT - 1, false, false, false, false); RESC();
    { float sacc = pB0[0] + pB0[1];
#pragma unroll
      for (int r = 2; r < 16; ++r) sacc += pB0[r];
#pragma unroll
      for (int r = 0; r < 16; ++r) sacc += pB1[r];
      l_reg += sacc;
      pw0 = (u32x4){PKW(pB0, 0), PKW(pB0, 2), PKW(pB0, 4), PKW(pB0, 6)}; pw1 = (u32x4){PKW(pB0, 8), PKW(pB0, 10), PKW(pB0, 12), PKW(pB0, 14)};
      pw2 = (u32x4){PKW(pB1, 0), PKW(pB1, 2), PKW(pB1, 4), PKW(pB1, 6)}; pw3 = (u32x4){PKW(pB1, 8), PKW(pB1, 10), PKW(pB1, 12), PKW(pB1, 14)};
      SBAR(); pv(o, vb0 + sl_cur, PAF(0), PAF(1), PAF(2), PAF(3)); }
#undef PKW
#undef PAF
#undef VFR
#undef PIN
#undef MX3
#undef GAPA
#undef GAPB
#undef EX
#undef VRD
#undef KRD
#undef STEP
#undef ENDW
    { auto rr = __builtin_amdgcn_permlane32_swap(__float_as_uint(l_reg), __float_as_uint(l_reg), false, false); l_reg = __uint_as_float(rr[0]) + __uint_as_float(rr[1]); }
    if (hi == 0) wsf[32 + r32] = l_reg;
    asm volatile("s_waitcnt lgkmcnt(0)" ::: "memory");
    float rli[16];
#pragma unroll
    for (int r = 0; r < 16; ++r) rli[r] = __builtin_amdgcn_rcpf(wsf[32 + crow(r, hi)]);
    bf16* Ow = O + (rowbase + q0 + wid * QBLK) * AW + h * 64;
    { ALAS bf16* stg = (ALAS bf16*)(shm + LDS_OST) + wid * 2048;
#pragma unroll
      for (int r = 0; r < 16; ++r) { const int orow = crow(r, hi);
#pragma unroll
          for (int d0 = 0; d0 < 2; ++d0) stg[orow * 64 + d0 * 32 + r32] = (bf16)(cvtpk_s(o[d0][r] * rli[r], 0.f) & 0xffffu); }
      asm volatile("s_waitcnt lgkmcnt(0)" ::: "memory");
#pragma unroll
      for (int i = 0; i < 4; ++i) { const int row = i * 8 + (lane >> 3), ch = lane & 7; const u32x4 v = *(const ALAS u32x4*)(stg + row * 64 + ch * 8); *(u32x4*)(Ow + (long)row * AW + ch * 8) = v; } }
    asm volatile("s_waitcnt lgkmcnt(0)\n\ts_barrier" ::: "memory");
#undef DMA_K
#undef DMA_V
#undef DMA_M
#undef CMASK
#undef RESC
#undef ROT
}
#undef SBAR
#undef ALAS
}

static_assert(attn_body::LDS_BYTES <= RING_BYTES, "attention LDS");
#define XB_TMO      128
#define XB_XCNT(j)  (256  + 64 * (j))
#define XB_XSUB(j)  (1280 + 64 * (j))
#define XB_XGEN(j)  (2304 + 64 * (j))
#define XB_TOP      3328
#define XB_TOPGEN   3392
#define XCD_BAR_WORDS 3456
#define XB_SPIN_CAP (1u << 18)

__device__ __forceinline__ unsigned xb_ld(unsigned* p)              { return __hip_atomic_load(p, __ATOMIC_RELAXED, __HIP_MEMORY_SCOPE_AGENT); }
__device__ __forceinline__ unsigned xb_add(unsigned* p, unsigned v) { return __hip_atomic_fetch_add(p, v, __ATOMIC_RELAXED, __HIP_MEMORY_SCOPE_AGENT); }
__device__ __forceinline__ unsigned xb_xcc_id() { return (unsigned)__builtin_amdgcn_s_getreg((3 << 11) | 20) & 0xFu; }
#define XB_SPIN(cond, bar) do { unsigned _sp = 0; while (cond) { __builtin_amdgcn_s_sleep(1); \
    if ((++_sp & 255u) == 0u) { if (xb_ld(&(bar)[XB_TMO])) break; if (_sp > XB_SPIN_CAP) { atomicAdd(&(bar)[XB_TMO], 1u); break; } } } } while (0)

struct XcdBarrier {
    unsigned* bar; unsigned x;
    volatile LAS unsigned* st;
};

__device__ __forceinline__ XcdBarrier xcd_barrier_post(unsigned* bar, volatile LAS unsigned* st) {
    XcdBarrier b; b.bar = bar; b.x = xb_xcc_id(); b.st = st;
    if (threadIdx.x == 0) (void)xb_add(&bar[XB_XCNT(b.x)], 1u);
    return b;
}
__device__ __forceinline__ void xcd_barrier_complete(unsigned* bar, unsigned x, unsigned& nloc, unsigned& nx) {
    const unsigned G = gridDim.x * gridDim.y * gridDim.z;
    unsigned sum, cnt, mine, sp = 0u;
    for (;;) {
        sum = 0u; cnt = 0u; mine = 0u;
#pragma unroll
        for (unsigned j = 0; j < 16; ++j) { const unsigned c = xb_ld(&bar[XB_XCNT(j)]); sum += c; cnt += (c > 0u) ? 1u : 0u; mine = (j == x) ? c : mine; }
        if (sum == G) break;
        __builtin_amdgcn_s_sleep(1);
        if ((++sp & 255u) == 0u) { if (xb_ld(&bar[XB_TMO])) break; if (sp > XB_SPIN_CAP) { atomicAdd(&bar[XB_TMO], 1u); break; } }
    }
    nloc = mine > 0u ? mine : 1u; nx = cnt > 0u ? cnt : 1u;
}

__device__ __forceinline__ void xcd_barrier(const XcdBarrier& b) {
    asm volatile("s_waitcnt vmcnt(0)" ::: "memory");
    __syncthreads();
    if (threadIdx.x == 0) {
        unsigned* bar = b.bar; unsigned bx = b.x;
        asm volatile("" : "+s"(bar), "+s"(bx));
        __builtin_amdgcn_s_waitcnt(0);
        unsigned nloc = b.st[0], nx = b.st[1];
        if (nloc == 0u) { xcd_barrier_complete(bar, bx, nloc, nx); b.st[0] = nloc; b.st[1] = nx; }
        const unsigned old = xb_add(&bar[XB_XSUB(bx)], 1u);
        const unsigned gen = old / nloc;
        if (old + 1u == (gen + 1u) * nloc) {
            __builtin_amdgcn_fence(__ATOMIC_RELEASE, "agent");
            asm volatile("s_waitcnt vmcnt(0)" ::: "memory");
            const unsigned og = xb_add(&bar[XB_TOP], 1u);
            const unsigned tg = og / nx;
            if (og + 1u == (tg + 1u) * nx) xb_add(&bar[XB_TOPGEN], 1u);
            else XB_SPIN(xb_ld(&bar[XB_TOPGEN]) == tg, bar);
            __builtin_amdgcn_fence(__ATOMIC_ACQUIRE, "agent");
            xb_add(&bar[XB_XGEN(bx)], 1u);
            asm volatile("s_waitcnt vmcnt(0)" ::: "memory");
        } else {
            XB_SPIN(xb_ld(&bar[XB_XGEN(bx)]) == gen, bar);
            __builtin_amdgcn_fence(__ATOMIC_ACQUIRE, "agent");
            asm volatile("s_waitcnt vmcnt(0)" ::: "memory");
        }
    }
    __syncthreads();
}
struct Frame {
    LAS unsigned char* lds;
    volatile LAS unsigned* MISC;
    gu32* ctl;
    int tid, lane, wave, G, bid;
    unsigned char* ws; float* out;
};
__device__ __forceinline__ float wave_sum(float v) {
#pragma unroll
    for (int o = 1; o < 64; o <<= 1) v += __shfl_xor(v, o);
    return v;
}

__device__ __forceinline__ int win_colmap(int dr) {
    const int tile = dr >> 8, j = dr & 255;
    if (tile < 4 || tile == 6 || tile == 7) { const int base = (tile < 2) ? 0 : (tile < 4 ? 512 : 1536); return base + 256 * (tile & 1) + 64 * ((j & 127) >> 5) + 32 * (j >> 7) + (j & 31); }
    if (tile < 6) return 1024 + 256 * (tile - 4) + j;
    if (tile < 14) return 2120 + 256 * (tile - 8) + j;
    if (tile < 22) return 3664 + 256 * (tile - 14) + j;
    if (j < 32) return 2048 + j;
    if (j < 40) return 2112 + (j - 32);
    if (j >= 64 && j < 72) return 3656 + (j - 64);
    if (j >= 128 && j < 160) return 2080 + (j - 128);
    return -1;
}
template <int KIND>
__device__ __forceinline__ void conv_item(const float* s0, const float* s1, int K, int Nsrc, int ndst, bf16* dst, int item, LAS unsigned char* scr, int lane) {
    const int nb = ndst >> 6, kb = item / nb, dg = item - kb * nb, k0 = kb << 6, d0 = dg << 6;
    const int nq = lane & 15, dr = d0 + 4 * nq;
    const float* sp = s0; int col;
    if (KIND == 0) col = dr;
    else if (KIND == 1) col = win_colmap(dr);
    else { const int tile = dr >> 8, j = dr & 255; col = 128 * tile + (j & 127); if (j >= 128) sp = s1; }
    f32x4 vv[16];
#pragma unroll
    for (int i = 0; i < 16; ++i) { const int k = 4 * i + (lane >> 4); vv[i] = (f32x4){0.f, 0.f, 0.f, 0.f}; if (col >= 0) vv[i] = *(const f32x4*)(sp + (size_t)(k0 + k) * Nsrc + col); }
#pragma unroll
    for (int i = 0; i < 16; ++i) {
        const int k = 4 * i + (lane >> 4); const f32x4 v = vv[i];
        LAS unsigned short* w = (LAS unsigned short*)(scr + (4 * nq) * 144 + k * 2);
        w[0] = (unsigned short)f2bf(v[0]); w[72] = (unsigned short)f2bf(v[1]); w[144] = (unsigned short)f2bf(v[2]); w[216] = (unsigned short)f2bf(v[3]);
    }
    asm volatile("s_waitcnt lgkmcnt(0)" ::: "memory");
#pragma unroll
    for (int i = 0; i < 8; ++i) { const int n = 8 * i + (lane >> 3), ch = lane & 7;
        const v4u o = *(const LAS v4u*)(scr + n * 144 + ch * 16);
        *(v4u*)(dst + (size_t)(d0 + n) * K + k0 + 8 * ch) = o; }
    asm volatile("s_waitcnt lgkmcnt(0)" ::: "memory");
}
template <int KIND>
__device__ __forceinline__ void conv_matrix(Frame& F, const float* s0, const float* s1, int K, int Nsrc, int ndst, bf16* dst) {
    LAS unsigned char* scr = F.lds + RING_OFF + F.wave * 9216;
    const int gw = F.bid * NWAVES + F.wave, NGW = F.G * NWAVES, nitems = (K >> 6) * (ndst >> 6);
    for (int it = gw; it < nitems; it += NGW) conv_item<KIND>(s0, s1, K, Nsrc, ndst, dst, it, scr, F.lane);
}
__device__ __forceinline__ void sincos_rev(double r, float& s, float& c) {
    const double k = rint(4.0 * r);
    const double y = (r - 0.25 * k) * 6.283185307179586;
    const double y2 = y * y;
    const double sy = y * (1.0 + y2 * (-1.0 / 6 + y2 * (1.0 / 120 + y2 * (-1.0 / 5040 + y2 * (1.0 / 362880 + y2 * (-1.0 / 39916800 + y2 * (1.0 / 6227020800.0)))))));
    const double cy = 1.0 + y2 * (-0.5 + y2 * (1.0 / 24 + y2 * (-1.0 / 720 + y2 * (1.0 / 40320 + y2 * (-1.0 / 3628800 + y2 * (1.0 / 479001600.0))))));
    const int q = ((int)k) & 3;
    const double sv = (q == 0) ? sy : (q == 1) ? cy : (q == 2) ? -sy : -cy;
    const double cv = (q == 0) ? cy : (q == 1) ? -sy : (q == 2) ? -cy : sy;
    s = (float)sv; c = (float)cv;
}
__device__ __forceinline__ void p0_prologue(Frame& F, const float* x_in, const int* pos, const float* w_in, const float* w_a, const float* w_b, const float* w_o, const float* f_g, const float* f_u, const float* f_d) {
    unsigned char* ws = F.ws;
    for (int l = 0; l < 2; ++l) {
        conv_matrix<1>(F, w_in + (size_t)l * DM * PROJ_TOTAL, nullptr, DM, PROJ_TOTAL, PROJ_PAD, (bf16*)(ws + WS_WIN + l * WIN_STRIDE));
        conv_matrix<0>(F, w_a + (size_t)l * AW * DM, nullptr, AW, DM, DM, (bf16*)(ws + WS_WA) + (size_t)l * DM * AW);
        conv_matrix<0>(F, w_b + (size_t)l * AW * DM, nullptr, AW, DM, DM, (bf16*)(ws + WS_WB) + (size_t)l * DM * AW);
        conv_matrix<0>(F, w_o + (size_t)l * DM * DM, nullptr, DM, DM, DM, (bf16*)(ws + WS_WOUT) + (size_t)l * DM * DM);
    }
    conv_matrix<2>(F, f_g, f_u, DM, DFF, 2 * DFF, (bf16*)(ws + WS_FGU));
    conv_matrix<0>(F, f_d, nullptr, DFF, DM, DM, (bf16*)(ws + WS_FD));
    const int gt = F.bid * (NWAVES * 64) + F.tid, NGT = F.G * NWAVES * 64;
    { const f32x4* x4 = (const f32x4*)x_in; v2u* o2 = (v2u*)(ws + WS_XS);
      for (int i = gt; i < NTOK * DM / 4; i += NGT) { const f32x4 v = x4[i]; v2u o; o.x = pk2(v[0], v[1]); o.y = pk2(v[2], v[3]); o2[i] = o; } }
    { float* cs = (float*)(ws + WS_CS);
      for (int i = gt; i < NTOK * 32; i += NGT) { const int tok = i >> 5, fi = i & 31;
          const float invf = (float)exp2(-(double)fi * (13.287712379549449 / 32.0));
          const float ang = (float)pos[tok] * invf;
          double rev = (double)ang * 0.15915494309189535; rev -= floor(rev);
          float s, c; sincos_rev(rev, s, c); cs[2 * i] = c; cs[2 * i + 1] = s; } }
}
__device__ __forceinline__ void moe_convert(Frame& F, const float* wg, const float* wu, const float* wd) {
    bf16* gu = (bf16*)F.out; bf16* dn = (bf16*)(F.ws + WS_MWD);
    LAS unsigned char* scr = F.lds + RING_OFF + F.wave * 9216;
    const int gw = F.bid * NWAVES + F.wave, NGW = F.G * NWAVES;
    constexpr int IGU = (DM >> 6) * (2 * DFF >> 6), IDN = (DFF >> 6) * (DM >> 6);
    for (int it = gw; it < NEXP * (IGU + IDN); it += NGW) {
        const int e = it / (IGU + IDN), r = it - e * (IGU + IDN);
        if (r < IGU) conv_item<2>(wg + (size_t)e * DM * DFF, wu + (size_t)e * DM * DFF, DM, DFF, 2 * DFF, gu + (size_t)e * 2 * DFF * DM, r, scr, F.lane);
        else conv_item<0>(wd + (size_t)e * DFF * DM, nullptr, DFF, DM, DM, dn + (size_t)e * DM * DFF, r - IGU, scr, F.lane);
    }
}

typedef float f32x4i __attribute__((ext_vector_type(4)));
__device__ __forceinline__ unsigned sortkey16(float f) { const unsigned u = __float_as_uint(f); return (u ^ ((u >> 31) ? 0xffffffffu : 0x80000000u)) >> 16; }
__device__ __forceinline__ int wave_suffix_sum(int x, int lane) {
#pragma unroll
    for (int o = 1; o < 64; o <<= 1) { const int t = __shfl_down(x, o); if (lane + o < 64) x += t; }
    return x;
}
__device__ __forceinline__ int wave_sum_i(int v) {
    v += __builtin_amdgcn_update_dpp(0, v, 0xB1, 0xf, 0xf, false);
    v += __builtin_amdgcn_update_dpp(0, v, 0x4E, 0xf, 0xf, false);
    v += __builtin_amdgcn_update_dpp(0, v, 0x141, 0xf, 0xf, false);
    v += __builtin_amdgcn_update_dpp(0, v, 0x140, 0xf, 0xf, false);
    v += __shfl_xor(v, 16); v += __shfl_xor(v, 32);
    return __builtin_amdgcn_readfirstlane(v);
}
__device__ __forceinline__ int hist_select(const LAS unsigned* hist, int K, int lane, int& gt) {
    const v4u c = *(const LAS v4u*)(hist + 4 * lane);
    const int s = (int)(c.x + c.y + c.z + c.w);
    const int above = wave_suffix_sum(s, lane) - s;
    int bin = -1, g = 0;
    int a3 = above, a2 = above + (int)c.w, a1 = a2 + (int)c.z, a0 = a1 + (int)c.y;
    if (a3 < K && K <= a3 + (int)c.w) { bin = 4 * lane + 3; g = a3; }
    else if (a2 < K && K <= a2 + (int)c.z) { bin = 4 * lane + 2; g = a2; }
    else if (a1 < K && K <= a1 + (int)c.y) { bin = 4 * lane + 1; g = a1; }
    else if (a0 < K && K <= a0 + (int)c.x) { bin = 4 * lane + 0; g = a0; }
    const unsigned long long bal = __ballot(bin >= 0);
    const int src = bal ? (int)__builtin_ctzll(bal) : 0;
    gt = __shfl(g, src); return __shfl(bin, src);
}
__device__ __forceinline__ void idx_unit(Frame& F, int b, int qg, const bf16* IQ, const bf16* IK, const float* IW, unsigned* MASK) {
    const int lane = F.lane, wave = F.wave;
    const int t0 = 16 * qg, limit = 64 * (t0 / 64 + 1); const size_t row0 = (size_t)b * SEQ + t0;
    const int nwords = ((limit + 255) >> 8) << 3;
    if (limit <= 256) {
        for (int qq = 0; qq < 2; ++qq) { const int q = 2 * wave + qq; if (lane < nwords) MASK[(row0 + q) * 128 + lane] = (lane < (limit >> 5)) ? 0xffffffffu : 0u; }
        return;
    }
    LAS unsigned char* keys = F.lds;
    LAS unsigned* hist = (LAS unsigned*)(F.lds + IDX_HIST_OFF) + wave * 256;
#ifndef IDX_REP_SCORE
#define IDX_REP_SCORE 1
#endif
#ifndef IDX_REP_SEL
#define IDX_REP_SEL 1
#endif
    for (int rs_ = 0; rs_ < IDX_REP_SCORE; ++rs_)
    {
        const int qc = lane & 15, kq = lane >> 4;
        bf16x8 bq[8][2]; float w[8];
#pragma unroll
        for (int h = 0; h < 8; ++h) { const bf16* p = IQ + (row0 + qc) * AW + h * 64 + 8 * kq; bq[h][0] = *(const bf16x8*)p; bq[h][1] = *(const bf16x8*)(p + 32); }
        { const f32x4 w0 = *(const f32x4*)(IW + (row0 + qc) * 8), w1 = *(const f32x4*)(IW + (row0 + qc) * 8 + 4);
          w[0] = w0[0]; w[1] = w0[1]; w[2] = w0[2]; w[3] = w0[3]; w[4] = w1[0]; w[5] = w1[1]; w[6] = w1[2]; w[7] = w1[3]; }
        const bf16* ikb = IK + ((size_t)b * SEQ + qc) * 64 + 8 * kq;
        const int nkb = limit >> 4;
#define IDX_BLOCK(KB, A0, A1) do { f32x4i sc = {0.f, 0.f, 0.f, 0.f}; \
            _Pragma("unroll") for (int h = 0; h < 8; ++h) { f32x4i acc = {0.f, 0.f, 0.f, 0.f}; \
                acc = __builtin_amdgcn_mfma_f32_16x16x32_bf16(A0, bq[h][0], acc, 0, 0, 0); acc = __builtin_amdgcn_mfma_f32_16x16x32_bf16(A1, bq[h][1], acc, 0, 0, 0); \
                _Pragma("unroll") for (int r = 0; r < 4; ++r) sc[r] += w[h] * __builtin_amdgcn_fmed3f(acc[r], 0.f, 3.0e38f); }     \
            v2u pk; pk.x = sortkey16(sc[0]) | (sortkey16(sc[1]) << 16); pk.y = sortkey16(sc[2]) | (sortkey16(sc[3]) << 16); \
            *(LAS v2u*)(keys + qc * IDX_ROWB + ((KB) * 16 + 4 * kq) * 2) = pk; } while (0)
        const int kbB0 = (wave + 8 < nkb) ? wave + 8 : wave;
        bf16x8 a0 = *(const bf16x8*)(ikb + (size_t)wave * 1024), a1 = *(const bf16x8*)(ikb + (size_t)wave * 1024 + 32);
        bf16x8 b0 = *(const bf16x8*)(ikb + (size_t)kbB0 * 1024), b1 = *(const bf16x8*)(ikb + (size_t)kbB0 * 1024 + 32);
        for (int kb = wave; kb < nkb; kb += 16) {
            const int kbB = (kb + 8 < nkb) ? kb + 8 : kb;
            const int kn = (kb + 16 < nkb) ? kb + 16 : kb, km = (kb + 24 < nkb) ? kb + 24 : kn;
            const bf16x8 n0 = *(const bf16x8*)(ikb + (size_t)kn * 1024), n1 = *(const bf16x8*)(ikb + (size_t)kn * 1024 + 32);
            const bf16x8 m0 = *(const bf16x8*)(ikb + (size_t)km * 1024), m1 = *(const bf16x8*)(ikb + (size_t)km * 1024 + 32);
            IDX_BLOCK(kb, a0, a1);
            IDX_BLOCK(kbB, b0, b1);
            a0 = n0; a1 = n1; b0 = m0; b1 = m1;
        }
#undef IDX_BLOCK
    }
    __syncthreads();
    for (int rq_ = 0; rq_ < IDX_REP_SEL; ++rq_)
    for (int qq = 0; qq < 2; ++qq) {
        const int q = 2 * wave + qq; const LAS unsigned short* rowk = (const LAS unsigned short*)(keys + q * IDX_ROWB);
        const int nj = limit >> 6;
        unsigned kj[64];
#pragma unroll
        for (int j = 0; j < 64; ++j) { const unsigned v = rowk[64 * j + lane]; kj[j] = (j < nj) ? v : 0u; }
        unsigned T = 0u;
        for (int bit = 15; bit >= 0; --bit) {
            const unsigned cand = T | (1u << bit); int c = 0;
#pragma unroll
            for (int g = 0; g < 8; ++g) if (8 * g < nj) {
#pragma unroll
                for (int jj = 0; jj < 8; ++jj) c += (kj[8 * g + jj] >= cand) ? 1 : 0; }
            if (wave_sum_i(c) >= DSA_TOPK) T = cand;
        }
        int gt;
        { int c = 0;
#pragma unroll
          for (int g = 0; g < 8; ++g) if (8 * g < nj) {
#pragma unroll
              for (int jj = 0; jj < 8; ++jj) c += (kj[8 * g + jj] > T) ? 1 : 0; }
          gt = wave_sum_i(c); }
        const int need = DSA_TOPK - gt;
        unsigned long long mine = 0ull; int running = 0;
#pragma unroll
        for (int g = 0; g < 8; ++g) if (8 * g < nj) {
#pragma unroll
            for (int jj = 0; jj < 8; ++jj) { const int j = 8 * g + jj;
                unsigned long long m = __ballot(kj[j] > T);
                const unsigned long long eqm = __ballot(kj[j] == T);
                if (eqm) { const int rank = running + __popcll(eqm & ((1ull << lane) - 1ull));
                    m |= __ballot(kj[j] == T && rank < need); running += __popcll(eqm); }
                if (lane == j) mine = m; } }
        if (lane < (nwords >> 1)) *(unsigned long long*)(MASK + (row0 + q) * 128 + 2 * lane) = mine;
    }
    __syncthreads();
}
__device__ __forceinline__ void idx_phase(Frame& F, const bf16* IQ, const bf16* IK, const float* IW, const float* LOGF, float* CB, unsigned* MASK) {
    const int gw = F.bid * NWAVES + F.wave;
    if (gw < BATCH * NH) {
        const float* src = LOGF + (size_t)gw * SEQ; float* dst = CB + (size_t)gw * SEQ; float carry = 0.f;
        float vals[64];
#pragma unroll
        for (int i = 0; i < 64; ++i) vals[i] = src[64 * i + F.lane];
#pragma unroll
        for (int i = 0; i < 64; ++i) {
            float v = vals[i];
#pragma unroll
            for (int o = 1; o < 64; o <<= 1) { const float u = __shfl_up(v, o); if (F.lane >= o) v += u; }
            const float c = carry + v;
            dst[64 * i + F.lane] = -c * LOG2E;
            carry = __shfl(c, 63);
        }
    }
    for (int k = F.bid; k < BATCH * (SEQ / 16); k += F.G) {
        const int round = k >> 8, pos = k & 255, i = (round << 8) + ((round & 1) ? 255 - pos : pos);
        idx_unit(F, i & 7, 255 - (i >> 3), IQ, IK, IW, MASK);
    }
}

__device__ __forceinline__ void attn_phase(Frame& F, const bf16* DQ, const bf16* DK, const bf16* DV, const bf16* FQ, const bf16* FK, const bf16* FV, const unsigned* MASK, const float* CB) {
    for (int k = F.bid; k < 2 * BATCH * NH * (SEQ / 256); k += F.G) {
        const int round = k >> 8, pos = k & 255, i = (round << 8) + ((round & 1) ? 255 - pos : pos);
        const int qb = 15 - (i >> 7), r = i & 127, kind = r >> 6, b = (r >> 3) & 7, h = r & 7;
        if (kind == 0) attn_body::attn_unit<0, 8>(b, h, qb, DQ, DK, DV, (bf16*)DQ, MASK, CB, (LAS char*)F.lds);
        else attn_body::attn_unit<1, 8>(b, h, qb, FQ, FK, FV, (bf16*)FQ, MASK, CB, (LAS char*)F.lds);
    }
}

template <int MODE>
__device__ __forceinline__ void ln_phase(Frame& F, const float* gam, const float* bet, const float* router) {
    const float* Y = F.out; bf16* XS = (bf16*)(F.ws + WS_XS);
    const int tpb = NTOK / F.G, r_lo = F.bid * tpb;
    LAS unsigned* cnt = (LAS unsigned*)(F.lds + RING_OFF);
    if (MODE == 1) { if (F.tid < 8) cnt[F.tid] = 0u; __syncthreads(); }
    f32x4 g4[4], b4[4];
#pragma unroll
    for (int j = 0; j < 4; ++j) { g4[j] = *(const f32x4*)(gam + 4 * F.lane + 256 * j); b4[j] = *(const f32x4*)(bet + 4 * F.lane + 256 * j); }
    f32x4 vn[4];
    if (MODE != 3) {
#pragma unroll
        for (int j = 0; j < 4; ++j) vn[j] = *(const f32x4*)(Y + (size_t)(r_lo + F.wave) * DM + 4 * F.lane + 256 * j);
    }
    for (int rr = F.wave; rr < tpb; rr += NWAVES) {
        const int row = r_lo + rr;
        f32x4 v[4]; float s = 0.f;
        if (MODE == 3) {
            const int* ts = (const int*)(F.ws + MOE_TOKSLOT) + 2 * row; const int s0 = ts[0], s1 = ts[1];
            const bf16* yb = (const bf16*)(F.ws + WS_YB);
#pragma unroll
            for (int j = 0; j < 4; ++j) { const int c = 4 * F.lane + 256 * j;
                const v2u xr = *(const v2u*)(XS + (size_t)row * DM + c), y0 = *(const v2u*)(yb + (size_t)s0 * DM + c), y1 = *(const v2u*)(yb + (size_t)s1 * DM + c);
                v[j][0] = ALPHA * pg8::bf2f(xr.x & 0xffffu) + (pg8::bf2f(y0.x & 0xffffu) + pg8::bf2f(y1.x & 0xffffu));
                v[j][1] = ALPHA * __uint_as_float(xr.x & 0xffff0000u) + (__uint_as_float(y0.x & 0xffff0000u) + __uint_as_float(y1.x & 0xffff0000u));
                v[j][2] = ALPHA * pg8::bf2f(xr.y & 0xffffu) + (pg8::bf2f(y0.y & 0xffffu) + pg8::bf2f(y1.y & 0xffffu));
                v[j][3] = ALPHA * __uint_as_float(xr.y & 0xffff0000u) + (__uint_as_float(y0.y & 0xffff0000u) + __uint_as_float(y1.y & 0xffff0000u)); }
        } else {
#pragma unroll
            for (int j = 0; j < 4; ++j) v[j] = vn[j];
            const int rn = (rr + NWAVES < tpb) ? row + NWAVES : row;
#pragma unroll
            for (int j = 0; j < 4; ++j) vn[j] = *(const f32x4*)(Y + (size_t)rn * DM + 4 * F.lane + 256 * j);
        }
#pragma unroll
        for (int j = 0; j < 4; ++j) s += (v[j][0] + v[j][1]) + (v[j][2] + v[j][3]);
        const float mean = wave_sum(s) * (1.f / DM); float s2 = 0.f;
#pragma unroll
        for (int j = 0; j < 4; ++j) { v[j] = v[j] - mean; s2 += (v[j][0] * v[j][0] + v[j][1] * v[j][1]) + (v[j][2] * v[j][2] + v[j][3] * v[j][3]); }
        const float rstd = 1.f / sqrtf(wave_sum(s2) * (1.f / DM) + LN_EPS);
#pragma unroll
        for (int j = 0; j < 4; ++j) v[j] = v[j] * rstd * g4[j] + b4[j];
        if (MODE == 0 || MODE == 2 || MODE == 3) {
#pragma unroll
            for (int j = 0; j < 4; ++j) *(f32x4*)(F.out + (size_t)row * DM + 4 * F.lane + 256 * j) = v[j];
        }
        if (MODE == 0 || MODE == 1) {
#pragma unroll
            for (int j = 0; j < 4; ++j) { v2u o; o.x = pk2(v[j][0], v[j][1]); o.y = pk2(v[j][2], v[j][3]); *(v2u*)(XS + (size_t)row * DM + 4 * F.lane + 256 * j) = o; }
        }
        if (MODE == 1) {
            float lg[8];
#pragma unroll
            for (int e = 0; e < 8; ++e) lg[e] = 0.f;
#pragma unroll
            for (int j = 0; j < 4; ++j)
#pragma unroll
                for (int c = 0; c < 4; ++c) { const float* rp = router + (size_t)(4 * F.lane + 256 * j + c) * 8; const f32x4 r0 = *(const f32x4*)rp, r1 = *(const f32x4*)(rp + 4); const float x = v[j][c];
                    lg[0] += x * r0[0]; lg[1] += x * r0[1]; lg[2] += x * r0[2]; lg[3] += x * r0[3]; lg[4] += x * r1[0]; lg[5] += x * r1[1]; lg[6] += x * r1[2]; lg[7] += x * r1[3]; }
#pragma unroll
            for (int e = 0; e < 8; ++e) lg[e] = wave_sum(lg[e]);
            float bv = lg[0]; int bi = 0;
#pragma unroll
            for (int e = 1; e < 8; ++e) if (lg[e] > bv) { bv = lg[e]; bi = e; }
            float sv = -INFINITY; int si = 0;
#pragma unroll
            for (int e = 0; e < 8; ++e) if (e != bi && lg[e] > sv) { sv = lg[e]; si = e; }
            if (F.lane == 0) {
                const float g0 = 1.f / (1.f + __expf(sv - bv));
                ((unsigned*)(F.ws + MOE_TOPE))[row] = (unsigned)bi | ((unsigned)si << 8);
                float* tg = (float*)(F.ws + MOE_TOPG) + 2 * row; tg[0] = g0; tg[1] = 1.f - g0;
                __hip_atomic_fetch_add(cnt + bi, 1u, __ATOMIC_RELAXED, __HIP_MEMORY_SCOPE_WORKGROUP); __hip_atomic_fetch_add(cnt + si, 1u, __ATOMIC_RELAXED, __HIP_MEMORY_SCOPE_WORKGROUP);
            }
        }
    }
    if (MODE == 1) { __syncthreads(); if (F.tid < 8) ((unsigned*)(F.ws + MOE_CNT))[F.bid * 8 + F.tid] = cnt[F.tid]; }
}

__device__ __forceinline__ void moe_assign(Frame& F) {
    const unsigned* CNT = (const unsigned*)(F.ws + MOE_CNT);
    LAS int* part = (LAS int*)(F.lds + RING_OFF);
    LAS int* tot = part + 512;
    LAS int* base = tot + 8; LAS int* pst = tot + 16; LAS int* wcnt = tot + 24;
    const int G = F.G, tpb = NTOK / G, j = F.bid;
    __syncthreads();
    { const int e = F.tid & 7, grp = F.tid >> 3; int s = 0;
      const int gsz = (G + 63) / 64;
      for (int jj = grp * gsz; jj < (grp + 1) * gsz && jj < G; ++jj) s += (int)CNT[jj * 8 + e];
      part[grp * 8 + e] = s; }
    __syncthreads();
    if (F.tid < 8) { const int e = F.tid, gsz = (G + 63) / 64, myg = j / gsz; int t = 0, bs = 0;
        for (int g = 0; g < 64; ++g) { const int s = part[g * 8 + e]; if (g < myg) bs += s; t += s; }
        for (int jj = myg * gsz; jj < j; ++jj) bs += (int)CNT[jj * 8 + e];
        tot[e] = t; base[e] = bs; if (j == 0) ((int*)(F.ws + MOE_TOT))[e] = t; }
    __syncthreads();
    if (F.tid == 0) { int ps = 0; for (int e = 0; e < 8; ++e) { pst[e] = ps; ps += ((tot[e] + 255) >> 8) << 8; } }
    const unsigned* TOPE = (const unsigned*)(F.ws + MOE_TOPE); const float* TOPG = (const float*)(F.ws + MOE_TOPG);
    int* SLOTTOK = (int*)(F.ws + MOE_SLOTTOK); float* SLOTGATE = (float*)(F.ws + MOE_SLOTGATE); int* TOKSLOT = (int*)(F.ws + MOE_TOKSLOT);
    const int na = 2 * tpb;
    int done_before[8];
#pragma unroll
    for (int e = 0; e < 8; ++e) done_before[e] = 0;
    for (int a0 = 0; a0 < na; a0 += NWAVES * 64) {
        const int a = a0 + F.tid; const bool valid = a < na;
        const int tok = j * tpb + (a >> 1), k = a & 1;
        int e = -1; if (valid) { const unsigned te = TOPE[tok]; e = (int)((te >> (8 * k)) & 255u); }
        int rank = 0;
#pragma unroll
        for (int x = 0; x < 8; ++x) { const unsigned long long bm = __ballot(e == x); if (e == x) rank = __popcll(bm & ((1ull << F.lane) - 1ull)); if (F.lane == 0) wcnt[F.wave * 8 + x] = __popcll(bm); }
        __syncthreads();
        if (valid) { int pre = 0, all = 0;
#pragma unroll
            for (int x = 0; x < 8; ++x) { int ps = 0, al = 0;
#pragma unroll
                for (int w = 0; w < NWAVES; ++w) { const int c = wcnt[w * 8 + x]; if (w < F.wave) ps += c; al += c; }
                if (e == x) { pre = ps + done_before[x]; } all = al; done_before[x] += all; }
            const int slot = pst[e] + base[e] + pre + rank;
            SLOTTOK[slot] = tok; SLOTGATE[slot] = TOPG[2 * tok + k]; TOKSLOT[2 * tok + k] = slot;
        } else {
#pragma unroll
            for (int x = 0; x < 8; ++x) { int al = 0;
#pragma unroll
                for (int w = 0; w < NWAVES; ++w) al += wcnt[w * 8 + x];
                done_before[x] += al; }
        }
        __syncthreads();
    }
    if (j < 8) { const int e = j, t = tot[e], padded = ((t + 255) >> 8) << 8; for (int s = t + F.tid; s < padded; s += NWAVES * 64) { SLOTTOK[pst[e] + s] = 0; SLOTGATE[pst[e] + s] = 0.f; } }
    __syncthreads();
}

constexpr int NPHASE = 27;
__device__ __forceinline__ const void* kin_load(const __attribute__((address_space(4))) char* ka, int i) {
    int z; asm volatile("s_mov_b32 %0, 0" : "=s"(z));
    return *(const void* const __attribute__((address_space(4)))*)(ka + 8 * (i + z));
}
struct Args { const void* in[18]; float* out; unsigned char* ws; int ph_lo, ph_hi; };
__global__ void __launch_bounds__(NWAVES * 64, 2) mk_fwd(Args args) {
    extern __shared__ __attribute__((aligned(16))) unsigned char lds[];
    Frame F;
    F.lds = (LAS unsigned char*)lds;
    F.MISC = (volatile LAS unsigned*)(F.lds + MISC_OFF);
    F.tid = threadIdx.x; F.lane = F.tid & 63; F.wave = __builtin_amdgcn_readfirstlane(F.tid >> 6);
    F.G = gridDim.x; F.bid = blockIdx.x;
    F.ws = args.ws; F.out = args.out; F.ctl = (gu32*)(args.ws + WS_CTL);
    const __attribute__((address_space(4))) char* KA = (const __attribute__((address_space(4))) char*)__builtin_amdgcn_kernarg_segment_ptr();
#define KIN(T, i) ((T)kin_load(KA, (i)))
    for (int u = F.tid; u < (LDS_BYTES - MISC_OFF) / 4; u += NWAVES * 64) ((LAS unsigned*)(F.lds + MISC_OFF))[u] = 0u;
    __syncthreads();
    const int lo = args.ph_lo, hi = args.ph_hi;
    XcdBarrier bar; bar.bar = (unsigned*)(F.ctl + CW_BAR); bar.x = 0; bar.st = nullptr;
    if (hi - lo > 1) bar = xcd_barrier_post((unsigned*)(F.ctl + CW_BAR), F.MISC + 8);
#ifndef PHS
#define PHS(s) 1
#endif
#ifndef DUP_SLOT
#define DUP_SLOT -1
#endif
#define NREP(s) (((s) == (DUP_SLOT)) ? 2 : 1)
#define IN(k) (lo <= (k) && (k) < hi)
#define PHASE_BEGIN() do { int t_ = threadIdx.x; asm volatile("" : "+v"(t_)); F.tid = t_; F.lane = t_ & 63; F.wave = __builtin_amdgcn_readfirstlane(t_ >> 6); } while (0)
#define INS(s) (PHS(s) && IN(pb + (s)))
#define INM(s) (PHS((s) + 20) && IN(pb + (s)))
#define SEAM(k) do { if (IN((k) + 1)) xcd_barrier(bar); } while (0)
    unsigned char* ws = args.ws;
#define XS ((bf16*)(ws + WS_XS))
#define DQ ((bf16*)(ws + WS_DQ))
#define DK ((bf16*)(ws + WS_DK))
#define DV ((bf16*)(ws + WS_DV))
#define IQ ((bf16*)(ws + WS_IQ))
#define FQ ((bf16*)(ws + WS_FQ))
#define FK ((bf16*)(ws + WS_FK))
#define FV ((bf16*)(ws + WS_FV))
#define GA ((bf16*)(ws + WS_GA))
#define GB ((bf16*)(ws + WS_GB))
#define IK ((bf16*)(ws + WS_IK))
#define MERGED ((bf16*)(ws + WS_MERGED))
#define IW ((float*)(ws + WS_IW))
#define LOGF ((float*)(ws + WS_LOGF))
#define CB ((float*)(ws + WS_CB))
#define MASK ((unsigned*)(ws + WS_MASK))

    if (PHS(100) && IN(0)) { for (int rep_ = 0; rep_ < NREP(100); ++rep_) { PHASE_BEGIN(); p0_prologue(F, KIN(const float*, 0), KIN(const int*, 1), KIN(const float*, 2), KIN(const float*, 4), KIN(const float*, 5), KIN(const float*, 6), KIN(const float*, 11), KIN(const float*, 12), KIN(const float*, 13)); if (rep_ + 1 < NREP(100)) xcd_barrier(bar); } SEAM(0); }

    for (int layer = 0; layer < 2; ++layer) {
        const int pb = 1 + 13 * layer; const bool moe = (layer & 1) != 0;
        if (INS(0)) { for (int rep_ = 0; rep_ < NREP(0); ++rep_) { PHASE_BEGIN();
            pg8::Gemm g{XS, (const bf16*)(ws + WS_WIN + layer * WIN_STRIDE), NTOK, PROJ_PAD, DM}; pg8::StaticOrder S; S.init(NTOK, PROJ_PAD, F.G, F.bid);
            pg8::EpiProj E{ws, KIN(const float*, 3) + layer * NH};
            pg8::gemm_phase<pg8::EpiProj, pg8::StaticOrder, true, true>(F.lds + RING_OFF, g, S, E);
            if (rep_ + 1 < NREP(0)) xcd_barrier(bar); } SEAM(pb + 0);
        }
        if (INS(1)) { for (int rep_ = 0; rep_ < NREP(1); ++rep_) { PHASE_BEGIN(); idx_phase(F, IQ, IK, IW, LOGF, CB, MASK); if (rep_ + 1 < NREP(1)) xcd_barrier(bar); } SEAM(pb + 1); }
        if (INS(2)) { for (int rep_ = 0; rep_ < NREP(2); ++rep_) { PHASE_BEGIN(); attn_phase(F, DQ, DK, DV, FQ, FK, FV, MASK, CB); if (rep_ + 1 < NREP(2)) xcd_barrier(bar); } SEAM(pb + 2); }
        if (INS(3)) { for (int rep_ = 0; rep_ < NREP(3); ++rep_) { PHASE_BEGIN();
            static_assert((WS_FQ - WS_DQ) == (size_t)512 * 256 * AW * 2 && (WS_WB - WS_WA) == (size_t)8 * 256 * AW * 2, "branch B = branch A + 512 row tiles / + 8 column tiles");
            pg8::Gemm g{DQ, (const bf16*)(ws + WS_WA) + (size_t)layer * DM * AW, NTOK, DM, AW}; pg8::D1Order S; S.init(NTOK, DM, F.G, F.bid);
            pg8::EpiGate2 E{MERGED, GA, GB};
            pg8::gemm_phase<pg8::EpiGate2, pg8::D1Order, true, true>(F.lds + RING_OFF, g, S, E);
            if (rep_ + 1 < NREP(3)) xcd_barrier(bar); } SEAM(pb + 3);
        }
        if (INS(5)) { for (int rep_ = 0; rep_ < NREP(5); ++rep_) { PHASE_BEGIN();
            pg8::Gemm g{MERGED, (const bf16*)(ws + WS_WOUT) + (size_t)layer * DM * DM, NTOK, DM, DM}; pg8::StaticOrder S; S.init(NTOK, DM, F.G, F.bid);
            pg8::EpiY E{F.out, layer == 0 ? KIN(const float*, 0) : (const float*)F.out};
            pg8::gemm_phase<pg8::EpiY, pg8::StaticOrder, true, true>(F.lds + RING_OFF, g, S, E);
            if (rep_ + 1 < NREP(5)) xcd_barrier(bar); } SEAM(pb + 5);
        }
        if (INS(6)) { for (int rep_ = 0; rep_ < NREP(6); ++rep_) { PHASE_BEGIN();
            if (moe) ln_phase<1>(F, KIN(const float*, 7) + layer * DM, KIN(const float*, 8) + layer * DM, KIN(const float*, 14) + (size_t)(layer >> 1) * DM * NEXP);
            else ln_phase<0>(F, KIN(const float*, 7) + layer * DM, KIN(const float*, 8) + layer * DM, nullptr);
            if (rep_ + 1 < NREP(6)) xcd_barrier(bar); } SEAM(pb + 6);
        }
        if (!moe) {
            if (INS(8)) { for (int rep_ = 0; rep_ < NREP(8); ++rep_) { PHASE_BEGIN();
                pg8::Gemm g{XS, (const bf16*)(ws + WS_FGU), NTOK, 2 * DFF, DM}; pg8::StaticOrder S; S.init(NTOK, 2 * DFF, F.G, F.bid);
                pg8::EpiSwiglu E{(bf16*)(ws + WS_H), 28};
                pg8::gemm_phase<pg8::EpiSwiglu, pg8::StaticOrder, true, true>(F.lds + RING_OFF, g, S, E);
                if (rep_ + 1 < NREP(8)) xcd_barrier(bar); } SEAM(pb + 8);
            }
            if (INS(9)) { for (int rep_ = 0; rep_ < NREP(9); ++rep_) { PHASE_BEGIN();
                pg8::Gemm g{(const bf16*)(ws + WS_H), (const bf16*)(ws + WS_FD), NTOK, DM, DFF}; pg8::StaticOrder S; S.init(NTOK, DM, F.G, F.bid);
                pg8::EpiY E{F.out, F.out};
                pg8::gemm_phase<pg8::EpiY, pg8::StaticOrder, true, true>(F.lds + RING_OFF, g, S, E);
                if (rep_ + 1 < NREP(9)) xcd_barrier(bar); } SEAM(pb + 9);
            }
            if (INS(12)) { for (int rep_ = 0; rep_ < NREP(12); ++rep_) { PHASE_BEGIN();
                ln_phase<0>(F, KIN(const float*, 9) + layer * DM, KIN(const float*, 10) + layer * DM, nullptr);
                if (rep_ + 1 < NREP(12)) xcd_barrier(bar); } SEAM(pb + 12);
            }
        } else {
            if (INS(7)) { for (int rep_ = 0; rep_ < NREP(7); ++rep_) { PHASE_BEGIN(); moe_convert(F, KIN(const float*, 15), KIN(const float*, 16), KIN(const float*, 17)); moe_assign(F); if (rep_ + 1 < NREP(7)) xcd_barrier(bar); } SEAM(pb + 7); }
            pg8::MoeOrder MO; MO.G = F.G; MO.c = F.bid; MO.slot_tok = (const int*)(ws + MOE_SLOTTOK);
            if (INM(8) || INM(9) || INM(10) || INM(11)) {
                const int* tot = (const int*)(ws + MOE_TOT); int cs = 0;
#pragma unroll
                for (int e = 0; e < 8; ++e) { cs += (tot[e] + 255) >> 8; MO.cum[e] = cs; }
            } else {
#pragma unroll
                for (int e = 0; e < 8; ++e) MO.cum[e] = 0;
            }
#pragma unroll
            for (int pass = 0; pass < 2; ++pass) {
                const int t_lo = pass * MOE_RT, t_hi = (MO.cum[7] < (pass + 1) * MOE_RT) ? MO.cum[7] : (pass + 1) * MOE_RT;
                if (INM(8 + 2 * pass)) { for (int rep_ = 0; rep_ < NREP(8 + 2 * pass); ++rep_) { PHASE_BEGIN();
                    MO.t_lo = t_lo; MO.t_hi = t_hi > t_lo ? t_hi : t_lo; MO.nc = 28;
                    pg8::Gemm g{XS, (const bf16*)F.out, NTOK, NEXP * 2 * DFF, DM};
                    pg8::EpiSwiglu E{(bf16*)(ws + WS_H2), 28};
                    pg8::gemm_phase<pg8::EpiSwiglu, pg8::MoeOrder, true, true, true>(F.lds + RING_OFF, g, MO, E);
                    if (rep_ + 1 < NREP(8 + 2 * pass)) xcd_barrier(bar); } SEAM(pb + 8 + 2 * pass);
                }
                if (INM(9 + 2 * pass)) { for (int rep_ = 0; rep_ < NREP(9 + 2 * pass); ++rep_) { PHASE_BEGIN();
                    MO.t_lo = t_lo; MO.t_hi = t_hi > t_lo ? t_hi : t_lo; MO.nc = 4;
                    pg8::Gemm g{(const bf16*)(ws + WS_H2), (const bf16*)(ws + WS_MWD), MOE_RT * 256, NEXP * DM, DFF};
                    pg8::EpiDownMoe E{(bf16*)(ws + WS_YB), (const float*)(ws + MOE_SLOTGATE), t_lo};
                    pg8::gemm_phase<pg8::EpiDownMoe, pg8::MoeOrder, true, true>(F.lds + RING_OFF, g, MO, E);
                    if (rep_ + 1 < NREP(9 + 2 * pass)) xcd_barrier(bar); } SEAM(pb + 9 + 2 * pass);
                }
            }
            if (INS(12)) { for (int rep_ = 0; rep_ < NREP(12); ++rep_) { PHASE_BEGIN(); ln_phase<3>(F, KIN(const float*, 9) + layer * DM, KIN(const float*, 10) + layer * DM, nullptr); if (rep_ + 1 < NREP(12)) xcd_barrier(bar); } SEAM(pb + 12); }
        }
    }
#undef IN
#undef INS
#undef SEAM
}


#if MK_MULTI && defined(MK_DUMP)
__global__ void dump_kernel(unsigned char* ws, float* out, int mode) {
    const size_t n = (size_t)NTOK * DM;
    for (size_t i = (size_t)blockIdx.x * blockDim.x + threadIdx.x; i < n; i += (size_t)gridDim.x * blockDim.x) {
        const size_t row = i >> 10; const int c = (int)(i & 1023);
        float v = 0.f;
        auto B = [&](size_t off, int pitch, int col) { return pg8::bf2f(((const bf16*)(ws + off))[row * pitch + col]); };
        if (mode == 1) { if (c < 512) v = B(WS_DQ, 512, c) + 2.f * B(WS_DK, 512, c) + 4.f * B(WS_DV, 512, c) + 8.f * B(WS_IQ, 512, c);
                         else v = B(WS_FQ, 512, c - 512) + 2.f * B(WS_FK, 512, c - 512) + 4.f * B(WS_FV, 512, c - 512) + 8.f * B(WS_IK, 64, c & 63) + ((const float*)(ws + WS_IW))[row * 8 + (c & 7)] + ((const float*)(ws + WS_LOGF))[row * 8 + (c & 7)]; }
        else if (mode == 2) v = B(WS_GA, 1024, c) + 2.f * B(WS_GB, 1024, c);
        else if (mode == 3) { const unsigned w = ((const unsigned*)(ws + WS_MASK))[row * 128 + (c & 127)]; const int qb = (int)((row & 4095) >> 8); v = ((c & 127) < 8 * (qb + 1)) ? (float)((w >> (4 * (c >> 7))) & 0xffffu) : 0.f; }
        else if (mode == 4) v = ((const float*)(ws + WS_CB))[(row >> 12) * 8 * 4096 + (size_t)(c & 7) * 4096 + (row & 4095)];
        else if (mode == 5) v = c < 512 ? B(WS_DQ, 512, c) : B(WS_FQ, 512, c - 512);
        else if (mode == 6) v = B(WS_MERGED, 1024, c);
        else if (mode == 7) v = B(WS_XS, 1024, c);
        out[i] = v;
    }
}
#endif
extern "C" void kernel_launch(void* const* d_in, const int* in_sizes, int n_in, void* d_out, int out_size, void* d_ws, size_t ws_size, hipStream_t stream) {
    static int grid = 0;
    if (grid == 0) {
        if (n_in != 18 || in_sizes[0] != NTOK * DM || out_size != NTOK * DM || ws_size < WS_END) {
            fprintf(stderr, "kernel_launch: unexpected shapes: n_in %d in0 %d out %d ws %zu (need %zu); nothing launched\n", n_in, n_in > 0 ? in_sizes[0] : -1, out_size, ws_size, (size_t)WS_END); grid = -1; return; }
        int dev = 0, cus = 0, per_cu = 0;
        if (hipGetDevice(&dev) != hipSuccess || hipDeviceGetAttribute(&cus, hipDeviceAttributeMultiprocessorCount, dev) != hipSuccess) { fprintf(stderr, "kernel_launch: device query failed\n"); grid = -1; return; }
        if (hipFuncSetAttribute((const void*)mk_fwd, hipFuncAttributeMaxDynamicSharedMemorySize, LDS_BYTES) != hipSuccess) { fprintf(stderr, "kernel_launch: hipFuncSetAttribute failed\n"); grid = -1; return; }
        if (hipOccupancyMaxActiveBlocksPerMultiprocessor(&per_cu, (const void*)mk_fwd, NWAVES * 64, LDS_BYTES) != hipSuccess || per_cu < 1)
            fprintf(stderr, "kernel_launch: note: occupancy query reports %d workgroups per CU\n", per_cu);
        (void)hipGetLastError();
        grid = cus;
        if (grid != 256) fprintf(stderr, "kernel_launch: note: %d CUs (built for 256)\n", grid);
    }
    if (grid < 0) return;
    if (hipMemsetAsync((char*)d_ws + WS_CTL, 0, CTL_ZERO_BYTES, stream) != hipSuccess) { fprintf(stderr, "kernel_launch: memset failed\n"); return; }
    Args a{};
    for (int i = 0; i < 18; ++i) a.in[i] = d_in[i];
    a.out = (float*)d_out; a.ws = (unsigned char*)d_ws;
#if MK_MULTI
#ifndef MK_MAXPH
#define MK_MAXPH NPHASE
#endif
    for (int k = 0; k < MK_MAXPH; ++k) {
        if (k >= 1) { const int layer = (k - 1) / 13, s = (k - 1) % 13; const bool moe = layer & 1;
            if (s == 4 || (!moe && (s == 7 || s == 10 || s == 11))) continue; }
        a.ph_lo = k; a.ph_hi = k + 1;
        hipLaunchKernelGGL(mk_fwd, dim3(grid), dim3(NWAVES * 64), LDS_BYTES, stream, a);
    }
#ifdef MK_DUMP
    hipLaunchKernelGGL(dump_kernel, dim3(2048), dim3(256), 0, stream, (unsigned char*)d_ws, (float*)d_out, MK_DUMP);
#endif
#else
    a.ph_lo = 0; a.ph_hi = NPHASE;
    hipLaunchKernelGGL(mk_fwd, dim3(grid), dim3(NWAVES * 64), LDS_BYTES, stream, a);
#endif
    const hipError_t le = hipPeekAtLastError();
    if (le != hipSuccess) fprintf(stderr, "kernel_launch: launch failed: %s\n", hipGetErrorName(le));
}
```

```cpp
#include <hip/hip_runtime.h>
#include <hip/hip_bf16.h>
#include <cstdio>
#include <cstdint>
#include <cmath>

#ifndef MK_MULTI
#define MK_MULTI 0
#endif

constexpr int BATCH = 8, SEQ = 4096, DM = 1024, NTOK = BATCH * SEQ, AW = 512, NH = 8;
constexpr int PROJ_TOTAL = 5712, PROJ_PAD = 5888, DFF = 3584, NEXP = 8;
constexpr float LN_EPS = 1e-5f;
constexpr float ALPHA = 1.4142135623730951f;
constexpr float LOG2E = 1.4426950408889634f;
constexpr float C2 = 0.125f * LOG2E;
constexpr int DSA_TOPK = 256;
constexpr int MOE_H2_TILES = 136;
constexpr int MOE_NT_MAX = 264;

constexpr int NWAVES = 8;
constexpr size_t MiB = 1u << 20;
constexpr size_t WS_CTL = 0, CTL_ZERO_BYTES = 1 * MiB;
constexpr size_t WS_WIN = 1 * MiB;
constexpr size_t WIN_STRIDE = (size_t)PROJ_PAD * DM * 2;
constexpr size_t WS_WA = 24 * MiB, WS_WB = 26 * MiB, WS_WOUT = 28 * MiB;
constexpr size_t WS_FGU = 32 * MiB, WS_FD = 46 * MiB;
constexpr size_t WS_CS = 53 * MiB;
constexpr size_t WS_IW = 61 * MiB, WS_LOGF = 62 * MiB, WS_CB = 63 * MiB;
constexpr size_t WS_MOE = 64 * MiB;
constexpr size_t MOE_TOPE = WS_MOE, MOE_TOPG = WS_MOE + 128 * 1024, MOE_TOKSLOT = WS_MOE + 384 * 1024, MOE_SLOTTOK = WS_MOE + 640 * 1024,
                 MOE_SLOTGATE = WS_MOE + 1024 * 1024, MOE_CNT = WS_MOE + 1408 * 1024, MOE_TOT = MOE_CNT + 16 * 1024;
constexpr size_t WS_XS = 66 * MiB;
constexpr size_t WS_DQ = 130 * MiB, WS_DK = 162 * MiB, WS_DV = 194 * MiB, WS_IQ = 226 * MiB, WS_FQ = 258 * MiB, WS_FK = 290 * MiB, WS_FV = 322 * MiB;
constexpr size_t WS_GA = 354 * MiB, WS_GB = 418 * MiB;
constexpr size_t WS_IK = 482 * MiB, WS_MASK = 486 * MiB;
constexpr size_t WS_MERGED = WS_DK;
constexpr size_t WS_H = 130 * MiB;
constexpr size_t WS_H2 = 130 * MiB;
constexpr size_t WS_YB = 368 * MiB;
constexpr size_t WS_MWD = 500 * MiB;
constexpr size_t WS_END = 556 * MiB;
static_assert(WS_MASK + (size_t)NTOK * 128 * 4 <= WS_END && WS_H2 + (size_t)MOE_H2_TILES * 256 * DFF * 2 <= WS_YB && WS_YB + (size_t)MOE_NT_MAX * 256 * DM * 2 <= WS_MWD && WS_MWD + (size_t)NEXP * DM * DFF * 2 <= WS_END, "ws map");
static_assert(WS_WIN + 2 * WIN_STRIDE <= WS_WA && WS_FD + (size_t)DM * DFF * 2 <= WS_CS && WS_H + (size_t)NTOK * DFF * 2 <= WS_GA, "ws map 2");
constexpr int CW_TMO = 0, CW_CODE = 1, CW_BAR = 4096;

constexpr int RING_OFF = 0, RING_BYTES = 131072;
constexpr int IDX_ROWB = 8200;
constexpr int IDX_HIST_OFF = 16 * IDX_ROWB;
constexpr int MISC_OFF = 146432;
constexpr int LDS_BYTES = 147456;
static_assert(IDX_HIST_OFF + 8 * 1024 <= MISC_OFF && MISC_OFF + 128 <= LDS_BYTES, "LDS map");

#define GAS __attribute__((address_space(1)))
#define LAS __attribute__((address_space(3)))
typedef unsigned short bf16;
typedef unsigned v4u __attribute__((ext_vector_type(4)));
typedef unsigned v2u __attribute__((ext_vector_type(2)));
typedef float f32x4 __attribute__((ext_vector_type(4)));
typedef short bf16x8 __attribute__((ext_vector_type(8)));
typedef GAS unsigned gu32;
#define RLX_AGENT __ATOMIC_RELAXED, __HIP_MEMORY_SCOPE_AGENT
__device__ __forceinline__ unsigned f2bf(float f) { unsigned u = __builtin_bit_cast(unsigned, f); return (u + 0x7fffu + ((u >> 16) & 1u)) >> 16; }
__device__ __forceinline__ unsigned pk2(float lo, float hi) { return f2bf(lo) | (f2bf(hi) << 16); }

namespace pg8 {
#define PG8_LAS __attribute__((address_space(3)))
typedef unsigned short bf16_t;
typedef short bf16x8 __attribute__((ext_vector_type(8)));
typedef float f32x4 __attribute__((ext_vector_type(4)));
typedef unsigned u32x4 __attribute__((ext_vector_type(4)));
constexpr int BM = 256, BK = 64, HALF = 128, HTB = HALF * BK * 2  , STAGE_BYTES = 8 * HTB, NXCD = 8, WGM = 8;

__host__ __device__ __forceinline__ int lds_byte(int r, int c) { const int st = (r >> 4) * 2 + (c >> 5), rr = r & 15, cc = c & 31, ob = rr * 64 + cc * 2; return st * 1024 + (ob ^ (((ob >> 9) & 1) << 5)); }
__host__ __device__ __forceinline__ void stage_rc(int b, int& R, int& C) { const int st = b / 1024, sb = b % 1024, swz = sb ^ (((sb >> 9) & 1) << 5); R = (st >> 1) * 16 + swz / 64; C = (st & 1) * 32 + (swz % 64) / 2; }
__host__ __device__ __forceinline__ int perm32(int rho) { const int n = rho >> 4, i = rho & 15; return 8 * (i >> 2) + 4 * n + (i & 3); }

struct Unit { int pm, pn; };
struct Gemm { const bf16_t* A; const bf16_t* Bt; int M, N, K; };

struct StaticOrder {
    int nM, nN, nwg, G, c;
    __host__ __device__ void init(int M, int N, int G_, int c_) { nM = M / BM; nN = N / BM; nwg = nM * nN; G = G_; c = c_; }
    __host__ __device__ bool next(int i, Unit& u) const {
        const long L = (long)i * G + c; if (L >= nwg) return false;
        int wgid = (int)L; { const int q = nwg / NXCD, r = nwg % NXCD, xcd = wgid % NXCD, off = wgid / NXCD; wgid = (xcd < r ? xcd * (q + 1) : r * (q + 1) + (xcd - r) * q) + off; }
        const int nig = WGM * nN, gid = wgid / nig, fm = gid * WGM, gsz = (nM - fm) < WGM ? (nM - fm) : WGM;
        u.pm = fm + ((wgid % nig) % gsz); u.pn = (wgid % nig) / gsz; return true;
    }
    __device__ __forceinline__ void a_ready(const Unit&) const {}
    __device__ __forceinline__ void done(const Unit&) const {}
};
__device__ __forceinline__ unsigned cvt_pk_bf16(float lo, float hi) { unsigned r; asm volatile("v_cvt_pk_bf16_f32 %0, %1, %2" : "=v"(r) : "v"(lo), "v"(hi)); return r; }
typedef float f32x2 __attribute__((ext_vector_type(2)));
template <class Epi, class Sched, bool ALIGN_EPI = false, bool SP2 = false, bool GATHER = false>
__device__ __forceinline__ void gemm_phase(PG8_LAS unsigned char* lds, const Gemm g, const Sched& S, const Epi& E) {
    int tid_ = threadIdx.x; asm volatile("" : "+v"(tid_));
    const int tid = tid_, wid = __builtin_amdgcn_readfirstlane(tid >> 6), lane = tid & 63, wr = wid >> 2, wc = wid & 3, fr = lane & 15, fq = lane >> 4;
    const int K = g.K, nt = K / BK;
    unsigned voffA[2], voffB[2]; int gR[2]; unsigned gC[2];
#pragma unroll
    for (int i = 0; i < 2; ++i) { int R, C; stage_rc(tid * 16 + i * 8192, R, C); const int Rb = Epi::PERM ? ((R & ~31) + perm32(R & 31)) : R;
        voffA[i] = (unsigned)(R * K + C) * 2u; voffB[i] = (unsigned)(Rb * K + C) * 2u; gR[i] = R; gC[i] = (unsigned)C * 2u; }
    static_assert(!GATHER || SP2, "gather mode is written for the SP2 loop only");
    unsigned cv[2][2] = {{0u, 0u}, {0u, 0u}}, nv[2][2] = {{0u, 0u}, {0u, 0u}};
    const size_t kstep = (size_t)(BK * 2);
    const size_t hstep = (size_t)HALF * K * 2;
    const size_t tstep = 2 * hstep;
    const unsigned ldsw = (unsigned)wid * 1024u;
    const int aoff = lds_byte(wr * 64 + fr, fq * 8), boff = lds_byte(wc * 32 + fr, fq * 8);
#define PG8_SA(b, h) (((b) * 2 + (h)) * HTB)
#define PG8_SB(b, h) ((4 + (b) * 2 + (h)) * HTB)
#define PG8_STAGE(bufoff, gbase, voff) do { _Pragma("unroll") for (int _i = 0; _i < 2; ++_i) \
        __builtin_amdgcn_global_load_lds((const unsigned*)((const char*)(gbase) + (voff)[_i]), (PG8_LAS unsigned*)(lds + (bufoff) + ldsw + _i * 8192), 16, 0, 0); } while (0)
#define PG8_STAGE_A(b, h, gbase, VO) do { if constexpr (GATHER) { PG8_STAGE(PG8_SA(b, h), gbase, VO[h]); } else { PG8_STAGE(PG8_SA(b, h), (gbase) + (h) * hstep, voffA); } } while (0)
#define PG8_LDA(dst, b, h) do { _Pragma("unroll") for (int m = 0; m < 4; ++m) _Pragma("unroll") for (int k = 0; k < 2; ++k) dst[m][k] = *(const PG8_LAS bf16x8*)(lds + PG8_SA(b, h) + aoff + m * 2048 + k * 1024); } while (0)
#define PG8_LDB(dst, b, h) do { _Pragma("unroll") for (int n = 0; n < 2; ++n) _Pragma("unroll") for (int k = 0; k < 2; ++k) dst[n][k] = *(const PG8_LAS bf16x8*)(lds + PG8_SB(b, h) + boff + n * 2048 + k * 1024); } while (0)
#define PG8_MMA(ai, bj, At, Bt) do { __builtin_amdgcn_s_setprio(1); _Pragma("unroll") for (int m = 0; m < 4; ++m) _Pragma("unroll") for (int n = 0; n < 2; ++n) _Pragma("unroll") for (int k = 0; k < 2; ++k) \
        acc[ai][bj][m][n] = __builtin_amdgcn_mfma_f32_16x16x32_bf16(Bt[n][k], At[m][k], acc[ai][bj][m][n], 0, 0, 0); __builtin_amdgcn_s_setprio(0); } while (0)
#define PG8_WAIT_V(n) asm volatile("s_waitcnt vmcnt(" #n ")" ::: "memory")
#define PG8_WAIT_L(n) asm volatile("s_waitcnt lgkmcnt(" #n ")" ::: "memory")
#define PG8_BAR __builtin_amdgcn_s_barrier()
#define PG8_SCHED __builtin_amdgcn_sched_barrier(0)
    Unit cur, nxt; int ui = 0;
    if (!S.next(0, cur)) return;
    f32x4 acc[2][2][4][2];
#pragma unroll
    for (int a = 0; a < 2; ++a)
#pragma unroll
        for (int b = 0; b < 2; ++b)
#pragma unroll
            for (int m = 0; m < 4; ++m)
#pragma unroll
                for (int n = 0; n < 2; ++n) acc[a][b][m][n] = (f32x4){0.f, 0.f, 0.f, 0.f};
    bf16x8 At[4][2], B0[2][2], B1[2][2];
    const char* cA = (const char*)g.A + (GATHER ? (size_t)0 : (size_t)cur.pm * tstep);
    if constexpr (GATHER) {
#pragma unroll
        for (int h = 0; h < 2; ++h)
#pragma unroll
            for (int i = 0; i < 2; ++i) { cv[h][i] = (unsigned)S.arow(cur, h * HALF + gR[i]) * (unsigned)(K * 2) + gC[i]; nv[h][i] = cv[h][i]; } } const char* cB = (const char*)g.Bt + (size_t)cur.pn * tstep;
    S.a_ready(cur);
    if constexpr (SP2) {
        PG8_STAGE(PG8_SB(0, 0), cB, voffB); PG8_STAGE(PG8_SB(0, 1), cB + hstep, voffB); PG8_STAGE_A(0, 0, cA, cv); PG8_STAGE_A(0, 1, cA, cv);
        if (wr == 1) PG8_BAR;
        PG8_WAIT_V(2); PG8_BAR;
        PG8_STAGE(PG8_SB(1, 0), cB + kstep, voffB); PG8_STAGE_A(1, 0, cA + kstep, cv); PG8_STAGE(PG8_SB(1, 1), cB + hstep + kstep, voffB);
        PG8_WAIT_V(6); PG8_BAR;
    } else {
        PG8_STAGE(PG8_SB(0, 0), cB, voffB); PG8_STAGE(PG8_SA(0, 0), cA, voffA); PG8_STAGE(PG8_SB(0, 1), cB + hstep, voffB); PG8_STAGE(PG8_SA(0, 1), cA + hstep, voffA);
        if (wr == 1) PG8_BAR;
        PG8_WAIT_V(4); PG8_BAR;
        PG8_STAGE(PG8_SB(1, 0), cB + kstep, voffB); PG8_STAGE_A(1, 0, cA + kstep, cv); PG8_STAGE(PG8_SB(1, 1), cB + hstep + kstep, voffB);
        PG8_WAIT_V(6); PG8_BAR;
    }
    for (;;) {
        const bool has_next = S.next(ui + 1, nxt);
        const char* nA = (has_next && !GATHER) ? (const char*)g.A + (size_t)nxt.pm * tstep : cA;
        if constexpr (GATHER) { if (has_next) {
#pragma unroll
            for (int h = 0; h < 2; ++h)
#pragma unroll
                for (int i = 0; i < 2; ++i) nv[h][i] = (unsigned)S.arow(nxt, h * HALF + gR[i]) * (unsigned)(K * 2) + gC[i]; } } const char* nB = has_next ? (const char*)g.Bt + (size_t)nxt.pn * tstep : cB;
        for (int t = 0; t < nt; t += 2) {
            const bool last = (t == nt - 2);
            const char* a1 = cA + (size_t)(t + 1) * kstep;
            const char* a2 = last ? nA : cA + (size_t)(t + 2) * kstep; const char* b2 = last ? nB : cB + (size_t)(t + 2) * kstep;
            const char* a3 = a2 + kstep; const char* b3 = b2 + kstep;
            if (last && has_next) S.a_ready(nxt);
            unsigned v2[2][2];
#pragma unroll
            for (int h = 0; h < 2; ++h)
#pragma unroll
                for (int i = 0; i < 2; ++i) v2[h][i] = last ? nv[h][i] : cv[h][i];
            if constexpr (SP2) {
            PG8_LDB(B0, 0, 0); PG8_LDB(B1, 0, 1); PG8_SCHED; PG8_LDA(At, 0, 0); PG8_STAGE_A(1, 1, a1, cv);
            PG8_WAIT_V(8); PG8_WAIT_L(0); PG8_BAR; PG8_MMA(0, 0, At, B0); PG8_MMA(0, 1, At, B1); PG8_BAR; PG8_SCHED;
            PG8_LDA(At, 0, 1); PG8_STAGE(PG8_SB(0, 0), b2, voffB); PG8_STAGE(PG8_SB(0, 1), b2 + hstep, voffB); PG8_STAGE_A(0, 0, a2, v2);
            PG8_WAIT_V(8); PG8_WAIT_L(0); PG8_BAR; PG8_MMA(1, 0, At, B0); PG8_MMA(1, 1, At, B1); PG8_BAR; PG8_SCHED;
            PG8_LDB(B0, 1, 0); PG8_LDB(B1, 1, 1); PG8_SCHED; PG8_LDA(At, 1, 0); PG8_STAGE_A(0, 1, a2, v2);
            PG8_WAIT_V(8); PG8_WAIT_L(0); PG8_BAR; PG8_MMA(0, 0, At, B0); PG8_MMA(0, 1, At, B1); PG8_BAR; PG8_SCHED;
            PG8_LDA(At, 1, 1); PG8_STAGE(PG8_SB(1, 0), b3, voffB); PG8_STAGE(PG8_SB(1, 1), b3 + hstep, voffB); PG8_STAGE_A(1, 0, a3, v2);
            PG8_WAIT_V(8); PG8_WAIT_L(0); PG8_BAR; PG8_MMA(1, 0, At, B0); PG8_MMA(1, 1, At, B1); PG8_BAR; PG8_SCHED;
            } else {
            PG8_LDB(B0, 0, 0); PG8_SCHED; PG8_LDA(At, 0, 0); PG8_STAGE(PG8_SA(1, 1), a1 + hstep, voffA);
            PG8_WAIT_L(8); PG8_BAR; PG8_WAIT_L(0); PG8_MMA(0, 0, At, B0); PG8_BAR; PG8_SCHED;
            PG8_LDB(B1, 0, 1); PG8_STAGE(PG8_SB(0, 0), b2, voffB);
            PG8_BAR; PG8_WAIT_L(0); PG8_MMA(0, 1, At, B1); PG8_BAR;
            PG8_LDA(At, 0, 1); PG8_STAGE(PG8_SA(0, 0), a2, voffA);
            PG8_BAR; PG8_WAIT_L(0); PG8_MMA(1, 0, At, B0); PG8_BAR; PG8_SCHED;
            PG8_STAGE(PG8_SB(0, 1), b2 + hstep, voffB);
            PG8_WAIT_V(6); PG8_BAR; PG8_MMA(1, 1, At, B1); PG8_BAR;
            PG8_LDB(B0, 1, 0); PG8_SCHED; PG8_LDA(At, 1, 0); PG8_STAGE(PG8_SA(0, 1), a2 + hstep, voffA);
            PG8_WAIT_L(8); PG8_BAR; PG8_WAIT_L(0); PG8_MMA(0, 0, At, B0); PG8_BAR; PG8_SCHED;
            PG8_LDB(B1, 1, 1); PG8_STAGE(PG8_SB(1, 0), b3, voffB);
            PG8_BAR; PG8_WAIT_L(0); PG8_MMA(0, 1, At, B1); PG8_BAR;
            PG8_LDA(At, 1, 1); PG8_STAGE(PG8_SA(1, 0), a3, voffA);
            PG8_BAR; PG8_WAIT_L(0); PG8_MMA(1, 0, At, B0); PG8_BAR; PG8_SCHED;
            PG8_STAGE(PG8_SB(1, 1), b3 + hstep, voffB);
            PG8_WAIT_V(6); PG8_BAR; PG8_MMA(1, 1, At, B1); PG8_BAR;
            }
        }
        if constexpr (ALIGN_EPI) { if (wr == 0) PG8_BAR; }
        if constexpr (!Epi::AFTER_DRAIN) { E(acc, cur, wr, wc, fr, fq); S.done(cur); }
        if (!has_next) break;
#pragma unroll
        for (int a = 0; a < 2; ++a)
#pragma unroll
            for (int b = 0; b < 2; ++b)
#pragma unroll
                for (int m = 0; m < 4; ++m)
#pragma unroll
                    for (int n = 0; n < 2; ++n) acc[a][b][m][n] = (f32x4){0.f, 0.f, 0.f, 0.f};
        cur = nxt; cA = nA; cB = nB; ++ui;
        if constexpr (GATHER) {
#pragma unroll
            for (int h = 0; h < 2; ++h)
#pragma unroll
                for (int i = 0; i < 2; ++i) cv[h][i] = nv[h][i]; }
        if constexpr (ALIGN_EPI) { if (wr == 1) PG8_BAR; }
    }
    PG8_WAIT_V(0);
    if constexpr (!ALIGN_EPI) { if (wr == 0) PG8_BAR; }
    PG8_BAR;
    if constexpr (Epi::AFTER_DRAIN) { E.fused(acc, cur, wr, wc, fr, fq, lds, wid, lane); S.done(cur); }
#undef PG8_SA
#undef PG8_SB
#undef PG8_STAGE
#undef PG8_STAGE_A
#undef PG8_LDA
#undef PG8_LDB
#undef PG8_MMA
#undef PG8_WAIT_V
#undef PG8_WAIT_L
#undef PG8_BAR
#undef PG8_SCHED
}
}
namespace pg8 {
typedef unsigned u32x2 __attribute__((ext_vector_type(2)));
__device__ __forceinline__ float bf2f(unsigned h16) { return __uint_as_float(h16 << 16); }
__device__ __forceinline__ float sigmoidf_fast(float x) { return __builtin_amdgcn_rcpf(1.0f + __builtin_amdgcn_exp2f(-x * 1.4426950408889634f)); }
typedef float f32x2c __attribute__((ext_vector_type(2))); typedef __bf16 bf16x2c __attribute__((ext_vector_type(2)));
__device__ __forceinline__ unsigned cvt2(float lo, float hi) { f32x2c v = {lo, hi}; bf16x2c b = __builtin_convertvector(v, bf16x2c); return __builtin_bit_cast(unsigned, b); }
__device__ __forceinline__ u32x4 pack8(const f32x4& a, const f32x4& b) { u32x4 w; w.x = cvt2(a[0], a[1]); w.y = cvt2(a[2], a[3]); w.z = cvt2(b[0], b[1]); w.w = cvt2(b[2], b[3]); return w; }
__device__ __forceinline__ void unpack8(const u32x4& w, f32x4& a, f32x4& b) {
    a[0] = bf2f(w.x & 0xffffu); a[1] = __uint_as_float(w.x & 0xffff0000u); a[2] = bf2f(w.y & 0xffffu); a[3] = __uint_as_float(w.y & 0xffff0000u);
    b[0] = bf2f(w.z & 0xffffu); b[1] = __uint_as_float(w.z & 0xffff0000u); b[2] = bf2f(w.w & 0xffffu); b[3] = __uint_as_float(w.w & 0xffff0000u); }

#ifdef DBG_NOSIG
#define SIGF(x) (x)
#else
#define SIGF(x) sigmoidf_fast(x)
#endif
struct EpiProj {
    static constexpr bool PERM = true, AFTER_DRAIN = false;
    unsigned char* ws; const float* bforget;
    __device__ __forceinline__ void operator()(const f32x4 (&acc)[2][2][4][2], const Unit& u, int wr, int wc, int fr, int fq) const {
        const int pn = u.pn; const int row0 = u.pm * BM + wr * 64 + fr;
        bf16_t *DQ = (bf16_t*)(ws + WS_DQ), *DK = (bf16_t*)(ws + WS_DK), *DV = (bf16_t*)(ws + WS_DV), *IQ = (bf16_t*)(ws + WS_IQ), *FQ = (bf16_t*)(ws + WS_FQ), *FK = (bf16_t*)(ws + WS_FK), *FV = (bf16_t*)(ws + WS_FV);
        bf16_t *GA = (bf16_t*)(ws + WS_GA), *GB = (bf16_t*)(ws + WS_GB), *IK = (bf16_t*)(ws + WS_IK); float *IW = (float*)(ws + WS_IW), *LOGF = (float*)(ws + WS_LOGF); const float* CS = (const float*)(ws + WS_CS);
        const bool rot = (pn < 4) || pn == 6 || pn == 7 || (pn == 22 && wc == 0);
        if (rot) {
            bf16_t* dst; int pitch, col1; float sc = 1.f;
            if (pn == 22) { dst = IK; pitch = 64; col1 = 8 * fq; }
            else { dst = pn < 2 ? DQ : (pn < 4 ? DK : IQ); pitch = AW; col1 = (4 * (pn & 1) + wc) * 64 + 8 * fq; if (pn < 2) sc = C2; }
#pragma unroll
            for (int ai = 0; ai < 2; ++ai)
#pragma unroll
                for (int m = 0; m < 4; ++m) {
                    const int row = row0 + ai * HALF + m * 16;
                    const float* cs = CS + (size_t)row * 64 + 16 * fq;
                    const f32x4 t0 = *(const f32x4*)(cs), t1 = *(const f32x4*)(cs + 4), t2 = *(const f32x4*)(cs + 8), t3 = *(const f32x4*)(cs + 12);
                    const f32x4 xa = acc[ai][0][m][0], xb = acc[ai][0][m][1], ya = acc[ai][1][m][0], yb = acc[ai][1][m][1];
                    f32x4 o1a, o1b, o2a, o2b;
                    o1a[0] = (xa[0] * t0[0] - ya[0] * t0[1]) * sc; o2a[0] = (ya[0] * t0[0] + xa[0] * t0[1]) * sc;
                    o1a[1] = (xa[1] * t0[2] - ya[1] * t0[3]) * sc; o2a[1] = (ya[1] * t0[2] + xa[1] * t0[3]) * sc;
                    o1a[2] = (xa[2] * t1[0] - ya[2] * t1[1]) * sc; o2a[2] = (ya[2] * t1[0] + xa[2] * t1[1]) * sc;
                    o1a[3] = (xa[3] * t1[2] - ya[3] * t1[3]) * sc; o2a[3] = (ya[3] * t1[2] + xa[3] * t1[3]) * sc;
                    o1b[0] = (xb[0] * t2[0] - yb[0] * t2[1]) * sc; o2b[0] = (yb[0] * t2[0] + xb[0] * t2[1]) * sc;
                    o1b[1] = (xb[1] * t2[2] - yb[1] * t2[3]) * sc; o2b[1] = (yb[1] * t2[2] + xb[1] * t2[3]) * sc;
                    o1b[2] = (xb[2] * t3[0] - yb[2] * t3[1]) * sc; o2b[2] = (yb[2] * t3[0] + xb[2] * t3[1]) * sc;
                    o1b[3] = (xb[3] * t3[2] - yb[3] * t3[3]) * sc; o2b[3] = (yb[3] * t3[2] + xb[3] * t3[3]) * sc;
                    bf16_t* rp = dst + (size_t)row * pitch + col1;
                    *(u32x4*)(rp) = pack8(o1a, o1b); *(u32x4*)(rp + 32) = pack8(o2a, o2b);
                }
        } else if (pn == 22) {
            if (fq == 0 && (wc == 1 || wc == 2)) {
                f32x4 b0 = {0.f, 0.f, 0.f, 0.f}, b1 = {0.f, 0.f, 0.f, 0.f};
                if (wc == 2) { b0 = *(const f32x4*)(bforget); b1 = *(const f32x4*)(bforget + 4); }
#pragma unroll
                for (int ai = 0; ai < 2; ++ai)
#pragma unroll
                    for (int m = 0; m < 4; ++m) {
                        const int row = row0 + ai * HALF + m * 16;
                        f32x4 va = acc[ai][0][m][0], vb = acc[ai][0][m][1];
                        if (wc == 1) { va = va * 0.04419417382415922f; vb = vb * 0.04419417382415922f;
                            *(f32x4*)(IW + (size_t)row * 8) = va; *(f32x4*)(IW + (size_t)row * 8 + 4) = vb; }
                        else { va = va + b0; vb = vb + b1; f32x4 la, lb;
#pragma unroll
                            for (int i = 0; i < 4; ++i) { const float za = va[i], zb = vb[i];
                                la[i] = fminf(za, 0.f) - log1pf(__expf(-fabsf(za))); lb[i] = fminf(zb, 0.f) - log1pf(__expf(-fabsf(zb))); }
                            float* lp = LOGF + (size_t)(row >> 12) * (NH * SEQ) + (row & (SEQ - 1));
                            lp[0] = la[0]; lp[SEQ] = la[1]; lp[2 * SEQ] = la[2]; lp[3 * SEQ] = la[3]; lp[4 * SEQ] = lb[0]; lp[5 * SEQ] = lb[1]; lp[6 * SEQ] = lb[2]; lp[7 * SEQ] = lb[3]; }
                    }
            }
        } else if (pn < 14) {
            bf16_t* dst = pn < 6 ? DV : (pn < 10 ? FQ : (pn < 12 ? FK : FV)); const float sc = (pn == 8 || pn == 9) ? C2 : 1.f;
            const int col0 = 256 * (pn & 1) + wc * 32 + 8 * fq;
#pragma unroll
            for (int ai = 0; ai < 2; ++ai)
#pragma unroll
                for (int m = 0; m < 4; ++m) { bf16_t* rp = dst + (size_t)(row0 + ai * HALF + m * 16) * AW + col0;
#pragma unroll
                    for (int bj = 0; bj < 2; ++bj) *(u32x4*)(rp + bj * HALF) = pack8(acc[ai][bj][m][0] * sc, acc[ai][bj][m][1] * sc); }
        } else {
            bf16_t* dst = pn < 18 ? GA : GB; const int col0 = 256 * ((pn - 14) & 3) + wc * 32 + 8 * fq;
#pragma unroll
            for (int ai = 0; ai < 2; ++ai)
#pragma unroll
                for (int m = 0; m < 4; ++m) { bf16_t* rp = dst + (size_t)(row0 + ai * HALF + m * 16) * DM + col0;
#pragma unroll
                    for (int bj = 0; bj < 2; ++bj) { f32x4 a = acc[ai][bj][m][0], b = acc[ai][bj][m][1];
#pragma unroll
                        for (int i = 0; i < 4; ++i) { a[i] = SIGF(a[i]); b[i] = SIGF(b[i]); }
                        *(u32x4*)(rp + bj * HALF) = pack8(a, b); } }
        }
    }
};

struct EpiGate2 {
    static constexpr bool PERM = true, AFTER_DRAIN = false;
    bf16_t* O; const bf16_t* GAp; const bf16_t* GBp;
    __device__ __forceinline__ void operator()(const f32x4 (&acc)[2][2][4][2], const Unit& u, int wr, int wc, int fr, int fq) const {
        const int br = u.pm >> 9; const bf16_t* G = br ? GBp : GAp;
        const int row0 = (u.pm & 511) * BM + wr * 64 + fr, col0 = (u.pn & 7) * BM + wc * 32 + 8 * fq;
#pragma unroll
        for (int ai = 0; ai < 2; ++ai) {
            u32x4 gv[4][2], pv_[4][2];
#pragma unroll
            for (int m = 0; m < 4; ++m)
#pragma unroll
                for (int bj = 0; bj < 2; ++bj) { const size_t off = (size_t)(row0 + ai * HALF + m * 16) * DM + col0 + bj * HALF;
                    gv[m][bj] = *(const u32x4*)(G + off); pv_[m][bj] = br ? *(const u32x4*)(O + off) : (u32x4){0u, 0u, 0u, 0u}; }
#pragma unroll
            for (int m = 0; m < 4; ++m)
#pragma unroll
                for (int bj = 0; bj < 2; ++bj) { const size_t off = (size_t)(row0 + ai * HALF + m * 16) * DM + col0 + bj * HALF;
                    f32x4 ga, gb, pa, pb; unpack8(gv[m][bj], ga, gb); unpack8(pv_[m][bj], pa, pb);
                    *(u32x4*)(O + off) = pack8(ga * acc[ai][bj][m][0] + pa, gb * acc[ai][bj][m][1] + pb); }
        }
    }
};
struct D1Order {
    StaticOrder S; int n;
    __device__ __forceinline__ void init(int M, int N, int G, int c) { S.init(M, N, G, c); n = (S.nwg - c + G - 1) / G; if (n < 0) n = 0; }
    __device__ __forceinline__ bool next(int i, Unit& u) const { if (i >= 2 * n) return false; const int br = (i >= n) ? 1 : 0; S.next(i - br * n, u); u.pm += 512 * br; u.pn += 8 * br; return true; }
    __device__ __forceinline__ void a_ready(const Unit&) const {}
    __device__ __forceinline__ void done(const Unit&) const {}
};

struct EpiY {
    static constexpr bool PERM = false, AFTER_DRAIN = false;
    float* Y; const float* R;
    __device__ __forceinline__ void operator()(const f32x4 (&acc)[2][2][4][2], const Unit& u, int wr, int wc, int fr, int fq) const {
        const int row0 = u.pm * BM + wr * 64 + fr, col0 = u.pn * BM + wc * 32 + 4 * fq;
#pragma unroll
        for (int ai = 0; ai < 2; ++ai)
#pragma unroll
            for (int mp = 0; mp < 2; ++mp) {
                f32x4 r[2][2][2];
#pragma unroll
                for (int mm = 0; mm < 2; ++mm)
#pragma unroll
                    for (int bj = 0; bj < 2; ++bj)
#pragma unroll
                        for (int n = 0; n < 2; ++n) r[mm][bj][n] = *(const f32x4*)(R + (size_t)(row0 + ai * HALF + (2 * mp + mm) * 16) * DM + col0 + bj * HALF + n * 16);
#pragma unroll
                for (int mm = 0; mm < 2; ++mm)
#pragma unroll
                    for (int bj = 0; bj < 2; ++bj)
#pragma unroll
                        for (int n = 0; n < 2; ++n) *(f32x4*)(Y + (size_t)(row0 + ai * HALF + (2 * mp + mm) * 16) * DM + col0 + bj * HALF + n * 16) = r[mm][bj][n] * ALPHA + acc[ai][bj][2 * mp + mm][n];
            }
    }
};

struct EpiSwiglu {
    static constexpr bool PERM = true, AFTER_DRAIN = false;
    bf16_t* H; int nc;
    __device__ __forceinline__ void operator()(const f32x4 (&acc)[2][2][4][2], const Unit& u, int wr, int wc, int fr, int fq) const {
        const int row0 = u.pm * BM + wr * 64 + fr, col0 = (u.pn % nc) * HALF + wc * 32 + 8 * fq;
#pragma unroll
        for (int ai = 0; ai < 2; ++ai)
#pragma unroll
            for (int m = 0; m < 4; ++m) { f32x4 a, b;
#pragma unroll
                for (int i = 0; i < 4; ++i) { const float g0 = acc[ai][0][m][0][i], g1 = acc[ai][0][m][1][i];
                    a[i] = g0 * sigmoidf_fast(g0) * acc[ai][1][m][0][i]; b[i] = g1 * sigmoidf_fast(g1) * acc[ai][1][m][1][i]; }
                *(u32x4*)(H + (size_t)(row0 + ai * HALF + m * 16) * DFF + col0) = pack8(a, b); }
    }
};

struct EpiDownMoe {
    static constexpr bool PERM = true, AFTER_DRAIN = false;
    bf16_t* YB; const float* gate; int gbase;
    __device__ __forceinline__ void operator()(const f32x4 (&acc)[2][2][4][2], const Unit& u, int wr, int wc, int fr, int fq) const {
        const int gt = u.pm + ((u.pm >= 128) ? 128 : gbase);
        const int row0 = gt * BM + wr * 64 + fr, col0 = (u.pn & 3) * BM + wc * 32 + 8 * fq;
#pragma unroll
        for (int ai = 0; ai < 2; ++ai)
#pragma unroll
            for (int m = 0; m < 4; ++m) { const int row = row0 + ai * HALF + m * 16; const float gt_ = gate[row]; bf16_t* rp = YB + (size_t)row * DM + col0;
#pragma unroll
                for (int bj = 0; bj < 2; ++bj) *(u32x4*)(rp + bj * HALF) = pack8(acc[ai][bj][m][0] * gt_, acc[ai][bj][m][1] * gt_); }
    }
};

struct MoeOrder {
    int cum[8]; int nc, G, c; const int* slot_tok; int mode, nrows, nmain, gbase, ut, y;
    __device__ __forceinline__ int gtile(int l) const { return l + ((l >= 128) ? 128 : gbase); }
    __device__ __forceinline__ bool next(int i, Unit& u) const {
        int l, pn;
        if (mode == 0) { if (nrows <= 0) return false;
            StaticOrder S; S.nM = nrows; S.nN = nc; S.nwg = nrows * nc; S.G = G; S.c = c; Unit v; if (!S.next(i, v)) return false;
            l = (v.pm < nmain) ? v.pm : 128 + (v.pm - nmain); pn = v.pn;
        } else if (mode == 1) { const int pool = nrows * nc; int L;
            if (c < ut) { if (i >= y) return false; L = c * y + i; } else L = y * ut + (c - ut) + i * (G - ut);
            if (L >= pool) return false; l = L / nc; pn = L - l * nc;
        } else { if (i != 0 || c >= ut) return false; l = 128 + (c >> 2); pn = c & 3; }
        const int tg = gtile(l); int e = 0;
#pragma unroll
        for (int j = 0; j < 7; ++j) e += (tg >= cum[j]) ? 1 : 0;
        u.pm = l; u.pn = e * nc + pn; return true;
    }
    __device__ __forceinline__ int arow(const Unit& u, int r) const { return slot_tok[gtile(u.pm) * BM + r]; }
    __device__ __forceinline__ void a_ready(const Unit&) const {}
    __device__ __forceinline__ void done(const Unit&) const {}
};
}

namespace attn_body {
using bf16 = unsigned short;
using bf16x8 = __attribute__((ext_vector_type(8))) short;
using s16x4 = __attribute__((ext_vector_type(4))) short;
using f32x16 = __attribute__((ext_vector_type(16))) float;
using f32x4a = __attribute__((ext_vector_type(4))) float;
using u32x4 = __attribute__((ext_vector_type(4))) unsigned;
using u32x2 = __attribute__((ext_vector_type(2))) unsigned;
#define ALAS __attribute__((address_space(3)))
constexpr int NW = 8, QBLK = 32, QB = QBLK * NW, KVBLK = 64;
constexpr int NSLOT = 3, SLOTB = 8192;
constexpr int LDS_K = 0, LDS_V = NSLOT * SLOTB, LDS_WS = 2 * NSLOT * SLOTB, LDS_OST = LDS_WS + NW * 64 * 4, LDS_BIAS = LDS_OST + NW * 4096, LDS_M = LDS_BIAS + 16384, LDS_BYTES = LDS_M + NW * 1024;
__device__ __forceinline__ int crow(int r, int hi) { return (r & 3) + 8 * (r >> 2) + 4 * hi; }
#define SBAR() __builtin_amdgcn_sched_barrier(0)
__device__ __forceinline__ void cmask(f32x16& p0, f32x16& p1, int jb, int qrel, int hi) {
    const float NEG = -INFINITY; const int kb = 64 * jb + 4 * hi;
#pragma unroll
    for (int r = 0; r < 16; ++r) { const int kv = kb + (r & 3) + 8 * (r >> 2); if (kv > qrel) p0[r] = NEG; if (kv + 32 > qrel) p1[r] = NEG; }
}
__device__ __forceinline__ void glds16(const void* gsrc, unsigned lds_dst) { unsigned keep;
    asm volatile("s_mov_b32 %0, m0\n\ts_mov_b32 m0, %2\n\ts_nop 0\n\tglobal_load_lds_dwordx4 %1, off\n\ts_mov_b32 m0, %0" : "=&s"(keep) : "v"(gsrc), "s"(lds_dst) : "memory"); }
__device__ __forceinline__ void glds4(const void* gsrc, unsigned lds_dst) { unsigned keep;
    asm volatile("s_mov_b32 %0, m0\n\ts_mov_b32 m0, %2\n\ts_nop 0\n\tglobal_load_lds_dword %1, off\n\ts_mov_b32 m0, %0" : "=&s"(keep) : "v"(gsrc), "s"(lds_dst) : "memory"); }
typedef float f32x2_t __attribute__((ext_vector_type(2))); typedef __bf16 bf16x2_t __attribute__((ext_vector_type(2)));
__device__ __forceinline__ unsigned cvtpk_s(float lo, float hi) { f32x2_t v = {lo, hi}; bf16x2_t b = __builtin_convertvector(v, bf16x2_t); return __builtin_bit_cast(unsigned, b); }
template <int N> __device__ __forceinline__ void wait_bar() {
    static_assert(N >= 0 && N <= 4, "wait_bar");
    if constexpr (N == 0) asm volatile("s_waitcnt vmcnt(0) lgkmcnt(0)\n\ts_barrier" ::: "memory");
    else if constexpr (N == 1) asm volatile("s_waitcnt vmcnt(1) lgkmcnt(0)\n\ts_barrier" ::: "memory");
    else if constexpr (N == 2) asm volatile("s_waitcnt vmcnt(2) lgkmcnt(0)\n\ts_barrier" ::: "memory");
    else if constexpr (N == 3) asm volatile("s_waitcnt vmcnt(3) lgkmcnt(0)\n\ts_barrier" ::: "memory");
    else asm volatile("s_waitcnt vmcnt(4) lgkmcnt(0)\n\ts_barrier" ::: "memory");
}
typedef __attribute__((address_space(3))) const char* lds_cptr;
typedef short v4i16_t __attribute__((ext_vector_type(4)));
__device__ __forceinline__ void kload8(bf16x8* kf, lds_cptr kp) {
    kf[0] = *(const ALAS bf16x8*)(kp);        kf[1] = *(const ALAS bf16x8*)(kp + 512);
    kf[2] = *(const ALAS bf16x8*)(kp + 2048); kf[3] = *(const ALAS bf16x8*)(kp + 2560);
    kf[4] = *(const ALAS bf16x8*)(kp + 4096); kf[5] = *(const ALAS bf16x8*)(kp + 4608);
    kf[6] = *(const ALAS bf16x8*)(kp + 6144); kf[7] = *(const ALAS bf16x8*)(kp + 6656);
}
__device__ __forceinline__ void kload2(bf16x8* kf, lds_cptr kp, int j) { kf[2 * j] = *(const ALAS bf16x8*)(kp + j * 2048); kf[2 * j + 1] = *(const ALAS bf16x8*)(kp + j * 2048 + 512); }
__device__ __forceinline__ s16x4 vtr(lds_cptr p) { return __builtin_bit_cast(s16x4, __builtin_amdgcn_ds_read_tr16_b64_v4i16((ALAS v4i16_t*)p)); }
__device__ __forceinline__ void pv(f32x16* o, int vb, bf16x8 pa0, bf16x8 pa1, bf16x8 pa2, bf16x8 pa3) {
#pragma unroll
    for (int d0 = 0; d0 < 2; ++d0) { s16x4 lo[4], hi[4];
#pragma unroll
        for (int ks = 0; ks < 4; ++ks) {
            asm volatile("ds_read_b64_tr_b16 %0,%1 offset:%c2" : "=&v"(lo[ks]) : "v"(vb), "i"(d0 * 4096 + ks * 1024) : "memory");
            asm volatile("ds_read_b64_tr_b16 %0,%1 offset:%c2" : "=&v"(hi[ks]) : "v"(vb), "i"(d0 * 4096 + ks * 1024 + 512) : "memory"); }
        asm volatile("s_waitcnt lgkmcnt(0)" ::: "memory"); SBAR();
#define PK(k) (bf16x8){lo[k][0], lo[k][1], lo[k][2], lo[k][3], hi[k][0], hi[k][1], hi[k][2], hi[k][3]}
        o[d0] = __builtin_amdgcn_mfma_f32_32x32x16_bf16(pa0, PK(0), o[d0], 0, 0, 0);
        o[d0] = __builtin_amdgcn_mfma_f32_32x32x16_bf16(pa1, PK(1), o[d0], 0, 0, 0);
        o[d0] = __builtin_amdgcn_mfma_f32_32x32x16_bf16(pa2, PK(2), o[d0], 0, 0, 0);
        o[d0] = __builtin_amdgcn_mfma_f32_32x32x16_bf16(pa3, PK(3), o[d0], 0, 0, 0);
#undef PK
    }
}
template <int KIND>
__device__ __forceinline__ void cload(f32x16& C0, f32x16& C1, unsigned& mw0, unsigned& mw1, const ALAS float* bl_t  , const ALAS unsigned* mw  ) {
    if constexpr (KIND == 1) {
#pragma unroll
        for (int g = 0; g < 4; ++g) { const f32x4a a = *(const ALAS f32x4a*)(bl_t + 8 * g), b = *(const ALAS f32x4a*)(bl_t + 32 + 8 * g);
            C0[4 * g] = a[0]; C0[4 * g + 1] = a[1]; C0[4 * g + 2] = a[2]; C0[4 * g + 3] = a[3];
            C1[4 * g] = b[0]; C1[4 * g + 1] = b[1]; C1[4 * g + 2] = b[2]; C1[4 * g + 3] = b[3]; }
    } else { mw0 = mw[0]; mw1 = mw[32]; }
}
template <int KIND>
__device__ __forceinline__ void cfin(f32x16& C0, f32x16& C1, unsigned mw0, unsigned mw1, int hi, float negmh) {
    if constexpr (KIND == 1) {
#pragma unroll
        for (int r = 0; r < 16; ++r) { C0[r] += negmh; C1[r] += negmh; }
    } else {
        const unsigned w0 = mw0 >> (4 * hi), w1 = mw1 >> (4 * hi); const unsigned ninf = 0xff800000u, nm = __float_as_uint(negmh);
#pragma unroll
        for (int r = 0; r < 16; ++r) { const int sh = (r & 3) + 8 * (r >> 2);
            const unsigned m0 = (unsigned)__builtin_amdgcn_sbfe((int)w0, sh, 1), m1 = (unsigned)__builtin_amdgcn_sbfe((int)w1, sh, 1);
            C0[r] = __uint_as_float((m0 & nm) | (~m0 & ninf)); C1[r] = __uint_as_float((m1 & nm) | (~m1 & ninf)); }
    }
}

template <int KIND, int THRL>
__device__ __forceinline__ void attn_unit(int b, int h, int qb, const bf16* Q, const bf16* __restrict__ K, const bf16* __restrict__ V, bf16* O,
                                          const unsigned* __restrict__ MASK, const float* __restrict__ CB, ALAS char* shm) {
    int tid_ = threadIdx.x; asm volatile("" : "+v"(tid_));
    const int tid = tid_, lane = tid & 63, r32 = lane & 31, hi = lane >> 5; const int wid = __builtin_amdgcn_readfirstlane(tid >> 6);
    constexpr int MX = (KIND == 0) ? 1 : 0;
    const long rowbase = (long)b * SEQ; const int q0 = qb * QB;
    const bf16* Qw = Q + (rowbase + q0 + wid * QBLK) * AW + h * 64;
    const bf16* Kh = K + rowbase * AW + h * 64, *Vh = V + rowbase * AW + h * 64;
    const unsigned lds0 = (unsigned)(uintptr_t)shm;
    ALAS float* wsf = (ALAS float*)(shm + LDS_WS) + wid * 64;
    const bf16* ksrc = Kh + (long)lane * AW + wid * 8;
    const bf16* vsrc = Vh + (long)(16 * (wid & 3) + (lane >> 2)) * AW + (wid >> 2) * 32 + (lane & 3) * 8;
    const unsigned kdst = lds0 + LDS_K + wid * 1024, vdst = lds0 + LDS_V + wid * 1024;
#define DMA_K(t, slot) glds16(ksrc + (long)(t) * KVBLK * AW, (unsigned)__builtin_amdgcn_readfirstlane(kdst + (slot)))
#define DMA_V(t, slot) glds16(vsrc + (long)(t) * KVBLK * AW, (unsigned)__builtin_amdgcn_readfirstlane(vdst + (slot)))
    const int qrel = wid * QBLK + r32;
    const unsigned* msrc = MASK + (size_t)(rowbase + q0 + qrel) * 128 + hi;
    const unsigned mdst = lds0 + LDS_M + wid * 1024;
#define DMA_M(t) glds4(msrc + 2 * (t), (unsigned)__builtin_amdgcn_readfirstlane(mdst + (((t) & 3) << 8)))
    const ALAS unsigned* mwb = (const ALAS unsigned*)(shm + LDS_M + wid * 1024) + r32;
    const ALAS float* blb = (const ALAS float*)(shm + LDS_BIAS) + 4 * hi;
    const float* cbh = CB + (size_t)(b * NH + h) * SEQ;
    const int vb0 = (int)(lds0 + LDS_V) + ((lane >> 4) & 1) * 32 + (lane & 3) * 8 + (4 * hi + ((lane & 15) >> 2)) * 64;
    bf16x8 kf[8];
    const lds_cptr shm3 = (lds_cptr)shm; const lds_cptr kp0 = shm3 + LDS_K + hi * 1024 + r32 * 16; const lds_cptr vp0 = shm3 + LDS_V + ((lane >> 4) & 1) * 32 + (lane & 3) * 8 + (4 * hi + ((lane & 15) >> 2)) * 64;
    const int NT = (q0 + QB) / KVBLK;
    if constexpr (KIND == 1) {
#pragma unroll
        for (int j = 0; j < 2; ++j) { const int piece = 2 * wid + j; if (piece * 256 < q0 + QB) glds16(cbh + piece * 256 + lane * 4, (unsigned)__builtin_amdgcn_readfirstlane(lds0 + LDS_BIAS + piece * 1024)); }
    } else { DMA_M(0); DMA_M(1); DMA_M(2); }
    DMA_K(0, 0); DMA_V(0, 0); DMA_K(1, SLOTB);
    bf16x8 qr[4];
#pragma unroll
    for (int d0 = 0; d0 < 4; ++d0) qr[d0] = *reinterpret_cast<const bf16x8*>(&Qw[(long)r32 * AW + d0 * 16 + hi * 8]);
    float mhat = 0.f; if constexpr (KIND == 1) mhat = cbh[q0 + qrel];
    float l_reg = 0.f; f32x16 o[2]; o[0] = f32x16{}; o[1] = f32x16{};
#define CMASK(P0, P1, t) do { if constexpr (KIND == 1) { int jb_ = (t) - (NT - 4); if (jb_ >= 0) cmask(P0, P1, jb_, qrel, hi); } } while (0)
    bool resc = false;
#define RESC() do { if (resc) { asm volatile("s_waitcnt lgkmcnt(0)" ::: "memory"); \
      _Pragma("unroll") for (int d_ = 0; d_ < 2; ++d_) _Pragma("unroll") for (int r = 0; r < 16; ++r) o[d_][r] *= wsf[crow(r, hi)]; } } while (0)
    f32x16 pA0, pA1, pB0, pB1;
    int sl_prev = 0, sl_cur = 0, sl_next = SLOTB;
#define ROT() do { sl_prev = sl_cur; sl_cur = sl_next; sl_next = (sl_next == (NSLOT - 1) * SLOTB) ? 0 : sl_next + SLOTB; } while (0)
    DMA_K(2, 2 * SLOTB);
    wait_bar<3>();
    unsigned mwn0 = 0u, mwn1 = 0u;
    cload<KIND>(pA0, pA1, mwn0, mwn1, blb, mwb); cfin<KIND>(pA0, pA1, mwn0, mwn1, hi, -mhat);
    { const lds_cptr kb = kp0;
#pragma unroll
      for (int d0 = 0; d0 < 4; ++d0) { const bf16x8 b0 = *(const ALAS bf16x8*)(kb + d0 * 2048), b1 = *(const ALAS bf16x8*)(kb + d0 * 2048 + 512);
          pA0 = __builtin_amdgcn_mfma_f32_32x32x16_bf16(b0, qr[d0], pA0, 0, 0, 0); pA1 = __builtin_amdgcn_mfma_f32_32x32x16_bf16(b1, qr[d0], pA1, 0, 0, 0); } }
    asm volatile("s_nop 15\n\ts_nop 7" : "+v"(pA0), "+v"(pA1)); CMASK(pA0, pA1, 0);
    { float rm = __builtin_fmaxf(pA0[0], pA1[0]);
#pragma unroll
      for (int r = 1; r < 16; ++r) rm = __builtin_fmaxf(rm, __builtin_fmaxf(pA0[r], pA1[r]));
      { auto rr = __builtin_amdgcn_permlane32_swap(__float_as_uint(rm), __float_as_uint(rm), false, false); rm = __builtin_fmaxf(__uint_as_float(rr[0]), __uint_as_float(rr[1])); }
      if (__any(rm > (float)THRL)) { const float dl = __builtin_fmaxf(rm, 0.f); mhat += dl;
#pragma unroll
          for (int r = 0; r < 16; ++r) { pA0[r] -= dl; pA1[r] -= dl; } } }
#pragma unroll
    for (int r = 0; r < 16; ++r) { pA0[r] = __builtin_amdgcn_exp2f(pA0[r]); pA1[r] = __builtin_amdgcn_exp2f(pA1[r]); }
    cload<KIND>(pB0, pB1, mwn0, mwn1, blb + 64, mwb + 64);
    wait_bar<0>();
    DMA_K(3, 0); DMA_V(1, SLOTB); if constexpr (MX) DMA_M(3);
    ROT();
    kload8(kf, kp0 + sl_cur);
    wait_bar<2 + MX>();
    s16x4 vlo[8], vhi[8]; u32x4 pw0, pw1, pw2, pw3;
#define PKW(P, B) cvtpk_s(P[B], P[B + 1])
#define PAF(k) __builtin_bit_cast(bf16x8, pw##k)
#define VFR(i) (bf16x8){vlo[i][0], vlo[i][1], vlo[i][2], vlo[i][3], vhi[i][0], vhi[i][1], vhi[i][2], vhi[i][3]}
#define PIN(x) asm volatile("" : "+v"(x))
#define MX3(a, b, c) __builtin_fmaxf(__builtin_fmaxf((a), (b)), (c))
#define GAPA(MF, A0, A1, A2, A3, W0, W1, PW) do { MF; sacc += A0; sacc += A1; sacc += A2; sacc += A3; PIN(sacc); W0; W1; PIN(PW); SBAR(); } while (0)
#define EX(v) __builtin_amdgcn_exp2f(v)
#define GAPB(MF, X, B) do { MF; X[B] = EX(X[B]); X[B + 1] = EX(X[B + 1]); X[B + 2] = EX(X[B + 2]); X[B + 3] = EX(X[B + 3]); PIN(X); SBAR(); } while (0)
#define VRD(i) do { vlo[i] = vtr(vp_ + (((i) >> 2) * 4096 + ((i) & 3) * 1024)); vhi[i] = vtr(vp_ + (((i) >> 2) * 4096 + ((i) & 3) * 1024 + 512)); } while (0)
#define KRD(G, j) do { if (G) { kload2(kf, kp0 + sl_next, j); SBAR(); } } while (0)
#define STEP(C0, C1, P0, P1, t, GK, GV, GL, GM) do { SBAR(); \
    cfin<KIND>(C0, C1, mwn0, mwn1, hi, -mhat); PIN(C0); PIN(C1); SBAR(); \
    const lds_cptr vp_ = vp0 + sl_prev; \
    VRD(0); SBAR(); float sacc = (P0[0] + P0[1]); \
    GAPA(C0 = __builtin_amdgcn_mfma_f32_32x32x16_bf16(kf[0], qr[0], C0, 0, 0, 0), P0[2], P0[3], P0[4], P0[5],     pw0[0] = PKW(P0, 0), pw0[1] = PKW(P0, 2), pw0); \
    VRD(4); SBAR(); GAPA(C1 = __builtin_amdgcn_mfma_f32_32x32x16_bf16(kf[1], qr[0], C1, 0, 0, 0), P0[6], P0[7], P0[8], P0[9],     pw0[2] = PKW(P0, 4), pw0[3] = PKW(P0, 6), pw0); \
    VRD(1); SBAR(); GAPA(C0 = __builtin_amdgcn_mfma_f32_32x32x16_bf16(kf[2], qr[1], C0, 0, 0, 0),   P0[10], P0[11], P0[12], P0[13], pw1[0] = PKW(P0, 8), pw1[1] = PKW(P0, 10), pw1); \
    VRD(5); SBAR(); GAPA(C1 = __builtin_amdgcn_mfma_f32_32x32x16_bf16(kf[3], qr[1], C1, 0, 0, 0),   P0[14], P0[15], P1[0], P1[1],   pw1[2] = PKW(P0, 12), pw1[3] = PKW(P0, 14), pw1); \
    VRD(2); SBAR(); GAPA(C0 = __builtin_amdgcn_mfma_f32_32x32x16_bf16(kf[4], qr[2], C0, 0, 0, 0),   P1[2], P1[3], P1[4], P1[5],     pw2[0] = PKW(P1, 0), pw2[1] = PKW(P1, 2), pw2); \
    VRD(6); SBAR(); GAPA(C1 = __builtin_amdgcn_mfma_f32_32x32x16_bf16(kf[5], qr[2], C1, 0, 0, 0),   P1[6], P1[7], P1[8], P1[9],     pw2[2] = PKW(P1, 4), pw2[3] = PKW(P1, 6), pw2); \
    VRD(3); SBAR(); GAPA(C0 = __builtin_amdgcn_mfma_f32_32x32x16_bf16(kf[6], qr[3], C0, 0, 0, 0),   P1[10], P1[11], P1[12], P1[13], pw3[0] = PKW(P1, 8), pw3[1] = PKW(P1, 10), pw3); \
    VRD(7); SBAR(); GAPA(C1 = __builtin_amdgcn_mfma_f32_32x32x16_bf16(kf[7], qr[3], C1, 0, 0, 0),   P1[14], P1[15], 0.f, 0.f,       pw3[2] = PKW(P1, 12), pw3[3] = PKW(P1, 14), pw3); \
    l_reg += sacc; \
    cload<KIND>(P0, P1, mwn0, mwn1, blb + 64 * ((t) + 1), mwb + ((((t) + 1) & 3) << 6)); SBAR();     \
    if (GK) { DMA_K((t) + 3, sl_cur); } if (GV) { DMA_V((t) + 1, sl_next); } if constexpr (MX) { if (GM) { DMA_M((t) + 3); } } \
    CMASK(C0, C1, t); \
    { float a = MX3(C0[0], C0[1], C1[0]), b = MX3(C0[2], C0[3], C1[1]); a = MX3(a, C1[2], C1[3]); \
      _Pragma("unroll") for (int r = 4; r < 16; r += 4) { a = MX3(a, C0[r], C0[r + 1]); b = MX3(b, C0[r + 2], C0[r + 3]); a = MX3(a, C1[r], C1[r + 1]); b = MX3(b, C1[r + 2], C1[r + 3]); } \
      float rm = __builtin_fmaxf(a, b); { auto rr = __builtin_amdgcn_permlane32_swap(__float_as_uint(rm), __float_as_uint(rm), false, false); rm = __builtin_fmaxf(__uint_as_float(rr[0]), __uint_as_float(rr[1])); } \
      resc = false; \
      if (__builtin_expect(__any(rm > (float)THRL), 0)) { const float dl = __builtin_fmaxf(rm, 0.f); mhat += dl; \
        _Pragma("unroll") for (int r = 0; r < 16; ++r) { C0[r] -= dl; C1[r] -= dl; } \
        const float f = __builtin_amdgcn_exp2f(-dl); l_reg *= f; if (hi == 0) wsf[r32] = f; resc = true; } } \
    SBAR(); \
    GAPB(o[0] = __builtin_amdgcn_mfma_f32_32x32x16_bf16(PAF(0), VFR(0), o[0], 0, 0, 0), C0, 0); \
    GAPB(o[1] = __builtin_amdgcn_mfma_f32_32x32x16_bf16(PAF(0), VFR(4), o[1], 0, 0, 0), C0, 4); \
    KRD(GL, 0); GAPB(o[0] = __builtin_amdgcn_mfma_f32_32x32x16_bf16(PAF(1), VFR(1), o[0], 0, 0, 0), C0, 8); \
    KRD(GL, 1); GAPB(o[1] = __builtin_amdgcn_mfma_f32_32x32x16_bf16(PAF(1), VFR(5), o[1], 0, 0, 0), C0, 12); \
    KRD(GL, 2); GAPB(o[0] = __builtin_amdgcn_mfma_f32_32x32x16_bf16(PAF(2), VFR(2), o[0], 0, 0, 0), C1, 0); \
    KRD(GL, 3); GAPB(o[1] = __builtin_amdgcn_mfma_f32_32x32x16_bf16(PAF(2), VFR(6), o[1], 0, 0, 0), C1, 4); \
    GAPB(o[0] = __builtin_amdgcn_mfma_f32_32x32x16_bf16(PAF(3), VFR(3), o[0], 0, 0, 0), C1, 8); \
    GAPB(o[1] = __builtin_amdgcn_mfma_f32_32x32x16_bf16(PAF(3), VFR(7), o[1], 0, 0, 0), C1, 12); \
    } while (0)
    int t = 1;
#undef CMASK
#define CMASK(P0, P1, t) do { } while (0)
    for (; t + 5 < NT; t += 2) {
        STEP(pB0, pB1, pA0, pA1, t, true, true, true, true);     wait_bar<2 + MX>(); RESC(); ROT();
        STEP(pA0, pA1, pB0, pB1, t + 1, true, true, true, true); wait_bar<2 + MX>(); RESC(); ROT();
    }
#undef CMASK
#define CMASK(P0, P1, t) do { if constexpr (KIND == 1) { int jb_ = (t) - (NT - 4); if (jb_ >= 0) cmask(P0, P1, jb_, qrel, hi); } } while (0)
#define ENDW(tt) do { if ((tt) + 3 < NT) { wait_bar<2 + MX>(); } else if ((tt) + 2 < NT) { wait_bar<1>(); } else { wait_bar<0>(); } } while (0)
    for (; t + 1 < NT; t += 2) {
        STEP(pB0, pB1, pA0, pA1, t, (t + 3 < NT), (t + 1 < NT), (t + 1 < NT), (t + 3 < NT));       ENDW(t);     RESC(); ROT();
        STEP(pA0, pA1, pB0, pB1, t + 1, (t + 4 < NT), (t + 2 < NT), (t + 2 < NT), (t + 4 < NT));   ENDW(t + 1); RESC(); ROT();
    }
    STEP(pB0, pB1, pA0, pA1, NT - 1, false, false, false, false); RESC();
    { float sacc = pB0[0] + pB0[1];
#pragma unroll
      for (int r = 2; r < 16; ++r) sacc += pB0[r];
#pragma unroll
      for (int r = 0; r < 16; ++r) sacc += pB1[r];
      l_reg += sacc;
      pw0 = (u32x4){PKW(pB0, 0), PKW(pB0, 2), PKW(pB0, 4), PKW(pB0, 6)}; pw1 = (u32x4){PKW(pB0, 8), PKW(pB0, 10), PKW(pB0, 12), PKW(pB0, 14)};
      pw2 = (u32x4){PKW(pB1, 0), PKW(pB1, 2), PKW(pB1, 4), PKW(pB1, 6)}; pw3 = (u32x4){PKW(pB1, 8), PKW(pB1, 10), PKW(pB1, 12), PKW(pB1, 14)};
      SBAR(); pv(o, vb0 + sl_cur, PAF(0), PAF(1), PAF(2), PAF(3)); }
#undef PKW
#undef PAF
#undef VFR
#undef PIN
#undef MX3
#undef GAPA
#undef GAPB
#undef EX
#undef VRD
#undef KRD
#undef STEP
#undef ENDW
    { auto rr = __builtin_amdgcn_permlane32_swap(__float_as_uint(l_reg), __float_as_uint(l_reg), false, false); l_reg = __uint_as_float(rr[0]) + __uint_as_float(rr[1]); }
    if (hi == 0) wsf[32 + r32] = l_reg;
    asm volatile("s_waitcnt lgkmcnt(0)" ::: "memory");
    float rli[16];
#pragma unroll
    for (int r = 0; r < 16; ++r) rli[r] = __builtin_amdgcn_rcpf(wsf[32 + crow(r, hi)]);
    bf16* Ow = O + (rowbase + q0 + wid * QBLK) * AW + h * 64;
    { ALAS bf16* stg = (ALAS bf16*)(shm + LDS_OST) + wid * 2048;
#pragma unroll
      for (int r = 0; r < 16; ++r) { const int orow = crow(r, hi);
#pragma unroll
          for (int d0 = 0; d0 < 2; ++d0) stg[orow * 64 + d0 * 32 + r32] = (bf16)(cvtpk_s(o[d0][r] * rli[r], 0.f) & 0xffffu); }
      asm volatile("s_waitcnt lgkmcnt(0)" ::: "memory");
#pragma unroll
      for (int i = 0; i < 4; ++i) { const int row = i * 8 + (lane >> 3), ch = lane & 7; const u32x4 v = *(const ALAS u32x4*)(stg + row * 64 + ch * 8); *(u32x4*)(Ow + (long)row * AW + ch * 8) = v; } }
    asm volatile("s_waitcnt lgkmcnt(0)\n\ts_barrier" ::: "memory");
#undef DMA_K
#undef DMA_V
#undef DMA_M
#undef CMASK
#undef RESC
#undef ROT
}
#undef SBAR
#undef ALAS
}

static_assert(attn_body::LDS_BYTES <= RING_BYTES, "attention LDS");
#define XB_TMO      128
#define XB_XCNT(j)  (256  + 64 * (j))
#define XB_XSUB(j)  (1280 + 64 * (j))
#define XB_XGEN(j)  (2304 + 64 * (j))
#define XB_TOP      3328
#define XB_TOPGEN   3392
#define XCD_BAR_WORDS 3456
#define XB_SPIN_CAP (1u << 18)

__device__ __forceinline__ unsigned xb_ld(unsigned* p)              { return __hip_atomic_load(p, __ATOMIC_RELAXED, __HIP_MEMORY_SCOPE_AGENT); }
__device__ __forceinline__ unsigned xb_add(unsigned* p, unsigned v) { return __hip_atomic_fetch_add(p, v, __ATOMIC_RELAXED, __HIP_MEMORY_SCOPE_AGENT); }
__device__ __forceinline__ unsigned xb_xcc_id() { return (unsigned)__builtin_amdgcn_s_getreg((3 << 11) | 20) & 0xFu; }
#define XB_SPIN(cond, bar) do { unsigned _sp = 0; while (cond) { __builtin_amdgcn_s_sleep(1); \
    if ((++_sp & 255u) == 0u) { if (xb_ld(&(bar)[XB_TMO])) break; if (_sp > XB_SPIN_CAP) { atomicAdd(&(bar)[XB_TMO], 1u); break; } } } } while (0)

struct XcdBarrier {
    unsigned* bar; unsigned x;
    volatile LAS unsigned* st;
};

__device__ __forceinline__ XcdBarrier xcd_barrier_post(unsigned* bar, volatile LAS unsigned* st) {
    XcdBarrier b; b.bar = bar; b.x = xb_xcc_id(); b.st = st;
    if (threadIdx.x == 0) (void)xb_add(&bar[XB_XCNT(b.x)], 1u);
    return b;
}
__device__ __forceinline__ void xcd_barrier_complete(unsigned* bar, unsigned x, unsigned& nloc, unsigned& nx) {
    const unsigned G = gridDim.x * gridDim.y * gridDim.z;
    unsigned sum, cnt, mine, sp = 0u;
    for (;;) {
        sum = 0u; cnt = 0u; mine = 0u;
#pragma unroll
        for (unsigned j = 0; j < 16; ++j) { const unsigned c = xb_ld(&bar[XB_XCNT(j)]); sum += c; cnt += (c > 0u) ? 1u : 0u; mine = (j == x) ? c : mine; }
        if (sum == G) break;
        __builtin_amdgcn_s_sleep(1);
        if ((++sp & 255u) == 0u) { if (xb_ld(&bar[XB_TMO])) break; if (sp > XB_SPIN_CAP) { atomicAdd(&bar[XB_TMO], 1u); break; } }
    }
    nloc = mine > 0u ? mine : 1u; nx = cnt > 0u ? cnt : 1u;
}

__device__ __forceinline__ void xcd_barrier(const XcdBarrier& b) {
    asm volatile("s_waitcnt vmcnt(0)" ::: "memory");
    __syncthreads();
    if (threadIdx.x == 0) {
        unsigned* bar = b.bar; unsigned bx = b.x;
        asm volatile("" : "+s"(bar), "+s"(bx));
        __builtin_amdgcn_s_waitcnt(0);
        unsigned nloc = b.st[0], nx = b.st[1];
        if (nloc == 0u) { xcd_barrier_complete(bar, bx, nloc, nx); b.st[0] = nloc; b.st[1] = nx; }
        const unsigned old = xb_add(&bar[XB_XSUB(bx)], 1u);
        const unsigned gen = old / nloc;
        if (old + 1u == (gen + 1u) * nloc) {
            __builtin_amdgcn_fence(__ATOMIC_RELEASE, "agent");
            asm volatile("s_waitcnt vmcnt(0)" ::: "memory");
            const unsigned og = xb_add(&bar[XB_TOP], 1u);
            const unsigned tg = og / nx;
            if (og + 1u == (tg + 1u) * nx) xb_add(&bar[XB_TOPGEN], 1u);
            else XB_SPIN(xb_ld(&bar[XB_TOPGEN]) == tg, bar);
            __builtin_amdgcn_fence(__ATOMIC_ACQUIRE, "agent");
            xb_add(&bar[XB_XGEN(bx)], 1u);
            asm volatile("s_waitcnt vmcnt(0)" ::: "memory");
        } else {
            XB_SPIN(xb_ld(&bar[XB_XGEN(bx)]) == gen, bar);
            __builtin_amdgcn_fence(__ATOMIC_ACQUIRE, "agent");
            asm volatile("s_waitcnt vmcnt(0)" ::: "memory");
        }
    }
    __syncthreads();
}
struct Frame {
    LAS unsigned char* lds;
    volatile LAS unsigned* MISC;
    gu32* ctl;
    int tid, lane, wave, G, bid;
    unsigned char* ws; float* out;
};
__device__ __forceinline__ float wave_sum(float v) {
#pragma unroll
    for (int o = 1; o < 64; o <<= 1) v += __shfl_xor(v, o);
    return v;
}

__device__ __forceinline__ int win_colmap(int dr) {
    const int tile = dr >> 8, j = dr & 255;
    if (tile < 4 || tile == 6 || tile == 7) { const int base = (tile < 2) ? 0 : (tile < 4 ? 512 : 1536); return base + 256 * (tile & 1) + 64 * ((j & 127) >> 5) + 32 * (j >> 7) + (j & 31); }
    if (tile < 6) return 1024 + 256 * (tile - 4) + j;
    if (tile < 14) return 2120 + 256 * (tile - 8) + j;
    if (tile < 22) return 3664 + 256 * (tile - 14) + j;
    if (j < 32) return 2048 + j;
    if (j < 40) return 2112 + (j - 32);
    if (j >= 64 && j < 72) return 3656 + (j - 64);
    if (j >= 128 && j < 160) return 2080 + (j - 128);
    return -1;
}
template <int KIND>
__device__ __forceinline__ void conv_item(const float* s0, const float* s1, int K, int Nsrc, int ndst, bf16* dst, int item, LAS unsigned char* scr, int lane) {
    const int nb = ndst >> 6, kb = item / nb, dg = item - kb * nb, k0 = kb << 6, d0 = dg << 6;
    const int nq = lane & 15, dr = d0 + 4 * nq;
    const float* sp = s0; int col;
    if (KIND == 0) col = dr;
    else if (KIND == 1) col = win_colmap(dr);
    else { const int tile = dr >> 8, j = dr & 255; col = 128 * tile + (j & 127); if (j >= 128) sp = s1; }
    f32x4 vv[16];
#pragma unroll
    for (int i = 0; i < 16; ++i) { const int k = 4 * i + (lane >> 4); vv[i] = (f32x4){0.f, 0.f, 0.f, 0.f}; if (col >= 0) vv[i] = *(const f32x4*)(sp + (size_t)(k0 + k) * Nsrc + col); }
#pragma unroll
    for (int i = 0; i < 16; ++i) {
        const int k = 4 * i + (lane >> 4); const f32x4 v = vv[i];
        LAS unsigned short* w = (LAS unsigned short*)(scr + (4 * nq) * 144 + k * 2);
        w[0] = (unsigned short)f2bf(v[0]); w[72] = (unsigned short)f2bf(v[1]); w[144] = (unsigned short)f2bf(v[2]); w[216] = (unsigned short)f2bf(v[3]);
    }
    asm volatile("s_waitcnt lgkmcnt(0)" ::: "memory");
#pragma unroll
    for (int i = 0; i < 8; ++i) { const int n = 8 * i + (lane >> 3), ch = lane & 7;
        const v4u o = *(const LAS v4u*)(scr + n * 144 + ch * 16);
        *(v4u*)(dst + (size_t)(d0 + n) * K + k0 + 8 * ch) = o; }
    asm volatile("s_waitcnt lgkmcnt(0)" ::: "memory");
}
template <int KIND>
__device__ __forceinline__ void conv_matrix(Frame& F, const float* s0, const float* s1, int K, int Nsrc, int ndst, bf16* dst) {
    LAS unsigned char* scr = F.lds + RING_OFF + F.wave * 9216;
    const int gw = F.bid * NWAVES + F.wave, NGW = F.G * NWAVES, nitems = (K >> 6) * (ndst >> 6);
    for (int it = gw; it < nitems; it += NGW) conv_item<KIND>(s0, s1, K, Nsrc, ndst, dst, it, scr, F.lane);
}
__device__ __forceinline__ void sincos_rev(double r, float& s, float& c) {
    const double k = rint(4.0 * r);
    const double y = (r - 0.25 * k) * 6.283185307179586;
    const double y2 = y * y;
    const double sy = y * (1.0 + y2 * (-1.0 / 6 + y2 * (1.0 / 120 + y2 * (-1.0 / 5040 + y2 * (1.0 / 362880 + y2 * (-1.0 / 39916800 + y2 * (1.0 / 6227020800.0)))))));
    const double cy = 1.0 + y2 * (-0.5 + y2 * (1.0 / 24 + y2 * (-1.0 / 720 + y2 * (1.0 / 40320 + y2 * (-1.0 / 3628800 + y2 * (1.0 / 479001600.0))))));
    const int q = ((int)k) & 3;
    const double sv = (q == 0) ? sy : (q == 1) ? cy : (q == 2) ? -sy : -cy;
    const double cv = (q == 0) ? cy : (q == 1) ? -sy : (q == 2) ? -cy : sy;
    s = (float)sv; c = (float)cv;
}
__device__ __forceinline__ void p0_prologue(Frame& F, const float* x_in, const int* pos, const float* w_in, const float* w_a, const float* w_b, const float* w_o, const float* f_g, const float* f_u, const float* f_d) {
    unsigned char* ws = F.ws;
    for (int l = 0; l < 2; ++l) {
        conv_matrix<1>(F, w_in + (size_t)l * DM * PROJ_TOTAL, nullptr, DM, PROJ_TOTAL, PROJ_PAD, (bf16*)(ws + WS_WIN + l * WIN_STRIDE));
        conv_matrix<0>(F, w_a + (size_t)l * AW * DM, nullptr, AW, DM, DM, (bf16*)(ws + WS_WA) + (size_t)l * DM * AW);
        conv_matrix<0>(F, w_b + (size_t)l * AW * DM, nullptr, AW, DM, DM, (bf16*)(ws + WS_WB) + (size_t)l * DM * AW);
        conv_matrix<0>(F, w_o + (size_t)l * DM * DM, nullptr, DM, DM, DM, (bf16*)(ws + WS_WOUT) + (size_t)l * DM * DM);
    }
    conv_matrix<2>(F, f_g, f_u, DM, DFF, 2 * DFF, (bf16*)(ws + WS_FGU));
    conv_matrix<0>(F, f_d, nullptr, DFF, DM, DM, (bf16*)(ws + WS_FD));
    const int gt = F.bid * (NWAVES * 64) + F.tid, NGT = F.G * NWAVES * 64;
    { const f32x4* x4 = (const f32x4*)x_in; v2u* o2 = (v2u*)(ws + WS_XS);
      for (int i = gt; i < NTOK * DM / 4; i += NGT) { const f32x4 v = x4[i]; v2u o; o.x = pk2(v[0], v[1]); o.y = pk2(v[2], v[3]); o2[i] = o; } }
    { float* cs = (float*)(ws + WS_CS);
      for (int i = gt; i < NTOK * 32; i += NGT) { const int tok = i >> 5, fi = i & 31;
          const float invf = (float)exp2(-(double)fi * (13.287712379549449 / 32.0));
          const float ang = (float)pos[tok] * invf;
          double rev = (double)ang * 0.15915494309189535; rev -= floor(rev);
          float s, c; sincos_rev(rev, s, c); cs[2 * i] = c; cs[2 * i + 1] = s; } }
}
__device__ __forceinline__ void moe_convert(Frame& F, const float* wg, const float* wu, const float* wd) {
    bf16* gu = (bf16*)F.out; bf16* dn = (bf16*)(F.ws + WS_MWD);
    LAS unsigned char* scr = F.lds + RING_OFF + F.wave * 9216;
    const int gw = F.bid * NWAVES + F.wave, NGW = F.G * NWAVES;
    constexpr int IGU = (DM >> 6) * (2 * DFF >> 6), IDN = (DFF >> 6) * (DM >> 6);
    for (int it = gw; it < NEXP * (IGU + IDN); it += NGW) {
        const int e = it / (IGU + IDN), r = it - e * (IGU + IDN);
        if (r < IGU) conv_item<2>(wg + (size_t)e * DM * DFF, wu + (size_t)e * DM * DFF, DM, DFF, 2 * DFF, gu + (size_t)e * 2 * DFF * DM, r, scr, F.lane);
        else conv_item<0>(wd + (size_t)e * DFF * DM, nullptr, DFF, DM, DM, dn + (size_t)e * DM * DFF, r - IGU, scr, F.lane);
    }
}

typedef float f32x4i __attribute__((ext_vector_type(4)));
__device__ __forceinline__ unsigned sortkey16(float f) { const unsigned u = __float_as_uint(f); return (u ^ ((u >> 31) ? 0xffffffffu : 0x80000000u)) >> 16; }
__device__ __forceinline__ int wave_suffix_sum(int x, int lane) {
#pragma unroll
    for (int o = 1; o < 64; o <<= 1) { const int t = __shfl_down(x, o); if (lane + o < 64) x += t; }
    return x;
}
__device__ __forceinline__ int wave_sum_i(int v) {
    v += __builtin_amdgcn_update_dpp(0, v, 0xB1, 0xf, 0xf, false);
    v += __builtin_amdgcn_update_dpp(0, v, 0x4E, 0xf, 0xf, false);
    v += __builtin_amdgcn_update_dpp(0, v, 0x141, 0xf, 0xf, false);
    v += __builtin_amdgcn_update_dpp(0, v, 0x140, 0xf, 0xf, false);
    v += __shfl_xor(v, 16); v += __shfl_xor(v, 32);
    return __builtin_amdgcn_readfirstlane(v);
}
__device__ __forceinline__ int hist_select(const LAS unsigned* hist, int K, int lane, int& gt) {
    const v4u c = *(const LAS v4u*)(hist + 4 * lane);
    const int s = (int)(c.x + c.y + c.z + c.w);
    const int above = wave_suffix_sum(s, lane) - s;
    int bin = -1, g = 0;
    int a3 = above, a2 = above + (int)c.w, a1 = a2 + (int)c.z, a0 = a1 + (int)c.y;
    if (a3 < K && K <= a3 + (int)c.w) { bin = 4 * lane + 3; g = a3; }
    else if (a2 < K && K <= a2 + (int)c.z) { bin = 4 * lane + 2; g = a2; }
    else if (a1 < K && K <= a1 + (int)c.y) { bin = 4 * lane + 1; g = a1; }
    else if (a0 < K && K <= a0 + (int)c.x) { bin = 4 * lane + 0; g = a0; }
    const unsigned long long bal = __ballot(bin >= 0);
    const int src = bal ? (int)__builtin_ctzll(bal) : 0;
    gt = __shfl(g, src); return __shfl(bin, src);
}
__device__ __forceinline__ void idx_unit(Frame& F, int b, int qg, const bf16* IQ, const bf16* IK, const float* IW, unsigned* MASK) {
    const int lane = F.lane, wave = F.wave;
    const int t0 = 16 * qg, limit = 64 * (t0 / 64 + 1); const size_t row0 = (size_t)b * SEQ + t0;
    const int nwords = ((limit + 255) >> 8) << 3;
    if (limit <= 256) {
        for (int qq = 0; qq < 2; ++qq) { const int q = 2 * wave + qq; if (lane < nwords) MASK[(row0 + q) * 128 + lane] = (lane < (limit >> 5)) ? 0xffffffffu : 0u; }
        return;
    }
    LAS unsigned char* keys = F.lds;
    LAS unsigned* hist = (LAS unsigned*)(F.lds + IDX_HIST_OFF) + wave * 256;
#ifndef IDX_REP_SCORE
#define IDX_REP_SCORE 1
#endif
#ifndef IDX_REP_SEL
#define IDX_REP_SEL 1
#endif
    for (int rs_ = 0; rs_ < IDX_REP_SCORE; ++rs_)
    {
        const int qc = lane & 15, kq = lane >> 4;
        bf16x8 bq[8][2]; float w[8];
#pragma unroll
        for (int h = 0; h < 8; ++h) { const bf16* p = IQ + (row0 + qc) * AW + h * 64 + 8 * kq; bq[h][0] = *(const bf16x8*)p; bq[h][1] = *(const bf16x8*)(p + 32); }
        { const f32x4 w0 = *(const f32x4*)(IW + (row0 + qc) * 8), w1 = *(const f32x4*)(IW + (row0 + qc) * 8 + 4);
          w[0] = w0[0]; w[1] = w0[1]; w[2] = w0[2]; w[3] = w0[3]; w[4] = w1[0]; w[5] = w1[1]; w[6] = w1[2]; w[7] = w1[3]; }
        const bf16* ikb = IK + ((size_t)b * SEQ + qc) * 64 + 8 * kq;
        const int nkb = limit >> 4;
#define IDX_BLOCK(KB, A0, A1) do { f32x4i sc = {0.f, 0.f, 0.f, 0.f}; \
            _Pragma("unroll") for (int h = 0; h < 8; ++h) { f32x4i acc = {0.f, 0.f, 0.f, 0.f}; \
                acc = __builtin_amdgcn_mfma_f32_16x16x32_bf16(A0, bq[h][0], acc, 0, 0, 0); acc = __builtin_amdgcn_mfma_f32_16x16x32_bf16(A1, bq[h][1], acc, 0, 0, 0); \
                _Pragma("unroll") for (int r = 0; r < 4; ++r) sc[r] += w[h] * __builtin_amdgcn_fmed3f(acc[r], 0.f, 3.0e38f); }     \
            v2u pk; pk.x = sortkey16(sc[0]) | (sortkey16(sc[1]) << 16); pk.y = sortkey16(sc[2]) | (sortkey16(sc[3]) << 16); \
            *(LAS v2u*)(keys + qc * IDX_ROWB + ((KB) * 16 + 4 * kq) * 2) = pk; } while (0)
        const int kbB0 = (wave + 8 < nkb) ? wave + 8 : wave;
        bf16x8 a0 = *(const bf16x8*)(ikb + (size_t)wave * 1024), a1 = *(const bf16x8*)(ikb + (size_t)wave * 1024 + 32);
        bf16x8 b0 = *(const bf16x8*)(ikb + (size_t)kbB0 * 1024), b1 = *(const bf16x8*)(ikb + (size_t)kbB0 * 1024 + 32);
        for (int kb = wave; kb < nkb; kb += 16) {
            const int kbB = (kb + 8 < nkb) ? kb + 8 : kb;
            const int kn = (kb + 16 < nkb) ? kb + 16 : kb, km = (kb + 24 < nkb) ? kb + 24 : kn;
            const bf16x8 n0 = *(const bf16x8*)(ikb + (size_t)kn * 1024), n1 = *(const bf16x8*)(ikb + (size_t)kn * 1024 + 32);
            const bf16x8 m0 = *(const bf16x8*)(ikb + (size_t)km * 1024), m1 = *(const bf16x8*)(ikb + (size_t)km * 1024 + 32);
            IDX_BLOCK(kb, a0, a1);
            IDX_BLOCK(kbB, b0, b1);
            a0 = n0; a1 = n1; b0 = m0; b1 = m1;
        }
#undef IDX_BLOCK
    }
    {
        const int tail = ((limit + 511) & ~511) - limit;
        for (int i = F.tid; i < 16 * (tail >> 1); i += NWAVES * 64) { const int row = i / (tail >> 1), k2 = i - row * (tail >> 1);
            *(LAS unsigned*)(keys + row * IDX_ROWB + (limit + 2 * k2) * 2) = 0u; }
    }
    __syncthreads();
    for (int rq_ = 0; rq_ < IDX_REP_SEL; ++rq_)
    for (int qq = 0; qq < 2; ++qq) {
        const int q = 2 * wave + qq; const LAS unsigned short* rowk = (const LAS unsigned short*)(keys + q * IDX_ROWB);
        const int nj = limit >> 6;
        unsigned kj[64];
#pragma unroll
        for (int g = 0; g < 8; ++g) {
            if (8 * g < nj) {
#pragma unroll
                for (int jj = 0; jj < 8; ++jj) kj[8 * g + jj] = rowk[64 * (8 * g + jj) + lane];
            } else {
#pragma unroll
                for (int jj = 0; jj < 8; ++jj) kj[8 * g + jj] = 0u;
            }
        }
        unsigned T = 0u;
        for (int bit = 15; bit >= 0; --bit) {
            const unsigned cand = T | (1u << bit); int c = 0;
#pragma unroll
            for (int g = 0; g < 8; ++g) if (8 * g < nj) {
#pragma unroll
                for (int jj = 0; jj < 8; ++jj) c += (kj[8 * g + jj] >= cand) ? 1 : 0; }
            if (wave_sum_i(c) >= DSA_TOPK) T = cand;
        }
        int gt;
        { int c = 0;
#pragma unroll
          for (int g = 0; g < 8; ++g) if (8 * g < nj) {
#pragma unroll
              for (int jj = 0; jj < 8; ++jj) c += (kj[8 * g + jj] > T) ? 1 : 0; }
          gt = wave_sum_i(c); }
        const int need = DSA_TOPK - gt;
        unsigned mine_lo = 0u, mine_hi = 0u; int running = 0;
#pragma unroll
        for (int g = 0; g < 8; ++g) if (8 * g < nj) {
#pragma unroll
            for (int jj = 0; jj < 8; ++jj) { const int j = 8 * g + jj;
                unsigned long long m = __ballot(kj[j] > T);
                const unsigned long long eqm = __ballot(kj[j] == T);
                if (eqm) { const int rank = running + __popcll(eqm & ((1ull << lane) - 1ull));
                    m |= __ballot(kj[j] == T && rank < need); running += __popcll(eqm); }
                { const unsigned mlo_ = (unsigned)m, mhi_ = (unsigned)(m >> 32);
                  asm volatile("s_nop 4\n\tv_writelane_b32 %0, %2, %4\n\tv_writelane_b32 %1, %3, %4" : "+v"(mine_lo), "+v"(mine_hi) : "s"(mlo_), "s"(mhi_), "i"(j)); } } }
        if (lane < (nwords >> 1)) *(v2u*)(MASK + (row0 + q) * 128 + 2 * lane) = (v2u){mine_lo, mine_hi};
    }
    __syncthreads();
}
__device__ __forceinline__ void idx_phase(Frame& F, const bf16* IQ, const bf16* IK, const float* IW, const float* LOGF, float* CB, unsigned* MASK) {
    const int gw = F.bid * NWAVES + F.wave;
    if (gw < BATCH * NH) {
        const float* src = LOGF + (size_t)gw * SEQ; float* dst = CB + (size_t)gw * SEQ; float carry = 0.f;
        float vals[64];
#pragma unroll
        for (int i = 0; i < 64; ++i) vals[i] = src[64 * i + F.lane];
#pragma unroll
        for (int i = 0; i < 64; ++i) {
            float v = vals[i];
#pragma unroll
            for (int o = 1; o < 64; o <<= 1) { const float u = __shfl_up(v, o); if (F.lane >= o) v += u; }
            const float c = carry + v;
            dst[64 * i + F.lane] = -c * LOG2E;
            carry = __shfl(c, 63);
        }
    }
    for (int k = F.bid; k < BATCH * (SEQ / 16); k += F.G) {
        const int round = k >> 8, pos = k & 255, i = (round << 8) + ((round & 1) ? 255 - pos : pos);
        idx_unit(F, i & 7, 255 - (i >> 3), IQ, IK, IW, MASK);
    }
}

__device__ __forceinline__ void attn_phase(Frame& F, const bf16* DQ, const bf16* DK, const bf16* DV, const bf16* FQ, const bf16* FK, const bf16* FV, const unsigned* MASK, const float* CB, bf16* OA, bf16* OB) {
    for (int k = F.bid; k < 2 * BATCH * NH * (SEQ / 256); k += F.G) {
        const int round = k >> 8, pos = k & 255, i = (round << 8) + ((round & 1) ? 255 - pos : pos);
        const int qb = 15 - (i >> 7), r = i & 127, kind = r >> 6, b = (r >> 3) & 7, h = r & 7;
        if (kind == 0) attn_body::attn_unit<0, 8>(b, h, qb, DQ, DK, DV, OA, MASK, CB, (LAS char*)F.lds);
        else attn_body::attn_unit<1, 8>(b, h, qb, FQ, FK, FV, OB, MASK, CB, (LAS char*)F.lds);
    }
}

template <int MODE>
__device__ __forceinline__ void ln_phase(Frame& F, const float* gam, const float* bet, const float* router) {
    const float* Y = F.out; bf16* XS = (bf16*)(F.ws + WS_XS);
    const int tpb = NTOK / F.G, r_lo = F.bid * tpb;
    LAS unsigned* cnt = (LAS unsigned*)(F.lds + RING_OFF);
    if (MODE == 1) { if (F.tid < 8) cnt[F.tid] = 0u; __syncthreads(); }
    f32x4 g4[4], b4[4];
#pragma unroll
    for (int j = 0; j < 4; ++j) { g4[j] = *(const f32x4*)(gam + 4 * F.lane + 256 * j); b4[j] = *(const f32x4*)(bet + 4 * F.lane + 256 * j); }
    f32x4 vn[4];
    if (MODE != 3) {
#pragma unroll
        for (int j = 0; j < 4; ++j) vn[j] = *(const f32x4*)(Y + (size_t)(r_lo + F.wave) * DM + 4 * F.lane + 256 * j);
    }
    for (int rr = F.wave; rr < tpb; rr += NWAVES) {
        const int row = r_lo + rr;
        f32x4 v[4]; float s = 0.f;
        if (MODE == 3) {
            const int* ts = (const int*)(F.ws + MOE_TOKSLOT) + 2 * row; const int s0 = ts[0], s1 = ts[1];
            const bf16* yb = (const bf16*)(F.ws + WS_YB);
#pragma unroll
            for (int j = 0; j < 4; ++j) { const int c = 4 * F.lane + 256 * j;
                const v2u xr = *(const v2u*)(XS + (size_t)row * DM + c), y0 = *(const v2u*)(yb + (size_t)s0 * DM + c), y1 = *(const v2u*)(yb + (size_t)s1 * DM + c);
                v[j][0] = ALPHA * pg8::bf2f(xr.x & 0xffffu) + (pg8::bf2f(y0.x & 0xffffu) + pg8::bf2f(y1.x & 0xffffu));
                v[j][1] = ALPHA * __uint_as_float(xr.x & 0xffff0000u) + (__uint_as_float(y0.x & 0xffff0000u) + __uint_as_float(y1.x & 0xffff0000u));
                v[j][2] = ALPHA * pg8::bf2f(xr.y & 0xffffu) + (pg8::bf2f(y0.y & 0xffffu) + pg8::bf2f(y1.y & 0xffffu));
                v[j][3] = ALPHA * __uint_as_float(xr.y & 0xffff0000u) + (__uint_as_float(y0.y & 0xffff0000u) + __uint_as_float(y1.y & 0xffff0000u)); }
        } else {
#pragma unroll
            for (int j = 0; j < 4; ++j) v[j] = vn[j];
            const int rn = (rr + NWAVES < tpb) ? row + NWAVES : row;
#pragma unroll
            for (int j = 0; j < 4; ++j) vn[j] = *(const f32x4*)(Y + (size_t)rn * DM + 4 * F.lane + 256 * j);
        }
#pragma unroll
        for (int j = 0; j < 4; ++j) s += (v[j][0] + v[j][1]) + (v[j][2] + v[j][3]);
        const float mean = wave_sum(s) * (1.f / DM); float s2 = 0.f;
#pragma unroll
        for (int j = 0; j < 4; ++j) { v[j] = v[j] - mean; s2 += (v[j][0] * v[j][0] + v[j][1] * v[j][1]) + (v[j][2] * v[j][2] + v[j][3] * v[j][3]); }
        const float rstd = 1.f / sqrtf(wave_sum(s2) * (1.f / DM) + LN_EPS);
#pragma unroll
        for (int j = 0; j < 4; ++j) v[j] = v[j] * rstd * g4[j] + b4[j];
        if (MODE == 0 || MODE == 2 || MODE == 3) {
#pragma unroll
            for (int j = 0; j < 4; ++j) *(f32x4*)(F.out + (size_t)row * DM + 4 * F.lane + 256 * j) = v[j];
        }
        if (MODE == 0 || MODE == 1) {
#pragma unroll
            for (int j = 0; j < 4; ++j) { v2u o; o.x = pk2(v[j][0], v[j][1]); o.y = pk2(v[j][2], v[j][3]); *(v2u*)(XS + (size_t)row * DM + 4 * F.lane + 256 * j) = o; }
        }
        if (MODE == 1) {
            float lg[8];
#pragma unroll
            for (int e = 0; e < 8; ++e) lg[e] = 0.f;
#pragma unroll
            for (int j = 0; j < 4; ++j)
#pragma unroll
                for (int c = 0; c < 4; ++c) { const float* rp = router + (size_t)(4 * F.lane + 256 * j + c) * 8; const f32x4 r0 = *(const f32x4*)rp, r1 = *(const f32x4*)(rp + 4); const float x = v[j][c];
                    lg[0] += x * r0[0]; lg[1] += x * r0[1]; lg[2] += x * r0[2]; lg[3] += x * r0[3]; lg[4] += x * r1[0]; lg[5] += x * r1[1]; lg[6] += x * r1[2]; lg[7] += x * r1[3]; }
#pragma unroll
            for (int e = 0; e < 8; ++e) lg[e] = wave_sum(lg[e]);
            float bv = lg[0]; int bi = 0;
#pragma unroll
            for (int e = 1; e < 8; ++e) if (lg[e] > bv) { bv = lg[e]; bi = e; }
            float sv = -INFINITY; int si = 0;
#pragma unroll
            for (int e = 0; e < 8; ++e) if (e != bi && lg[e] > sv) { sv = lg[e]; si = e; }
            if (F.lane == 0) {
                const float g0 = 1.f / (1.f + __expf(sv - bv));
                ((unsigned*)(F.ws + MOE_TOPE))[row] = (unsigned)bi | ((unsigned)si << 8);
                float* tg = (float*)(F.ws + MOE_TOPG) + 2 * row; tg[0] = g0; tg[1] = 1.f - g0;
                __hip_atomic_fetch_add(cnt + bi, 1u, __ATOMIC_RELAXED, __HIP_MEMORY_SCOPE_WORKGROUP); __hip_atomic_fetch_add(cnt + si, 1u, __ATOMIC_RELAXED, __HIP_MEMORY_SCOPE_WORKGROUP);
            }
        }
    }
    if (MODE == 1) { __syncthreads(); if (F.tid < 8) ((unsigned*)(F.ws + MOE_CNT))[F.bid * 8 + F.tid] = cnt[F.tid]; }
}

__device__ __forceinline__ void moe_assign(Frame& F) {
    const unsigned* CNT = (const unsigned*)(F.ws + MOE_CNT);
    LAS int* part = (LAS int*)(F.lds + RING_OFF);
    LAS int* tot = part + 512;
    LAS int* base = tot + 8; LAS int* pst = tot + 16; LAS int* wcnt = tot + 24;
    const int G = F.G, tpb = NTOK / G, j = F.bid;
    __syncthreads();
    { const int e = F.tid & 7, grp = F.tid >> 3; int s = 0;
      const int gsz = (G + 63) / 64;
      for (int jj = grp * gsz; jj < (grp + 1) * gsz && jj < G; ++jj) s += (int)CNT[jj * 8 + e];
      part[grp * 8 + e] = s; }
    __syncthreads();
    if (F.tid < 8) { const int e = F.tid, gsz = (G + 63) / 64, myg = j / gsz; int t = 0, bs = 0;
        for (int g = 0; g < 64; ++g) { const int s = part[g * 8 + e]; if (g < myg) bs += s; t += s; }
        for (int jj = myg * gsz; jj < j; ++jj) bs += (int)CNT[jj * 8 + e];
        tot[e] = t; base[e] = bs; if (j == 0) ((int*)(F.ws + MOE_TOT))[e] = t; }
    __syncthreads();
    if (F.tid == 0) { int ps = 0; for (int e = 0; e < 8; ++e) { pst[e] = ps; ps += ((tot[e] + 255) >> 8) << 8; } }
    const unsigned* TOPE = (const unsigned*)(F.ws + MOE_TOPE); const float* TOPG = (const float*)(F.ws + MOE_TOPG);
    int* SLOTTOK = (int*)(F.ws + MOE_SLOTTOK); float* SLOTGATE = (float*)(F.ws + MOE_SLOTGATE); int* TOKSLOT = (int*)(F.ws + MOE_TOKSLOT);
    const int na = 2 * tpb;
    int done_before[8];
#pragma unroll
    for (int e = 0; e < 8; ++e) done_before[e] = 0;
    for (int a0 = 0; a0 < na; a0 += NWAVES * 64) {
        const int a = a0 + F.tid; const bool valid = a < na;
        const int tok = j * tpb + (a >> 1), k = a & 1;
        int e = -1; if (valid) { const unsigned te = TOPE[tok]; e = (int)((te >> (8 * k)) & 255u); }
        int rank = 0;
#pragma unroll
        for (int x = 0; x < 8; ++x) { const unsigned long long bm = __ballot(e == x); if (e == x) rank = __popcll(bm & ((1ull << F.lane) - 1ull)); if (F.lane == 0) wcnt[F.wave * 8 + x] = __popcll(bm); }
        __syncthreads();
        if (valid) { int pre = 0, all = 0;
#pragma unroll
            for (int x = 0; x < 8; ++x) { int ps = 0, al = 0;
#pragma unroll
                for (int w = 0; w < NWAVES; ++w) { const int c = wcnt[w * 8 + x]; if (w < F.wave) ps += c; al += c; }
                if (e == x) { pre = ps + done_before[x]; } all = al; done_before[x] += all; }
            const int slot = pst[e] + base[e] + pre + rank;
            SLOTTOK[slot] = tok; SLOTGATE[slot] = TOPG[2 * tok + k]; TOKSLOT[2 * tok + k] = slot;
        } else {
#pragma unroll
            for (int x = 0; x < 8; ++x) { int al = 0;
#pragma unroll
                for (int w = 0; w < NWAVES; ++w) al += wcnt[w * 8 + x];
                done_before[x] += al; }
        }
        __syncthreads();
    }
    if (j < 8) { const int e = j, t = tot[e], padded = ((t + 255) >> 8) << 8; for (int s = t + F.tid; s < padded; s += NWAVES * 64) { SLOTTOK[pst[e] + s] = 0; SLOTGATE[pst[e] + s] = 0.f; } }
    __syncthreads();
}

constexpr int NPHASE = 27;
__device__ __forceinline__ const void* kin_load(const __attribute__((address_space(4))) char* ka, int i) {
    int z; asm volatile("s_mov_b32 %0, 0" : "=s"(z));
    return *(const void* const __attribute__((address_space(4)))*)(ka + 8 * (i + z));
}
struct Args { const void* in[18]; float* out; unsigned char* ws; int ph_lo, ph_hi; };
__global__ void __launch_bounds__(NWAVES * 64, 2) mk_fwd(Args args) {
    extern __shared__ __attribute__((aligned(16))) unsigned char lds[];
    Frame F;
    F.lds = (LAS unsigned char*)lds;
    F.MISC = (volatile LAS unsigned*)(F.lds + MISC_OFF);
    F.tid = threadIdx.x; F.lane = F.tid & 63; F.wave = __builtin_amdgcn_readfirstlane(F.tid >> 6);
    F.G = gridDim.x; F.bid = blockIdx.x;
    F.ws = args.ws; F.out = args.out; F.ctl = (gu32*)(args.ws + WS_CTL);
    const __attribute__((address_space(4))) char* KA = (const __attribute__((address_space(4))) char*)__builtin_amdgcn_kernarg_segment_ptr();
#define KIN(T, i) ((T)kin_load(KA, (i)))
    for (int u = F.tid; u < (LDS_BYTES - MISC_OFF) / 4; u += NWAVES * 64) ((LAS unsigned*)(F.lds + MISC_OFF))[u] = 0u;
    __syncthreads();
    const int lo = args.ph_lo, hi = args.ph_hi;
    XcdBarrier bar; bar.bar = (unsigned*)(F.ctl + CW_BAR); bar.x = 0; bar.st = nullptr;
    if (hi - lo > 1) bar = xcd_barrier_post((unsigned*)(F.ctl + CW_BAR), F.MISC + 8);
#ifndef PHS
#define PHS(s) 1
#endif
#ifndef DUP_SLOT
#define DUP_SLOT -1
#endif
#define NREP(s) (((s) == (DUP_SLOT)) ? 2 : 1)
#define IN(k) (lo <= (k) && (k) < hi)
#define PHASE_BEGIN() do { int t_ = threadIdx.x; asm volatile("" : "+v"(t_)); F.tid = t_; F.lane = t_ & 63; F.wave = __builtin_amdgcn_readfirstlane(t_ >> 6); } while (0)
#define INS(s) (PHS(s) && IN(pb + (s)))
#define INM(s) (PHS((s) + 20) && IN(pb + (s)))
#define SEAM(k) do { if (IN((k) + 1)) xcd_barrier(bar); } while (0)
    unsigned char* ws = args.ws;
#define XS ((bf16*)(ws + WS_XS))
#define DQ ((bf16*)(ws + WS_DQ))
#define DK ((bf16*)(ws + WS_DK))
#define DV ((bf16*)(ws + WS_DV))
#define IQ ((bf16*)(ws + WS_IQ))
#define FQ ((bf16*)(ws + WS_FQ))
#define FK ((bf16*)(ws + WS_FK))
#define FV ((bf16*)(ws + WS_FV))
#define GA ((bf16*)(ws + WS_GA))
#define GB ((bf16*)(ws + WS_GB))
#define IK ((bf16*)(ws + WS_IK))
#define MERGED ((bf16*)(ws + WS_MERGED))
#define IW ((float*)(ws + WS_IW))
#define LOGF ((float*)(ws + WS_LOGF))
#define CB ((float*)(ws + WS_CB))
#define MASK ((unsigned*)(ws + WS_MASK))

    if (PHS(100) && IN(0)) { for (int rep_ = 0; rep_ < NREP(100); ++rep_) { PHASE_BEGIN(); p0_prologue(F, KIN(const float*, 0), KIN(const int*, 1), KIN(const float*, 2), KIN(const float*, 4), KIN(const float*, 5), KIN(const float*, 6), KIN(const float*, 11), KIN(const float*, 12), KIN(const float*, 13)); if (rep_ + 1 < NREP(100)) xcd_barrier(bar); } SEAM(0); }

    for (int layer = 0; layer < 2; ++layer) {
        const int pb = 1 + 13 * layer; const bool moe = (layer & 1) != 0;
        if (INS(0)) { for (int rep_ = 0; rep_ < NREP(0); ++rep_) { PHASE_BEGIN();
            pg8::Gemm g{XS, (const bf16*)(ws + WS_WIN + layer * WIN_STRIDE), NTOK, PROJ_PAD, DM}; pg8::StaticOrder S; S.init(NTOK, PROJ_PAD, F.G, F.bid);
            pg8::EpiProj E{ws, KIN(const float*, 3) + layer * NH};
            pg8::gemm_phase<pg8::EpiProj, pg8::StaticOrder, true, true>(F.lds + RING_OFF, g, S, E);
            if (rep_ + 1 < NREP(0)) xcd_barrier(bar); } SEAM(pb + 0);
        }
        if (INS(1)) { for (int rep_ = 0; rep_ < NREP(1); ++rep_) { PHASE_BEGIN(); idx_phase(F, IQ, IK, IW, LOGF, CB, MASK); if (rep_ + 1 < NREP(1)) xcd_barrier(bar); } SEAM(pb + 1); }
        if (INS(2)) { for (int rep_ = 0; rep_ < NREP(2); ++rep_) { PHASE_BEGIN();
#ifdef ATT_PROBE
            attn_phase(F, DQ, DK, DV, FQ, FK, FV, MASK, CB, XS, XS + (size_t)NTOK * AW); xcd_barrier(bar); PHASE_BEGIN();
#endif
            attn_phase(F, DQ, DK, DV, FQ, FK, FV, MASK, CB, DQ, FQ); if (rep_ + 1 < NREP(2)) xcd_barrier(bar); } SEAM(pb + 2); }
        if (INS(3)) { for (int rep_ = 0; rep_ < NREP(3); ++rep_) { PHASE_BEGIN();
            static_assert((WS_FQ - WS_DQ) == (size_t)512 * 256 * AW * 2 && (WS_WB - WS_WA) == (size_t)8 * 256 * AW * 2, "branch B = branch A + 512 row tiles / + 8 column tiles");
            pg8::Gemm g{DQ, (const bf16*)(ws + WS_WA) + (size_t)layer * DM * AW, NTOK, DM, AW}; pg8::D1Order S; S.init(NTOK, DM, F.G, F.bid);
            pg8::EpiGate2 E{MERGED, GA, GB};
            pg8::gemm_phase<pg8::EpiGate2, pg8::D1Order, true, true>(F.lds + RING_OFF, g, S, E);
            if (rep_ + 1 < NREP(3)) xcd_barrier(bar); } SEAM(pb + 3);
        }
        if (INS(5)) { for (int rep_ = 0; rep_ < NREP(5); ++rep_) { PHASE_BEGIN();
            pg8::Gemm g{MERGED, (const bf16*)(ws + WS_WOUT) + (size_t)layer * DM * DM, NTOK, DM, DM}; pg8::StaticOrder S; S.init(NTOK, DM, F.G, F.bid);
            pg8::EpiY E{F.out, layer == 0 ? KIN(const float*, 0) : (const float*)F.out};
            pg8::gemm_phase<pg8::EpiY, pg8::StaticOrder, true, true>(F.lds + RING_OFF, g, S, E);
            if (rep_ + 1 < NREP(5)) xcd_barrier(bar); } SEAM(pb + 5);
        }
        if (INS(6)) { for (int rep_ = 0; rep_ < NREP(6); ++rep_) { PHASE_BEGIN();
            if (moe) ln_phase<1>(F, KIN(const float*, 7) + layer * DM, KIN(const float*, 8) + layer * DM, KIN(const float*, 14) + (size_t)(layer >> 1) * DM * NEXP);
            else ln_phase<0>(F, KIN(const float*, 7) + layer * DM, KIN(const float*, 8) + layer * DM, nullptr);
            if (rep_ + 1 < NREP(6)) xcd_barrier(bar); } SEAM(pb + 6);
        }
        if (!moe) {
            if (INS(8)) { for (int rep_ = 0; rep_ < NREP(8); ++rep_) { PHASE_BEGIN();
                pg8::Gemm g{XS, (const bf16*)(ws + WS_FGU), NTOK, 2 * DFF, DM}; pg8::StaticOrder S; S.init(NTOK, 2 * DFF, F.G, F.bid);
                pg8::EpiSwiglu E{(bf16*)(ws + WS_H), 28};
                pg8::gemm_phase<pg8::EpiSwiglu, pg8::StaticOrder, true, true>(F.lds + RING_OFF, g, S, E);
                if (rep_ + 1 < NREP(8)) xcd_barrier(bar); } SEAM(pb + 8);
            }
            if (INS(9)) { for (int rep_ = 0; rep_ < NREP(9); ++rep_) { PHASE_BEGIN();
                pg8::Gemm g{(const bf16*)(ws + WS_H), (const bf16*)(ws + WS_FD), NTOK, DM, DFF}; pg8::StaticOrder S; S.init(NTOK, DM, F.G, F.bid);
                pg8::EpiY E{F.out, F.out};
                pg8::gemm_phase<pg8::EpiY, pg8::StaticOrder, true, true>(F.lds + RING_OFF, g, S, E);
                if (rep_ + 1 < NREP(9)) xcd_barrier(bar); } SEAM(pb + 9);
            }
            if (INS(12)) { for (int rep_ = 0; rep_ < NREP(12); ++rep_) { PHASE_BEGIN();
                ln_phase<0>(F, KIN(const float*, 9) + layer * DM, KIN(const float*, 10) + layer * DM, nullptr);
                if (rep_ + 1 < NREP(12)) xcd_barrier(bar); } SEAM(pb + 12);
            }
        } else {
            if (INS(7)) { for (int rep_ = 0; rep_ < NREP(7); ++rep_) { PHASE_BEGIN(); moe_convert(F, KIN(const float*, 15), KIN(const float*, 16), KIN(const float*, 17)); moe_assign(F); if (rep_ + 1 < NREP(7)) xcd_barrier(bar); } SEAM(pb + 7); }
            pg8::MoeOrder MO; MO.G = F.G; MO.c = F.bid; MO.slot_tok = (const int*)(ws + MOE_SLOTTOK);
            if (INM(8) || INM(9) || INM(10) || INM(11)) {
                const int* tot = (const int*)(ws + MOE_TOT); int cs = 0;
#pragma unroll
                for (int e = 0; e < 8; ++e) { cs += (tot[e] + 255) >> 8; MO.cum[e] = cs; }
            } else {
#pragma unroll
                for (int e = 0; e < 8; ++e) MO.cum[e] = 0;
            }
            const int ntile = MO.cum[7], nA = ntile < 128 ? ntile : 128, nT = ntile > 256 ? (ntile - 256 > 8 ? 8 : ntile - 256) : 0, nB = ntile > 128 ? (ntile - 128 > 128 ? 128 : ntile - 128) : 0;
            MO.nmain = nA; MO.gbase = 0; MO.ut = 4 * nT; MO.y = 4;
            if (INM(8)) { PHASE_BEGIN();
                MO.mode = 0; MO.nrows = nA + nT; MO.nmain = nA; MO.gbase = 0; MO.nc = 28;
                pg8::Gemm g{XS, (const bf16*)F.out, NTOK, NEXP * 2 * DFF, DM};
                pg8::EpiSwiglu E{(bf16*)(ws + WS_H2), 28};
                pg8::gemm_phase<pg8::EpiSwiglu, pg8::MoeOrder, true, true, true>(F.lds + RING_OFF, g, MO, E);
                SEAM(pb + 8);
            }
            if (INM(9)) { PHASE_BEGIN();
                MO.mode = 0; MO.nrows = nA; MO.nmain = nA; MO.gbase = 0; MO.nc = 4;
                pg8::Gemm g{(const bf16*)(ws + WS_H2), (const bf16*)(ws + WS_MWD), MOE_H2_TILES * 256, NEXP * DM, DFF};
                pg8::EpiDownMoe E{(bf16*)(ws + WS_YB), (const float*)(ws + MOE_SLOTGATE), 0};
                pg8::gemm_phase<pg8::EpiDownMoe, pg8::MoeOrder, true, true>(F.lds + RING_OFF, g, MO, E);
                SEAM(pb + 9);
            }
            if (INM(10)) { PHASE_BEGIN();
                { MO.mode = 2; MO.gbase = 0; MO.nc = 4;
                  pg8::Gemm g{(const bf16*)(ws + WS_H2), (const bf16*)(ws + WS_MWD), MOE_H2_TILES * 256, NEXP * DM, DFF};
                  pg8::EpiDownMoe E{(bf16*)(ws + WS_YB), (const float*)(ws + MOE_SLOTGATE), 0};
                  pg8::gemm_phase<pg8::EpiDownMoe, pg8::MoeOrder, true, true>(F.lds + RING_OFF, g, MO, E); }
                PHASE_BEGIN();
                { MO.mode = 1; MO.nrows = nB; MO.gbase = 128; MO.nc = 28;
                  pg8::Gemm g{XS, (const bf16*)F.out, NTOK, NEXP * 2 * DFF, DM};
                  pg8::EpiSwiglu E{(bf16*)(ws + WS_H2), 28};
                  pg8::gemm_phase<pg8::EpiSwiglu, pg8::MoeOrder, true, true, true>(F.lds + RING_OFF, g, MO, E); }
                SEAM(pb + 10);
            }
            if (INM(11)) { PHASE_BEGIN();
                MO.mode = 0; MO.nrows = nB; MO.nmain = nB; MO.gbase = 128; MO.nc = 4;
                pg8::Gemm g{(const bf16*)(ws + WS_H2), (const bf16*)(ws + WS_MWD), MOE_H2_TILES * 256, NEXP * DM, DFF};
                pg8::EpiDownMoe E{(bf16*)(ws + WS_YB), (const float*)(ws + MOE_SLOTGATE), 128};
                pg8::gemm_phase<pg8::EpiDownMoe, pg8::MoeOrder, true, true>(F.lds + RING_OFF, g, MO, E);
                SEAM(pb + 11);
            }
            if (INS(12)) { for (int rep_ = 0; rep_ < NREP(12); ++rep_) { PHASE_BEGIN(); ln_phase<3>(F, KIN(const float*, 9) + layer * DM, KIN(const float*, 10) + layer * DM, nullptr); if (rep_ + 1 < NREP(12)) xcd_barrier(bar); } SEAM(pb + 12); }
        }
    }
#undef IN
#undef INS
#undef SEAM
}


#if MK_MULTI && defined(MK_DUMP)
__global__ void dump_kernel(unsigned char* ws, float* out, int mode) {
    const size_t n = (size_t)NTOK * DM;
    for (size_t i = (size_t)blockIdx.x * blockDim.x + threadIdx.x; i < n; i += (size_t)gridDim.x * blockDim.x) {
        const size_t row = i >> 10; const int c = (int)(i & 1023);
        float v = 0.f;
        auto B = [&](size_t off, int pitch, int col) { return pg8::bf2f(((const bf16*)(ws + off))[row * pitch + col]); };
        if (mode == 1) { if (c < 512) v = B(WS_DQ, 512, c) + 2.f * B(WS_DK, 512, c) + 4.f * B(WS_DV, 512, c) + 8.f * B(WS_IQ, 512, c);
                         else v = B(WS_FQ, 512, c - 512) + 2.f * B(WS_FK, 512, c - 512) + 4.f * B(WS_FV, 512, c - 512) + 8.f * B(WS_IK, 64, c & 63) + ((const float*)(ws + WS_IW))[row * 8 + (c & 7)] + ((const float*)(ws + WS_LOGF))[row * 8 + (c & 7)]; }
        else if (mode == 2) v = B(WS_GA, 1024, c) + 2.f * B(WS_GB, 1024, c);
        else if (mode == 3) { const unsigned w = ((const unsigned*)(ws + WS_MASK))[row * 128 + (c & 127)]; const int qb = (int)((row & 4095) >> 8); v = ((c & 127) < 8 * (qb + 1)) ? (float)((w >> (4 * (c >> 7))) & 0xffffu) : 0.f; }
        else if (mode == 4) v = ((const float*)(ws + WS_CB))[(row >> 12) * 8 * 4096 + (size_t)(c & 7) * 4096 + (row & 4095)];
        else if (mode == 5) v = c < 512 ? B(WS_DQ, 512, c) : B(WS_FQ, 512, c - 512);
        else if (mode == 6) v = B(WS_MERGED, 1024, c);
        else if (mode == 7) v = B(WS_XS, 1024, c);
        out[i] = v;
    }
}
#endif
extern "C" void kernel_launch(void* const* d_in, const int* in_sizes, int n_in, void* d_out, int out_size, void* d_ws, size_t ws_size, hipStream_t stream) {
    static int grid = 0;
    if (grid == 0) {
        if (n_in != 18 || in_sizes[0] != NTOK * DM || out_size != NTOK * DM || ws_size < WS_END) {
            fprintf(stderr, "kernel_launch: unexpected shapes: n_in %d in0 %d out %d ws %zu (need %zu); nothing launched\n", n_in, n_in > 0 ? in_sizes[0] : -1, out_size, ws_size, (size_t)WS_END); grid = -1; return; }
        int dev = 0, cus = 0, per_cu = 0;
        if (hipGetDevice(&dev) != hipSuccess || hipDeviceGetAttribute(&cus, hipDeviceAttributeMultiprocessorCount, dev) != hipSuccess) { fprintf(stderr, "kernel_launch: device query failed\n"); grid = -1; return; }
        if (hipFuncSetAttribute((const void*)mk_fwd, hipFuncAttributeMaxDynamicSharedMemorySize, LDS_BYTES) != hipSuccess) { fprintf(stderr, "kernel_launch: hipFuncSetAttribute failed\n"); grid = -1; return; }
        if (hipOccupancyMaxActiveBlocksPerMultiprocessor(&per_cu, (const void*)mk_fwd, NWAVES * 64, LDS_BYTES) != hipSuccess || per_cu < 1)
            fprintf(stderr, "kernel_launch: note: occupancy query reports %d workgroups per CU\n", per_cu);
        (void)hipGetLastError();
        grid = cus;
        if (grid != 256) fprintf(stderr, "kernel_launch: note: %d CUs (built for 256)\n", grid);
    }
    if (grid < 0) return;
    if (hipMemsetAsync((char*)d_ws + WS_CTL, 0, CTL_ZERO_BYTES, stream) != hipSuccess) { fprintf(stderr, "kernel_launch: memset failed\n"); return; }
    Args a{};
    for (int i = 0; i < 18; ++i) a.in[i] = d_in[i];
    a.out = (float*)d_out; a.ws = (unsigned char*)d_ws;
#if MK_MULTI
#ifndef MK_MAXPH
#define MK_MAXPH NPHASE
#endif
    for (int k = 0; k < MK_MAXPH; ++k) {
        if (k >= 1) { const int layer = (k - 1) / 13, s = (k - 1) % 13; const bool moe = layer & 1;
            if (s == 4 || (!moe && (s == 7 || s == 10 || s == 11))) continue; }
        a.ph_lo = k; a.ph_hi = k + 1;
        hipLaunchKernelGGL(mk_fwd, dim3(grid), dim3(NWAVES * 64), LDS_BYTES, stream, a);
    }
#ifdef MK_DUMP
    hipLaunchKernelGGL(dump_kernel, dim3(2048), dim3(256), 0, stream, (unsigned char*)d_ws, (float*)d_out, MK_DUMP);
#endif
#else
    a.ph_lo = 0; a.ph_hi = NPHASE;
    hipLaunchKernelGGL(mk_fwd, dim3(grid), dim3(NWAVES * 64), LDS_BYTES, stream, a);
#endif
    const hipError_t le = hipPeekAtLastError();
    if (le != hipSuccess) fprintf(stderr, "kernel_launch: launch failed: %s\n", hipGetErrorName(le));
}
```

```cpp
#include <hip/hip_runtime.h>
#include <hip/hip_bf16.h>
#include <cstdio>
#include <cstdint>
#include <cmath>

#ifndef MK_MULTI
#define MK_MULTI 0
#endif

constexpr int BATCH = 8, SEQ = 4096, DM = 1024, NTOK = BATCH * SEQ, AW = 512, NH = 8;
constexpr int PROJ_TOTAL = 5712, PROJ_PAD = 5888, DFF = 3584, NEXP = 8;
constexpr float LN_EPS = 1e-5f;
constexpr float ALPHA = 1.4142135623730951f;
constexpr float LOG2E = 1.4426950408889634f;
constexpr float C2 = 0.125f * LOG2E;
constexpr int DSA_TOPK = 256;
constexpr int MOE_H2_TILES = 136;
constexpr int MOE_NT_MAX = 264;

constexpr int NWAVES = 8;
constexpr size_t MiB = 1u << 20;
constexpr size_t WS_CTL = 0, CTL_ZERO_BYTES = 64 * 1024;
constexpr size_t WS_WIN = 1 * MiB;
constexpr size_t WIN_STRIDE = (size_t)PROJ_PAD * DM * 2;
constexpr size_t WS_WA = 24 * MiB, WS_WB = 26 * MiB, WS_WOUT = 28 * MiB;
constexpr size_t WS_FGU = 32 * MiB, WS_FD = 46 * MiB;
constexpr size_t WS_CS = 53 * MiB;
constexpr size_t WS_IW = 61 * MiB, WS_LOGF = 62 * MiB, WS_CB = 63 * MiB;
constexpr size_t WS_MOE = 64 * MiB;
constexpr size_t MOE_TOPE = WS_MOE, MOE_TOPG = WS_MOE + 128 * 1024, MOE_TOKSLOT = WS_MOE + 384 * 1024, MOE_SLOTTOK = WS_MOE + 640 * 1024,
                 MOE_SLOTGATE = WS_MOE + 1024 * 1024, MOE_CNT = WS_MOE + 1408 * 1024, MOE_TOT = MOE_CNT + 16 * 1024;
constexpr size_t WS_XS = 66 * MiB;
constexpr size_t WS_DQ = 130 * MiB, WS_DK = 162 * MiB, WS_DV = 194 * MiB, WS_IQ = 226 * MiB, WS_FQ = 258 * MiB, WS_FK = 290 * MiB, WS_FV = 322 * MiB;
constexpr size_t WS_GA = 354 * MiB, WS_GB = 418 * MiB;
constexpr size_t WS_IK = 482 * MiB, WS_MASK = 486 * MiB;
constexpr size_t WS_MERGED = WS_DK;
constexpr size_t WS_H = 130 * MiB;
constexpr size_t WS_H2 = 130 * MiB;
constexpr size_t WS_YB = 368 * MiB;
constexpr size_t WS_MWD = 500 * MiB;
constexpr size_t WS_END = 556 * MiB;
constexpr size_t WS_XS8 = 502 * MiB, WS_XSCALE = 534 * MiB;
constexpr size_t WS_XS8M = 1 * MiB, WS_XSCALEM = 33 * MiB, WS_MGUSC = 34 * MiB, MOE_SLOTSCALE = 35 * MiB;
constexpr size_t WS_WINSC = WS_WIN + 6 * MiB;
constexpr size_t WS_WOSC = WS_WOUT + 3 * MiB;
constexpr size_t WS_MSCALE = 534 * MiB + 256 * 1024;
constexpr size_t WS_H2SCALE = 36 * MiB, WS_MWDSC = 37 * MiB;
constexpr size_t WS_OA8 = 386 * MiB, WS_OB8 = 450 * MiB;
constexpr size_t WS_WABSC = WS_WB;
constexpr size_t WS_FDSC = WS_FD + 4 * MiB;
constexpr size_t WS_FGUSC = WS_FGU + 8 * MiB;
static_assert(WS_MASK + (size_t)NTOK * 128 * 4 <= WS_END && WS_H2 + (size_t)MOE_H2_TILES * 256 * DFF * 2 <= WS_YB && WS_YB + (size_t)MOE_NT_MAX * 256 * DM * 2 <= WS_MWD && WS_MWD + (size_t)NEXP * DM * DFF * 2 <= WS_END, "ws map");
static_assert(WS_WIN + 2 * WIN_STRIDE <= WS_WA && WS_FD + (size_t)DM * DFF * 2 <= WS_CS && WS_H + (size_t)NTOK * DFF * 2 <= WS_GA, "ws map 2");
constexpr int CW_TMO = 0, CW_CODE = 1, CW_BAR = 4096;
constexpr int CW_CMAX = 16384;
constexpr int CW_NORMS = 8192, CW_QCTR = 9216;

constexpr int RING_OFF = 0, RING_BYTES = 131072;
constexpr int IDX_ROWB = 8200;
constexpr int IDX_HIST_OFF = 16 * IDX_ROWB;
constexpr int MISC_OFF = 146432;
constexpr int LDS_BYTES = 147456;
constexpr int WTAB_OFF = 140288;
static_assert(IDX_HIST_OFF + 8 * 1024 <= WTAB_OFF && WTAB_OFF + 256 <= MISC_OFF && MISC_OFF + 128 <= LDS_BYTES, "LDS map");

#define OPQ(x) ({ size_t o_ = (size_t)(x); asm volatile("" : "+s"(o_)); o_; })
#define GAS __attribute__((address_space(1)))
#define LAS __attribute__((address_space(3)))
typedef unsigned short bf16;
typedef unsigned v4u __attribute__((ext_vector_type(4)));
typedef unsigned v2u __attribute__((ext_vector_type(2)));
typedef float f32x4 __attribute__((ext_vector_type(4)));
typedef short bf16x8 __attribute__((ext_vector_type(8)));
typedef GAS unsigned gu32;
#define RLX_AGENT __ATOMIC_RELAXED, __HIP_MEMORY_SCOPE_AGENT
__device__ __forceinline__ unsigned f2bf(float f) { unsigned u = __builtin_bit_cast(unsigned, f); return (u + 0x7fffu + ((u >> 16) & 1u)) >> 16; }
__device__ __forceinline__ unsigned pk2(float lo, float hi) { return f2bf(lo) | (f2bf(hi) << 16); }
__device__ __forceinline__ int mk_lane() { int l; asm volatile("v_mbcnt_lo_u32_b32 %0, -1, 0\n\tv_mbcnt_hi_u32_b32 %0, -1, %0" : "=v"(l)); return l; }

namespace pg8 {
#define PG8_LAS __attribute__((address_space(3)))
typedef unsigned short bf16_t;
typedef short bf16x8 __attribute__((ext_vector_type(8)));
typedef float f32x4 __attribute__((ext_vector_type(4)));
typedef unsigned u32x4 __attribute__((ext_vector_type(4)));
typedef int i32x4 __attribute__((ext_vector_type(4)));
typedef int i32x8 __attribute__((ext_vector_type(8)));
constexpr int BM = 256, BK = 64, HALF = 128, HTB = HALF * BK * 2  , STAGE_BYTES = 8 * HTB, NXCD = 8, WGM = 8;

__host__ __device__ __forceinline__ int lds_byte(int r, int c) { const int st = (r >> 4) * 2 + (c >> 5), rr = r & 15, cc = c & 31, ob = rr * 64 + cc * 2; return st * 1024 + (ob ^ (((ob >> 9) & 1) << 5)); }
__host__ __device__ __forceinline__ void stage_rc(int b, int& R, int& C) { const int st = b / 1024, sb = b % 1024, swz = sb ^ (((sb >> 9) & 1) << 5); R = (st >> 1) * 16 + swz / 64; C = (st & 1) * 32 + (swz % 64) / 2; }
__host__ __device__ __forceinline__ int perm32(int rho) { const int n = rho >> 4, i = rho & 15; return 8 * (i >> 2) + 4 * n + (i & 3); }

struct Unit { int pm, pn; };
struct Gemm { const bf16_t* A; const bf16_t* Bt; int M, N, K; int lda = 0; int wave = 0; };

struct StaticOrder {
    int nM, nN, nwg, G, c;
    __host__ __device__ void init(int M, int N, int G_, int c_) { nM = M / BM; nN = N / BM; nwg = nM * nN; G = G_; c = c_; }
    __host__ __device__ bool next(int i, Unit& u) const {
        const long L = (long)i * G + c; if (L >= nwg) return false;
        int wgid = (int)L; { const int q = nwg / NXCD, r = nwg % NXCD, xcd = wgid % NXCD, off = wgid / NXCD; wgid = (xcd < r ? xcd * (q + 1) : r * (q + 1) + (xcd - r) * q) + off; }
        const int nig = WGM * nN, gid = wgid / nig, fm = gid * WGM, gsz = (nM - fm) < WGM ? (nM - fm) : WGM;
        u.pm = fm + ((wgid % nig) % gsz); u.pn = (wgid % nig) / gsz; return true;
    }
    __device__ __forceinline__ void a_ready(const Unit&) const {}
    __device__ __forceinline__ void done(const Unit&) const {}
};
__device__ __forceinline__ unsigned cvt_pk_bf16(float lo, float hi) { unsigned r; asm volatile("v_cvt_pk_bf16_f32 %0, %1, %2" : "=v"(r) : "v"(lo), "v"(hi)); return r; }
typedef float f32x2 __attribute__((ext_vector_type(2)));
template <bool PERM>
__device__ __forceinline__ void scale_cols(f32x4 (&acc)[2][2][4][2], const Unit& u, const float* sw, int wc, int fq) {
    const float* swp = sw + (size_t)u.pn * BM + wc * 32 + (PERM ? 8 * fq : 4 * fq);
#pragma unroll
    for (int bj = 0; bj < 2; ++bj) { const f32x4 s0 = *(const f32x4*)(swp + bj * HALF), s1 = *(const f32x4*)(swp + bj * HALF + (PERM ? 4 : 16));
#pragma unroll
        for (int ai = 0; ai < 2; ++ai)
#pragma unroll
            for (int m = 0; m < 4; ++m) { acc[ai][bj][m][0] = acc[ai][bj][m][0] * s0; acc[ai][bj][m][1] = acc[ai][bj][m][1] * s1; } }
}
template <bool PERM>
__device__ __forceinline__ void dequant_acc(f32x4 (&acc)[2][2][4][2], const Unit& u, const float* sa, const float* sw, int wr, int wc, int fr, int fq, float ksc = 1.f) {
    const float* sap = sa + u.pm * BM + wr * 64 + fr;
    const float* swp = sw + (size_t)u.pn * BM + wc * 32 + (PERM ? 8 * fq : 4 * fq);
#pragma unroll
    for (int ai = 0; ai < 2; ++ai) {
        float sr[4];
#pragma unroll
        for (int m = 0; m < 4; ++m) sr[m] = sap[ai * HALF + m * 16] * ksc;
#pragma unroll
        for (int bj = 0; bj < 2; ++bj) { const f32x4 s0 = *(const f32x4*)(swp + bj * HALF), s1 = *(const f32x4*)(swp + bj * HALF + (PERM ? 4 : 16));
#pragma unroll
            for (int m = 0; m < 4; ++m) { const i32x4 i0 = __builtin_bit_cast(i32x4, acc[ai][bj][m][0]), i1 = __builtin_bit_cast(i32x4, acc[ai][bj][m][1]); const float s_ = sr[m];
#pragma unroll
                for (int i = 0; i < 4; ++i) { acc[ai][bj][m][0][i] = (float)i0[i] * (s_ * s0[i]); acc[ai][bj][m][1][i] = (float)i1[i] * (s_ * s1[i]); } } }
    }
}
template <class Epi, class Sched, bool ALIGN_EPI = false, bool SP2 = false, bool GATHER = false, bool I8 = false, bool F8 = false>
__device__ __forceinline__ void gemm_phase(PG8_LAS unsigned char* lds, const Gemm g, const Sched& S, const Epi& E) {
    int tid_ = g.wave * 64 + ::mk_lane(); asm volatile("" : "+v"(tid_));
    const int tid = tid_, wid = __builtin_amdgcn_readfirstlane(tid >> 6), lane = tid & 63, wr = wid >> 2, wc = wid & 3, fr = lane & 15, fq = lane >> 4;
    int K_ = g.K; asm volatile("" : "+s"(K_));
    const int K = K_, nt = K / BK; const unsigned lda = g.lda ? (unsigned)g.lda : (unsigned)(K * 2);
    unsigned voffA[2], voffB[2]; int gR[2]; unsigned gC[2];
#pragma unroll
    for (int i = 0; i < 2; ++i) { int R, C; stage_rc(tid * 16 + i * 8192, R, C); const int Rb = Epi::PERM ? ((R & ~31) + perm32(R & 31)) : R;
        voffA[i] = (unsigned)R * lda + (unsigned)C * 2u; voffB[i] = (unsigned)(Rb * K + C) * 2u; gR[i] = R; gC[i] = (unsigned)C * 2u; }
    static_assert(!GATHER || SP2, "gather mode is written for the SP2 loop only");
    unsigned cv[2][2] = {{0u, 0u}, {0u, 0u}}, nv[2][2] = {{0u, 0u}, {0u, 0u}};
    const size_t kstep = (size_t)(BK * 2);
    const size_t hstep = (size_t)HALF * K * 2;
    const size_t tstep = 2 * hstep;
    const size_t hstepA = (size_t)HALF * lda, tstepA = 2 * hstepA;
    const unsigned ldsw = (unsigned)wid * 1024u;
    const int aoff = lds_byte(wr * 64 + fr, fq * 8), boff = lds_byte(wc * 32 + fr, fq * 8);
#define PG8_SA(b, h) (((b) * 2 + (h)) * HTB)
#define PG8_SB(b, h) ((4 + (b) * 2 + (h)) * HTB)
#define PG8_STAGE(bufoff, gbase, voff) do { _Pragma("unroll") for (int _i = 0; _i < 2; ++_i) \
        { unsigned vo_ = (voff)[_i]; asm volatile("" : "+v"(vo_));   \
          __builtin_amdgcn_global_load_lds((const unsigned*)((const char*)(gbase) + vo_), (PG8_LAS unsigned*)(lds + (bufoff) + ldsw + _i * 8192), 16, 0, 0); } } while (0)
#define PG8_STAGE_A(b, h, gbase, VO) do { if constexpr (GATHER) { PG8_STAGE(PG8_SA(b, h), gbase, VO[h]); } else { PG8_STAGE(PG8_SA(b, h), (gbase) + (h) * hstepA, voffA); } } while (0)
#define PG8_CAT(x0, x1) __builtin_shufflevector(__builtin_bit_cast(i32x4, (x0)), __builtin_bit_cast(i32x4, (x1)), 0, 1, 2, 3, 4, 5, 6, 7)
#define PG8_LDA(dst, b, h) do { if constexpr (F8) { _Pragma("unroll") for (int m = 0; m < 4; ++m) dst##8[m] = PG8_CAT(*(const PG8_LAS bf16x8*)(lds + PG8_SA(b, h) + aoff + m * 2048), *(const PG8_LAS bf16x8*)(lds + PG8_SA(b, h) + aoff + m * 2048 + 1024)); } \
    else { _Pragma("unroll") for (int m = 0; m < 4; ++m) { _Pragma("unroll") for (int k = 0; k < 2; ++k) dst[m][k] = *(const PG8_LAS bf16x8*)(lds + PG8_SA(b, h) + aoff + m * 2048 + k * 1024); } } } while (0)
#define PG8_LDB(dst, b, h) do { if constexpr (F8) { _Pragma("unroll") for (int n = 0; n < 2; ++n) dst##8[n] = PG8_CAT(*(const PG8_LAS bf16x8*)(lds + PG8_SB(b, h) + boff + n * 2048), *(const PG8_LAS bf16x8*)(lds + PG8_SB(b, h) + boff + n * 2048 + 1024)); } \
    else { _Pragma("unroll") for (int n = 0; n < 2; ++n) { _Pragma("unroll") for (int k = 0; k < 2; ++k) dst[n][k] = *(const PG8_LAS bf16x8*)(lds + PG8_SB(b, h) + boff + n * 2048 + k * 1024); } } } while (0)
#define PG8_MMA(ai, bj, At, Bt) do { __builtin_amdgcn_s_setprio(1); \
    if constexpr (F8) { _Pragma("unroll") for (int m = 0; m < 4; ++m) { _Pragma("unroll") for (int n = 0; n < 2; ++n) \
        acc[ai][bj][m][n] = __builtin_amdgcn_mfma_scale_f32_16x16x128_f8f6f4(Bt##8[n], At##8[m], acc[ai][bj][m][n], 0, 0, 0, 0x7f7f7f7f, 0, 0x7f7f7f7f); } } \
    else { _Pragma("unroll") for (int m = 0; m < 4; ++m) { _Pragma("unroll") for (int n = 0; n < 2; ++n) { _Pragma("unroll") for (int k = 0; k < 2; ++k) \
        { if constexpr (I8) acc[ai][bj][m][n] = __builtin_bit_cast(f32x4, __builtin_amdgcn_mfma_i32_16x16x64_i8(__builtin_bit_cast(i32x4, Bt[n][k]), __builtin_bit_cast(i32x4, At[m][k]), __builtin_bit_cast(i32x4, acc[ai][bj][m][n]), 0, 0, 0)); \
          else acc[ai][bj][m][n] = __builtin_amdgcn_mfma_f32_16x16x32_bf16(Bt[n][k], At[m][k], acc[ai][bj][m][n], 0, 0, 0); } } } } \
    __builtin_amdgcn_s_setprio(0); } while (0)
#define PG8_WAIT_V(n) asm volatile("s_waitcnt vmcnt(" #n ")" ::: "memory")
#define PG8_WAIT_L(n) asm volatile("s_waitcnt lgkmcnt(" #n ")" ::: "memory")
#define PG8_BAR __builtin_amdgcn_s_barrier()
#define PG8_SCHED __builtin_amdgcn_sched_barrier(0)
#ifdef KDUP
    constexpr bool KD = I8;
#else
    constexpr bool KD = false;
#endif
#define PG8_SNEXT(i, u) (KD ? S.next((i) >> 1, (u)) : S.next((i), (u)))
    Unit cur, nxt; int ui = 0;
    if (!PG8_SNEXT(0, cur)) return;
    cur.pm = __builtin_amdgcn_readfirstlane(cur.pm); cur.pn = __builtin_amdgcn_readfirstlane(cur.pn);
    f32x4 acc[2][2][4][2];
#pragma unroll
    for (int a = 0; a < 2; ++a)
#pragma unroll
        for (int b = 0; b < 2; ++b)
#pragma unroll
            for (int m = 0; m < 4; ++m)
#pragma unroll
                for (int n = 0; n < 2; ++n) acc[a][b][m][n] = (f32x4){0.f, 0.f, 0.f, 0.f};
    bf16x8 At[4][2], B0[2][2], B1[2][2]; i32x8 At8[4], B08[2], B18[2];
    const char* cA = (const char*)g.A + (GATHER ? (size_t)0 : (size_t)cur.pm * tstepA);
    if constexpr (GATHER) {
#pragma unroll
        for (int h = 0; h < 2; ++h)
#pragma unroll
            for (int i = 0; i < 2; ++i) { cv[h][i] = (unsigned)S.arow(cur, h * HALF + gR[i]) * lda + gC[i]; nv[h][i] = cv[h][i]; } } const char* cB = (const char*)g.Bt + (size_t)cur.pn * tstep;
    S.a_ready(cur);
    if constexpr (SP2) {
        PG8_STAGE(PG8_SB(0, 0), cB, voffB); PG8_STAGE(PG8_SB(0, 1), cB + hstep, voffB); PG8_STAGE_A(0, 0, cA, cv); PG8_STAGE_A(0, 1, cA, cv);
        if (wr == 1) PG8_BAR;
        PG8_WAIT_V(2); PG8_BAR;
        PG8_STAGE(PG8_SB(1, 0), cB + kstep, voffB); PG8_STAGE_A(1, 0, cA + kstep, cv); PG8_STAGE(PG8_SB(1, 1), cB + hstep + kstep, voffB);
        PG8_WAIT_V(6); PG8_BAR;
    } else {
        PG8_STAGE(PG8_SB(0, 0), cB, voffB); PG8_STAGE(PG8_SA(0, 0), cA, voffA); PG8_STAGE(PG8_SB(0, 1), cB + hstep, voffB); PG8_STAGE(PG8_SA(0, 1), cA + hstepA, voffA);
        if (wr == 1) PG8_BAR;
        PG8_WAIT_V(4); PG8_BAR;
        PG8_STAGE(PG8_SB(1, 0), cB + kstep, voffB); PG8_STAGE_A(1, 0, cA + kstep, cv); PG8_STAGE(PG8_SB(1, 1), cB + hstep + kstep, voffB);
        PG8_WAIT_V(6); PG8_BAR;
    }
    for (;;) {
        const bool has_next = PG8_SNEXT(ui + 1, nxt);
        nxt.pm = __builtin_amdgcn_readfirstlane(nxt.pm); nxt.pn = __builtin_amdgcn_readfirstlane(nxt.pn);
        const char* nA = (has_next && !GATHER) ? (const char*)g.A + (size_t)nxt.pm * tstepA : cA;
        if constexpr (GATHER) { if (has_next) {
#pragma unroll
            for (int h = 0; h < 2; ++h)
#pragma unroll
                for (int i = 0; i < 2; ++i) { int t2_ = tid; asm volatile("" : "+v"(t2_)); int R_, C_; stage_rc(t2_ * 16 + i * 8192, R_, C_);
                    nv[h][i] = (unsigned)S.arow(nxt, h * HALF + R_) * lda + (unsigned)C_ * 2u; } } } const char* nB = has_next ? (const char*)g.Bt + (size_t)nxt.pn * tstep : cB;
        for (int t = 0; t < nt; t += 2) {
            const bool last = (t == nt - 2);
            const char* a1 = cA + (size_t)(t + 1) * kstep;
            const char* a2 = last ? nA : cA + (size_t)(t + 2) * kstep; const char* b2 = last ? nB : cB + (size_t)(t + 2) * kstep;
            const char* a3 = a2 + kstep; const char* b3 = b2 + kstep;
            if (last && has_next) S.a_ready(nxt);
            unsigned v2[2][2];
#pragma unroll
            for (int h = 0; h < 2; ++h)
#pragma unroll
                for (int i = 0; i < 2; ++i) v2[h][i] = last ? nv[h][i] : cv[h][i];
            if constexpr (SP2) {
            PG8_LDB(B0, 0, 0); PG8_LDB(B1, 0, 1); PG8_SCHED; PG8_LDA(At, 0, 0); PG8_STAGE_A(1, 1, a1, cv);
            PG8_WAIT_V(8); PG8_WAIT_L(0); PG8_BAR; PG8_MMA(0, 0, At, B0); PG8_MMA(0, 1, At, B1); PG8_BAR; PG8_SCHED;
            PG8_LDA(At, 0, 1); PG8_STAGE(PG8_SB(0, 0), b2, voffB); PG8_STAGE(PG8_SB(0, 1), b2 + hstep, voffB); PG8_STAGE_A(0, 0, a2, v2);
            PG8_WAIT_V(8); PG8_WAIT_L(0); PG8_BAR; PG8_MMA(1, 0, At, B0); PG8_MMA(1, 1, At, B1); PG8_BAR; PG8_SCHED;
            PG8_LDB(B0, 1, 0); PG8_LDB(B1, 1, 1); PG8_SCHED; PG8_LDA(At, 1, 0); PG8_STAGE_A(0, 1, a2, v2);
            PG8_WAIT_V(8); PG8_WAIT_L(0); PG8_BAR; PG8_MMA(0, 0, At, B0); PG8_MMA(0, 1, At, B1); PG8_BAR; PG8_SCHED;
            PG8_LDA(At, 1, 1); PG8_STAGE(PG8_SB(1, 0), b3, voffB); PG8_STAGE(PG8_SB(1, 1), b3 + hstep, voffB); PG8_STAGE_A(1, 0, a3, v2);
            PG8_WAIT_V(8); PG8_WAIT_L(0); PG8_BAR; PG8_MMA(1, 0, At, B0); PG8_MMA(1, 1, At, B1); PG8_BAR; PG8_SCHED;
            } else {
            PG8_LDB(B0, 0, 0); PG8_SCHED; PG8_LDA(At, 0, 0); PG8_STAGE(PG8_SA(1, 1), a1 + hstepA, voffA);
            PG8_WAIT_L(8); PG8_BAR; PG8_WAIT_L(0); PG8_MMA(0, 0, At, B0); PG8_BAR; PG8_SCHED;
            PG8_LDB(B1, 0, 1); PG8_STAGE(PG8_SB(0, 0), b2, voffB);
            PG8_BAR; PG8_WAIT_L(0); PG8_MMA(0, 1, At, B1); PG8_BAR;
            PG8_LDA(At, 0, 1); PG8_STAGE(PG8_SA(0, 0), a2, voffA);
            PG8_BAR; PG8_WAIT_L(0); PG8_MMA(1, 0, At, B0); PG8_BAR; PG8_SCHED;
            PG8_STAGE(PG8_SB(0, 1), b2 + hstep, voffB);
            PG8_WAIT_V(6); PG8_BAR; PG8_MMA(1, 1, At, B1); PG8_BAR;
            PG8_LDB(B0, 1, 0); PG8_SCHED; PG8_LDA(At, 1, 0); PG8_STAGE(PG8_SA(0, 1), a2 + hstepA, voffA);
            PG8_WAIT_L(8); PG8_BAR; PG8_WAIT_L(0); PG8_MMA(0, 0, At, B0); PG8_BAR; PG8_SCHED;
            PG8_LDB(B1, 1, 1); PG8_STAGE(PG8_SB(1, 0), b3, voffB);
            PG8_BAR; PG8_WAIT_L(0); PG8_MMA(0, 1, At, B1); PG8_BAR;
            PG8_LDA(At, 1, 1); PG8_STAGE(PG8_SA(1, 0), a3, voffA);
            PG8_BAR; PG8_WAIT_L(0); PG8_MMA(1, 0, At, B0); PG8_BAR; PG8_SCHED;
            PG8_STAGE(PG8_SB(1, 1), b3 + hstep, voffB);
            PG8_WAIT_V(6); PG8_BAR; PG8_MMA(1, 1, At, B1); PG8_BAR;
            }
        }
        if constexpr (ALIGN_EPI) { if (wr == 0) PG8_BAR; }
        const bool do_epi = !KD || (ui & 1);
        Unit cu_ = cur; cu_.pm = __builtin_amdgcn_readfirstlane(cur.pm); cu_.pn = __builtin_amdgcn_readfirstlane(cur.pn);
        int te_ = ::mk_lane(); asm volatile("" : "+v"(te_)); const int fr_e = te_ & 15, fq_e = (te_ & 63) >> 4;
        if (do_epi) { if constexpr (F8) { if constexpr (Epi::DEQ) scale_cols<Epi::PERM>(acc, cu_, E.sw, wc, fq_e); }
            if constexpr (I8) { if constexpr (Epi::DEQ) dequant_acc<Epi::PERM>(acc, cu_, E.sa_of(cu_), E.sw, wr, wc, fr_e, fq_e, KD ? 0.5f : 1.f); }
        if constexpr (!Epi::AFTER_DRAIN) { E(acc, cu_, wr, wc, fr_e, fq_e);
#ifdef EPI_REP
            if constexpr (I8 && !GATHER) { asm volatile("" ::: "memory"); E(acc, cu_, wr, wc, fr_e, fq_e); }
#endif
            S.done(cur); } }
        if (!has_next) break;
        if (do_epi) {
#pragma unroll
        for (int a = 0; a < 2; ++a)
#pragma unroll
            for (int b = 0; b < 2; ++b)
#pragma unroll
                for (int m = 0; m < 4; ++m)
#pragma unroll
                    for (int n = 0; n < 2; ++n) acc[a][b][m][n] = (f32x4){0.f, 0.f, 0.f, 0.f};
        }
        cur = nxt; cA = nA; cB = nB; ++ui;
        if constexpr (GATHER) {
#pragma unroll
            for (int h = 0; h < 2; ++h)
#pragma unroll
                for (int i = 0; i < 2; ++i) cv[h][i] = nv[h][i]; }
        if constexpr (ALIGN_EPI) { if (wr == 1) PG8_BAR; }
    }
    PG8_WAIT_V(0);
    if constexpr (!ALIGN_EPI) { if (wr == 0) PG8_BAR; }
    PG8_BAR;
    if constexpr (Epi::AFTER_DRAIN) { E.fused(acc, cur, wr, wc, fr, fq, lds, wid, lane); S.done(cur); }
#undef PG8_SNEXT
#undef PG8_SA
#undef PG8_SB
#undef PG8_STAGE
#undef PG8_STAGE_A
#undef PG8_LDA
#undef PG8_LDB
#undef PG8_MMA
#undef PG8_CAT
#undef PG8_WAIT_V
#undef PG8_WAIT_L
#undef PG8_BAR
#undef PG8_SCHED
}
}
namespace pg8 {
typedef unsigned u32x2 __attribute__((ext_vector_type(2)));
__device__ __forceinline__ float bf2f(unsigned h16) { return __uint_as_float(h16 << 16); }
constexpr float HSC = 8.f, MSC = 16.f, OSC = 64.f, F8MAX = 440.f;
__device__ __forceinline__ float sigmoidf_fast(float x) { return __builtin_amdgcn_rcpf(1.0f + __builtin_amdgcn_exp2f(-x * 1.4426950408889634f)); }
typedef float f32x2c __attribute__((ext_vector_type(2))); typedef __bf16 bf16x2c __attribute__((ext_vector_type(2)));
__device__ __forceinline__ unsigned cvt2(float lo, float hi) { f32x2c v = {lo, hi}; bf16x2c b = __builtin_convertvector(v, bf16x2c); return __builtin_bit_cast(unsigned, b); }
__device__ __forceinline__ u32x4 pack8(const f32x4& a, const f32x4& b) { u32x4 w; w.x = cvt2(a[0], a[1]); w.y = cvt2(a[2], a[3]); w.z = cvt2(b[0], b[1]); w.w = cvt2(b[2], b[3]); return w; }
__device__ __forceinline__ void unpack8(const u32x4& w, f32x4& a, f32x4& b) {
    a[0] = bf2f(w.x & 0xffffu); a[1] = __uint_as_float(w.x & 0xffff0000u); a[2] = bf2f(w.y & 0xffffu); a[3] = __uint_as_float(w.y & 0xffff0000u);
    b[0] = bf2f(w.z & 0xffffu); b[1] = __uint_as_float(w.z & 0xffff0000u); b[2] = bf2f(w.w & 0xffffu); b[3] = __uint_as_float(w.w & 0xffff0000u); }

#ifdef DBG_NOSIG
#define SIGF(x) (x)
#else
#define SIGF(x) sigmoidf_fast(x)
#endif
#ifdef GATE_SIG_IN_D1
#define SIGP(x) (x)
#else
#define SIGP(x) SIGF(x)
#endif
#define GATE255(x) __builtin_amdgcn_rcpf(__builtin_fmaf(__builtin_amdgcn_exp2f(x), 1.0f / 255.0f, 1.0f / 255.0f))
struct EpiProj {
    static constexpr bool PERM = true, AFTER_DRAIN = false;
    unsigned char* ws; const float* bforget;
    __device__ __forceinline__ void operator()(const f32x4 (&acc)[2][2][4][2], const Unit& u, int wr, int wc, int fr, int fq) const {
        const int pn = u.pn; const int row0 = u.pm * BM + wr * 64 + fr;
        bf16_t *DQ = (bf16_t*)(ws + OPQ(WS_DQ)), *DK = (bf16_t*)(ws + OPQ(WS_DK)), *DV = (bf16_t*)(ws + OPQ(WS_DV)), *IQ = (bf16_t*)(ws + OPQ(WS_IQ)), *FQ = (bf16_t*)(ws + OPQ(WS_FQ)), *FK = (bf16_t*)(ws + OPQ(WS_FK)), *FV = (bf16_t*)(ws + OPQ(WS_FV));
        bf16_t *GA = (bf16_t*)(ws + OPQ(WS_GA)), *GB = (bf16_t*)(ws + OPQ(WS_GB)), *IK = (bf16_t*)(ws + OPQ(WS_IK)); float *IW = (float*)(ws + OPQ(WS_IW)), *LOGF = (float*)(ws + OPQ(WS_LOGF)); const float* CS = (const float*)(ws + OPQ(WS_CS));
        const bool rot = (pn < 4) || pn == 6 || pn == 7 || (pn == 22 && wc == 0);
        if (rot) {
            bf16_t* dst; int pitch, col1; float sc = 1.f;
            if (pn == 22) { dst = IK; pitch = 64; col1 = 8 * fq; }
            else { dst = pn < 2 ? DQ : (pn < 4 ? DK : IQ); pitch = AW; col1 = (4 * (pn & 1) + wc) * 64 + 8 * fq; if (pn < 2) sc = C2; }
#pragma unroll
            for (int ai = 0; ai < 2; ++ai)
#pragma unroll
                for (int m = 0; m < 4; ++m) {
                    const int row = row0 + ai * HALF + m * 16;
                    const float* cs = CS + (size_t)row * 64 + 16 * fq;
                    const f32x4 t0 = *(const f32x4*)(cs), t1 = *(const f32x4*)(cs + 4), t2 = *(const f32x4*)(cs + 8), t3 = *(const f32x4*)(cs + 12);
                    const f32x4 xa = acc[ai][0][m][0], xb = acc[ai][0][m][1], ya = acc[ai][1][m][0], yb = acc[ai][1][m][1];
                    f32x4 o1a, o1b, o2a, o2b;
                    o1a[0] = (xa[0] * t0[0] - ya[0] * t0[1]) * sc; o2a[0] = (ya[0] * t0[0] + xa[0] * t0[1]) * sc;
                    o1a[1] = (xa[1] * t0[2] - ya[1] * t0[3]) * sc; o2a[1] = (ya[1] * t0[2] + xa[1] * t0[3]) * sc;
                    o1a[2] = (xa[2] * t1[0] - ya[2] * t1[1]) * sc; o2a[2] = (ya[2] * t1[0] + xa[2] * t1[1]) * sc;
                    o1a[3] = (xa[3] * t1[2] - ya[3] * t1[3]) * sc; o2a[3] = (ya[3] * t1[2] + xa[3] * t1[3]) * sc;
                    o1b[0] = (xb[0] * t2[0] - yb[0] * t2[1]) * sc; o2b[0] = (yb[0] * t2[0] + xb[0] * t2[1]) * sc;
                    o1b[1] = (xb[1] * t2[2] - yb[1] * t2[3]) * sc; o2b[1] = (yb[1] * t2[2] + xb[1] * t2[3]) * sc;
                    o1b[2] = (xb[2] * t3[0] - yb[2] * t3[1]) * sc; o2b[2] = (yb[2] * t3[0] + xb[2] * t3[1]) * sc;
                    o1b[3] = (xb[3] * t3[2] - yb[3] * t3[3]) * sc; o2b[3] = (yb[3] * t3[2] + xb[3] * t3[3]) * sc;
                    bf16_t* rp = dst + (size_t)row * pitch + col1;
                    *(u32x4*)(rp) = pack8(o1a, o1b); *(u32x4*)(rp + 32) = pack8(o2a, o2b);
                }
        } else if (pn == 22) {
            if (fq == 0 && (wc == 1 || wc == 2)) {
                f32x4 b0 = {0.f, 0.f, 0.f, 0.f}, b1 = {0.f, 0.f, 0.f, 0.f};
                if (wc == 2) { b0 = *(const f32x4*)(bforget); b1 = *(const f32x4*)(bforget + 4); }
#pragma unroll
                for (int ai = 0; ai < 2; ++ai)
#pragma unroll
                    for (int m = 0; m < 4; ++m) {
                        const int row = row0 + ai * HALF + m * 16;
                        f32x4 va = acc[ai][0][m][0], vb = acc[ai][0][m][1];
                        if (wc == 1) { va = va * 0.04419417382415922f; vb = vb * 0.04419417382415922f;
                            *(f32x4*)(IW + (size_t)row * 8) = va; *(f32x4*)(IW + (size_t)row * 8 + 4) = vb; }
                        else { va = va + b0; vb = vb + b1; f32x4 la, lb;
#pragma unroll
                            for (int i = 0; i < 4; ++i) { const float za = va[i], zb = vb[i];
                                la[i] = fminf(za, 0.f) - log1pf(__expf(-fabsf(za))); lb[i] = fminf(zb, 0.f) - log1pf(__expf(-fabsf(zb))); }
                            float* lp = LOGF + (size_t)(row >> 12) * (NH * SEQ) + (row & (SEQ - 1));
                            lp[0] = la[0]; lp[SEQ] = la[1]; lp[2 * SEQ] = la[2]; lp[3 * SEQ] = la[3]; lp[4 * SEQ] = lb[0]; lp[5 * SEQ] = lb[1]; lp[6 * SEQ] = lb[2]; lp[7 * SEQ] = lb[3]; }
                    }
            }
        } else if (pn < 14) {
            bf16_t* dst = pn < 6 ? DV : (pn < 10 ? FQ : (pn < 12 ? FK : FV)); const float sc = (pn == 8 || pn == 9) ? C2 : 1.f;
            const int col0 = 256 * (pn & 1) + wc * 32 + 8 * fq;
#pragma unroll
            for (int ai = 0; ai < 2; ++ai)
#pragma unroll
                for (int m = 0; m < 4; ++m) { bf16_t* rp = dst + (size_t)(row0 + ai * HALF + m * 16) * AW + col0;
#pragma unroll
                    for (int bj = 0; bj < 2; ++bj) *(u32x4*)(rp + bj * HALF) = pack8(acc[ai][bj][m][0] * sc, acc[ai][bj][m][1] * sc); }
        } else {
            unsigned char* dst = (unsigned char*)(pn < 18 ? GA : GB); const int col0 = 256 * ((pn - 14) & 3) + wc * 32 + 8 * fq;
#pragma unroll
            for (int ai = 0; ai < 2; ++ai)
#pragma unroll
                for (int m = 0; m < 4; ++m) { unsigned char* rp = dst + (size_t)(row0 + ai * HALF + m * 16) * DM + col0;
#pragma unroll
                    for (int bj = 0; bj < 2; ++bj) { const f32x4 a = acc[ai][bj][m][0], b = acc[ai][bj][m][1]; u32x2 o = {0u, 0u};
#pragma unroll
                        for (int i = 0; i < 4; ++i) { o.x = __builtin_amdgcn_cvt_pk_u8_f32(GATE255(a[i]), i, o.x); o.y = __builtin_amdgcn_cvt_pk_u8_f32(GATE255(b[i]), i, o.y); }
                        *(u32x2*)(rp + bj * HALF) = o; } }
        }
    }
};
struct EpiProj8 : EpiProj { static constexpr bool DEQ = true; const float* sa; const float* sw; __device__ __forceinline__ const float* sa_of(const Unit&) const { return sa; } };

struct EpiGate2 {
    static constexpr bool PERM = true, AFTER_DRAIN = false, DEQ = true;
    bf16_t* O; const bf16_t* GAp; const bf16_t* GBp; unsigned char* O8; const float* sw;
    __device__ __forceinline__ void operator()(const f32x4 (&acc)[2][2][4][2], const Unit& u, int wr, int wc, int fr, int fq) const {
        const int br = u.pm >> 9; const bf16_t* G = br ? GBp : GAp;
        const int row0 = (u.pm & 511) * BM + wr * 64 + fr, col0 = (u.pn & 7) * BM + wc * 32 + 8 * fq;
        u32x2 gv[4][2];
#pragma unroll
        for (int am = 0; am < 4; ++am) {
            const int ai = am >> 1;
            if ((am & 1) == 0) {
#pragma unroll
                for (int m = 0; m < 4; ++m)
#pragma unroll
                    for (int bj = 0; bj < 2; ++bj) gv[m][bj] = *(const u32x2*)((const unsigned char*)G + (size_t)(row0 + ai * HALF + m * 16) * DM + col0 + bj * HALF);
            }
            u32x4 pv_[4][2];
#pragma unroll
            for (int m = 2 * (am & 1); m < 2 * (am & 1) + 2; ++m)
#pragma unroll
                for (int bj = 0; bj < 2; ++bj) { const size_t off = (size_t)(row0 + ai * HALF + m * 16) * DM + col0 + bj * HALF;
                    pv_[m][bj] = br ? *(const u32x4*)(O + off) : (u32x4){0u, 0u, 0u, 0u}; }
#pragma unroll
            for (int m = 2 * (am & 1); m < 2 * (am & 1) + 2; ++m)
#pragma unroll
                for (int bj = 0; bj < 2; ++bj) { const size_t off = (size_t)(row0 + ai * HALF + m * 16) * DM + col0 + bj * HALF;
                    f32x4 ga, gb, pa, pb; unpack8(pv_[m][bj], pa, pb);
#pragma unroll
                    for (int i = 0; i < 4; ++i) { ga[i] = (float)((gv[m][bj].x >> (8 * i)) & 255u) * (1.f / 255.f); gb[i] = (float)((gv[m][bj].y >> (8 * i)) & 255u) * (1.f / 255.f); }
                    const f32x4 ra = ga * acc[ai][bj][m][0] + pa, rb = gb * acc[ai][bj][m][1] + pb;
                    if (br == 0) *(u32x4*)(O + off) = pack8(ra, rb);
                    else { f32x4 a, b;
#pragma unroll
                        for (int i = 0; i < 4; ++i) { a[i] = __builtin_amdgcn_fmed3f(ra[i] * MSC, -F8MAX, F8MAX); b[i] = __builtin_amdgcn_fmed3f(rb[i] * MSC, -F8MAX, F8MAX); }
                        u32x2 o; int w0 = __builtin_amdgcn_cvt_pk_fp8_f32(a[0], a[1], 0, false); w0 = __builtin_amdgcn_cvt_pk_fp8_f32(a[2], a[3], w0, true);
                        int w1 = __builtin_amdgcn_cvt_pk_fp8_f32(b[0], b[1], 0, false); w1 = __builtin_amdgcn_cvt_pk_fp8_f32(b[2], b[3], w1, true);
                        o.x = (unsigned)w0; o.y = (unsigned)w1; *(u32x2*)(O8 + off) = o; } }
        }
    }
};
struct D1Order {
    StaticOrder S; int n;
    __device__ __forceinline__ void init(int M, int N, int G, int c) { S.init(M, N, G, c); n = (S.nwg - c + G - 1) / G; if (n < 0) n = 0; }
    __device__ __forceinline__ bool next(int i, Unit& u) const { if (i >= 2 * n) return false; const int br = (i >= n) ? 1 : 0; S.next(i - br * n, u); u.pm += 512 * br; u.pn += 8 * br; return true; }
    __device__ __forceinline__ void a_ready(const Unit&) const {}
    __device__ __forceinline__ void done(const Unit&) const {}
};

struct EpiY {
    static constexpr bool PERM = false, AFTER_DRAIN = false;
    bf16_t* Y; const bf16_t* R;
    __device__ __forceinline__ void operator()(const f32x4 (&acc)[2][2][4][2], const Unit& u, int wr, int wc, int fr, int fq) const {
        const int row0 = u.pm * BM + wr * 64 + fr, col0 = u.pn * BM + wc * 32 + 4 * fq;
#pragma unroll
        for (int ai = 0; ai < 2; ++ai)
#pragma unroll
            for (int mp = 0; mp < 2; ++mp) {
                u32x2 r[2][2][2];
#pragma unroll
                for (int mm = 0; mm < 2; ++mm)
#pragma unroll
                    for (int bj = 0; bj < 2; ++bj)
#pragma unroll
                        for (int n = 0; n < 2; ++n) r[mm][bj][n] = *(const u32x2*)(R + (size_t)(row0 + ai * HALF + (2 * mp + mm) * 16) * DM + col0 + bj * HALF + n * 16);
#pragma unroll
                for (int mm = 0; mm < 2; ++mm)
#pragma unroll
                    for (int bj = 0; bj < 2; ++bj)
#pragma unroll
                        for (int n = 0; n < 2; ++n) { const u32x2 w = r[mm][bj][n]; f32x4 rv;
                            rv[0] = bf2f(w.x & 0xffffu); rv[1] = __uint_as_float(w.x & 0xffff0000u); rv[2] = bf2f(w.y & 0xffffu); rv[3] = __uint_as_float(w.y & 0xffff0000u);
                            const f32x4 o = rv * ALPHA + acc[ai][bj][2 * mp + mm][n]; u32x2 ob; ob.x = cvt2(o[0], o[1]); ob.y = cvt2(o[2], o[3]);
                            *(u32x2*)(Y + (size_t)(row0 + ai * HALF + (2 * mp + mm) * 16) * DM + col0 + bj * HALF + n * 16) = ob; }
            }
    }
};
struct EpiYF8 : EpiY { static constexpr bool DEQ = true; const float* sw; };
struct EpiY8 : EpiY { static constexpr bool DEQ = true; const float* sa; const float* sw; __device__ __forceinline__ const float* sa_of(const Unit&) const { return sa; } };

struct EpiSwiglu {
    static constexpr bool PERM = true, AFTER_DRAIN = false;
    bf16_t* H; int nc;
    __device__ __forceinline__ void operator()(const f32x4 (&acc)[2][2][4][2], const Unit& u, int wr, int wc, int fr, int fq) const {
        const int row0 = u.pm * BM + wr * 64 + fr, col0 = (u.pn % nc) * HALF + wc * 32 + 8 * fq;
#pragma unroll
        for (int ai = 0; ai < 2; ++ai)
#pragma unroll
            for (int m = 0; m < 4; ++m) { f32x4 a, b;
#pragma unroll
                for (int i = 0; i < 4; ++i) { const float g0 = acc[ai][0][m][0][i], g1 = acc[ai][0][m][1][i];
#ifdef SWIGLU_PROBE
                    float t0 = g0, t1 = g1; asm volatile("" : "+v"(t0), "+v"(t1));
                    a[i] = g0 * (0.5f * (sigmoidf_fast(g0) + sigmoidf_fast(t0))) * acc[ai][1][m][0][i]; b[i] = g1 * (0.5f * (sigmoidf_fast(g1) + sigmoidf_fast(t1))) * acc[ai][1][m][1][i]; }
#else
                    a[i] = g0 * sigmoidf_fast(g0) * acc[ai][1][m][0][i]; b[i] = g1 * sigmoidf_fast(g1) * acc[ai][1][m][1][i]; }
#endif
                *(u32x4*)(H + (size_t)(row0 + ai * HALF + m * 16) * DFF + col0) = pack8(a, b); }
    }
};

struct EpiSwigluQ {
    static constexpr bool PERM = true, AFTER_DRAIN = false;
    unsigned char* H; int nc;
    __device__ __forceinline__ void operator()(const f32x4 (&acc)[2][2][4][2], const Unit& u, int wr, int wc, int fr, int fq) const {
        const int row0 = u.pm * BM + wr * 64 + fr, col0 = (u.pn % nc) * HALF + wc * 32 + 8 * fq;
#pragma unroll
        for (int ai = 0; ai < 2; ++ai)
#pragma unroll
            for (int m = 0; m < 4; ++m) { f32x4 a, b;
#pragma unroll
                for (int i = 0; i < 4; ++i) { const float g0 = acc[ai][0][m][0][i], g1 = acc[ai][0][m][1][i];
                    a[i] = g0 * sigmoidf_fast(g0) * acc[ai][1][m][0][i]; b[i] = g1 * sigmoidf_fast(g1) * acc[ai][1][m][1][i]; }
#pragma unroll
                for (int i = 0; i < 4; ++i) { a[i] = __builtin_amdgcn_fmed3f(a[i], -F8MAX, F8MAX); b[i] = __builtin_amdgcn_fmed3f(b[i], -F8MAX, F8MAX); }
                u32x2 o; int w0 = __builtin_amdgcn_cvt_pk_fp8_f32(a[0], a[1], 0, false); w0 = __builtin_amdgcn_cvt_pk_fp8_f32(a[2], a[3], w0, true);
                int w1 = __builtin_amdgcn_cvt_pk_fp8_f32(b[0], b[1], 0, false); w1 = __builtin_amdgcn_cvt_pk_fp8_f32(b[2], b[3], w1, true);
                o.x = (unsigned)w0; o.y = (unsigned)w1;
                *(u32x2*)(H + (size_t)(row0 + ai * HALF + m * 16) * DFF + col0) = o; }
    }
};
struct EpiSwiglu8 : EpiSwigluQ {
    static constexpr bool DEQ = true;
    const float* sa; const float* sw; int gbase;
    __device__ __forceinline__ const float* sa_of(const Unit& u) const { return sa + (size_t)((u.pm >= 128) ? 128 : gbase) * BM; }
};

struct EpiDownMoe {
    static constexpr bool PERM = true, AFTER_DRAIN = false;
    bf16_t* YB; const float* gate; int gbase;
    __device__ __forceinline__ void operator()(const f32x4 (&acc)[2][2][4][2], const Unit& u, int wr, int wc, int fr, int fq) const {
        const int gt = u.pm + ((u.pm >= 128) ? 128 : gbase);
        const int row0 = gt * BM + wr * 64 + fr, col0 = (u.pn & 3) * BM + wc * 32 + 8 * fq;
#pragma unroll
        for (int ai = 0; ai < 2; ++ai)
#pragma unroll
            for (int m = 0; m < 4; ++m) { const int row = row0 + ai * HALF + m * 16; const float gt_ = gate[row]; bf16_t* rp = YB + (size_t)row * DM + col0;
#pragma unroll
                for (int bj = 0; bj < 2; ++bj) *(u32x4*)(rp + bj * HALF) = pack8(acc[ai][bj][m][0] * gt_, acc[ai][bj][m][1] * gt_); }
    }
};
struct EpiDownMoeF8 : EpiDownMoe { static constexpr bool DEQ = true; const float* sw; };
struct EpiDownMoe8 : EpiDownMoe { static constexpr bool DEQ = true; const float* sa; const float* sw; __device__ __forceinline__ const float* sa_of(const Unit&) const { return sa; } };

struct MoeOrder {
    int cum[8]; int nc, G, c; const int* slot_tok; int mode, nrows, nmain, gbase, ut, y;
    __device__ __forceinline__ int gtile(int l) const { return l + ((l >= 128) ? 128 : gbase); }
    __device__ __forceinline__ bool next(int i, Unit& u) const {
        int l, pn;
        if (mode == 0) { if (nrows <= 0) return false;
            StaticOrder S; S.nM = nrows; S.nN = nc; S.nwg = nrows * nc; S.G = G; S.c = c; Unit v; if (!S.next(i, v)) return false;
            l = (v.pm < nmain) ? v.pm : 128 + (v.pm - nmain); pn = v.pn;
        } else if (mode == 1) { const int pool = nrows * nc; int L;
            if (c < ut) { if (i >= y) return false; L = c * y + i; } else L = y * ut + (c - ut) + i * (G - ut);
            if (L >= pool) return false; l = L / nc; pn = L - l * nc;
        } else { if (i != 0 || c >= ut) return false; l = 128 + (c >> 2); pn = c & 3; }
        const int tg = gtile(l); int e = 0;
#pragma unroll
        for (int j = 0; j < 7; ++j) e += (tg >= cum[j]) ? 1 : 0;
        u.pm = l; u.pn = e * nc + pn; return true;
    }
    __device__ __forceinline__ int arow(const Unit& u, int r) const { return slot_tok[gtile(u.pm) * BM + r]; }
    __device__ __forceinline__ void a_ready(const Unit&) const {}
    __device__ __forceinline__ void done(const Unit&) const {}
};
}

namespace attn_body {
using bf16 = unsigned short;
using bf16x8 = __attribute__((ext_vector_type(8))) short;
using s16x4 = __attribute__((ext_vector_type(4))) short;
using f32x16 = __attribute__((ext_vector_type(16))) float;
using f32x4a = __attribute__((ext_vector_type(4))) float;
using u32x4 = __attribute__((ext_vector_type(4))) unsigned;
using u32x2 = __attribute__((ext_vector_type(2))) unsigned;
#define ALAS __attribute__((address_space(3)))
constexpr int NW = 8, QBLK = 32, QB = QBLK * NW, KVBLK = 64;
constexpr int NSLOT = 3, SLOTB = 8192;
constexpr int LDS_K = 0, LDS_V = NSLOT * SLOTB, LDS_WS = 2 * NSLOT * SLOTB, LDS_OST = LDS_WS + NW * 64 * 4, LDS_BIAS = LDS_OST + NW * 4096, LDS_M = LDS_BIAS + 16384, LDS_BYTES = LDS_M + NW * 1024;
__device__ __forceinline__ int crow(int r, int hi) { return (r & 3) + 8 * (r >> 2) + 4 * hi; }
#define SBAR() __builtin_amdgcn_sched_barrier(0)
__device__ __forceinline__ void cmask(f32x16& p0, f32x16& p1, int jb, int qrel, int hi) {
    const float NEG = -INFINITY; const int kb = 64 * jb + 4 * hi;
#pragma unroll
    for (int r = 0; r < 16; ++r) { const int kv = kb + (r & 3) + 8 * (r >> 2); if (kv > qrel) p0[r] = NEG; if (kv + 32 > qrel) p1[r] = NEG; }
}
__device__ __forceinline__ void glds16(const void* gsrc, unsigned lds_dst) { unsigned keep;
    asm volatile("s_mov_b32 %0, m0\n\ts_mov_b32 m0, %2\n\ts_nop 0\n\tglobal_load_lds_dwordx4 %1, off\n\ts_mov_b32 m0, %0" : "=&s"(keep) : "v"(gsrc), "s"(lds_dst) : "memory"); }
__device__ __forceinline__ void glds4(const void* gsrc, unsigned lds_dst) { unsigned keep;
    asm volatile("s_mov_b32 %0, m0\n\ts_mov_b32 m0, %2\n\ts_nop 0\n\tglobal_load_lds_dword %1, off\n\ts_mov_b32 m0, %0" : "=&s"(keep) : "v"(gsrc), "s"(lds_dst) : "memory"); }
typedef float f32x2_t __attribute__((ext_vector_type(2))); typedef __bf16 bf16x2_t __attribute__((ext_vector_type(2)));
__device__ __forceinline__ unsigned cvtpk_s(float lo, float hi) { f32x2_t v = {lo, hi}; bf16x2_t b = __builtin_convertvector(v, bf16x2_t); return __builtin_bit_cast(unsigned, b); }
template <int N> __device__ __forceinline__ void wait_bar() {
    static_assert(N >= 0 && N <= 4, "wait_bar");
    if constexpr (N == 0) asm volatile("s_waitcnt vmcnt(0) lgkmcnt(0)\n\ts_barrier" ::: "memory");
    else if constexpr (N == 1) asm volatile("s_waitcnt vmcnt(1) lgkmcnt(0)\n\ts_barrier" ::: "memory");
    else if constexpr (N == 2) asm volatile("s_waitcnt vmcnt(2) lgkmcnt(0)\n\ts_barrier" ::: "memory");
    else if constexpr (N == 3) asm volatile("s_waitcnt vmcnt(3) lgkmcnt(0)\n\ts_barrier" ::: "memory");
    else asm volatile("s_waitcnt vmcnt(4) lgkmcnt(0)\n\ts_barrier" ::: "memory");
}
typedef __attribute__((address_space(3))) const char* lds_cptr;
typedef short v4i16_t __attribute__((ext_vector_type(4)));
__device__ __forceinline__ void kload8(bf16x8* kf, lds_cptr kp) {
    kf[0] = *(const ALAS bf16x8*)(kp);        kf[1] = *(const ALAS bf16x8*)(kp + 512);
    kf[2] = *(const ALAS bf16x8*)(kp + 2048); kf[3] = *(const ALAS bf16x8*)(kp + 2560);
    kf[4] = *(const ALAS bf16x8*)(kp + 4096); kf[5] = *(const ALAS bf16x8*)(kp + 4608);
    kf[6] = *(const ALAS bf16x8*)(kp + 6144); kf[7] = *(const ALAS bf16x8*)(kp + 6656);
}
__device__ __forceinline__ void kload2(bf16x8* kf, lds_cptr kp, int j) { kf[2 * j] = *(const ALAS bf16x8*)(kp + j * 2048); kf[2 * j + 1] = *(const ALAS bf16x8*)(kp + j * 2048 + 512); }
__device__ __forceinline__ s16x4 vtr(lds_cptr p) { return __builtin_bit_cast(s16x4, __builtin_amdgcn_ds_read_tr16_b64_v4i16((ALAS v4i16_t*)p)); }
__device__ __forceinline__ void pv(f32x16* o, int vb, bf16x8 pa0, bf16x8 pa1, bf16x8 pa2, bf16x8 pa3) {
#pragma unroll
    for (int d0 = 0; d0 < 2; ++d0) { s16x4 lo[4], hi[4];
#pragma unroll
        for (int ks = 0; ks < 4; ++ks) {
            asm volatile("ds_read_b64_tr_b16 %0,%1 offset:%c2" : "=&v"(lo[ks]) : "v"(vb), "i"(d0 * 4096 + ks * 1024) : "memory");
            asm volatile("ds_read_b64_tr_b16 %0,%1 offset:%c2" : "=&v"(hi[ks]) : "v"(vb), "i"(d0 * 4096 + ks * 1024 + 512) : "memory"); }
        asm volatile("s_waitcnt lgkmcnt(0)" ::: "memory"); SBAR();
#define PK(k) (bf16x8){lo[k][0], lo[k][1], lo[k][2], lo[k][3], hi[k][0], hi[k][1], hi[k][2], hi[k][3]}
        o[d0] = __builtin_amdgcn_mfma_f32_32x32x16_bf16(pa0, PK(0), o[d0], 0, 0, 0);
        o[d0] = __builtin_amdgcn_mfma_f32_32x32x16_bf16(pa1, PK(1), o[d0], 0, 0, 0);
        o[d0] = __builtin_amdgcn_mfma_f32_32x32x16_bf16(pa2, PK(2), o[d0], 0, 0, 0);
        o[d0] = __builtin_amdgcn_mfma_f32_32x32x16_bf16(pa3, PK(3), o[d0], 0, 0, 0);
#undef PK
    }
}
template <int KIND>
__device__ __forceinline__ void cload(f32x16& C0, f32x16& C1, unsigned& mw0, unsigned& mw1, const ALAS float* bl_t  , const ALAS unsigned* mw  ) {
    if constexpr (KIND == 1) {
#pragma unroll
        for (int g = 0; g < 4; ++g) { const f32x4a a = *(const ALAS f32x4a*)(bl_t + 8 * g), b = *(const ALAS f32x4a*)(bl_t + 32 + 8 * g);
            C0[4 * g] = a[0]; C0[4 * g + 1] = a[1]; C0[4 * g + 2] = a[2]; C0[4 * g + 3] = a[3];
            C1[4 * g] = b[0]; C1[4 * g + 1] = b[1]; C1[4 * g + 2] = b[2]; C1[4 * g + 3] = b[3]; }
    } else { mw0 = mw[0]; mw1 = mw[32]; }
}
template <int KIND>
__device__ __forceinline__ void cfin(f32x16& C0, f32x16& C1, unsigned mw0, unsigned mw1, int hi, float negmh) {
    if constexpr (KIND == 1) {
#pragma unroll
        for (int r = 0; r < 16; ++r) { C0[r] += negmh; C1[r] += negmh; }
    } else {
        const unsigned w0 = mw0 >> (4 * hi), w1 = mw1 >> (4 * hi); const unsigned ninf = 0xff800000u, nm = __float_as_uint(negmh);
#pragma unroll
        for (int r = 0; r < 16; ++r) { const int sh = (r & 3) + 8 * (r >> 2);
            const unsigned m0 = (unsigned)__builtin_amdgcn_sbfe((int)w0, sh, 1), m1 = (unsigned)__builtin_amdgcn_sbfe((int)w1, sh, 1);
            unsigned c0, c1;
            asm("v_bfi_b32 %0, %1, %2, %3" : "=v"(c0) : "v"(m0), "v"(nm), "v"(ninf));
            asm("v_bfi_b32 %0, %1, %2, %3" : "=v"(c1) : "v"(m1), "v"(nm), "v"(ninf));
            C0[r] = __uint_as_float(c0); C1[r] = __uint_as_float(c1); }
    }
}

template <int KIND, int THRL>
__device__ __forceinline__ void attn_unit(int b, int h, int qb, const bf16* Q, const bf16* __restrict__ K, const bf16* __restrict__ V, bf16* O,
                                          const unsigned* __restrict__ MASK, const float* __restrict__ CB, ALAS char* shm, float smax, unsigned* qctr, unsigned& pend, unsigned p_old, volatile ALAS int* qs, int wave_) {
    int tid_ = wave_ * 64 + mk_lane(); asm volatile("" : "+v"(tid_));
    const int tid = tid_, lane = tid & 63, r32 = lane & 31, hi = lane >> 5; const int wid = __builtin_amdgcn_readfirstlane(tid >> 6);
    constexpr int MX = (KIND == 0) ? 1 : 0;
    const long rowbase = (long)b * SEQ; const int q0 = qb * QB;
    const bf16* Qw = Q + (rowbase + q0 + wid * QBLK) * AW + h * 64;
    const float* cbh = CB + (size_t)(b * NH + h) * SEQ;
    int ts = 0;
    if constexpr (KIND == 1) {
        const int NT0 = (q0 + QB) / KVBLK;
        const float b0 = cbh[q0], be = cbh[64 * (lane < NT0 ? lane : NT0 - 1) + 63];
        const unsigned long long need = __ballot(lane >= NT0 || smax + be - b0 >= -165.f);
        ts = (int)__builtin_ctzll(need) & ~1; if (ts > NT0 - 4) ts = NT0 - 4;
        ts = __builtin_amdgcn_readfirstlane(ts);
    }
    const bf16* Kh = K + (rowbase + ts * KVBLK) * AW + h * 64, *Vh = V + (rowbase + ts * KVBLK) * AW + h * 64;
    const unsigned lds0 = (unsigned)(uintptr_t)shm;
    ALAS float* wsf = (ALAS float*)(shm + LDS_WS) + wid * 64;
    const bf16* ksrc = Kh + (long)lane * AW + wid * 8;
    const bf16* vsrc = Vh + (long)(16 * (wid & 3) + (lane >> 2)) * AW + (wid >> 2) * 32 + (lane & 3) * 8;
    const unsigned kdst = lds0 + LDS_K + wid * 1024, vdst = lds0 + LDS_V + wid * 1024;
#define DMA_K(t, slot) glds16(ksrc + (long)(t) * KVBLK * AW, (unsigned)__builtin_amdgcn_readfirstlane(kdst + (slot)))
#define DMA_V(t, slot) glds16(vsrc + (long)(t) * KVBLK * AW, (unsigned)__builtin_amdgcn_readfirstlane(vdst + (slot)))
    const int qrel = wid * QBLK + r32;
    const unsigned* msrc = MASK + (size_t)(rowbase + q0 + qrel) * 128 + hi;
    const unsigned mdst = lds0 + LDS_M + wid * 1024;
#define DMA_M(t) glds4(msrc + 2 * (t), (unsigned)__builtin_amdgcn_readfirstlane(mdst + (((t) & 3) << 8)))
    const ALAS unsigned* mwb = (const ALAS unsigned*)(shm + LDS_M + wid * 1024) + r32;
    const ALAS float* blb = (const ALAS float*)(shm + LDS_BIAS) + 4 * hi + 64 * ts;
    const int vb0 = (int)(lds0 + LDS_V) + ((lane >> 4) & 1) * 32 + (lane & 3) * 8 + (4 * hi + ((lane & 15) >> 2)) * 64;
    bf16x8 kf[8];
    const lds_cptr shm3 = (lds_cptr)shm; const lds_cptr kp0 = shm3 + LDS_K + hi * 1024 + r32 * 16; const lds_cptr vp0 = shm3 + LDS_V + ((lane >> 4) & 1) * 32 + (lane & 3) * 8 + (4 * hi + ((lane & 15) >> 2)) * 64;
    const int NT = (q0 + QB) / KVBLK - ts;
    if constexpr (KIND == 1) {
#pragma unroll
        for (int j = 0; j < 2; ++j) { const int piece = 2 * wid + j; if (piece * 256 < q0 + QB) glds16(cbh + piece * 256 + lane * 4, (unsigned)__builtin_amdgcn_readfirstlane(lds0 + LDS_BIAS + piece * 1024)); }
    } else { DMA_M(0); DMA_M(1); DMA_M(2); }
    DMA_K(0, 0); DMA_V(0, 0); DMA_K(1, SLOTB);
    bf16x8 qr[4];
#pragma unroll
    for (int d0 = 0; d0 < 4; ++d0) qr[d0] = *reinterpret_cast<const bf16x8*>(&Qw[(long)r32 * AW + d0 * 16 + hi * 8]);
    float mhat = 0.f; if constexpr (KIND == 1) mhat = cbh[q0 + qrel];
    float l_reg = 0.f; f32x16 o[2]; o[0] = f32x16{}; o[1] = f32x16{};
#define CMASK(P0, P1, t) do { if constexpr (KIND == 1) { int jb_ = (t) - (NT - 4); if (jb_ >= 0) cmask(P0, P1, jb_, qrel, hi); } } while (0)
    bool resc = false;
#define RESC() do { if (resc) { asm volatile("s_waitcnt lgkmcnt(0)" ::: "memory"); \
      _Pragma("unroll") for (int d_ = 0; d_ < 2; ++d_) _Pragma("unroll") for (int r = 0; r < 16; ++r) o[d_][r] *= wsf[crow(r, hi)]; } } while (0)
    f32x16 pA0, pA1, pB0, pB1;
    int sl_prev = 0, sl_cur = 0, sl_next = SLOTB;
#define ROT() do { sl_prev = sl_cur; sl_cur = sl_next; sl_next = (sl_next == (NSLOT - 1) * SLOTB) ? 0 : sl_next + SLOTB; } while (0)
    DMA_K(2, 2 * SLOTB);
    wait_bar<3>();
    unsigned mwn0 = 0u, mwn1 = 0u;
    cload<KIND>(pA0, pA1, mwn0, mwn1, blb, mwb); cfin<KIND>(pA0, pA1, mwn0, mwn1, hi, -mhat);
    { const lds_cptr kb = kp0;
#pragma unroll
      for (int d0 = 0; d0 < 4; ++d0) { const bf16x8 b0 = *(const ALAS bf16x8*)(kb + d0 * 2048), b1 = *(const ALAS bf16x8*)(kb + d0 * 2048 + 512);
          pA0 = __builtin_amdgcn_mfma_f32_32x32x16_bf16(b0, qr[d0], pA0, 0, 0, 0); pA1 = __builtin_amdgcn_mfma_f32_32x32x16_bf16(b1, qr[d0], pA1, 0, 0, 0); } }
    asm volatile("s_nop 15\n\ts_nop 7" : "+v"(pA0), "+v"(pA1)); CMASK(pA0, pA1, 0);
    { float rm = __builtin_fmaxf(pA0[0], pA1[0]);
#pragma unroll
      for (int r = 1; r < 16; ++r) rm = __builtin_fmaxf(rm, __builtin_fmaxf(pA0[r], pA1[r]));
      { auto rr = __builtin_amdgcn_permlane32_swap(__float_as_uint(rm), __float_as_uint(rm), false, false); rm = __builtin_fmaxf(__uint_as_float(rr[0]), __uint_as_float(rr[1])); }
      if (__any(rm > (float)THRL)) { const float dl = __builtin_fmaxf(rm, 0.f); mhat += dl;
#pragma unroll
          for (int r = 0; r < 16; ++r) { pA0[r] -= dl; pA1[r] -= dl; } } }
#pragma unroll
    for (int r = 0; r < 16; ++r) { pA0[r] = __builtin_amdgcn_exp2f(pA0[r]); pA1[r] = __builtin_amdgcn_exp2f(pA1[r]); }
    cload<KIND>(pB0, pB1, mwn0, mwn1, blb + 64, mwb + 64);
    wait_bar<0>();
    DMA_K(3, 0); DMA_V(1, SLOTB); if constexpr (MX) DMA_M(3);
    ROT();
    kload8(kf, kp0 + sl_cur);
    wait_bar<2 + MX>();
    s16x4 vlo[8], vhi[8]; u32x4 pw0, pw1, pw2, pw3;
#define PKW(P, B) cvtpk_s(P[B], P[B + 1])
#define PAF(k) __builtin_bit_cast(bf16x8, pw##k)
#define VFR(i) (bf16x8){vlo[i][0], vlo[i][1], vlo[i][2], vlo[i][3], vhi[i][0], vhi[i][1], vhi[i][2], vhi[i][3]}
#define PIN(x) asm volatile("" : "+v"(x))
#define MX3(a, b, c) __builtin_fmaxf(__builtin_fmaxf((a), (b)), (c))
#define GAPA(MF, A0, A1, A2, A3, W0, W1, PW) do { MF; sacc += A0; sacc += A1; sacc += A2; sacc += A3; PIN(sacc); W0; W1; PIN(PW); SBAR(); } while (0)
#define EX(v) __builtin_amdgcn_exp2f(v)
#define GAPB(MF, X, B) do { MF; X[B] = EX(X[B]); X[B + 1] = EX(X[B + 1]); X[B + 2] = EX(X[B + 2]); X[B + 3] = EX(X[B + 3]); PIN(X); SBAR(); } while (0)
#define VRD(i) do { vlo[i] = vtr(vp_ + (((i) >> 2) * 4096 + ((i) & 3) * 1024)); vhi[i] = vtr(vp_ + (((i) >> 2) * 4096 + ((i) & 3) * 1024 + 512)); } while (0)
#define KRD(G, j) do { if (G) { kload2(kf, kp0 + sl_next, j); SBAR(); } } while (0)
#define STEP(C0, C1, P0, P1, t, GK, GV, GL, GM) do { SBAR(); \
    cfin<KIND>(C0, C1, mwn0, mwn1, hi, -mhat); PIN(C0); PIN(C1); SBAR(); \
    const lds_cptr vp_ = vp0 + sl_prev; \
    VRD(0); SBAR(); float sacc = (P0[0] + P0[1]); \
    GAPA(C0 = __builtin_amdgcn_mfma_f32_32x32x16_bf16(kf[0], qr[0], C0, 0, 0, 0), P0[2], P0[3], P0[4], P0[5],     pw0[0] = PKW(P0, 0), pw0[1] = PKW(P0, 2), pw0); \
    VRD(4); SBAR(); GAPA(C1 = __builtin_amdgcn_mfma_f32_32x32x16_bf16(kf[1], qr[0], C1, 0, 0, 0), P0[6], P0[7], P0[8], P0[9],     pw0[2] = PKW(P0, 4), pw0[3] = PKW(P0, 6), pw0); \
    VRD(1); SBAR(); GAPA(C0 = __builtin_amdgcn_mfma_f32_32x32x16_bf16(kf[2], qr[1], C0, 0, 0, 0),   P0[10], P0[11], P0[12], P0[13], pw1[0] = PKW(P0, 8), pw1[1] = PKW(P0, 10), pw1); \
    VRD(5); SBAR(); GAPA(C1 = __builtin_amdgcn_mfma_f32_32x32x16_bf16(kf[3], qr[1], C1, 0, 0, 0),   P0[14], P0[15], P1[0], P1[1],   pw1[2] = PKW(P0, 12), pw1[3] = PKW(P0, 14), pw1); \
    VRD(2); SBAR(); GAPA(C0 = __builtin_amdgcn_mfma_f32_32x32x16_bf16(kf[4], qr[2], C0, 0, 0, 0),   P1[2], P1[3], P1[4], P1[5],     pw2[0] = PKW(P1, 0), pw2[1] = PKW(P1, 2), pw2); \
    VRD(6); SBAR(); GAPA(C1 = __builtin_amdgcn_mfma_f32_32x32x16_bf16(kf[5], qr[2], C1, 0, 0, 0),   P1[6], P1[7], P1[8], P1[9],     pw2[2] = PKW(P1, 4), pw2[3] = PKW(P1, 6), pw2); \
    VRD(3); SBAR(); GAPA(C0 = __builtin_amdgcn_mfma_f32_32x32x16_bf16(kf[6], qr[3], C0, 0, 0, 0),   P1[10], P1[11], P1[12], P1[13], pw3[0] = PKW(P1, 8), pw3[1] = PKW(P1, 10), pw3); \
    VRD(7); SBAR(); GAPA(C1 = __builtin_amdgcn_mfma_f32_32x32x16_bf16(kf[7], qr[3], C1, 0, 0, 0),   P1[14], P1[15], 0.f, 0.f,       pw3[2] = PKW(P1, 12), pw3[3] = PKW(P1, 14), pw3); \
    l_reg += sacc; \
    cload<KIND>(P0, P1, mwn0, mwn1, blb + 64 * ((t) + 1), mwb + ((((t) + 1) & 3) << 6)); SBAR();     \
    if (GK) { DMA_K((t) + 3, sl_cur); } if (GV) { DMA_V((t) + 1, sl_next); } if constexpr (MX) { if (GM) { DMA_M((t) + 3); } } \
    CMASK(C0, C1, t); \
    { float a = MX3(C0[0], C0[1], C1[0]), b = MX3(C0[2], C0[3], C1[1]); a = MX3(a, C1[2], C1[3]); \
      _Pragma("unroll") for (int r = 4; r < 16; r += 4) { a = MX3(a, C0[r], C0[r + 1]); b = MX3(b, C0[r + 2], C0[r + 3]); a = MX3(a, C1[r], C1[r + 1]); b = MX3(b, C1[r + 2], C1[r + 3]); } \
      float rm = __builtin_fmaxf(a, b); { auto rr = __builtin_amdgcn_permlane32_swap(__float_as_uint(rm), __float_as_uint(rm), false, false); rm = __builtin_fmaxf(__uint_as_float(rr[0]), __uint_as_float(rr[1])); } \
      resc = false; \
      if (__builtin_expect(__any(rm > (float)THRL), 0)) { const float dl = __builtin_fmaxf(rm, 0.f); mhat += dl; \
        _Pragma("unroll") for (int r = 0; r < 16; ++r) { C0[r] -= dl; C1[r] -= dl; } \
        const float f = __builtin_amdgcn_exp2f(-dl); l_reg *= f; if (hi == 0) wsf[r32] = f; resc = true; } } \
    SBAR(); \
    GAPB(o[0] = __builtin_amdgcn_mfma_f32_32x32x16_bf16(PAF(0), VFR(0), o[0], 0, 0, 0), C0, 0); \
    GAPB(o[1] = __builtin_amdgcn_mfma_f32_32x32x16_bf16(PAF(0), VFR(4), o[1], 0, 0, 0), C0, 4); \
    KRD(GL, 0); GAPB(o[0] = __builtin_amdgcn_mfma_f32_32x32x16_bf16(PAF(1), VFR(1), o[0], 0, 0, 0), C0, 8); \
    KRD(GL, 1); GAPB(o[1] = __builtin_amdgcn_mfma_f32_32x32x16_bf16(PAF(1), VFR(5), o[1], 0, 0, 0), C0, 12); \
    KRD(GL, 2); GAPB(o[0] = __builtin_amdgcn_mfma_f32_32x32x16_bf16(PAF(2), VFR(2), o[0], 0, 0, 0), C1, 0); \
    KRD(GL, 3); GAPB(o[1] = __builtin_amdgcn_mfma_f32_32x32x16_bf16(PAF(2), VFR(6), o[1], 0, 0, 0), C1, 4); \
    GAPB(o[0] = __builtin_amdgcn_mfma_f32_32x32x16_bf16(PAF(3), VFR(3), o[0], 0, 0, 0), C1, 8); \
    GAPB(o[1] = __builtin_amdgcn_mfma_f32_32x32x16_bf16(PAF(3), VFR(7), o[1], 0, 0, 0), C1, 12); \
    } while (0)
    int t = 1;
#undef CMASK
#define CMASK(P0, P1, t) do { } while (0)
    for (; t + 5 < NT; t += 2) {
        STEP(pB0, pB1, pA0, pA1, t, true, true, true, true);     wait_bar<2 + MX>(); RESC(); ROT();
        STEP(pA0, pA1, pB0, pB1, t + 1, true, true, true, true); wait_bar<2 + MX>(); RESC(); ROT();
    }
#undef CMASK
#define CMASK(P0, P1, t) do { if constexpr (KIND == 1) { int jb_ = (t) - (NT - 4); if (jb_ >= 0) cmask(P0, P1, jb_, qrel, hi); } } while (0)
#define ENDW(tt) do { if ((tt) + 3 < NT) { wait_bar<2 + MX>(); } else if ((tt) + 2 < NT) { wait_bar<1>(); } else { wait_bar<0>(); } } while (0)
    for (; t + 1 < NT; t += 2) {
        STEP(pB0, pB1, pA0, pA1, t, (t + 3 < NT), (t + 1 < NT), (t + 1 < NT), (t + 3 < NT));       ENDW(t);     RESC(); ROT();
        STEP(pA0, pA1, pB0, pB1, t + 1, (t + 4 < NT), (t + 2 < NT), (t + 2 < NT), (t + 4 < NT));   ENDW(t + 1); RESC(); ROT();
    }
    STEP(pB0, pB1, pA0, pA1, NT - 1, false, false, false, false); RESC();
    { float sacc = pB0[0] + pB0[1];
#pragma unroll
      for (int r = 2; r < 16; ++r) sacc += pB0[r];
#pragma unroll
      for (int r = 0; r < 16; ++r) sacc += pB1[r];
      l_reg += sacc;
      pw0 = (u32x4){PKW(pB0, 0), PKW(pB0, 2), PKW(pB0, 4), PKW(pB0, 6)}; pw1 = (u32x4){PKW(pB0, 8), PKW(pB0, 10), PKW(pB0, 12), PKW(pB0, 14)};
      pw2 = (u32x4){PKW(pB1, 0), PKW(pB1, 2), PKW(pB1, 4), PKW(pB1, 6)}; pw3 = (u32x4){PKW(pB1, 8), PKW(pB1, 10), PKW(pB1, 12), PKW(pB1, 14)};
      SBAR(); pv(o, vb0 + sl_cur, PAF(0), PAF(1), PAF(2), PAF(3)); }
#undef PKW
#undef PAF
#undef VFR
#undef PIN
#undef MX3
#undef GAPA
#undef GAPB
#undef EX
#undef VRD
#undef KRD
#undef STEP
#undef ENDW
    { auto rr = __builtin_amdgcn_permlane32_swap(__float_as_uint(l_reg), __float_as_uint(l_reg), false, false); l_reg = __uint_as_float(rr[0]) + __uint_as_float(rr[1]); }
    if (hi == 0) wsf[32 + r32] = l_reg;
    asm volatile("s_waitcnt lgkmcnt(0)" ::: "memory");
    float rli[16];
#pragma unroll
    for (int r = 0; r < 16; ++r) rli[r] = __builtin_amdgcn_rcpf(wsf[32 + crow(r, hi)]);
    if (tid == 0) pend = __hip_atomic_fetch_add(qctr, 1u, __ATOMIC_RELAXED, __HIP_MEMORY_SCOPE_AGENT);
    unsigned char* Ow = (unsigned char*)O + (rowbase + q0 + wid * QBLK) * AW + h * 64;
    { ALAS unsigned char* stg = (ALAS unsigned char*)(shm + LDS_OST) + wid * 4096;
#pragma unroll
      for (int r = 0; r < 16; ++r) { const int orow = crow(r, hi); const float sc_ = rli[r] * pg8::OSC;
#pragma unroll
          for (int d0 = 0; d0 < 2; ++d0) { const float x = __builtin_amdgcn_fmed3f(o[d0][r] * sc_, -pg8::F8MAX, pg8::F8MAX);
              stg[orow * 64 + d0 * 32 + r32] = (unsigned char)(__builtin_amdgcn_cvt_pk_fp8_f32(x, x, 0, false) & 255); } }
      asm volatile("s_waitcnt lgkmcnt(0)" ::: "memory");
#pragma unroll
      for (int i = 0; i < 2; ++i) { const int row = i * 16 + (lane >> 2), ch = lane & 3; const u32x4 v = *(const ALAS u32x4*)(stg + row * 64 + ch * 16); *(u32x4*)(Ow + (long)row * AW + ch * 16) = v; } }
    if (tid == 0) qs[0] = (int)p_old;
    asm volatile("s_waitcnt lgkmcnt(0)\n\ts_barrier" ::: "memory");
#undef DMA_K
#undef DMA_V
#undef DMA_M
#undef CMASK
#undef RESC
#undef ROT
}
#undef SBAR
#undef ALAS
}

static_assert(attn_body::LDS_BYTES <= RING_BYTES, "attention LDS");
#define XB_TMO      128
#define XB_XCNT(j)  (256  + 64 * (j))
#define XB_XSUB(j)  (1280 + 64 * (j))
#define XB_XGEN(j)  (2304 + 64 * (j))
#define XB_TOP      3328
#define XB_TOPGEN   3392
#define XCD_BAR_WORDS 3456
#define XB_SPIN_CAP (1u << 18)

__device__ __forceinline__ unsigned xb_ld(unsigned* p)              { return __hip_atomic_load(p, __ATOMIC_RELAXED, __HIP_MEMORY_SCOPE_AGENT); }
__device__ __forceinline__ unsigned xb_add(unsigned* p, unsigned v) { return __hip_atomic_fetch_add(p, v, __ATOMIC_RELAXED, __HIP_MEMORY_SCOPE_AGENT); }
__device__ __forceinline__ unsigned xb_xcc_id() { return (unsigned)__builtin_amdgcn_s_getreg((3 << 11) | 20) & 0xFu; }
#define XB_SPIN(cond, bar) do { unsigned _sp = 0; while (cond) { __builtin_amdgcn_s_sleep(1); \
    if ((++_sp & 255u) == 0u) { if (xb_ld(&(bar)[XB_TMO])) break; if (_sp > XB_SPIN_CAP) { atomicAdd(&(bar)[XB_TMO], 1u); break; } } } } while (0)

struct XcdBarrier {
    unsigned* bar; unsigned x; int wv;
    volatile LAS unsigned* st;
};

__device__ __forceinline__ XcdBarrier xcd_barrier_post(unsigned* bar, volatile LAS unsigned* st, int wv) {
    XcdBarrier b; b.bar = bar; b.x = xb_xcc_id(); b.st = st; b.wv = wv;
    if (wv == 0 && mk_lane() == 0) (void)xb_add(&bar[XB_XCNT(b.x)], 1u);
    return b;
}
__device__ __forceinline__ void xcd_barrier_complete(unsigned* bar, unsigned x, unsigned& nloc, unsigned& nx) {
    const unsigned G = gridDim.x * gridDim.y * gridDim.z;
    unsigned sum, cnt, mine, sp = 0u;
    for (;;) {
        sum = 0u; cnt = 0u; mine = 0u;
#pragma unroll
        for (unsigned j = 0; j < 16; ++j) { const unsigned c = xb_ld(&bar[XB_XCNT(j)]); sum += c; cnt += (c > 0u) ? 1u : 0u; mine = (j == x) ? c : mine; }
        if (sum == G) break;
        __builtin_amdgcn_s_sleep(1);
        if ((++sp & 255u) == 0u) { if (xb_ld(&bar[XB_TMO])) break; if (sp > XB_SPIN_CAP) { atomicAdd(&bar[XB_TMO], 1u); break; } }
    }
    nloc = mine > 0u ? mine : 1u; nx = cnt > 0u ? cnt : 1u;
}

__device__ __forceinline__ void xcd_barrier(const XcdBarrier& b) {
    asm volatile("s_waitcnt vmcnt(0)" ::: "memory");
    __syncthreads();
    if (b.wv == 0 && mk_lane() == 0) {
        unsigned* bar = b.bar; unsigned bx = b.x;
        asm volatile("" : "+s"(bar), "+s"(bx));
        __builtin_amdgcn_s_waitcnt(0);
        unsigned nloc = b.st[0], nx = b.st[1];
        if (nloc == 0u) { xcd_barrier_complete(bar, bx, nloc, nx); b.st[0] = nloc; b.st[1] = nx; }
        const unsigned old = xb_add(&bar[XB_XSUB(bx)], 1u);
        const unsigned gen = old / nloc;
        if (old + 1u == (gen + 1u) * nloc) {
            __builtin_amdgcn_fence(__ATOMIC_RELEASE, "agent");
            asm volatile("s_waitcnt vmcnt(0)" ::: "memory");
            const unsigned og = xb_add(&bar[XB_TOP], 1u);
            const unsigned tg = og / nx;
            if (og + 1u == (tg + 1u) * nx) xb_add(&bar[XB_TOPGEN], 1u);
            else XB_SPIN(xb_ld(&bar[XB_TOPGEN]) == tg, bar);
            __builtin_amdgcn_fence(__ATOMIC_ACQUIRE, "agent");
            xb_add(&bar[XB_XGEN(bx)], 1u);
            asm volatile("s_waitcnt vmcnt(0)" ::: "memory");
        } else {
            XB_SPIN(xb_ld(&bar[XB_XGEN(bx)]) == gen, bar);
            __builtin_amdgcn_fence(__ATOMIC_ACQUIRE, "agent");
            asm volatile("s_waitcnt vmcnt(0)" ::: "memory");
        }
    }
    __syncthreads();
}
struct Frame {
    LAS unsigned char* lds;
    volatile LAS unsigned* MISC;
    gu32* ctl;
    int tid, lane, wave, G, bid;
    unsigned char* ws; float* out;
};
__device__ __forceinline__ float wave_sum(float v) {
#define DPP_F(x, ctrl) __int_as_float(__builtin_amdgcn_update_dpp(0, __float_as_int(x), (ctrl), 0xf, 0xf, true))
    v += DPP_F(v, 0xB1); v += DPP_F(v, 0x4E); v += DPP_F(v, 0x141); v += DPP_F(v, 0x140);
#undef DPP_F
    const float a = __int_as_float(__builtin_amdgcn_readlane(__float_as_int(v), 0)), b = __int_as_float(__builtin_amdgcn_readlane(__float_as_int(v), 16));
    const float c = __int_as_float(__builtin_amdgcn_readlane(__float_as_int(v), 32)), d = __int_as_float(__builtin_amdgcn_readlane(__float_as_int(v), 48));
    return (a + b) + (c + d);
}

__device__ __forceinline__ float wave_max(float v) {
#define DPP_F(x, ctrl) __int_as_float(__builtin_amdgcn_update_dpp(0, __float_as_int(x), (ctrl), 0xf, 0xf, true))
    v = fmaxf(v, DPP_F(v, 0xB1)); v = fmaxf(v, DPP_F(v, 0x4E)); v = fmaxf(v, DPP_F(v, 0x141)); v = fmaxf(v, DPP_F(v, 0x140));
#undef DPP_F
    const float a = __int_as_float(__builtin_amdgcn_readlane(__float_as_int(v), 0)), b = __int_as_float(__builtin_amdgcn_readlane(__float_as_int(v), 16));
    const float c = __int_as_float(__builtin_amdgcn_readlane(__float_as_int(v), 32)), d = __int_as_float(__builtin_amdgcn_readlane(__float_as_int(v), 48));
    return fmaxf(fmaxf(a, b), fmaxf(c, d));
}
__device__ __forceinline__ unsigned q4(const f32x4 v, float inv) {
    const int a = (int)rintf(v[0] * inv), b = (int)rintf(v[1] * inv), c = (int)rintf(v[2] * inv), d = (int)rintf(v[3] * inv);
    return ((unsigned)a & 255u) | (((unsigned)b & 255u) << 8) | (((unsigned)c & 255u) << 16) | ((unsigned)d << 24);
}

__device__ __forceinline__ int win_colmap(int dr) {
    const int tile = dr >> 8, j = dr & 255;
    if (tile < 4 || tile == 6 || tile == 7) { const int base = (tile < 2) ? 0 : (tile < 4 ? 512 : 1536); return base + 256 * (tile & 1) + 64 * ((j & 127) >> 5) + 32 * (j >> 7) + (j & 31); }
    if (tile < 6) return 1024 + 256 * (tile - 4) + j;
    if (tile < 14) return 2120 + 256 * (tile - 8) + j;
    if (tile < 22) return 3664 + 256 * (tile - 14) + j;
    if (j < 32) return 2048 + j;
    if (j < 40) return 2112 + (j - 32);
    if (j >= 64 && j < 72) return 3656 + (j - 64);
    if (j >= 128 && j < 160) return 2080 + (j - 128);
    return -1;
}
template <int KIND>
__device__ __forceinline__ void conv_item(const float* s0, const float* s1, int K, int Nsrc, int ndst, bf16* dst, int item, LAS unsigned char* scr, int lane) {
    const int nb = ndst >> 6, kb = item / nb, dg = item - kb * nb, k0 = kb << 6, d0 = dg << 6;
    const int nq = lane & 15, dr = d0 + 4 * nq;
    const float* sp = s0; int col;
    if (KIND == 0) col = dr;
    else if (KIND == 1) col = win_colmap(dr);
    else { const int tile = dr >> 8, j = dr & 255; col = 128 * tile + (j & 127); if (j >= 128) sp = s1; }
    f32x4 vv[16];
#pragma unroll
    for (int i = 0; i < 16; ++i) { const int k = 4 * i + (lane >> 4); vv[i] = (f32x4){0.f, 0.f, 0.f, 0.f}; if (col >= 0) vv[i] = *(const f32x4*)(sp + (size_t)(k0 + k) * Nsrc + col); }
#pragma unroll
    for (int i = 0; i < 16; ++i) {
        const int k = 4 * i + (lane >> 4); const f32x4 v = vv[i];
        LAS unsigned short* w = (LAS unsigned short*)(scr + (4 * nq) * 144 + k * 2);
        w[0] = (unsigned short)f2bf(v[0]); w[72] = (unsigned short)f2bf(v[1]); w[144] = (unsigned short)f2bf(v[2]); w[216] = (unsigned short)f2bf(v[3]);
    }
    asm volatile("s_waitcnt lgkmcnt(0)" ::: "memory");
#pragma unroll
    for (int i = 0; i < 8; ++i) { const int n = 8 * i + (lane >> 3), ch = lane & 7;
        const v4u o = *(const LAS v4u*)(scr + n * 144 + ch * 16);
        *(v4u*)(dst + (size_t)(d0 + n) * K + k0 + 8 * ch) = o; }
    asm volatile("s_waitcnt lgkmcnt(0)" ::: "memory");
}
template <int KIND>
__device__ __forceinline__ void conv_matrix(Frame& F, const float* s0, const float* s1, int K, int Nsrc, int ndst, bf16* dst) {
    LAS unsigned char* scr = F.lds + RING_OFF + F.wave * 9216;
    const int gw = F.bid * NWAVES + F.wave, NGW = F.G * NWAVES, nitems = (K >> 6) * (ndst >> 6);
    for (int it = gw; it < nitems; it += NGW) conv_item<KIND>(s0, s1, K, Nsrc, ndst, dst, it, scr, F.lane);
}
template <int KIND>
__device__ __forceinline__ void colmax_item(const float* s0, const float* s1, int K, int Nsrc, int ndst, unsigned* cmax, int item, LAS unsigned char* scr, int lane) {
    const int nb = ndst >> 6, kb = item / nb, dg = item - kb * nb, k0 = kb << 6, d0 = dg << 6;
    const int nq = lane & 15, dr = d0 + 4 * nq;
    const float* sp = s0; int col;
    if (KIND == 0) col = dr;
    else if (KIND == 1) col = win_colmap(dr);
    else { const int tile = dr >> 8, j = dr & 255; col = 128 * tile + (j & 127); if (j >= 128) sp = s1; }
    f32x4 vv[16];
#pragma unroll
    for (int i = 0; i < 16; ++i) { const int k = 4 * i + (lane >> 4); vv[i] = (f32x4){0.f, 0.f, 0.f, 0.f}; if (col >= 0) vv[i] = *(const f32x4*)(sp + (size_t)(k0 + k) * Nsrc + col); }
    f32x4 mx = {0.f, 0.f, 0.f, 0.f};
#pragma unroll
    for (int i = 0; i < 16; ++i) { mx[0] = fmaxf(mx[0], fabsf(vv[i][0])); mx[1] = fmaxf(mx[1], fabsf(vv[i][1])); mx[2] = fmaxf(mx[2], fabsf(vv[i][2])); mx[3] = fmaxf(mx[3], fabsf(vv[i][3])); }
    *(LAS f32x4*)(scr + (lane >> 4) * 256 + nq * 16) = mx;
    asm volatile("s_waitcnt lgkmcnt(0)" ::: "memory");
    const LAS float* sf = (const LAS float*)scr;
    const float m = fmaxf(fmaxf(sf[lane], sf[64 + lane]), fmaxf(sf[128 + lane], sf[192 + lane]));
    asm volatile("s_waitcnt lgkmcnt(0)" ::: "memory");
    __hip_atomic_fetch_max(cmax + d0 + lane, __float_as_uint(m), __ATOMIC_RELAXED, __HIP_MEMORY_SCOPE_AGENT);
}
template <int KIND>
__device__ __forceinline__ void conv8_item(const float* s0, const float* s1, int K, int Nsrc, int ndst, unsigned char* dst, float* scale, const unsigned* cmax, int item, LAS unsigned char* scr, int lane) {
    const int nb = ndst >> 6, kb = item / nb, dg = item - kb * nb, k0 = kb << 6, d0 = dg << 6;
    const int nq = lane & 15, dr = d0 + 4 * nq;
    const float* sp = s0; int col;
    if (KIND == 0) col = dr;
    else if (KIND == 1) col = win_colmap(dr);
    else { const int tile = dr >> 8, j = dr & 255; col = 128 * tile + (j & 127); if (j >= 128) sp = s1; }
    f32x4 vv[16];
#pragma unroll
    for (int i = 0; i < 16; ++i) { const int k = 4 * i + (lane >> 4); vv[i] = (f32x4){0.f, 0.f, 0.f, 0.f}; if (col >= 0) vv[i] = *(const f32x4*)(sp + (size_t)(k0 + k) * Nsrc + col); }
    const v4u cm = *(const v4u*)(cmax + dr);
    float inv[4];
#pragma unroll
    for (int c = 0; c < 4; ++c) { const float a = __uint_as_float(cm[c]); inv[c] = a > 0.f ? 127.f / a : 0.f; }
    if (kb == 0) { const float a = __uint_as_float(cmax[d0 + lane]); scale[d0 + lane] = a * (1.f / 127.f); }
#pragma unroll
    for (int i = 0; i < 16; ++i) {
        const int k = 4 * i + (lane >> 4); const f32x4 v = vv[i];
        LAS unsigned char* w = (LAS unsigned char*)(scr + (4 * nq) * 80 + k);
        w[0] = (unsigned char)(int)rintf(v[0] * inv[0]); w[80] = (unsigned char)(int)rintf(v[1] * inv[1]); w[160] = (unsigned char)(int)rintf(v[2] * inv[2]); w[240] = (unsigned char)(int)rintf(v[3] * inv[3]);
    }
    asm volatile("s_waitcnt lgkmcnt(0)" ::: "memory");
#pragma unroll
    for (int i = 0; i < 4; ++i) { const int n = 16 * i + (lane >> 2), ch = lane & 3;
        const v4u o = *(const LAS v4u*)(scr + n * 80 + ch * 16);
        *(v4u*)(dst + (size_t)(d0 + n) * K + k0 + 16 * ch) = o; }
    asm volatile("s_waitcnt lgkmcnt(0)" ::: "memory");
}
template <int KIND>
__device__ __forceinline__ void conv8_strip_k(Frame& F, const float* s0, const float* s1, int Nsrc, unsigned char* dst, float* scale, int dg) {
    LAS unsigned char* scr = F.lds + RING_OFF + F.wave * 9216; LAS float* red = (LAS float*)(F.lds + RING_OFF + 8 * 9216);
    const int lane = F.lane, nq = lane & 15, d0 = dg << 6, dr = d0 + 4 * nq; int col;
    if (KIND == 1) col = win_colmap(dr);
    else { const int tile = dr >> 8, j = dr & 255; col = 128 * tile + (j & 127); if (j >= 128) s0 = s1; }
    f32x4 mx = {0.f, 0.f, 0.f, 0.f};
    for (int h = 0; h < 2; ++h) { const int k0 = (2 * F.wave + h) << 6;
        f32x4 vv[16];
#pragma unroll
        for (int i = 0; i < 16; ++i) { const int k = 4 * i + (lane >> 4); vv[i] = (f32x4){0.f, 0.f, 0.f, 0.f}; if (col >= 0) vv[i] = *(const f32x4*)(s0 + (size_t)(k0 + k) * Nsrc + col); }
#pragma unroll
        for (int i = 0; i < 16; ++i) { mx[0] = fmaxf(mx[0], fabsf(vv[i][0])); mx[1] = fmaxf(mx[1], fabsf(vv[i][1])); mx[2] = fmaxf(mx[2], fabsf(vv[i][2])); mx[3] = fmaxf(mx[3], fabsf(vv[i][3])); } }
    *(LAS f32x4*)(red + (F.wave * 4 + (lane >> 4)) * 64 + 4 * nq) = mx;
    __syncthreads();
    f32x4 m4 = {0.f, 0.f, 0.f, 0.f};
    for (int j = 0; j < 32; ++j) { const f32x4 t = *(const LAS f32x4*)(red + j * 64 + 4 * nq); m4[0] = fmaxf(m4[0], t[0]); m4[1] = fmaxf(m4[1], t[1]); m4[2] = fmaxf(m4[2], t[2]); m4[3] = fmaxf(m4[3], t[3]); }
    float inv[4];
#pragma unroll
    for (int c = 0; c < 4; ++c) inv[c] = m4[c] > 0.f ? 127.f / m4[c] : 0.f;
    if (F.wave == 0 && lane < 16) *(f32x4*)(scale + dr) = m4 * ((KIND == 2 && (dr & 255) >= 128) ? pg8::HSC / 127.f : (KIND == 1 && dr >= 14 * 256 && dr < 22 * 256) ? -1.4426950408889634f / 127.f : 1.f / 127.f);
    for (int h = 0; h < 2; ++h) { const int k0 = (2 * F.wave + h) << 6;
        f32x4 vv[16];
#pragma unroll
        for (int i = 0; i < 16; ++i) { const int k = 4 * i + (lane >> 4); vv[i] = (f32x4){0.f, 0.f, 0.f, 0.f}; if (col >= 0) vv[i] = *(const f32x4*)(s0 + (size_t)(k0 + k) * Nsrc + col); }
#pragma unroll
        for (int i = 0; i < 16; ++i) { const int k = 4 * i + (lane >> 4); const f32x4 v = vv[i];
            LAS unsigned char* w = (LAS unsigned char*)(scr + (4 * nq) * 80 + k);
            w[0] = (unsigned char)(int)rintf(v[0] * inv[0]); w[80] = (unsigned char)(int)rintf(v[1] * inv[1]); w[160] = (unsigned char)(int)rintf(v[2] * inv[2]); w[240] = (unsigned char)(int)rintf(v[3] * inv[3]); }
        asm volatile("s_waitcnt lgkmcnt(0)" ::: "memory");
#pragma unroll
        for (int i = 0; i < 4; ++i) { const int n = 16 * i + (lane >> 2), ch = lane & 3;
            const v4u o = *(const LAS v4u*)(scr + n * 80 + ch * 16);
            *(v4u*)(dst + (size_t)(d0 + n) * DM + k0 + 16 * ch) = o; }
        asm volatile("s_waitcnt lgkmcnt(0)" ::: "memory"); }
    __syncthreads();
}
template <int NKB, bool F8 = false>
__device__ __forceinline__ void conv8_strip(Frame& F, const float* s0, int Nsrc, unsigned char* dst, float* scale, int dg, float presc = pg8::HSC) {
    constexpr int K = NKB * 64;
    LAS unsigned char* scr = F.lds + RING_OFF + F.wave * 9216; LAS float* red = (LAS float*)(F.lds + RING_OFF + 8 * 9216);
    const int lane = F.lane, nq = lane & 15, d0 = dg << 6, dr = d0 + 4 * nq;
    f32x4 mx = {0.f, 0.f, 0.f, 0.f};
    for (int kb = F.wave; kb < NKB; kb += NWAVES) { const int k0 = kb << 6;
        f32x4 vv[16];
#pragma unroll
        for (int i = 0; i < 16; ++i) { const int k = 4 * i + (lane >> 4); vv[i] = *(const f32x4*)(s0 + (size_t)(k0 + k) * Nsrc + dr); }
#pragma unroll
        for (int i = 0; i < 16; ++i) { mx[0] = fmaxf(mx[0], fabsf(vv[i][0])); mx[1] = fmaxf(mx[1], fabsf(vv[i][1])); mx[2] = fmaxf(mx[2], fabsf(vv[i][2])); mx[3] = fmaxf(mx[3], fabsf(vv[i][3])); } }
    *(LAS f32x4*)(red + (F.wave * 4 + (lane >> 4)) * 64 + 4 * nq) = mx;
    __syncthreads();
    f32x4 m4 = {0.f, 0.f, 0.f, 0.f};
    for (int j = 0; j < 32; ++j) { const f32x4 t = *(const LAS f32x4*)(red + j * 64 + 4 * nq); m4[0] = fmaxf(m4[0], t[0]); m4[1] = fmaxf(m4[1], t[1]); m4[2] = fmaxf(m4[2], t[2]); m4[3] = fmaxf(m4[3], t[3]); }
    float inv[4];
#pragma unroll
    for (int c = 0; c < 4; ++c) inv[c] = m4[c] > 0.f ? (F8 ? 256.f : 127.f) / m4[c] : 0.f;
    if (F.wave == 0 && lane < 16) *(f32x4*)(scale + dr) = m4 * (F8 ? 1.f / (256.f * presc) : 1.f / 127.f);
    for (int kb = F.wave; kb < NKB; kb += NWAVES) { const int k0 = kb << 6;
        f32x4 vv[16];
#pragma unroll
        for (int i = 0; i < 16; ++i) { const int k = 4 * i + (lane >> 4); vv[i] = *(const f32x4*)(s0 + (size_t)(k0 + k) * Nsrc + dr); }
#pragma unroll
        for (int i = 0; i < 16; ++i) { const int k = 4 * i + (lane >> 4); const f32x4 v = vv[i];
            LAS unsigned char* w = (LAS unsigned char*)(scr + (4 * nq) * 80 + k);
            if (F8) { const int p0 = __builtin_amdgcn_cvt_pk_fp8_f32(v[0] * inv[0], v[1] * inv[1], 0, false), p1 = __builtin_amdgcn_cvt_pk_fp8_f32(v[2] * inv[2], v[3] * inv[3], 0, false);
                w[0] = (unsigned char)(p0 & 255); w[80] = (unsigned char)((p0 >> 8) & 255); w[160] = (unsigned char)(p1 & 255); w[240] = (unsigned char)((p1 >> 8) & 255); }
            else { w[0] = (unsigned char)(int)rintf(v[0] * inv[0]); w[80] = (unsigned char)(int)rintf(v[1] * inv[1]); w[160] = (unsigned char)(int)rintf(v[2] * inv[2]); w[240] = (unsigned char)(int)rintf(v[3] * inv[3]); } }
        asm volatile("s_waitcnt lgkmcnt(0)" ::: "memory");
#pragma unroll
        for (int i = 0; i < 4; ++i) { const int n = 16 * i + (lane >> 2), ch = lane & 3;
            const v4u o = *(const LAS v4u*)(scr + n * 80 + ch * 16);
            *(v4u*)(dst + (size_t)(d0 + n) * K + k0 + 16 * ch) = o; }
        asm volatile("s_waitcnt lgkmcnt(0)" ::: "memory"); }
    __syncthreads();
}
template <int W>
__device__ __forceinline__ void quant_rows(Frame& F, unsigned char* base, size_t pitch, int nrows, float* scale) {
    constexpr int NC = W / 512;
    static_assert(W % 512 == 0, "row width");
    const int gw = F.bid * NWAVES + F.wave, NGW = F.G * NWAVES;
    if (gw >= nrows) return;
    v4u vn[NC];
#pragma unroll
    for (int j = 0; j < NC; ++j) vn[j] = *(const v4u*)(base + (size_t)gw * pitch + 16 * (F.lane + 64 * j));
    for (int row = gw; row < nrows; row += NGW) {
        v4u v[NC];
#pragma unroll
        for (int j = 0; j < NC; ++j) v[j] = vn[j];
        const int rn = (row + NGW < nrows) ? row + NGW : row;
#pragma unroll
        for (int j = 0; j < NC; ++j) vn[j] = *(const v4u*)(base + (size_t)rn * pitch + 16 * (F.lane + 64 * j));
        float am = 0.f;
#pragma unroll
        for (int j = 0; j < NC; ++j)
#pragma unroll
            for (int c = 0; c < 4; ++c) am = fmaxf(am, fmaxf(fabsf(__uint_as_float(v[j][c] << 16)), fabsf(__uint_as_float(v[j][c] & 0xffff0000u))));
        am = wave_max(am);
        const float inv = am > 0.f ? 127.f / am : 0.f;
#pragma unroll
        for (int j = 0; j < NC; ++j) { v2u o;
            { const f32x4 a = {__uint_as_float(v[j][0] << 16), __uint_as_float(v[j][0] & 0xffff0000u), __uint_as_float(v[j][1] << 16), __uint_as_float(v[j][1] & 0xffff0000u)}; o.x = q4(a, inv); }
            { const f32x4 a = {__uint_as_float(v[j][2] << 16), __uint_as_float(v[j][2] & 0xffff0000u), __uint_as_float(v[j][3] << 16), __uint_as_float(v[j][3] & 0xffff0000u)}; o.y = q4(a, inv); }
            *(v2u*)(base + (size_t)row * pitch + 8 * (F.lane + 64 * j)) = o; }
        if (F.lane == 0) scale[row] = am * (1.f / 127.f);
    }
}
template <int KIND>
__device__ __forceinline__ void colmax_matrix(Frame& F, const float* s0, const float* s1, int K, int Nsrc, int ndst, unsigned* cmax) {
    LAS unsigned char* scr = F.lds + RING_OFF + F.wave * 9216;
    const int gw = F.bid * NWAVES + F.wave, NGW = F.G * NWAVES, nitems = (K >> 6) * (ndst >> 6);
    for (int it = gw; it < nitems; it += NGW) colmax_item<KIND>(s0, s1, K, Nsrc, ndst, cmax, it, scr, F.lane);
}
template <int KIND>
__device__ __forceinline__ void conv8_matrix(Frame& F, const float* s0, const float* s1, int K, int Nsrc, int ndst, unsigned char* dst, float* scale, const unsigned* cmax) {
    LAS unsigned char* scr = F.lds + RING_OFF + F.wave * 9216;
    const int gw = F.bid * NWAVES + F.wave, NGW = F.G * NWAVES, nitems = (K >> 6) * (ndst >> 6);
    for (int it = gw; it < nitems; it += NGW) conv8_item<KIND>(s0, s1, K, Nsrc, ndst, dst, scale, cmax, it, scr, F.lane);
}
__device__ __forceinline__ void sincos_rev(double r, float& s, float& c) {
    const double k = rint(4.0 * r);
    const double y = (r - 0.25 * k) * 6.283185307179586;
    const double y2 = y * y;
    const double sy = y * (1.0 + y2 * (-1.0 / 6 + y2 * (1.0 / 120 + y2 * (-1.0 / 5040 + y2 * (1.0 / 362880 + y2 * (-1.0 / 39916800 + y2 * (1.0 / 6227020800.0)))))));
    const double cy = 1.0 + y2 * (-0.5 + y2 * (1.0 / 24 + y2 * (-1.0 / 720 + y2 * (1.0 / 40320 + y2 * (-1.0 / 3628800 + y2 * (1.0 / 479001600.0))))));
    const int q = ((int)k) & 3;
    const double sv = (q == 0) ? sy : (q == 1) ? cy : (q == 2) ? -sy : -cy;
    const double cv = (q == 0) ? cy : (q == 1) ? -sy : (q == 2) ? -cy : sy;
    s = (float)sv; c = (float)cv;
}
__device__ __forceinline__ void p0_prologue(Frame& F, const float* x_in, const int* pos, const float* w_in, const float* w_a, const float* w_b, const float* w_o, const float* f_g, const float* f_u, const float* f_d) {
    unsigned char* ws = F.ws;
    for (int st = F.bid; st < 2 * (PROJ_PAD >> 6); st += F.G) { const int l = st / (PROJ_PAD >> 6), dg = st - l * (PROJ_PAD >> 6);
        conv8_strip_k<1>(F, w_in + (size_t)l * DM * PROJ_TOTAL, nullptr, PROJ_TOTAL, ws + OPQ(WS_WIN) + l * WIN_STRIDE, (float*)(ws + OPQ(WS_WINSC) + l * WIN_STRIDE), dg); }
    for (int st = F.G - 1 - F.bid; st < (2 * DFF >> 6); st += F.G)
        conv8_strip_k<2>(F, f_g, f_u, DFF, ws + OPQ(WS_FGU), (float*)(ws + OPQ(WS_FGUSC)), st);
    for (int l = 0; l < 2; ++l) {
    }
    for (int st = F.bid - 48; st >= 0 && st < 4 * (DM >> 6); st += F.G) { const int l = st >> 5, br = (st >> 4) & 1, dg = st & 15;
        conv8_strip<AW / 64, true>(F, (br ? w_b : w_a) + (size_t)l * AW * DM, DM, ws + OPQ(WS_WA) + (size_t)br * MiB + (size_t)l * (DM * AW), (float*)(ws + OPQ(WS_WABSC)) + l * 4096 + br * 2048, dg, pg8::OSC); }
    for (int st = F.bid - 16; st >= 0 && st < 2 * (DM >> 6); st += F.G) { const int l = st / (DM >> 6), dg = st - l * (DM >> 6);
        conv8_strip<DM / 64, true>(F, w_o + (size_t)l * DM * DM, DM, ws + OPQ(WS_WOUT) + (size_t)l * DM * DM, (float*)(ws + OPQ(WS_WOSC)) + l * DM, dg, pg8::MSC); }
    for (int st = F.bid; st < (DM >> 6); st += F.G) conv8_strip<DFF / 64, true>(F, f_d, DM, ws + OPQ(WS_FD), (float*)(ws + OPQ(WS_FDSC)), st);
    const int gt = F.bid * (NWAVES * 64) + F.tid, NGT = F.G * NWAVES * 64;
    const int RSK = (F.G >= 64) ? 16 : 0;
    if (F.bid >= RSK) { const int gw = (F.bid - RSK) * NWAVES + F.wave, NGW = (F.G - RSK) * NWAVES;
      f32x4 vn[4];
#pragma unroll
      for (int j = 0; j < 4; ++j) vn[j] = *(const f32x4*)(x_in + (size_t)gw * DM + 4 * F.lane + 256 * j);
      for (int row = gw; row < NTOK; row += NGW) {
          f32x4 v[4];
#pragma unroll
          for (int j = 0; j < 4; ++j) v[j] = vn[j];
          const int rn = (row + NGW < NTOK) ? row + NGW : row;
#pragma unroll
          for (int j = 0; j < 4; ++j) vn[j] = *(const f32x4*)(x_in + (size_t)rn * DM + 4 * F.lane + 256 * j);
          float am = 0.f;
#pragma unroll
          for (int j = 0; j < 4; ++j) am = fmaxf(fmaxf(am, fmaxf(fabsf(v[j][0]), fabsf(v[j][1]))), fmaxf(fabsf(v[j][2]), fabsf(v[j][3])));
          am = wave_max(am);
          const float inv = am > 0.f ? 127.f / am : 0.f;
          unsigned* x8 = (unsigned*)(ws + OPQ(WS_XS8)) + (size_t)row * (DM / 4) + F.lane;
#pragma unroll
          for (int j = 0; j < 4; ++j) { v2u o; o.x = pk2(v[j][0], v[j][1]); o.y = pk2(v[j][2], v[j][3]); *(v2u*)((bf16*)(ws + OPQ(WS_XS)) + (size_t)row * DM + 4 * F.lane + 256 * j) = o; x8[64 * j] = q4(v[j], inv); }
          if (F.lane == 0) ((float*)(ws + OPQ(WS_XSCALE)))[row] = am * (1.f / 127.f);
      } }
    { float* cs = (float*)(ws + OPQ(WS_CS));
      for (int i = gt; i < NTOK * 32; i += NGT) { const int tok = i >> 5, fi = i & 31;
          const float invf = (float)exp2(-(double)fi * (13.287712379549449 / 32.0));
          const float ang = (float)pos[tok] * invf;
          double rev = (double)ang * 0.15915494309189535; rev -= floor(rev);
          float s, c; sincos_rev(rev, s, c); cs[2 * i] = c; cs[2 * i + 1] = s; } }
}
__device__ __forceinline__ void moe_convert(Frame& F, const float* wg, const float* wu, const float* wd) {
    unsigned char* gu = (unsigned char*)F.out; float* gsc = (float*)(F.ws + OPQ(WS_MGUSC));
    constexpr int SPE = 2 * DFF >> 6;
    for (int st = F.bid; st < NEXP * SPE; st += F.G) { const int e = st / SPE, dg = st - e * SPE;
        conv8_strip_k<2>(F, wg + (size_t)e * DM * DFF, wu + (size_t)e * DM * DFF, DFF, gu + (size_t)e * 2 * DFF * DM, gsc + e * 2 * DFF, dg); }
    unsigned char* dn = (unsigned char*)(F.ws + OPQ(WS_MWD)); float* dsc = (float*)(F.ws + OPQ(WS_MWDSC));
    for (int st = F.G - 1 - F.bid; st < NEXP * (DM >> 6); st += F.G) { const int e = st / (DM >> 6), dg = st - e * (DM >> 6);
        conv8_strip<DFF / 64, true>(F, wd + (size_t)e * DFF * DM, DM, dn + (size_t)e * DM * DFF, dsc + e * DM, dg); }
}

typedef float f32x4i __attribute__((ext_vector_type(4)));
typedef short s16x2v __attribute__((ext_vector_type(2)));
__device__ __forceinline__ unsigned sortkey16x2(float a, float b) {
    const unsigned p = __builtin_amdgcn_perm(__float_as_uint(b), __float_as_uint(a), 0x07060302u);
    const s16x2v m = __builtin_bit_cast(s16x2v, p) >> (s16x2v){15, 15};
    return p ^ (__builtin_bit_cast(unsigned, m) | 0x80008000u);
}
__device__ __forceinline__ unsigned sortkey16(float f) { const unsigned u = __float_as_uint(f); return (u ^ ((u >> 31) ? 0xffffffffu : 0x80000000u)) >> 16; }
#define DPP_I(v, ctrl) __builtin_amdgcn_update_dpp(0, (v), (ctrl), 0xf, 0xf, true)
__device__ __forceinline__ int wave_suffix_sum(int x, int lane) {
    x += DPP_I(x, 0x101); x += DPP_I(x, 0x102); x += DPP_I(x, 0x104); x += DPP_I(x, 0x108);
    const int t1 = __builtin_amdgcn_readlane(x, 16), t2 = __builtin_amdgcn_readlane(x, 32), t3 = __builtin_amdgcn_readlane(x, 48);
    const int row = lane >> 4;
    return x + (row == 0 ? t1 + t2 + t3 : row == 1 ? t2 + t3 : row == 2 ? t3 : 0);
}
__device__ __forceinline__ int wave_sum_i(int v) {
    v += __builtin_amdgcn_update_dpp(0, v, 0xB1, 0xf, 0xf, false);
    v += __builtin_amdgcn_update_dpp(0, v, 0x4E, 0xf, 0xf, false);
    v += __builtin_amdgcn_update_dpp(0, v, 0x141, 0xf, 0xf, false);
    v += __builtin_amdgcn_update_dpp(0, v, 0x140, 0xf, 0xf, false);
    return __builtin_amdgcn_readlane(v, 0) + __builtin_amdgcn_readlane(v, 16) + __builtin_amdgcn_readlane(v, 32) + __builtin_amdgcn_readlane(v, 48);
}
__device__ __forceinline__ int hist_select(const LAS unsigned* hist, int K, int lane, int& gt) {
    const v4u c = *(const LAS v4u*)(hist + 4 * lane);
    const int s = (int)(c.x + c.y + c.z + c.w);
    const int above = wave_suffix_sum(s, lane) - s;
    int bin = -1, g = 0;
    int a3 = above, a2 = above + (int)c.w, a1 = a2 + (int)c.z, a0 = a1 + (int)c.y;
    if (a3 < K && K <= a3 + (int)c.w) { bin = 4 * lane + 3; g = a3; }
    else if (a2 < K && K <= a2 + (int)c.z) { bin = 4 * lane + 2; g = a2; }
    else if (a1 < K && K <= a1 + (int)c.y) { bin = 4 * lane + 1; g = a1; }
    else if (a0 < K && K <= a0 + (int)c.x) { bin = 4 * lane + 0; g = a0; }
    const unsigned long long bal = __ballot(bin >= 0);
    const int src = bal ? (int)__builtin_ctzll(bal) : 0;
    gt = __builtin_amdgcn_readlane(g, src); return __builtin_amdgcn_readlane(bin, src);
}
__device__ __forceinline__ int wave_prefix_sum(int x, int lane) {
    x += DPP_I(x, 0x111); x += DPP_I(x, 0x112); x += DPP_I(x, 0x114); x += DPP_I(x, 0x118);
    const int t0 = __builtin_amdgcn_readlane(x, 15), t1 = __builtin_amdgcn_readlane(x, 31), t2 = __builtin_amdgcn_readlane(x, 47);
    const int row = lane >> 4;
    return x + (row == 0 ? 0 : row == 1 ? t0 : row == 2 ? t0 + t1 : t0 + t1 + t2);
}
template <int S>
__device__ __forceinline__ unsigned bt_stage(unsigned x, unsigned t, bool upper) {
    constexpr unsigned M = S == 16 ? 0x0000ffffu : S == 8 ? 0x00ff00ffu : S == 4 ? 0x0f0f0f0fu : S == 2 ? 0x33333333u : 0x55555555u;
    const unsigned keep = upper ? ~M : M, sh = upper ? (t >> S) : (t << S);
    return (x & keep) | (sh & ~keep);
}
__device__ __forceinline__ void idx_unit(Frame& F, int b, int qg, const bf16* IQ, const bf16* IK, const float* IW, unsigned* MASK) {
    const int lane = F.lane, wave = F.wave;
    const int t0 = 16 * qg, limit = 64 * (t0 / 64 + 1); const size_t row0 = (size_t)b * SEQ + t0;
    const int nwords = ((limit + 255) >> 8) << 3;
    if (limit <= 256) {
        for (int qq = 0; qq < 2; ++qq) { const int q = 2 * wave + qq; if (lane < nwords) MASK[(row0 + q) * 128 + lane] = (lane < (limit >> 5)) ? 0xffffffffu : 0u; }
        return;
    }
    LAS unsigned char* keys = F.lds;
    LAS unsigned* hist = (LAS unsigned*)(F.lds + IDX_HIST_OFF) + wave * 256;
#ifndef IDX_REP_SCORE
#define IDX_REP_SCORE 1
#endif
#ifndef IDX_REP_SEL
#define IDX_REP_SEL 1
#endif
    for (int rs_ = 0; rs_ < IDX_REP_SCORE; ++rs_)
    {
        const int qc = lane & 15, kq = lane >> 4;
        bf16x8 bq[8][2]; float w[8];
#pragma unroll
        for (int h = 0; h < 8; ++h) { const bf16* p = IQ + (row0 + qc) * AW + h * 64 + 8 * kq; bq[h][0] = *(const bf16x8*)p; bq[h][1] = *(const bf16x8*)(p + 32); }
        { const f32x4 w0 = *(const f32x4*)(IW + (row0 + qc) * 8), w1 = *(const f32x4*)(IW + (row0 + qc) * 8 + 4);
          w[0] = w0[0]; w[1] = w0[1]; w[2] = w0[2]; w[3] = w0[3]; w[4] = w1[0]; w[5] = w1[1]; w[6] = w1[2]; w[7] = w1[3]; }
        const bf16* ikb = IK + ((size_t)b * SEQ + qc) * 64 + 8 * kq;
        const int nkb = limit >> 4;
#define IDX_BLOCK(KB, A0, A1) do { f32x4i sc = {0.f, 0.f, 0.f, 0.f}; f32x4i ac8[8]; \
              \
            _Pragma("unroll") for (int h = 0; h < 8; ++h) ac8[h] = __builtin_amdgcn_mfma_f32_16x16x32_bf16(A0, bq[h][0], (f32x4i){0.f, 0.f, 0.f, 0.f}, 0, 0, 0); \
            _Pragma("unroll") for (int h = 0; h < 8; ++h) ac8[h] = __builtin_amdgcn_mfma_f32_16x16x32_bf16(A1, bq[h][1], ac8[h], 0, 0, 0); \
            _Pragma("unroll") for (int h = 0; h < 8; ++h) { \
                _Pragma("unroll") for (int r = 0; r < 4; ++r) sc[r] = __builtin_fmaf(w[h], __builtin_amdgcn_fmed3f(ac8[h][r], 0.f, 3.0e38f), sc[r]); } \
            v2u pk; pk.x = sortkey16x2(sc[0], sc[1]); pk.y = sortkey16x2(sc[2], sc[3]); \
            *(LAS v2u*)(keys + qc * IDX_ROWB + ((KB) * 16 + 4 * kq) * 2) = pk; } while (0)
        const int kbB0 = (wave + 8 < nkb) ? wave + 8 : wave;
        bf16x8 a0 = *(const bf16x8*)(ikb + (size_t)wave * 1024), a1 = *(const bf16x8*)(ikb + (size_t)wave * 1024 + 32);
        bf16x8 b0 = *(const bf16x8*)(ikb + (size_t)kbB0 * 1024), b1 = *(const bf16x8*)(ikb + (size_t)kbB0 * 1024 + 32);
        for (int kb = wave; kb < nkb; kb += 32) {
            bf16x8 n0, n1, m0, m1;
            { const int kbB = (kb + 8 < nkb) ? kb + 8 : kb;
              const int kn = (kb + 16 < nkb) ? kb + 16 : kb, km = (kb + 24 < nkb) ? kb + 24 : kn;
              n0 = *(const bf16x8*)(ikb + (size_t)kn * 1024); n1 = *(const bf16x8*)(ikb + (size_t)kn * 1024 + 32);
              m0 = *(const bf16x8*)(ikb + (size_t)km * 1024); m1 = *(const bf16x8*)(ikb + (size_t)km * 1024 + 32);
              IDX_BLOCK(kb, a0, a1);
              IDX_BLOCK(kbB, b0, b1); }
            const int k2 = kb + 16;
            if (k2 >= nkb) break;
            { const int kbB = (k2 + 8 < nkb) ? k2 + 8 : k2;
              const int kn = (k2 + 16 < nkb) ? k2 + 16 : k2, km = (k2 + 24 < nkb) ? k2 + 24 : kn;
              a0 = *(const bf16x8*)(ikb + (size_t)kn * 1024); a1 = *(const bf16x8*)(ikb + (size_t)kn * 1024 + 32);
              b0 = *(const bf16x8*)(ikb + (size_t)km * 1024); b1 = *(const bf16x8*)(ikb + (size_t)km * 1024 + 32);
              IDX_BLOCK(k2, n0, n1);
              IDX_BLOCK(kbB, m0, m1); }
        }
#undef IDX_BLOCK
    }
    {
        const int tail = ((limit + 511) & ~511) - limit;
        for (int i = F.tid; i < 16 * (tail >> 1); i += NWAVES * 64) { const int row = i / (tail >> 1), k2 = i - row * (tail >> 1);
            *(LAS unsigned*)(keys + row * IDX_ROWB + (limit + 2 * k2) * 2) = 0u; }
    }
    __syncthreads();
    for (int rq_ = 0; rq_ < IDX_REP_SEL; ++rq_)
    for (int qq = 0; qq < 2; ++qq) {
        const int q = 2 * wave + qq; const LAS unsigned short* rowk = (const LAS unsigned short*)(keys + q * IDX_ROWB);
        const int nj = limit >> 6;
        unsigned kj[64];
#pragma unroll
        for (int g = 0; g < 8; ++g) {
            if (8 * g < nj) {
#pragma unroll
                for (int jj = 0; jj < 8; ++jj) kj[8 * g + jj] = rowk[64 * (8 * g + jj) + lane];
            } else {
#pragma unroll
                for (int jj = 0; jj < 8; ++jj) kj[8 * g + jj] = 0u;
            }
        }
#define IDX_COUNT(COND, OUT) do { int c_ = 0; \
            _Pragma("unroll") for (int g = 0; g < 8; ++g) if (8 * g < nj) { _Pragma("unroll") for (int jj = 0; jj < 8; ++jj) { const unsigned kv_ = kj[8 * g + jj]; c_ += (COND) ? 1 : 0; } } \
            OUT = wave_sum_i(c_); } while (0)
#ifndef SEL_REP_A
#define SEL_REP_A 1
#define SEL_REP_B 1
#define SEL_REP_C 1
#endif
        unsigned T = 0u; int gt8 = 0; bool hb_ok = false;
        for (int ra_ = 0; ra_ < SEL_REP_A; ++ra_)
        {   constexpr int HB0 = 0xB4;
            LAS unsigned* pc = hist + lane;
            { unsigned z_ = 0u; asm volatile("" : "+v"(z_)); pc[0] = z_; pc[64] = z_; pc[128] = z_; pc[192] = z_; }
#pragma unroll
            for (int g = 0; g < 8; ++g) if (8 * g < nj) {
#pragma unroll
                for (int jj = 0; jj < 8; ++jj) { int ix = (int)(kj[8 * g + jj] >> 8) - HB0; ix = ix < 0 ? 0 : (ix > 15 ? 15 : ix);
                    __hip_atomic_fetch_add(pc + ((ix >> 2) << 6), 1u << ((ix & 3) << 3), __ATOMIC_RELAXED, __HIP_MEMORY_SCOPE_WORKGROUP); } }
            asm volatile("s_waitcnt lgkmcnt(0)" ::: "memory");
            int cb[16];
#pragma unroll
            for (int w = 0; w < 4; ++w) { const unsigned x = pc[64 * w];
                const int e = wave_sum_i((int)(x & 0x00ff00ffu)), o = wave_sum_i((int)((x >> 8) & 0x00ff00ffu));
                cb[4 * w] = e & 0xffff; cb[4 * w + 2] = (e >> 16) & 0xffff; cb[4 * w + 1] = o & 0xffff; cb[4 * w + 3] = (o >> 16) & 0xffff; }
            int cum = 0, bin = -1, above = 0;
#pragma unroll
            for (int bi = 15; bi >= 0; --bi) { if (bin < 0) { if (cum + cb[bi] >= DSA_TOPK) { bin = bi; above = cum; } cum += cb[bi]; } }
            if (bin >= 1 && bin <= 14) { T = (unsigned)(HB0 + bin) << 8; gt8 = above; hb_ok = true; }
        }
        if (!hb_ok) {
            T = 0u;
            for (int bit = 15; bit >= 8; --bit) { const unsigned cand = T | (1u << bit); int cnt; IDX_COUNT(kv_ >= cand, cnt); if (cnt >= DSA_TOPK) T = cand; }
            const unsigned nxt = T + 256u; IDX_COUNT(kv_ >= nxt, gt8);
        }
        int gt2 = 0, lo8 = 0;
        for (int rb_ = 0; rb_ < SEL_REP_B; ++rb_) {
        { unsigned z_ = 0u; asm volatile("" : "+v"(z_)); *(LAS v4u*)(hist + 4 * lane) = (v4u){z_, z_, z_, z_}; }
        { const unsigned p8 = T >> 8;
#pragma unroll
          for (int g = 0; g < 8; ++g) if (8 * g < nj) {
#pragma unroll
              for (int jj = 0; jj < 8; ++jj) { const unsigned kv_ = kj[8 * g + jj]; if ((kv_ >> 8) == p8) __hip_atomic_fetch_add(hist + (kv_ & 255u), 1u, __ATOMIC_RELAXED, __HIP_MEMORY_SCOPE_WORKGROUP); } } }
        asm volatile("s_waitcnt lgkmcnt(0)" ::: "memory");
        lo8 = hist_select(hist, DSA_TOPK - gt8, lane, gt2); }
        T |= (unsigned)lo8; const int gt = gt8 + gt2;
#undef IDX_COUNT
        const int need = DSA_TOPK - gt;
        unsigned glo = 0u, ghi = 0u, elo = 0u, ehi = 0u;
#pragma unroll
        for (int g = 0; g < 8; ++g) if (8 * g < nj) {
#pragma unroll
            for (int jj = 0; jj < 8; ++jj) { const int j = 8 * g + jj; const unsigned kv_ = kj[j], bit = 1u << (j & 31);
                if (j < 32) { glo |= (kv_ > T) ? bit : 0u; elo |= (kv_ == T) ? bit : 0u; } else { ghi |= (kv_ > T) ? bit : 0u; ehi |= (kv_ == T) ? bit : 0u; } } }
        { const int cnt = __popc(elo) + __popc(ehi); const int nL = need - (wave_prefix_sum(cnt, lane) - cnt);
          if (nL <= 0) { elo = 0u; ehi = 0u; }
          else if (nL < cnt) { unsigned long long e = ((unsigned long long)ehi << 32) | elo;
              for (int rem = cnt - nL; rem > 0; --rem) e &= ~(1ull << (63 - __builtin_clzll(e)));
              elo = (unsigned)e; ehi = (unsigned)(e >> 32); } }
        unsigned mine_lo = glo | elo, mine_hi = ghi | ehi;
        { auto sw = __builtin_amdgcn_permlane32_swap(mine_lo, mine_hi, false, false); mine_lo = sw[0]; mine_hi = sw[1]; }
        { const int l5 = mk_lane();
          { const bool up = (l5 & 16) != 0;
            mine_lo = bt_stage<16>(mine_lo, (unsigned)__builtin_amdgcn_ds_swizzle((int)mine_lo, (16 << 10) | 0x1f), up); mine_hi = bt_stage<16>(mine_hi, (unsigned)__builtin_amdgcn_ds_swizzle((int)mine_hi, (16 << 10) | 0x1f), up); }
          { const bool up = (l5 & 8) != 0;
            mine_lo = bt_stage<8>(mine_lo, (unsigned)__builtin_amdgcn_update_dpp(0, (int)mine_lo, 0x128, 0xf, 0xf, false), up); mine_hi = bt_stage<8>(mine_hi, (unsigned)__builtin_amdgcn_update_dpp(0, (int)mine_hi, 0x128, 0xf, 0xf, false), up); }
          { const bool up = (l5 & 4) != 0;
            const unsigned tl = (unsigned)__builtin_amdgcn_update_dpp(0, __builtin_amdgcn_update_dpp(0, (int)mine_lo, 0x141, 0xf, 0xf, false), 0x1B, 0xf, 0xf, false);
            const unsigned th = (unsigned)__builtin_amdgcn_update_dpp(0, __builtin_amdgcn_update_dpp(0, (int)mine_hi, 0x141, 0xf, 0xf, false), 0x1B, 0xf, 0xf, false);
            mine_lo = bt_stage<4>(mine_lo, tl, up); mine_hi = bt_stage<4>(mine_hi, th, up); }
          { const bool up = (l5 & 2) != 0;
            mine_lo = bt_stage<2>(mine_lo, (unsigned)__builtin_amdgcn_update_dpp(0, (int)mine_lo, 0x4E, 0xf, 0xf, false), up); mine_hi = bt_stage<2>(mine_hi, (unsigned)__builtin_amdgcn_update_dpp(0, (int)mine_hi, 0x4E, 0xf, 0xf, false), up); }
          { const bool up = (l5 & 1) != 0;
            mine_lo = bt_stage<1>(mine_lo, (unsigned)__builtin_amdgcn_update_dpp(0, (int)mine_lo, 0xB1, 0xf, 0xf, false), up); mine_hi = bt_stage<1>(mine_hi, (unsigned)__builtin_amdgcn_update_dpp(0, (int)mine_hi, 0xB1, 0xf, 0xf, false), up); } }
        if (lane < (nwords >> 1)) *(v2u*)(MASK + (row0 + q) * 128 + 2 * lane) = (v2u){mine_lo, mine_hi};
    }
    __syncthreads();
}
__device__ __forceinline__ void idx_phase(Frame& F, const bf16* IQ, const bf16* IK, const float* IW, const float* LOGF, float* CB, unsigned* MASK, const bf16* FQ, const bf16* FK, unsigned* norms) {
    {
        const int tpb = NTOK / F.G, r0 = F.bid * tpb, rpw = tpb / NWAVES; float mq = 0.f, mk = 0.f;
        constexpr int RPW = 16;
        for (int base = 0; base < rpw; base += RPW) {
            v4u qa[RPW], ka[RPW];
#pragma unroll
            for (int i = 0; i < RPW; ++i) { const size_t row = (size_t)(r0 + F.wave * rpw + (base + i < rpw ? base + i : base)); qa[i] = *(const v4u*)(FQ + row * AW + 8 * F.lane); ka[i] = *(const v4u*)(FK + row * AW + 8 * F.lane); }
#pragma unroll
            for (int i = 0; i < RPW; ++i) {
                const v4u q8 = qa[i], k8 = ka[i]; float sq = 0.f, sk = 0.f;
#pragma unroll
                for (int j = 0; j < 4; ++j) { const float a = __uint_as_float(q8[j] << 16), b2 = __uint_as_float(q8[j] & 0xffff0000u), c = __uint_as_float(k8[j] << 16), d = __uint_as_float(k8[j] & 0xffff0000u);
                    sq += a * a + b2 * b2; sk += c * c + d * d; }
#define DPP_F(x, ctrl) __int_as_float(__builtin_amdgcn_update_dpp(0, __float_as_int(x), (ctrl), 0xf, 0xf, true))
                sq += DPP_F(sq, 0xB1); sq += DPP_F(sq, 0x4E); sq += DPP_F(sq, 0x141); sk += DPP_F(sk, 0xB1); sk += DPP_F(sk, 0x4E); sk += DPP_F(sk, 0x141);
#undef DPP_F
                mq = fmaxf(mq, sq); mk = fmaxf(mk, sk); } }
        LAS float* nl = (LAS float*)(F.lds + IDX_HIST_OFF);
        if ((F.lane & 7) == 0) { nl[F.wave * 16 + (F.lane >> 3)] = mq; nl[F.wave * 16 + 8 + (F.lane >> 3)] = mk; }
        __syncthreads();
        if (F.tid < 16) { float m = 0.f;
#pragma unroll
            for (int w = 0; w < NWAVES; ++w) m = fmaxf(m, nl[w * 16 + F.tid]);
            __hip_atomic_fetch_max(norms + ((r0 / SEQ) * NH + (F.tid & 7)) * 2 + (F.tid >> 3), __float_as_uint(m), __ATOMIC_RELAXED, __HIP_MEMORY_SCOPE_AGENT); }
        __syncthreads();
    }
    const int gw = F.bid * NWAVES + F.wave;
    if (gw < BATCH * NH) {
        const float* src = LOGF + (size_t)gw * SEQ; float* dst = CB + (size_t)gw * SEQ; float carry = 0.f;
        float vals[64];
#pragma unroll
        for (int i = 0; i < 64; ++i) vals[i] = src[64 * i + F.lane];
#pragma unroll
        for (int i = 0; i < 64; ++i) {
            float v = vals[i];
            v += __int_as_float(DPP_I(__float_as_int(v), 0x111)); v += __int_as_float(DPP_I(__float_as_int(v), 0x112));
            v += __int_as_float(DPP_I(__float_as_int(v), 0x114)); v += __int_as_float(DPP_I(__float_as_int(v), 0x118));
            { const float r0 = __int_as_float(__builtin_amdgcn_readlane(__float_as_int(v), 15)), r1 = __int_as_float(__builtin_amdgcn_readlane(__float_as_int(v), 31)),
                          r2 = __int_as_float(__builtin_amdgcn_readlane(__float_as_int(v), 47)); const int row = F.lane >> 4;
              v += (row == 0 ? 0.f : row == 1 ? r0 : row == 2 ? r0 + r1 : (r0 + r1) + r2); }
            const float c = carry + v;
            dst[64 * i + F.lane] = -c * LOG2E;
            carry = __int_as_float(__builtin_amdgcn_readlane(__float_as_int(c), 63));
        }
    }
    for (int k = F.bid; k < BATCH * (SEQ / 16); k += F.G) {
        const int round = k >> 8, pos = k & 255, i = (round << 8) + ((round & 1) ? 255 - pos : pos);
        idx_unit(F, i & 7, 255 - (i >> 3), IQ, IK, IW, MASK);
    }
}

__device__ __forceinline__ void attn_phase(Frame& F, const bf16* DQ, const bf16* DK, const bf16* DV, const bf16* FQ, const bf16* FK, const bf16* FV, const unsigned* MASK, const float* CB, bf16* OA, bf16* OB,
                                           unsigned* qctr, const unsigned* norms) {
    constexpr int NUNITS = 2 * BATCH * NH * (SEQ / 256);
    volatile LAS int* qs = (volatile LAS int*)(F.lds + MISC_OFF + 64);
    unsigned p_old = 0u, p_new = 0u;
    if (F.tid == 0) { qs[0] = (int)__hip_atomic_fetch_add(qctr, 1u, __ATOMIC_RELAXED, __HIP_MEMORY_SCOPE_AGENT); qs[1] = (int)__hip_atomic_fetch_add(qctr, 1u, __ATOMIC_RELAXED, __HIP_MEMORY_SCOPE_AGENT);
                      p_old = __hip_atomic_fetch_add(qctr, 1u, __ATOMIC_RELAXED, __HIP_MEMORY_SCOPE_AGENT); }
    __syncthreads();
    int cur = qs[0], nxt = qs[1];
    __syncthreads();
    while (cur < NUNITS) {
        const int qb = 15 - (cur >> 7), r = cur & 127, kind = r >> 6, b = (r >> 3) & 7, h = r & 7;
        if (kind == 0) attn_body::attn_unit<0, 8>(b, h, qb, DQ, DK, DV, OA, MASK, CB, (LAS char*)F.lds, 0.f, qctr, p_new, p_old, qs, F.wave);
        else { const float q2 = __uint_as_float(__hip_atomic_load(norms + (b * NH + h) * 2, __ATOMIC_RELAXED, __HIP_MEMORY_SCOPE_AGENT)), k2 = __uint_as_float(__hip_atomic_load(norms + (b * NH + h) * 2 + 1, __ATOMIC_RELAXED, __HIP_MEMORY_SCOPE_AGENT));
            attn_body::attn_unit<1, 8>(b, h, qb, FQ, FK, FV, OB, MASK, CB, (LAS char*)F.lds, sqrtf(q2 * k2) * 1.02f + 2.f, qctr, p_new, p_old, qs, F.wave); }
        cur = nxt; nxt = qs[0]; p_old = p_new;
    }
}

template <int MODE, bool Q8 = false>
__device__ __forceinline__ void ln_phase(Frame& F, const float* gam, const float* bet, const float* router, size_t x8off = 0, size_t xscoff = 0) {
    const bf16* Y = (const bf16*)F.out; bf16* XS = (bf16*)(F.ws + OPQ(WS_XS));
    const int tpb = NTOK / F.G, r_lo = F.bid * tpb;
    LAS unsigned* cnt = (LAS unsigned*)(F.lds + RING_OFF);
    if (MODE == 1) { if (F.tid < 8) cnt[F.tid] = 0u; __syncthreads(); }
    f32x4 g4[4], b4[4];
#pragma unroll
    for (int j = 0; j < 4; ++j) { g4[j] = *(const f32x4*)(gam + 4 * F.lane + 256 * j); b4[j] = *(const f32x4*)(bet + 4 * F.lane + 256 * j); }
    f32x4 rw[4][4][2];
    if (MODE == 1) {
#pragma unroll
        for (int j = 0; j < 4; ++j)
#pragma unroll
            for (int c = 0; c < 4; ++c) { const float* rp = router + (size_t)(4 * F.lane + 256 * j + c) * 8; rw[j][c][0] = *(const f32x4*)rp; rw[j][c][1] = *(const f32x4*)(rp + 4); }
    }
    v2u vn[4];
    if (MODE != 3) {
#pragma unroll
        for (int j = 0; j < 4; ++j) vn[j] = *(const v2u*)(Y + (size_t)(r_lo + F.wave) * DM + 4 * F.lane + 256 * j);
    }
    v2u xn[4], y0n[4], y1n[4]; int sn0 = 0, sn1 = 0;
    if (MODE == 3) {
        const int* tsb = (const int*)(F.ws + OPQ(MOE_TOKSLOT)); const bf16* yb = (const bf16*)(F.ws + OPQ(WS_YB));
        const int r0_ = r_lo + F.wave; const int a0 = tsb[2 * r0_], a1 = tsb[2 * r0_ + 1];
#pragma unroll
        for (int j = 0; j < 4; ++j) { const int c = 4 * F.lane + 256 * j; xn[j] = *(const v2u*)(XS + (size_t)r0_ * DM + c); y0n[j] = *(const v2u*)(yb + (size_t)a0 * DM + c); y1n[j] = *(const v2u*)(yb + (size_t)a1 * DM + c); }
        const int r1_ = (F.wave + NWAVES < tpb) ? r0_ + NWAVES : r0_; sn0 = tsb[2 * r1_]; sn1 = tsb[2 * r1_ + 1];
    }
    for (int rr = F.wave; rr < tpb; rr += NWAVES) {
        const int row = r_lo + rr;
        f32x4 v[4]; float s = 0.f;
        if (MODE == 3) {
            const int* tsb = (const int*)(F.ws + OPQ(MOE_TOKSLOT)); const bf16* yb = (const bf16*)(F.ws + OPQ(WS_YB));
            v2u xc[4], y0c[4], y1c[4];
#pragma unroll
            for (int j = 0; j < 4; ++j) { xc[j] = xn[j]; y0c[j] = y0n[j]; y1c[j] = y1n[j]; }
            const int rn = (rr + NWAVES < tpb) ? row + NWAVES : row, rn2 = (rr + 2 * NWAVES < tpb) ? row + 2 * NWAVES : rn;
#pragma unroll
            for (int j = 0; j < 4; ++j) { const int c = 4 * F.lane + 256 * j; xn[j] = *(const v2u*)(XS + (size_t)rn * DM + c); y0n[j] = *(const v2u*)(yb + (size_t)sn0 * DM + c); y1n[j] = *(const v2u*)(yb + (size_t)sn1 * DM + c); }
            sn0 = tsb[2 * rn2]; sn1 = tsb[2 * rn2 + 1];
#pragma unroll
            for (int j = 0; j < 4; ++j) {
                const v2u xr = xc[j], y0 = y0c[j], y1 = y1c[j];
                v[j][0] = ALPHA * pg8::bf2f(xr.x & 0xffffu) + (pg8::bf2f(y0.x & 0xffffu) + pg8::bf2f(y1.x & 0xffffu));
                v[j][1] = ALPHA * __uint_as_float(xr.x & 0xffff0000u) + (__uint_as_float(y0.x & 0xffff0000u) + __uint_as_float(y1.x & 0xffff0000u));
                v[j][2] = ALPHA * pg8::bf2f(xr.y & 0xffffu) + (pg8::bf2f(y0.y & 0xffffu) + pg8::bf2f(y1.y & 0xffffu));
                v[j][3] = ALPHA * __uint_as_float(xr.y & 0xffff0000u) + (__uint_as_float(y0.y & 0xffff0000u) + __uint_as_float(y1.y & 0xffff0000u)); }
        } else {
#pragma unroll
            for (int j = 0; j < 4; ++j) { v[j][0] = __uint_as_float(vn[j].x << 16); v[j][1] = __uint_as_float(vn[j].x & 0xffff0000u); v[j][2] = __uint_as_float(vn[j].y << 16); v[j][3] = __uint_as_float(vn[j].y & 0xffff0000u); }
            const int rn = (rr + NWAVES < tpb) ? row + NWAVES : row;
#pragma unroll
            for (int j = 0; j < 4; ++j) vn[j] = *(const v2u*)(Y + (size_t)rn * DM + 4 * F.lane + 256 * j);
        }
#pragma unroll
        for (int j = 0; j < 4; ++j) s += (v[j][0] + v[j][1]) + (v[j][2] + v[j][3]);
        const float mean = wave_sum(s) * (1.f / DM); float s2 = 0.f;
#pragma unroll
        for (int j = 0; j < 4; ++j) { v[j] = v[j] - mean; s2 += (v[j][0] * v[j][0] + v[j][1] * v[j][1]) + (v[j][2] * v[j][2] + v[j][3] * v[j][3]); }
        const float rstd = 1.f / sqrtf(wave_sum(s2) * (1.f / DM) + LN_EPS);
#pragma unroll
        for (int j = 0; j < 4; ++j) v[j] = v[j] * rstd * g4[j] + b4[j];
        if (MODE == 2 || MODE == 3) {
#pragma unroll
            for (int j = 0; j < 4; ++j) *(f32x4*)(F.out + (size_t)row * DM + 4 * F.lane + 256 * j) = v[j];
        }
        if (MODE == 0 || MODE == 1) {
#pragma unroll
            for (int j = 0; j < 4; ++j) { v2u o; o.x = pk2(v[j][0], v[j][1]); o.y = pk2(v[j][2], v[j][3]); *(v2u*)(XS + (size_t)row * DM + 4 * F.lane + 256 * j) = o; }
        }
        if ((MODE == 0 || MODE == 1) && Q8) {
            float am = 0.f;
#pragma unroll
            for (int j = 0; j < 4; ++j) am = fmaxf(fmaxf(am, fmaxf(fabsf(v[j][0]), fabsf(v[j][1]))), fmaxf(fabsf(v[j][2]), fabsf(v[j][3])));
            am = wave_max(am);
            const float inv = am > 0.f ? 127.f / am : 0.f;
            unsigned* x8 = (unsigned*)(F.ws + x8off) + (size_t)row * (DM / 4) + F.lane;
#pragma unroll
            for (int j = 0; j < 4; ++j) x8[64 * j] = q4(v[j], inv);
            if (F.lane == 0) ((float*)(F.ws + xscoff))[row] = am * (1.f / 127.f);
        }
        if (MODE == 1) {
            float lg[8];
#pragma unroll
            for (int e = 0; e < 8; ++e) lg[e] = 0.f;
#pragma unroll
            for (int j = 0; j < 4; ++j)
#pragma unroll
                for (int c = 0; c < 4; ++c) { const f32x4 r0 = rw[j][c][0], r1 = rw[j][c][1]; const float x = v[j][c];
                    lg[0] += x * r0[0]; lg[1] += x * r0[1]; lg[2] += x * r0[2]; lg[3] += x * r0[3]; lg[4] += x * r1[0]; lg[5] += x * r1[1]; lg[6] += x * r1[2]; lg[7] += x * r1[3]; }
#pragma unroll
            for (int e = 0; e < 8; ++e) lg[e] = wave_sum(lg[e]);
            float bv = lg[0]; int bi = 0;
#pragma unroll
            for (int e = 1; e < 8; ++e) if (lg[e] > bv) { bv = lg[e]; bi = e; }
            float sv = -INFINITY; int si = 0;
#pragma unroll
            for (int e = 0; e < 8; ++e) if (e != bi && lg[e] > sv) { sv = lg[e]; si = e; }
            if (F.lane == 0) {
                const float g0 = 1.f / (1.f + __expf(sv - bv));
                ((unsigned*)(F.ws + OPQ(MOE_TOPE)))[row] = (unsigned)bi | ((unsigned)si << 8);
                float* tg = (float*)(F.ws + OPQ(MOE_TOPG)) + 2 * row; tg[0] = g0; tg[1] = 1.f - g0;
                __hip_atomic_fetch_add(cnt + bi, 1u, __ATOMIC_RELAXED, __HIP_MEMORY_SCOPE_WORKGROUP); __hip_atomic_fetch_add(cnt + si, 1u, __ATOMIC_RELAXED, __HIP_MEMORY_SCOPE_WORKGROUP);
            }
        }
    }
    if (MODE == 1) { __syncthreads(); if (F.tid < 8) ((unsigned*)(F.ws + OPQ(MOE_CNT)))[F.bid * 8 + F.tid] = cnt[F.tid]; }
}

__device__ __forceinline__ void moe_assign(Frame& F) {
    const unsigned* CNT = (const unsigned*)(F.ws + OPQ(MOE_CNT));
    LAS int* part = (LAS int*)(F.lds + RING_OFF);
    LAS int* tot = part + 512;
    LAS int* base = tot + 8; LAS int* pst = tot + 16; LAS int* wcnt = tot + 24;
    const int G = F.G, tpb = NTOK / G, j = F.bid;
    __syncthreads();
    { const int e = F.tid & 7, grp = F.tid >> 3; int s = 0;
      const int gsz = (G + 63) / 64;
      for (int jj = grp * gsz; jj < (grp + 1) * gsz && jj < G; ++jj) s += (int)CNT[jj * 8 + e];
      part[grp * 8 + e] = s; }
    __syncthreads();
    if (F.tid < 8) { const int e = F.tid, gsz = (G + 63) / 64, myg = j / gsz; int t = 0, bs = 0;
        for (int g = 0; g < 64; ++g) { const int s = part[g * 8 + e]; if (g < myg) bs += s; t += s; }
        for (int jj = myg * gsz; jj < j; ++jj) bs += (int)CNT[jj * 8 + e];
        tot[e] = t; base[e] = bs; if (j == 0) ((int*)(F.ws + OPQ(MOE_TOT)))[e] = t; }
    __syncthreads();
    if (F.tid == 0) { int ps = 0; for (int e = 0; e < 8; ++e) { pst[e] = ps; ps += ((tot[e] + 255) >> 8) << 8; } }
    const unsigned* TOPE = (const unsigned*)(F.ws + OPQ(MOE_TOPE)); const float* TOPG = (const float*)(F.ws + OPQ(MOE_TOPG));
    int* SLOTTOK = (int*)(F.ws + OPQ(MOE_SLOTTOK)); float* SLOTGATE = (float*)(F.ws + OPQ(MOE_SLOTGATE)); int* TOKSLOT = (int*)(F.ws + OPQ(MOE_TOKSLOT)); float* SLOTSCALE = (float*)(F.ws + OPQ(MOE_SLOTSCALE)); const float* XSCM = (const float*)(F.ws + OPQ(WS_XSCALEM));
    const int na = 2 * tpb;
    int done_before[8];
#pragma unroll
    for (int e = 0; e < 8; ++e) done_before[e] = 0;
    for (int a0 = 0; a0 < na; a0 += NWAVES * 64) {
        const int a = a0 + F.tid; const bool valid = a < na;
        const int tok = j * tpb + (a >> 1), k = a & 1;
        int e = -1; if (valid) { const unsigned te = TOPE[tok]; e = (int)((te >> (8 * k)) & 255u); }
        int rank = 0;
#pragma unroll
        for (int x = 0; x < 8; ++x) { const unsigned long long bm = __ballot(e == x); if (e == x) rank = __popcll(bm & ((1ull << F.lane) - 1ull)); if (F.lane == 0) wcnt[F.wave * 8 + x] = __popcll(bm); }
        __syncthreads();
        if (valid) { int pre = 0, all = 0;
#pragma unroll
            for (int x = 0; x < 8; ++x) { int ps = 0, al = 0;
#pragma unroll
                for (int w = 0; w < NWAVES; ++w) { const int c = wcnt[w * 8 + x]; if (w < F.wave) ps += c; al += c; }
                if (e == x) { pre = ps + done_before[x]; } all = al; done_before[x] += all; }
            const int slot = pst[e] + base[e] + pre + rank;
            SLOTTOK[slot] = tok; SLOTGATE[slot] = TOPG[2 * tok + k]; TOKSLOT[2 * tok + k] = slot; SLOTSCALE[slot] = XSCM[tok];
        } else {
#pragma unroll
            for (int x = 0; x < 8; ++x) { int al = 0;
#pragma unroll
                for (int w = 0; w < NWAVES; ++w) al += wcnt[w * 8 + x];
                done_before[x] += al; }
        }
        __syncthreads();
    }
    if (j < 8) { const int e = j, t = tot[e], padded = ((t + 255) >> 8) << 8; for (int s = t + F.tid; s < padded; s += NWAVES * 64) { SLOTTOK[pst[e] + s] = 0; SLOTGATE[pst[e] + s] = 0.f; SLOTSCALE[pst[e] + s] = 0.f; } }
    __syncthreads();
}

constexpr int NPHASE = 27;
__device__ __forceinline__ const void* kin_load(const __attribute__((address_space(4))) char* ka, int i) {
    int z; asm volatile("s_mov_b32 %0, 0" : "=s"(z));
    return *(const void* const __attribute__((address_space(4)))*)(ka + 8 * (i + z));
}
struct Args { const void* in[18]; float* out; unsigned char* ws; int ph_lo, ph_hi; };
__global__ void __launch_bounds__(NWAVES * 64, 2) mk_fwd(Args args) {
    extern __shared__ __attribute__((aligned(16))) unsigned char lds[];
    Frame F;
    F.lds = (LAS unsigned char*)lds;
    F.MISC = (volatile LAS unsigned*)(F.lds + MISC_OFF);
    const int wave0_ = __builtin_amdgcn_readfirstlane((int)threadIdx.x >> 6);
    F.wave = wave0_; F.lane = mk_lane(); F.tid = wave0_ * 64 + F.lane;
    F.G = gridDim.x; F.bid = blockIdx.x;
    F.ws = args.ws; F.out = args.out; F.ctl = (gu32*)(args.ws + OPQ(WS_CTL));
    const __attribute__((address_space(4))) char* KA = (const __attribute__((address_space(4))) char*)__builtin_amdgcn_kernarg_segment_ptr();
#define KIN(T, i) ((T)kin_load(KA, (i)))
    for (int u = F.tid; u < (LDS_BYTES - MISC_OFF) / 4; u += NWAVES * 64) ((LAS unsigned*)(F.lds + MISC_OFF))[u] = 0u;
    __syncthreads();
    const int lo = args.ph_lo, hi = args.ph_hi;
    XcdBarrier bar; bar.bar = (unsigned*)(F.ctl + CW_BAR); bar.x = 0; bar.st = nullptr; bar.wv = wave0_;
    if (hi - lo > 1) bar = xcd_barrier_post((unsigned*)(F.ctl + CW_BAR), F.MISC + 8, wave0_);
#ifndef PHS
#define PHS(s) 1
#endif
#ifndef DUP_SLOT
#define DUP_SLOT -1
#endif
#ifdef DUP_MASK
#define NREP(s) ((((s) < 32) && ((DUP_MASK >> (s)) & 1)) ? 2 : 1)
#else
#define NREP(s) (((s) == (DUP_SLOT)) ? 2 : 1)
#endif
#define IN(k) (lo <= (k) && (k) < hi)
#define PHASE_BEGIN() do { int w_ = wave0_; asm volatile("" : "+s"(w_)); const int l_ = mk_lane(); F.wave = w_; F.lane = l_; F.tid = w_ * 64 + l_; } while (0)
#define INS(s) (PHS(s) && IN(pb + (s)))
#define INM(s) (PHS((s) + 20) && IN(pb + (s)))
#define SEAM(k) do { if (IN((k) + 1)) xcd_barrier(bar); } while (0)
    unsigned char* ws = args.ws;
#define XS ((bf16*)(ws + OPQ(WS_XS)))
#define DQ ((bf16*)(ws + OPQ(WS_DQ)))
#define DK ((bf16*)(ws + OPQ(WS_DK)))
#define DV ((bf16*)(ws + OPQ(WS_DV)))
#define IQ ((bf16*)(ws + OPQ(WS_IQ)))
#define FQ ((bf16*)(ws + OPQ(WS_FQ)))
#define FK ((bf16*)(ws + OPQ(WS_FK)))
#define FV ((bf16*)(ws + OPQ(WS_FV)))
#define GA ((bf16*)(ws + OPQ(WS_GA)))
#define GB ((bf16*)(ws + OPQ(WS_GB)))
#define IK ((bf16*)(ws + OPQ(WS_IK)))
#define MERGED ((bf16*)(ws + OPQ(WS_MERGED)))
#define IW ((float*)(ws + OPQ(WS_IW)))
#define LOGF ((float*)(ws + OPQ(WS_LOGF)))
#define CB ((float*)(ws + OPQ(WS_CB)))
#define MASK ((unsigned*)(ws + OPQ(WS_MASK)))

    if (PHS(100) && IN(0)) { for (int rep_ = 0; rep_ < NREP(100); ++rep_) { PHASE_BEGIN(); p0_prologue(F, KIN(const float*, 0), KIN(const int*, 1), KIN(const float*, 2), KIN(const float*, 4), KIN(const float*, 5), KIN(const float*, 6), KIN(const float*, 11), KIN(const float*, 12), KIN(const float*, 13)); if (rep_ + 1 < NREP(100)) xcd_barrier(bar); } SEAM(0); }

#ifdef BAR_PROBE_N
    for (int i_ = 0; i_ < BAR_PROBE_N; ++i_) xcd_barrier(bar);
#endif
#ifdef IDLE_PROBE_US
    { const unsigned long long t0_ = __builtin_amdgcn_s_memrealtime(); while (__builtin_amdgcn_s_memrealtime() - t0_ < (unsigned long long)IDLE_PROBE_US * 100ull) __builtin_amdgcn_s_sleep(64); }
#endif
    for (int layer = 0; layer < 2; ++layer) {
        const int pb = 1 + 13 * layer; const bool moe = (layer & 1) != 0;
        if (INS(0)) { for (int rep_ = 0; rep_ < NREP(0); ++rep_) { PHASE_BEGIN();
            pg8::Gemm g{(const bf16*)(ws + OPQ(WS_XS8)), (const bf16*)(ws + OPQ(WS_WIN) + layer * WIN_STRIDE), NTOK, PROJ_PAD, DM / 2}; g.wave = F.wave; pg8::StaticOrder S; S.init(NTOK, PROJ_PAD, F.G, F.bid);
            pg8::EpiProj8 E{{ws, KIN(const float*, 3) + layer * NH}, (const float*)(ws + OPQ(WS_XSCALE)), (const float*)(ws + OPQ(WS_WINSC) + layer * WIN_STRIDE)};
            pg8::gemm_phase<pg8::EpiProj8, pg8::StaticOrder, true, true, false, true>(F.lds + RING_OFF, g, S, E);
            if (rep_ + 1 < NREP(0)) xcd_barrier(bar); } SEAM(pb + 0);
        }
        if (INS(1)) { for (int rep_ = 0; rep_ < NREP(1); ++rep_) { PHASE_BEGIN(); idx_phase(F, IQ, IK, IW, LOGF, CB, MASK, FQ, FK, (unsigned*)(F.ctl + CW_NORMS + 256 * layer)); if (rep_ + 1 < NREP(1)) xcd_barrier(bar); } SEAM(pb + 1); }
        if (INS(2)) { for (int rep_ = 0; rep_ < NREP(2); ++rep_) { PHASE_BEGIN();
            attn_phase(F, DQ, DK, DV, FQ, FK, FV, MASK, CB, (bf16*)(ws + OPQ(WS_OA8)), (bf16*)(ws + OPQ(WS_OB8)), (unsigned*)(F.ctl + CW_QCTR + 64 * layer + 16 * rep_), (const unsigned*)(F.ctl + CW_NORMS + 256 * layer)); if (rep_ + 1 < NREP(2)) xcd_barrier(bar); } SEAM(pb + 2); }
        if (INS(3)) { for (int rep_ = 0; rep_ < NREP(3); ++rep_) { PHASE_BEGIN();
            static_assert((WS_OB8 - WS_OA8) == (size_t)512 * 256 * AW && MiB == (size_t)8 * 256 * AW, "branch B = branch A + 512 row tiles / + 8 column tiles (fp8 bytes)");
            pg8::Gemm g{(const bf16*)(ws + OPQ(WS_OA8)), (const bf16*)(ws + OPQ(WS_WA) + (size_t)layer * DM * AW), NTOK, DM, AW / 2}; g.wave = F.wave; pg8::D1Order S; S.init(NTOK, DM, F.G, F.bid);
            pg8::EpiGate2 E{MERGED, GA, GB, ws + OPQ(WS_IQ), (const float*)(ws + OPQ(WS_WABSC)) + layer * 4096};
            pg8::gemm_phase<pg8::EpiGate2, pg8::D1Order, false, true, false, false, true>(F.lds + RING_OFF, g, S, E);
            if (rep_ + 1 < NREP(3)) xcd_barrier(bar); } SEAM(pb + 3);
        }
        if (INS(5)) { for (int rep_ = 0; rep_ < NREP(5); ++rep_) { PHASE_BEGIN();
            pg8::Gemm g{(const bf16*)(ws + OPQ(WS_IQ)), (const bf16*)(ws + OPQ(WS_WOUT) + (size_t)layer * DM * DM), NTOK, DM, DM / 2}; g.wave = F.wave; pg8::StaticOrder S; S.init(NTOK, DM, F.G, F.bid);
            pg8::EpiYF8 E{{(bf16*)F.out, XS}, (const float*)(ws + OPQ(WS_WOSC)) + layer * DM};
            pg8::gemm_phase<pg8::EpiYF8, pg8::StaticOrder, false, true, false, false, true>(F.lds + RING_OFF, g, S, E);
            if (rep_ + 1 < NREP(5)) xcd_barrier(bar); } SEAM(pb + 5);
        }
        if (INS(6)) { for (int rep_ = 0; rep_ < NREP(6); ++rep_) { PHASE_BEGIN();
            if (moe) { ln_phase<1, true>(F, KIN(const float*, 7) + layer * DM, KIN(const float*, 8) + layer * DM, KIN(const float*, 14) + (size_t)(layer >> 1) * DM * NEXP, WS_XS8M, WS_XSCALEM); }
            else { ln_phase<0, true>(F, KIN(const float*, 7) + layer * DM, KIN(const float*, 8) + layer * DM, nullptr, WS_XS8, WS_XSCALE); }
            if (rep_ + 1 < NREP(6)) xcd_barrier(bar); } SEAM(pb + 6);
        }
        if (!moe) {
            if (INS(8)) { for (int rep_ = 0; rep_ < NREP(8); ++rep_) { PHASE_BEGIN();
                pg8::Gemm g{(const bf16*)(ws + OPQ(WS_XS8)), (const bf16*)(ws + OPQ(WS_FGU)), NTOK, 2 * DFF, DM / 2}; g.wave = F.wave; pg8::StaticOrder S; S.init(NTOK, 2 * DFF, F.G, F.bid);
                pg8::EpiSwiglu8 E{{ws + OPQ(WS_H), 28}, (const float*)(ws + OPQ(WS_XSCALE)), (const float*)(ws + OPQ(WS_FGUSC)), 0};
                pg8::gemm_phase<pg8::EpiSwiglu8, pg8::StaticOrder, true, true, false, true>(F.lds + RING_OFF, g, S, E);
                if (rep_ + 1 < NREP(8)) xcd_barrier(bar); } SEAM(pb + 8);
            }
            if (INS(9)) { for (int rep_ = 0; rep_ < NREP(9); ++rep_) { PHASE_BEGIN();
                pg8::Gemm g{(const bf16*)(ws + OPQ(WS_H)), (const bf16*)(ws + OPQ(WS_FD)), NTOK, DM, DFF / 2}; g.wave = F.wave; pg8::StaticOrder S; S.init(NTOK, DM, F.G, F.bid);
                pg8::EpiYF8 E{{(bf16*)F.out, XS}, (const float*)(ws + OPQ(WS_FDSC))};
                pg8::gemm_phase<pg8::EpiYF8, pg8::StaticOrder, false, true, false, false, true>(F.lds + RING_OFF, g, S, E);
                if (rep_ + 1 < NREP(9)) xcd_barrier(bar); } SEAM(pb + 9);
            }
            if (INS(12)) { for (int rep_ = 0; rep_ < NREP(12); ++rep_) { PHASE_BEGIN();
                ln_phase<0, true>(F, KIN(const float*, 9) + layer * DM, KIN(const float*, 10) + layer * DM, nullptr, WS_XS8, WS_XSCALE);
                if (rep_ + 1 < NREP(12)) xcd_barrier(bar); } SEAM(pb + 12);
            }
        } else {
            if (INS(7)) { for (int rep_ = 0; rep_ < NREP(7); ++rep_) { PHASE_BEGIN(); moe_convert(F, KIN(const float*, 15), KIN(const float*, 16), KIN(const float*, 17)); moe_assign(F); if (rep_ + 1 < NREP(7)) xcd_barrier(bar); } SEAM(pb + 7); }
            pg8::MoeOrder MO; MO.G = F.G; MO.c = F.bid; MO.slot_tok = (const int*)(ws + OPQ(MOE_SLOTTOK));
            if (INM(8) || INM(9) || INM(10) || INM(11)) {
                const int* tot = (const int*)(ws + OPQ(MOE_TOT)); int cs = 0;
#pragma unroll
                for (int e = 0; e < 8; ++e) { cs += (tot[e] + 255) >> 8; MO.cum[e] = cs; }
            } else {
#pragma unroll
                for (int e = 0; e < 8; ++e) MO.cum[e] = 0;
            }
            const int ntile = MO.cum[7], nA = ntile < 128 ? ntile : 128, nT = ntile > 256 ? (ntile - 256 > 8 ? 8 : ntile - 256) : 0, nB = ntile > 128 ? (ntile - 128 > 128 ? 128 : ntile - 128) : 0;
            MO.nmain = nA; MO.gbase = 0; MO.ut = 4 * nT; MO.y = 4;
            if (INM(8)) { PHASE_BEGIN();
                MO.mode = 0; MO.nrows = nA + nT; MO.nmain = nA; MO.gbase = 0; MO.nc = 28;
                pg8::Gemm g{(const bf16*)(ws + OPQ(WS_XS8M)), (const bf16*)F.out, NTOK, NEXP * 2 * DFF, DM / 2}; g.wave = F.wave;
                pg8::EpiSwiglu8 E{{ws + OPQ(WS_H2), 28}, (const float*)(ws + OPQ(MOE_SLOTSCALE)), (const float*)(ws + OPQ(WS_MGUSC)), 0};
                pg8::gemm_phase<pg8::EpiSwiglu8, pg8::MoeOrder, true, true, true, true>(F.lds + RING_OFF, g, MO, E);
                SEAM(pb + 8);
            }
            if (INM(9)) { PHASE_BEGIN();
                MO.mode = 0; MO.nrows = nA; MO.nmain = nA; MO.gbase = 0; MO.nc = 4;
                pg8::Gemm g{(const bf16*)(ws + OPQ(WS_H2)), (const bf16*)(ws + OPQ(WS_MWD)), MOE_H2_TILES * 256, NEXP * DM, DFF / 2}; g.wave = F.wave;
                pg8::EpiDownMoeF8 E{{(bf16*)(ws + OPQ(WS_YB)), (const float*)(ws + OPQ(MOE_SLOTGATE)), 0}, (const float*)(ws + OPQ(WS_MWDSC))};
                pg8::gemm_phase<pg8::EpiDownMoeF8, pg8::MoeOrder, true, true, false, false, true>(F.lds + RING_OFF, g, MO, E);
                SEAM(pb + 9);
            }
            if (INM(10)) { PHASE_BEGIN();
                { MO.mode = 2; MO.gbase = 0; MO.nc = 4;
                  pg8::Gemm g{(const bf16*)(ws + OPQ(WS_H2)), (const bf16*)(ws + OPQ(WS_MWD)), MOE_H2_TILES * 256, NEXP * DM, DFF / 2}; g.wave = F.wave;
                  pg8::EpiDownMoeF8 E{{(bf16*)(ws + OPQ(WS_YB)), (const float*)(ws + OPQ(MOE_SLOTGATE)), 0}, (const float*)(ws + OPQ(WS_MWDSC))};
                  pg8::gemm_phase<pg8::EpiDownMoeF8, pg8::MoeOrder, true, true, false, false, true>(F.lds + RING_OFF, g, MO, E); }
                PHASE_BEGIN();
                { MO.mode = 1; MO.nrows = nB; MO.gbase = 128; MO.nc = 28;
                  pg8::Gemm g{(const bf16*)(ws + OPQ(WS_XS8M)), (const bf16*)F.out, NTOK, NEXP * 2 * DFF, DM / 2}; g.wave = F.wave;
                  pg8::EpiSwiglu8 E{{ws + OPQ(WS_H2), 28}, (const float*)(ws + OPQ(MOE_SLOTSCALE)), (const float*)(ws + OPQ(WS_MGUSC)), 128};
                  pg8::gemm_phase<pg8::EpiSwiglu8, pg8::MoeOrder, true, true, true, true>(F.lds + RING_OFF, g, MO, E); }
                SEAM(pb + 10);
            }
            if (INM(11)) { PHASE_BEGIN();
                MO.mode = 0; MO.nrows = nB; MO.nmain = nB; MO.gbase = 128; MO.nc = 4;
                pg8::Gemm g{(const bf16*)(ws + OPQ(WS_H2)), (const bf16*)(ws + OPQ(WS_MWD)), MOE_H2_TILES * 256, NEXP * DM, DFF / 2}; g.wave = F.wave;
                pg8::EpiDownMoeF8 E{{(bf16*)(ws + OPQ(WS_YB)), (const float*)(ws + OPQ(MOE_SLOTGATE)), 128}, (const float*)(ws + OPQ(WS_MWDSC))};
                pg8::gemm_phase<pg8::EpiDownMoeF8, pg8::MoeOrder, true, true, false, false, true>(F.lds + RING_OFF, g, MO, E);
                SEAM(pb + 11);
            }
            if (INS(12)) { for (int rep_ = 0; rep_ < NREP(12); ++rep_) { PHASE_BEGIN(); ln_phase<3>(F, KIN(const float*, 9) + layer * DM, KIN(const float*, 10) + layer * DM, nullptr); if (rep_ + 1 < NREP(12)) xcd_barrier(bar); } SEAM(pb + 12); }
        }
    }
#undef IN
#undef INS
#undef SEAM
}


#if MK_MULTI && defined(MK_DUMP)
__global__ void dump_kernel(unsigned char* ws, float* out, int mode) {
    const size_t n = (size_t)NTOK * DM;
    for (size_t i = (size_t)blockIdx.x * blockDim.x + threadIdx.x; i < n; i += (size_t)gridDim.x * blockDim.x) {
        const size_t row = i >> 10; const int c = (int)(i & 1023);
        float v = 0.f;
        auto B = [&](size_t off, int pitch, int col) { return pg8::bf2f(((const bf16*)(ws + off))[row * pitch + col]); };
        if (mode == 1) { if (c < 512) v = B(WS_DQ, 512, c) + 2.f * B(WS_DK, 512, c) + 4.f * B(WS_DV, 512, c) + 8.f * B(WS_IQ, 512, c);
                         else v = B(WS_FQ, 512, c - 512) + 2.f * B(WS_FK, 512, c - 512) + 4.f * B(WS_FV, 512, c - 512) + 8.f * B(WS_IK, 64, c & 63) + ((const float*)(ws + OPQ(WS_IW)))[row * 8 + (c & 7)] + ((const float*)(ws + OPQ(WS_LOGF)))[row * 8 + (c & 7)]; }
        else if (mode == 2) v = B(WS_GA, 1024, c) + 2.f * B(WS_GB, 1024, c);
        else if (mode == 3) { const unsigned w = ((const unsigned*)(ws + OPQ(WS_MASK)))[row * 128 + (c & 127)]; const int qb = (int)((row & 4095) >> 8); v = ((c & 127) < 8 * (qb + 1)) ? (float)((w >> (4 * (c >> 7))) & 0xffffu) : 0.f; }
        else if (mode == 4) v = ((const float*)(ws + OPQ(WS_CB)))[(row >> 12) * 8 * 4096 + (size_t)(c & 7) * 4096 + (row & 4095)];
        else if (mode == 5) v = c < 512 ? B(WS_DQ, 512, c) : B(WS_FQ, 512, c - 512);
        else if (mode == 6) v = B(WS_MERGED, 1024, c);
        else if (mode == 7) v = B(WS_XS, 1024, c);
        out[i] = v;
    }
}
#endif
extern "C" void kernel_launch(void* const* d_in, const int* in_sizes, int n_in, void* d_out, int out_size, void* d_ws, size_t ws_size, hipStream_t stream) {
    static int grid = 0;
    if (grid == 0) {
        if (n_in != 18 || in_sizes[0] != NTOK * DM || out_size != NTOK * DM || ws_size < WS_END) {
            fprintf(stderr, "kernel_launch: unexpected shapes: n_in %d in0 %d out %d ws %zu (need %zu); nothing launched\n", n_in, n_in > 0 ? in_sizes[0] : -1, out_size, ws_size, (size_t)WS_END); grid = -1; return; }
        int dev = 0, cus = 0, per_cu = 0;
        if (hipGetDevice(&dev) != hipSuccess || hipDeviceGetAttribute(&cus, hipDeviceAttributeMultiprocessorCount, dev) != hipSuccess) { fprintf(stderr, "kernel_launch: device query failed\n"); grid = -1; return; }
        if (hipFuncSetAttribute((const void*)mk_fwd, hipFuncAttributeMaxDynamicSharedMemorySize, LDS_BYTES) != hipSuccess) { fprintf(stderr, "kernel_launch: hipFuncSetAttribute failed\n"); grid = -1; return; }
        if (hipOccupancyMaxActiveBlocksPerMultiprocessor(&per_cu, (const void*)mk_fwd, NWAVES * 64, LDS_BYTES) != hipSuccess || per_cu < 1)
            fprintf(stderr, "kernel_launch: note: occupancy query reports %d workgroups per CU\n", per_cu);
        (void)hipGetLastError();
        grid = cus;
        if (grid != 256) fprintf(stderr, "kernel_launch: note: %d CUs (built for 256)\n", grid);
    }
    if (grid < 0) return;
    if (hipMemsetAsync((char*)d_ws + WS_CTL, 0, CTL_ZERO_BYTES, stream) != hipSuccess) { fprintf(stderr, "kernel_launch: memset failed\n"); return; }
    Args a{};
    for (int i = 0; i < 18; ++i) a.in[i] = d_in[i];
    a.out = (float*)d_out; a.ws = (unsigned char*)d_ws;
#if MK_MULTI
#ifndef MK_MAXPH
#define MK_MAXPH NPHASE
#endif
    for (int k = 0; k < MK_MAXPH; ++k) {
        if (k >= 1) { const int layer = (k - 1) / 13, s = (k - 1) % 13; const bool moe = layer & 1;
            if (s == 4 || (!moe && (s == 7 || s == 10 || s == 11))) continue; }
        a.ph_lo = k; a.ph_hi = k + 1;
        hipLaunchKernelGGL(mk_fwd, dim3(grid), dim3(NWAVES * 64), LDS_BYTES, stream, a);
    }
#ifdef MK_DUMP
    hipLaunchKernelGGL(dump_kernel, dim3(2048), dim3(256), 0, stream, (unsigned char*)d_ws, (float*)d_out, MK_DUMP);
#endif
#else
    a.ph_lo = 0; a.ph_hi = NPHASE;
    hipLaunchKernelGGL(mk_fwd, dim3(grid), dim3(NWAVES * 64), LDS_BYTES, stream, a);
#endif
    const hipError_t le = hipPeekAtLastError();
    if (le != hipSuccess) fprintf(stderr, "kernel_launch: launch failed: %s\n", hipGetErrorName(le));
}
```

```cpp
#include <hip/hip_runtime.h>
#include <hip/hip_bf16.h>
#include <cstdio>
#include <cstdint>
#include <cmath>

#ifndef MK_MULTI
#define MK_MULTI 0
#endif

constexpr int BATCH = 8, SEQ = 4096, DM = 1024, NTOK = BATCH * SEQ, AW = 512, NH = 8;
constexpr int PROJ_TOTAL = 5712, PROJ_PAD = 5888, DFF = 3584, NEXP = 8;
constexpr float LN_EPS = 1e-5f;
constexpr float ALPHA = 1.4142135623730951f;
constexpr float LOG2E = 1.4426950408889634f;
constexpr float C2 = 0.125f * LOG2E;
constexpr int DSA_TOPK = 256;
constexpr int MOE_H2_TILES = 136;
constexpr int MOE_NT_MAX = 264;

constexpr int NWAVES = 8;
constexpr size_t MiB = 1u << 20;
constexpr size_t WS_CTL = 0, CTL_ZERO_BYTES = 64 * 1024;
constexpr size_t WS_WIN = 1 * MiB;
constexpr size_t WIN_STRIDE = (size_t)PROJ_PAD * DM * 2;
constexpr size_t WS_WA = 24 * MiB, WS_WB = 26 * MiB, WS_WOUT = 28 * MiB;
constexpr size_t WS_FGU = 32 * MiB, WS_FD = 46 * MiB;
constexpr size_t WS_CS = 53 * MiB;
constexpr size_t WS_IW = 61 * MiB, WS_LOGF = 62 * MiB, WS_CB = 63 * MiB;
constexpr size_t WS_MOE = 64 * MiB;
constexpr size_t MOE_TOPE = WS_MOE, MOE_TOPG = WS_MOE + 128 * 1024, MOE_TOKSLOT = WS_MOE + 384 * 1024, MOE_SLOTTOK = WS_MOE + 640 * 1024,
                 MOE_SLOTGATE = WS_MOE + 1024 * 1024, MOE_CNT = WS_MOE + 1408 * 1024, MOE_TOT = MOE_CNT + 16 * 1024;
constexpr size_t WS_XS = 66 * MiB;
constexpr size_t WS_DQ = 130 * MiB, WS_DK = 162 * MiB, WS_DV = 194 * MiB, WS_IQ = 226 * MiB, WS_FQ = 258 * MiB, WS_FK = 290 * MiB, WS_FV = 322 * MiB;
constexpr size_t WS_GA = 354 * MiB, WS_GB = 418 * MiB;
constexpr size_t WS_IK = 482 * MiB, WS_MASK = 486 * MiB;
constexpr size_t WS_MERGED = WS_DK;
constexpr size_t WS_H = 130 * MiB;
constexpr size_t WS_H2 = 130 * MiB;
constexpr size_t WS_YB = 368 * MiB;
constexpr size_t WS_MWD = 500 * MiB;
constexpr size_t WS_END = 556 * MiB;
constexpr size_t WS_XS8 = 502 * MiB, WS_XSCALE = 534 * MiB;
constexpr size_t WS_XS8M = 1 * MiB, WS_XSCALEM = 33 * MiB, WS_MGUSC = 34 * MiB, MOE_SLOTSCALE = 35 * MiB;
constexpr size_t WS_WINSC = WS_WIN + 6 * MiB;
constexpr size_t WS_WOSC = WS_WOUT + 3 * MiB;
constexpr size_t WS_MSCALE = 534 * MiB + 256 * 1024;
constexpr size_t WS_H2SCALE = 36 * MiB, WS_MWDSC = 37 * MiB;
constexpr size_t WS_OA8 = 386 * MiB, WS_OB8 = 450 * MiB;
constexpr size_t WS_WABSC = WS_WB;
constexpr size_t WS_FDSC = WS_FD + 4 * MiB;
constexpr size_t WS_FGUSC = WS_FGU + 8 * MiB;
static_assert(WS_MASK + (size_t)NTOK * 128 * 4 <= WS_END && WS_H2 + (size_t)MOE_H2_TILES * 256 * DFF * 2 <= WS_YB && WS_YB + (size_t)MOE_NT_MAX * 256 * DM * 2 <= WS_MWD && WS_MWD + (size_t)NEXP * DM * DFF * 2 <= WS_END, "ws map");
static_assert(WS_WIN + 2 * WIN_STRIDE <= WS_WA && WS_FD + (size_t)DM * DFF * 2 <= WS_CS && WS_H + (size_t)NTOK * DFF * 2 <= WS_GA, "ws map 2");
constexpr int CW_TMO = 0, CW_CODE = 1, CW_BAR = 4096;
constexpr int CW_CMAX = 16384;
constexpr int CW_NORMS = 8192, CW_QCTR = 9216;

constexpr int RING_OFF = 0, RING_BYTES = 131072;
constexpr int IDX_ROWB = 8200;
constexpr int IDX_HIST_OFF = 16 * IDX_ROWB;
constexpr int MISC_OFF = 146432;
constexpr int LDS_BYTES = 147456;
constexpr int WTAB_OFF = 140288;
static_assert(IDX_HIST_OFF + 8 * 1024 <= WTAB_OFF && WTAB_OFF + 256 <= MISC_OFF && MISC_OFF + 128 <= LDS_BYTES, "LDS map");

#define OPQ(x) ({ size_t o_ = (size_t)(x); asm volatile("" : "+s"(o_)); o_; })
#define GAS __attribute__((address_space(1)))
#define LAS __attribute__((address_space(3)))
typedef unsigned short bf16;
typedef unsigned v4u __attribute__((ext_vector_type(4)));
typedef unsigned v2u __attribute__((ext_vector_type(2)));
typedef float f32x4 __attribute__((ext_vector_type(4)));
typedef short bf16x8 __attribute__((ext_vector_type(8)));
typedef GAS unsigned gu32;
#define RLX_AGENT __ATOMIC_RELAXED, __HIP_MEMORY_SCOPE_AGENT
__device__ __forceinline__ unsigned f2bf(float f) { unsigned u = __builtin_bit_cast(unsigned, f); return (u + 0x7fffu + ((u >> 16) & 1u)) >> 16; }
__device__ __forceinline__ unsigned pk2(float lo, float hi) { return f2bf(lo) | (f2bf(hi) << 16); }
__device__ __forceinline__ int mk_lane() { int l; asm volatile("v_mbcnt_lo_u32_b32 %0, -1, 0\n\tv_mbcnt_hi_u32_b32 %0, -1, %0" : "=v"(l)); return l; }

namespace pg8 {
#define PG8_LAS __attribute__((address_space(3)))
typedef unsigned short bf16_t;
typedef short bf16x8 __attribute__((ext_vector_type(8)));
typedef float f32x4 __attribute__((ext_vector_type(4)));
typedef unsigned u32x4 __attribute__((ext_vector_type(4)));
typedef int i32x4 __attribute__((ext_vector_type(4)));
typedef int i32x8 __attribute__((ext_vector_type(8)));
constexpr int BM = 256, BK = 64, HALF = 128, HTB = HALF * BK * 2  , STAGE_BYTES = 8 * HTB, NXCD = 8, WGM = 8;

__host__ __device__ __forceinline__ int lds_byte(int r, int c) { const int st = (r >> 4) * 2 + (c >> 5), rr = r & 15, cc = c & 31, ob = rr * 64 + cc * 2; return st * 1024 + (ob ^ (((ob >> 9) & 1) << 5)); }
__host__ __device__ __forceinline__ void stage_rc(int b, int& R, int& C) { const int st = b / 1024, sb = b % 1024, swz = sb ^ (((sb >> 9) & 1) << 5); R = (st >> 1) * 16 + swz / 64; C = (st & 1) * 32 + (swz % 64) / 2; }
__host__ __device__ __forceinline__ int perm32(int rho) { const int n = rho >> 4, i = rho & 15; return 8 * (i >> 2) + 4 * n + (i & 3); }

struct Unit { int pm, pn; };
struct Gemm { const bf16_t* A; const bf16_t* Bt; int M, N, K; int lda = 0; int wave = 0; };

struct StaticOrder {
    int nM, nN, nwg, G, c;
    __host__ __device__ void init(int M, int N, int G_, int c_) { nM = M / BM; nN = N / BM; nwg = nM * nN; G = G_; c = c_; }
    __host__ __device__ bool next(int i, Unit& u) const {
        const long L = (long)i * G + c; if (L >= nwg) return false;
        int wgid = (int)L; { const int q = nwg / NXCD, r = nwg % NXCD, xcd = wgid % NXCD, off = wgid / NXCD; wgid = (xcd < r ? xcd * (q + 1) : r * (q + 1) + (xcd - r) * q) + off; }
        const int nig = WGM * nN, gid = wgid / nig, fm = gid * WGM, gsz = (nM - fm) < WGM ? (nM - fm) : WGM;
        u.pm = fm + ((wgid % nig) % gsz); u.pn = (wgid % nig) / gsz; return true;
    }
    __device__ __forceinline__ void a_ready(const Unit&) const {}
    __device__ __forceinline__ void done(const Unit&) const {}
};
__device__ __forceinline__ unsigned cvt_pk_bf16(float lo, float hi) { unsigned r; asm volatile("v_cvt_pk_bf16_f32 %0, %1, %2" : "=v"(r) : "v"(lo), "v"(hi)); return r; }
typedef float f32x2 __attribute__((ext_vector_type(2)));
typedef float f32x2z __attribute__((ext_vector_type(2)));
template <bool PERM>
__device__ __forceinline__ void scale_cols(f32x4 (&acc)[2][2][4][2], const Unit& u, const float* sw, int wc, int fq) {
    const float* swp = sw + (size_t)u.pn * BM + wc * 32 + (PERM ? 8 * fq : 4 * fq);
#pragma unroll
    for (int bj = 0; bj < 2; ++bj) { const f32x4 s0 = *(const f32x4*)(swp + bj * HALF), s1 = *(const f32x4*)(swp + bj * HALF + (PERM ? 4 : 16));
#pragma unroll
        for (int ai = 0; ai < 2; ++ai)
#pragma unroll
            for (int m = 0; m < 4; ++m) { acc[ai][bj][m][0] = acc[ai][bj][m][0] * s0; acc[ai][bj][m][1] = acc[ai][bj][m][1] * s1; } }
}
template <bool PERM>
__device__ __forceinline__ void dequant_acc(f32x4 (&acc)[2][2][4][2], const Unit& u, const float* sa, const float* sw, int wr, int wc, int fr, int fq, float ksc = 1.f) {
    const float* sap = sa + u.pm * BM + wr * 64 + fr;
    const float* swp = sw + (size_t)u.pn * BM + wc * 32 + (PERM ? 8 * fq : 4 * fq);
#pragma unroll
    for (int ai = 0; ai < 2; ++ai) {
        float sr[4];
#pragma unroll
        for (int m = 0; m < 4; ++m) sr[m] = sap[ai * HALF + m * 16] * ksc;
#pragma unroll
        for (int bj = 0; bj < 2; ++bj) { const f32x4 s0 = *(const f32x4*)(swp + bj * HALF), s1 = *(const f32x4*)(swp + bj * HALF + (PERM ? 4 : 16));
#pragma unroll
            for (int m = 0; m < 4; ++m) { const i32x4 i0 = __builtin_bit_cast(i32x4, acc[ai][bj][m][0]), i1 = __builtin_bit_cast(i32x4, acc[ai][bj][m][1]); const float s_ = sr[m];
#pragma unroll
                for (int i = 0; i < 4; ++i) { acc[ai][bj][m][0][i] = (float)i0[i] * (s_ * s0[i]); acc[ai][bj][m][1][i] = (float)i1[i] * (s_ * s1[i]); } } }
    }
}
template <class Epi, class Sched, bool ALIGN_EPI = false, bool SP2 = false, bool GATHER = false, bool I8 = false, bool F8 = false>
__device__ __forceinline__ void gemm_phase(PG8_LAS unsigned char* lds, const Gemm g, const Sched& S, const Epi& E) {
    int tid_ = g.wave * 64 + ::mk_lane(); asm volatile("" : "+v"(tid_));
    const int tid = tid_, wid = __builtin_amdgcn_readfirstlane(tid >> 6), lane = tid & 63, wr = wid >> 2, wc = wid & 3, fr = lane & 15, fq = lane >> 4;
    int K_ = g.K; asm volatile("" : "+s"(K_));
    const int K = K_, nt = K / BK; const unsigned lda = g.lda ? (unsigned)g.lda : (unsigned)(K * 2);
    unsigned voffA[2], voffB[2]; int gR[2]; unsigned gC[2];
#pragma unroll
    for (int i = 0; i < 2; ++i) { int R, C; stage_rc(tid * 16 + i * 8192, R, C); const int Rb = Epi::PERM ? ((R & ~31) + perm32(R & 31)) : R;
        voffA[i] = (unsigned)R * lda + (unsigned)C * 2u; voffB[i] = (unsigned)(Rb * K + C) * 2u; gR[i] = R; gC[i] = (unsigned)C * 2u; }
    static_assert(!GATHER || SP2, "gather mode is written for the SP2 loop only");
    unsigned cv[2][2] = {{0u, 0u}, {0u, 0u}}, nv[2][2] = {{0u, 0u}, {0u, 0u}};
    const size_t kstep = (size_t)(BK * 2);
    const size_t hstep = (size_t)HALF * K * 2;
    const size_t tstep = 2 * hstep;
    const size_t hstepA = (size_t)HALF * lda, tstepA = 2 * hstepA;
    const unsigned ldsw = (unsigned)wid * 1024u;
    const int aoff = lds_byte(wr * 64 + fr, fq * 8), boff = lds_byte(wc * 32 + fr, fq * 8);
#define PG8_SA(b, h) (((b) * 2 + (h)) * HTB)
#define PG8_SB(b, h) ((4 + (b) * 2 + (h)) * HTB)
#define PG8_STAGE(bufoff, gbase, voff) do { _Pragma("unroll") for (int _i = 0; _i < 2; ++_i) \
        { unsigned vo_ = (voff)[_i]; asm volatile("" : "+v"(vo_));   \
          __builtin_amdgcn_global_load_lds((const unsigned*)((const char*)(gbase) + vo_), (PG8_LAS unsigned*)(lds + (bufoff) + ldsw + _i * 8192), 16, 0, 0); } } while (0)
#define PG8_STAGE_A(b, h, gbase, VO) do { if constexpr (GATHER) { PG8_STAGE(PG8_SA(b, h), gbase, VO[h]); } else { PG8_STAGE(PG8_SA(b, h), (gbase) + (h) * hstepA, voffA); } } while (0)
#define PG8_CAT(x0, x1) __builtin_shufflevector(__builtin_bit_cast(i32x4, (x0)), __builtin_bit_cast(i32x4, (x1)), 0, 1, 2, 3, 4, 5, 6, 7)
#define PG8_LDA(dst, b, h) do { if constexpr (F8) { _Pragma("unroll") for (int m = 0; m < 4; ++m) dst##8[m] = PG8_CAT(*(const PG8_LAS bf16x8*)(lds + PG8_SA(b, h) + aoff + m * 2048), *(const PG8_LAS bf16x8*)(lds + PG8_SA(b, h) + aoff + m * 2048 + 1024)); } \
    else { _Pragma("unroll") for (int m = 0; m < 4; ++m) { _Pragma("unroll") for (int k = 0; k < 2; ++k) dst[m][k] = *(const PG8_LAS bf16x8*)(lds + PG8_SA(b, h) + aoff + m * 2048 + k * 1024); } } } while (0)
#define PG8_LDB(dst, b, h) do { if constexpr (F8) { _Pragma("unroll") for (int n = 0; n < 2; ++n) dst##8[n] = PG8_CAT(*(const PG8_LAS bf16x8*)(lds + PG8_SB(b, h) + boff + n * 2048), *(const PG8_LAS bf16x8*)(lds + PG8_SB(b, h) + boff + n * 2048 + 1024)); } \
    else { _Pragma("unroll") for (int n = 0; n < 2; ++n) { _Pragma("unroll") for (int k = 0; k < 2; ++k) dst[n][k] = *(const PG8_LAS bf16x8*)(lds + PG8_SB(b, h) + boff + n * 2048 + k * 1024); } } } while (0)
#define PG8_MMA(ai, bj, At, Bt) do { __builtin_amdgcn_s_setprio(1); \
    if constexpr (F8) { _Pragma("unroll") for (int m = 0; m < 4; ++m) { _Pragma("unroll") for (int n = 0; n < 2; ++n) \
        acc[ai][bj][m][n] = __builtin_amdgcn_mfma_scale_f32_16x16x128_f8f6f4(Bt##8[n], At##8[m], acc[ai][bj][m][n], 0, 0, 0, 0x7f7f7f7f, 0, 0x7f7f7f7f); } } \
    else { _Pragma("unroll") for (int m = 0; m < 4; ++m) { _Pragma("unroll") for (int n = 0; n < 2; ++n) { _Pragma("unroll") for (int k = 0; k < 2; ++k) \
        { if constexpr (I8) acc[ai][bj][m][n] = __builtin_bit_cast(f32x4, __builtin_amdgcn_mfma_i32_16x16x64_i8(__builtin_bit_cast(i32x4, Bt[n][k]), __builtin_bit_cast(i32x4, At[m][k]), __builtin_bit_cast(i32x4, acc[ai][bj][m][n]), 0, 0, 0)); \
          else acc[ai][bj][m][n] = __builtin_amdgcn_mfma_f32_16x16x32_bf16(Bt[n][k], At[m][k], acc[ai][bj][m][n], 0, 0, 0); } } } } \
    __builtin_amdgcn_s_setprio(0); } while (0)
#define PG8_WAIT_V(n) asm volatile("s_waitcnt vmcnt(" #n ")" ::: "memory")
#define PG8_WAIT_L(n) asm volatile("s_waitcnt lgkmcnt(" #n ")" ::: "memory")
#define PG8_BAR __builtin_amdgcn_s_barrier()
#define PG8_SCHED __builtin_amdgcn_sched_barrier(0)
#ifdef KDUP
    constexpr bool KD = I8;
#else
    constexpr bool KD = false;
#endif
#define PG8_SNEXT(i, u) (KD ? S.next((i) >> 1, (u)) : S.next((i), (u)))
    Unit cur, nxt; int ui = 0;
    if (!PG8_SNEXT(0, cur)) return;
    cur.pm = __builtin_amdgcn_readfirstlane(cur.pm); cur.pn = __builtin_amdgcn_readfirstlane(cur.pn);
    f32x4 acc[2][2][4][2];
#pragma unroll
    for (int a = 0; a < 2; ++a)
#pragma unroll
        for (int b = 0; b < 2; ++b)
#pragma unroll
            for (int m = 0; m < 4; ++m)
#pragma unroll
                for (int n = 0; n < 2; ++n) acc[a][b][m][n] = (f32x4){0.f, 0.f, 0.f, 0.f};
    bf16x8 At[4][2], B0[2][2], B1[2][2]; i32x8 At8[4], B08[2], B18[2];
    const char* cA = (const char*)g.A + (GATHER ? (size_t)0 : (size_t)cur.pm * tstepA);
    if constexpr (GATHER) {
#pragma unroll
        for (int h = 0; h < 2; ++h)
#pragma unroll
            for (int i = 0; i < 2; ++i) { cv[h][i] = (unsigned)S.arow(cur, h * HALF + gR[i]) * lda + gC[i]; nv[h][i] = cv[h][i]; } } const char* cB = (const char*)g.Bt + (size_t)cur.pn * tstep;
    S.a_ready(cur);
    if constexpr (SP2) {
        PG8_STAGE(PG8_SB(0, 0), cB, voffB); PG8_STAGE(PG8_SB(0, 1), cB + hstep, voffB); PG8_STAGE_A(0, 0, cA, cv); PG8_STAGE_A(0, 1, cA, cv);
        if (wr == 1) PG8_BAR;
        PG8_WAIT_V(2); PG8_BAR;
        PG8_STAGE(PG8_SB(1, 0), cB + kstep, voffB); PG8_STAGE_A(1, 0, cA + kstep, cv); PG8_STAGE(PG8_SB(1, 1), cB + hstep + kstep, voffB);
        PG8_WAIT_V(6); PG8_BAR;
    } else {
        PG8_STAGE(PG8_SB(0, 0), cB, voffB); PG8_STAGE(PG8_SA(0, 0), cA, voffA); PG8_STAGE(PG8_SB(0, 1), cB + hstep, voffB); PG8_STAGE(PG8_SA(0, 1), cA + hstepA, voffA);
        if (wr == 1) PG8_BAR;
        PG8_WAIT_V(4); PG8_BAR;
        PG8_STAGE(PG8_SB(1, 0), cB + kstep, voffB); PG8_STAGE_A(1, 0, cA + kstep, cv); PG8_STAGE(PG8_SB(1, 1), cB + hstep + kstep, voffB);
        PG8_WAIT_V(6); PG8_BAR;
    }
    for (;;) {
        const bool has_next = PG8_SNEXT(ui + 1, nxt);
        nxt.pm = __builtin_amdgcn_readfirstlane(nxt.pm); nxt.pn = __builtin_amdgcn_readfirstlane(nxt.pn);
        const char* nA = (has_next && !GATHER) ? (const char*)g.A + (size_t)nxt.pm * tstepA : cA;
        if constexpr (GATHER) { if (has_next) {
#pragma unroll
            for (int h = 0; h < 2; ++h)
#pragma unroll
                for (int i = 0; i < 2; ++i) { int t2_ = tid; asm volatile("" : "+v"(t2_)); int R_, C_; stage_rc(t2_ * 16 + i * 8192, R_, C_);
                    nv[h][i] = (unsigned)S.arow(nxt, h * HALF + R_) * lda + (unsigned)C_ * 2u; } } } const char* nB = has_next ? (const char*)g.Bt + (size_t)nxt.pn * tstep : cB;
        for (int t = 0; t < nt; t += 2) {
            const bool last = (t == nt - 2);
            const char* a1 = cA + (size_t)(t + 1) * kstep;
            const char* a2 = last ? nA : cA + (size_t)(t + 2) * kstep; const char* b2 = last ? nB : cB + (size_t)(t + 2) * kstep;
            const char* a3 = a2 + kstep; const char* b3 = b2 + kstep;
            if (last && has_next) S.a_ready(nxt);
            unsigned v2[2][2];
#pragma unroll
            for (int h = 0; h < 2; ++h)
#pragma unroll
                for (int i = 0; i < 2; ++i) v2[h][i] = last ? nv[h][i] : cv[h][i];
            if constexpr (SP2) {
            PG8_LDB(B0, 0, 0); PG8_LDB(B1, 0, 1); PG8_SCHED; PG8_LDA(At, 0, 0); PG8_STAGE_A(1, 1, a1, cv);
            PG8_WAIT_V(8); PG8_WAIT_L(0); PG8_BAR; PG8_MMA(0, 0, At, B0); PG8_MMA(0, 1, At, B1); PG8_BAR; PG8_SCHED;
            PG8_LDA(At, 0, 1); PG8_STAGE(PG8_SB(0, 0), b2, voffB); PG8_STAGE(PG8_SB(0, 1), b2 + hstep, voffB); PG8_STAGE_A(0, 0, a2, v2);
            PG8_WAIT_V(8); PG8_WAIT_L(0); PG8_BAR; PG8_MMA(1, 0, At, B0); PG8_MMA(1, 1, At, B1); PG8_BAR; PG8_SCHED;
            PG8_LDB(B0, 1, 0); PG8_LDB(B1, 1, 1); PG8_SCHED; PG8_LDA(At, 1, 0); PG8_STAGE_A(0, 1, a2, v2);
            PG8_WAIT_V(8); PG8_WAIT_L(0); PG8_BAR; PG8_MMA(0, 0, At, B0); PG8_MMA(0, 1, At, B1); PG8_BAR; PG8_SCHED;
            PG8_LDA(At, 1, 1); PG8_STAGE(PG8_SB(1, 0), b3, voffB); PG8_STAGE(PG8_SB(1, 1), b3 + hstep, voffB); PG8_STAGE_A(1, 0, a3, v2);
            PG8_WAIT_V(8); PG8_WAIT_L(0); PG8_BAR; PG8_MMA(1, 0, At, B0); PG8_MMA(1, 1, At, B1); PG8_BAR; PG8_SCHED;
            } else {
            PG8_LDB(B0, 0, 0); PG8_SCHED; PG8_LDA(At, 0, 0); PG8_STAGE(PG8_SA(1, 1), a1 + hstepA, voffA);
            PG8_WAIT_L(8); PG8_BAR; PG8_WAIT_L(0); PG8_MMA(0, 0, At, B0); PG8_BAR; PG8_SCHED;
            PG8_LDB(B1, 0, 1); PG8_STAGE(PG8_SB(0, 0), b2, voffB);
            PG8_BAR; PG8_WAIT_L(0); PG8_MMA(0, 1, At, B1); PG8_BAR;
            PG8_LDA(At, 0, 1); PG8_STAGE(PG8_SA(0, 0), a2, voffA);
            PG8_BAR; PG8_WAIT_L(0); PG8_MMA(1, 0, At, B0); PG8_BAR; PG8_SCHED;
            PG8_STAGE(PG8_SB(0, 1), b2 + hstep, voffB);
            PG8_WAIT_V(6); PG8_BAR; PG8_MMA(1, 1, At, B1); PG8_BAR;
            PG8_LDB(B0, 1, 0); PG8_SCHED; PG8_LDA(At, 1, 0); PG8_STAGE(PG8_SA(0, 1), a2 + hstepA, voffA);
            PG8_WAIT_L(8); PG8_BAR; PG8_WAIT_L(0); PG8_MMA(0, 0, At, B0); PG8_BAR; PG8_SCHED;
            PG8_LDB(B1, 1, 1); PG8_STAGE(PG8_SB(1, 0), b3, voffB);
            PG8_BAR; PG8_WAIT_L(0); PG8_MMA(0, 1, At, B1); PG8_BAR;
            PG8_LDA(At, 1, 1); PG8_STAGE(PG8_SA(1, 0), a3, voffA);
            PG8_BAR; PG8_WAIT_L(0); PG8_MMA(1, 0, At, B0); PG8_BAR; PG8_SCHED;
            PG8_STAGE(PG8_SB(1, 1), b3 + hstep, voffB);
            PG8_WAIT_V(6); PG8_BAR; PG8_MMA(1, 1, At, B1); PG8_BAR;
            }
        }
        if constexpr (ALIGN_EPI) { if (wr == 0) PG8_BAR; }
        const bool do_epi = !KD || (ui & 1);
        Unit cu_ = cur; cu_.pm = __builtin_amdgcn_readfirstlane(cur.pm); cu_.pn = __builtin_amdgcn_readfirstlane(cur.pn);
        int te_ = ::mk_lane(); asm volatile("" : "+v"(te_)); const int fr_e = te_ & 15, fq_e = (te_ & 63) >> 4;
        if (do_epi) { if constexpr (F8) { if constexpr (Epi::DEQ) scale_cols<Epi::PERM>(acc, cu_, E.sw, wc, fq_e); }
            if constexpr (I8) { if constexpr (Epi::DEQ) dequant_acc<Epi::PERM>(acc, cu_, E.sa_of(cu_), E.sw, wr, wc, fr_e, fq_e, KD ? 0.5f : 1.f); }
        if constexpr (!Epi::AFTER_DRAIN) { E(acc, cu_, wr, wc, fr_e, fq_e);
#ifdef EPI_REP
            if constexpr (I8 && !GATHER) { asm volatile("" ::: "memory"); E(acc, cu_, wr, wc, fr_e, fq_e); }
#endif
            S.done(cur); } }
        if (!has_next) break;
        if (do_epi) {
#pragma unroll
        for (int a = 0; a < 2; ++a)
#pragma unroll
            for (int b = 0; b < 2; ++b)
#pragma unroll
                for (int m = 0; m < 4; ++m)
#pragma unroll
                    for (int n = 0; n < 2; ++n) { f32x2z lo_, hi_; asm volatile("v_mov_b64 %0, 0" : "=v"(lo_)); asm volatile("v_mov_b64 %0, 0" : "=v"(hi_));
                        acc[a][b][m][n] = (f32x4){lo_[0], lo_[1], hi_[0], hi_[1]}; }
        }
        cur = nxt; cA = nA; cB = nB; ++ui;
        if constexpr (GATHER) {
#pragma unroll
            for (int h = 0; h < 2; ++h)
#pragma unroll
                for (int i = 0; i < 2; ++i) cv[h][i] = nv[h][i]; }
        if constexpr (ALIGN_EPI) { if (wr == 1) PG8_BAR; }
    }
    PG8_WAIT_V(0);
    if constexpr (!ALIGN_EPI) { if (wr == 0) PG8_BAR; }
    PG8_BAR;
    if constexpr (Epi::AFTER_DRAIN) { E.fused(acc, cur, wr, wc, fr, fq, lds, wid, lane); S.done(cur); }
#undef PG8_SNEXT
#undef PG8_SA
#undef PG8_SB
#undef PG8_STAGE
#undef PG8_STAGE_A
#undef PG8_LDA
#undef PG8_LDB
#undef PG8_MMA
#undef PG8_CAT
#undef PG8_WAIT_V
#undef PG8_WAIT_L
#undef PG8_BAR
#undef PG8_SCHED
}
}
namespace pg8 {
typedef unsigned u32x2 __attribute__((ext_vector_type(2)));
__device__ __forceinline__ float bf2f(unsigned h16) { return __uint_as_float(h16 << 16); }
constexpr float HSC = 8.f, MSC = 16.f, OSC = 64.f, F8MAX = 440.f;
__device__ __forceinline__ float sigmoidf_fast(float x) { return __builtin_amdgcn_rcpf(1.0f + __builtin_amdgcn_exp2f(-x * 1.4426950408889634f)); }
typedef float f32x2c __attribute__((ext_vector_type(2))); typedef __bf16 bf16x2c __attribute__((ext_vector_type(2)));
__device__ __forceinline__ unsigned cvt2(float lo, float hi) { f32x2c v = {lo, hi}; bf16x2c b = __builtin_convertvector(v, bf16x2c); return __builtin_bit_cast(unsigned, b); }
__device__ __forceinline__ u32x4 pack8(const f32x4& a, const f32x4& b) { u32x4 w; w.x = cvt2(a[0], a[1]); w.y = cvt2(a[2], a[3]); w.z = cvt2(b[0], b[1]); w.w = cvt2(b[2], b[3]); return w; }
__device__ __forceinline__ void unpack8(const u32x4& w, f32x4& a, f32x4& b) {
    a[0] = bf2f(w.x & 0xffffu); a[1] = __uint_as_float(w.x & 0xffff0000u); a[2] = bf2f(w.y & 0xffffu); a[3] = __uint_as_float(w.y & 0xffff0000u);
    b[0] = bf2f(w.z & 0xffffu); b[1] = __uint_as_float(w.z & 0xffff0000u); b[2] = bf2f(w.w & 0xffffu); b[3] = __uint_as_float(w.w & 0xffff0000u); }

#ifdef DBG_NOSIG
#define SIGF(x) (x)
#else
#define SIGF(x) sigmoidf_fast(x)
#endif
#ifdef GATE_SIG_IN_D1
#define SIGP(x) (x)
#else
#define SIGP(x) SIGF(x)
#endif
#define GATE255(x) __builtin_amdgcn_rcpf(__builtin_fmaf(__builtin_amdgcn_exp2f(x), 1.0f / 255.0f, 1.0f / 255.0f))
struct EpiProj {
    static constexpr bool PERM = true, AFTER_DRAIN = false;
    unsigned char* ws; const float* bforget;
    __device__ __forceinline__ void operator()(const f32x4 (&acc)[2][2][4][2], const Unit& u, int wr, int wc, int fr, int fq) const {
        const int pn = u.pn; const int row0 = u.pm * BM + wr * 64 + fr;
        bf16_t *DQ = (bf16_t*)(ws + OPQ(WS_DQ)), *DK = (bf16_t*)(ws + OPQ(WS_DK)), *DV = (bf16_t*)(ws + OPQ(WS_DV)), *IQ = (bf16_t*)(ws + OPQ(WS_IQ)), *FQ = (bf16_t*)(ws + OPQ(WS_FQ)), *FK = (bf16_t*)(ws + OPQ(WS_FK)), *FV = (bf16_t*)(ws + OPQ(WS_FV));
        bf16_t *GA = (bf16_t*)(ws + OPQ(WS_GA)), *GB = (bf16_t*)(ws + OPQ(WS_GB)), *IK = (bf16_t*)(ws + OPQ(WS_IK)); float *IW = (float*)(ws + OPQ(WS_IW)), *LOGF = (float*)(ws + OPQ(WS_LOGF)); const float* CS = (const float*)(ws + OPQ(WS_CS));
        const bool rot = (pn < 4) || pn == 6 || pn == 7 || (pn == 22 && wc == 0);
        if (rot) {
            bf16_t* dst; int pitch, col1; float sc = 1.f;
            if (pn == 22) { dst = IK; pitch = 64; col1 = 8 * fq; }
            else { dst = pn < 2 ? DQ : (pn < 4 ? DK : IQ); pitch = AW; col1 = (4 * (pn & 1) + wc) * 64 + 8 * fq; if (pn < 2) sc = C2; }
#pragma unroll
            for (int ai = 0; ai < 2; ++ai)
#pragma unroll
                for (int m = 0; m < 4; ++m) {
                    const int row = row0 + ai * HALF + m * 16;
                    const float* cs = CS + (size_t)row * 64 + 16 * fq;
                    const f32x4 t0 = *(const f32x4*)(cs), t1 = *(const f32x4*)(cs + 4), t2 = *(const f32x4*)(cs + 8), t3 = *(const f32x4*)(cs + 12);
                    const f32x4 xa = acc[ai][0][m][0], xb = acc[ai][0][m][1], ya = acc[ai][1][m][0], yb = acc[ai][1][m][1];
                    f32x4 o1a, o1b, o2a, o2b;
                    o1a[0] = (xa[0] * t0[0] - ya[0] * t0[1]) * sc; o2a[0] = (ya[0] * t0[0] + xa[0] * t0[1]) * sc;
                    o1a[1] = (xa[1] * t0[2] - ya[1] * t0[3]) * sc; o2a[1] = (ya[1] * t0[2] + xa[1] * t0[3]) * sc;
                    o1a[2] = (xa[2] * t1[0] - ya[2] * t1[1]) * sc; o2a[2] = (ya[2] * t1[0] + xa[2] * t1[1]) * sc;
                    o1a[3] = (xa[3] * t1[2] - ya[3] * t1[3]) * sc; o2a[3] = (ya[3] * t1[2] + xa[3] * t1[3]) * sc;
                    o1b[0] = (xb[0] * t2[0] - yb[0] * t2[1]) * sc; o2b[0] = (yb[0] * t2[0] + xb[0] * t2[1]) * sc;
                    o1b[1] = (xb[1] * t2[2] - yb[1] * t2[3]) * sc; o2b[1] = (yb[1] * t2[2] + xb[1] * t2[3]) * sc;
                    o1b[2] = (xb[2] * t3[0] - yb[2] * t3[1]) * sc; o2b[2] = (yb[2] * t3[0] + xb[2] * t3[1]) * sc;
                    o1b[3] = (xb[3] * t3[2] - yb[3] * t3[3]) * sc; o2b[3] = (yb[3] * t3[2] + xb[3] * t3[3]) * sc;
                    bf16_t* rp = dst + (size_t)row * pitch + col1;
                    *(u32x4*)(rp) = pack8(o1a, o1b); *(u32x4*)(rp + 32) = pack8(o2a, o2b);
                }
        } else if (pn == 22) {
            if (fq == 0 && (wc == 1 || wc == 2)) {
                f32x4 b0 = {0.f, 0.f, 0.f, 0.f}, b1 = {0.f, 0.f, 0.f, 0.f};
                if (wc == 2) { b0 = *(const f32x4*)(bforget); b1 = *(const f32x4*)(bforget + 4); }
#pragma unroll
                for (int ai = 0; ai < 2; ++ai)
#pragma unroll
                    for (int m = 0; m < 4; ++m) {
                        const int row = row0 + ai * HALF + m * 16;
                        f32x4 va = acc[ai][0][m][0], vb = acc[ai][0][m][1];
                        if (wc == 1) { va = va * 0.04419417382415922f; vb = vb * 0.04419417382415922f;
                            *(f32x4*)(IW + (size_t)row * 8) = va; *(f32x4*)(IW + (size_t)row * 8 + 4) = vb; }
                        else { va = va + b0; vb = vb + b1; f32x4 la, lb;
#pragma unroll
                            for (int i = 0; i < 4; ++i) { const float za = va[i], zb = vb[i];
                                la[i] = fminf(za, 0.f) - log1pf(__expf(-fabsf(za))); lb[i] = fminf(zb, 0.f) - log1pf(__expf(-fabsf(zb))); }
                            float* lp = LOGF + (size_t)(row >> 12) * (NH * SEQ) + (row & (SEQ - 1));
                            lp[0] = la[0]; lp[SEQ] = la[1]; lp[2 * SEQ] = la[2]; lp[3 * SEQ] = la[3]; lp[4 * SEQ] = lb[0]; lp[5 * SEQ] = lb[1]; lp[6 * SEQ] = lb[2]; lp[7 * SEQ] = lb[3]; }
                    }
            }
        } else if (pn < 14) {
            bf16_t* dst = pn < 6 ? DV : (pn < 10 ? FQ : (pn < 12 ? FK : FV)); const float sc = (pn == 8 || pn == 9) ? C2 : 1.f;
            const int col0 = 256 * (pn & 1) + wc * 32 + 8 * fq;
#pragma unroll
            for (int ai = 0; ai < 2; ++ai)
#pragma unroll
                for (int m = 0; m < 4; ++m) { bf16_t* rp = dst + (size_t)(row0 + ai * HALF + m * 16) * AW + col0;
#pragma unroll
                    for (int bj = 0; bj < 2; ++bj) *(u32x4*)(rp + bj * HALF) = pack8(acc[ai][bj][m][0] * sc, acc[ai][bj][m][1] * sc); }
        } else {
            unsigned char* dst = (unsigned char*)(pn < 18 ? GA : GB); const int col0 = 256 * ((pn - 14) & 3) + wc * 32 + 8 * fq;
#pragma unroll
            for (int ai = 0; ai < 2; ++ai)
#pragma unroll
                for (int m = 0; m < 4; ++m) { unsigned char* rp = dst + (size_t)(row0 + ai * HALF + m * 16) * DM + col0;
#pragma unroll
                    for (int bj = 0; bj < 2; ++bj) { const f32x4 a = acc[ai][bj][m][0], b = acc[ai][bj][m][1]; u32x2 o = {0u, 0u};
#pragma unroll
                        for (int i = 0; i < 4; ++i) { o.x = __builtin_amdgcn_cvt_pk_u8_f32(GATE255(a[i]), i, o.x); o.y = __builtin_amdgcn_cvt_pk_u8_f32(GATE255(b[i]), i, o.y); }
                        *(u32x2*)(rp + bj * HALF) = o; } }
        }
    }
};
struct EpiProj8 : EpiProj { static constexpr bool DEQ = true; const float* sa; const float* sw; __device__ __forceinline__ const float* sa_of(const Unit&) const { return sa; } };

struct EpiGate2 {
    static constexpr bool PERM = true, AFTER_DRAIN = false, DEQ = true;
    bf16_t* O; const bf16_t* GAp; const bf16_t* GBp; unsigned char* O8; const float* sw;
    __device__ __forceinline__ void operator()(const f32x4 (&acc)[2][2][4][2], const Unit& u, int wr, int wc, int fr, int fq) const {
        const int br = u.pm >> 9; const bf16_t* G = br ? GBp : GAp;
        const int row0 = (u.pm & 511) * BM + wr * 64 + fr, col0 = (u.pn & 7) * BM + wc * 32 + 8 * fq;
        u32x2 gv[4][2];
#pragma unroll
        for (int am = 0; am < 4; ++am) {
            const int ai = am >> 1;
            if ((am & 1) == 0) {
#pragma unroll
                for (int m = 0; m < 4; ++m)
#pragma unroll
                    for (int bj = 0; bj < 2; ++bj) gv[m][bj] = *(const u32x2*)((const unsigned char*)G + (size_t)(row0 + ai * HALF + m * 16) * DM + col0 + bj * HALF);
            }
            u32x4 pv_[4][2];
#pragma unroll
            for (int m = 2 * (am & 1); m < 2 * (am & 1) + 2; ++m)
#pragma unroll
                for (int bj = 0; bj < 2; ++bj) { const size_t off = (size_t)(row0 + ai * HALF + m * 16) * DM + col0 + bj * HALF;
                    pv_[m][bj] = br ? *(const u32x4*)(O + off) : (u32x4){0u, 0u, 0u, 0u}; }
#pragma unroll
            for (int m = 2 * (am & 1); m < 2 * (am & 1) + 2; ++m)
#pragma unroll
                for (int bj = 0; bj < 2; ++bj) { const size_t off = (size_t)(row0 + ai * HALF + m * 16) * DM + col0 + bj * HALF;
                    f32x4 ga, gb, pa, pb; unpack8(pv_[m][bj], pa, pb);
#pragma unroll
                    for (int i = 0; i < 4; ++i) { ga[i] = (float)((gv[m][bj].x >> (8 * i)) & 255u) * (1.f / 255.f); gb[i] = (float)((gv[m][bj].y >> (8 * i)) & 255u) * (1.f / 255.f); }
                    const f32x4 ra = ga * acc[ai][bj][m][0] + pa, rb = gb * acc[ai][bj][m][1] + pb;
                    if (br == 0) *(u32x4*)(O + off) = pack8(ra, rb);
                    else { f32x4 a, b;
#pragma unroll
                        for (int i = 0; i < 4; ++i) { a[i] = __builtin_amdgcn_fmed3f(ra[i] * MSC, -F8MAX, F8MAX); b[i] = __builtin_amdgcn_fmed3f(rb[i] * MSC, -F8MAX, F8MAX); }
                        u32x2 o; int w0 = __builtin_amdgcn_cvt_pk_fp8_f32(a[0], a[1], 0, false); w0 = __builtin_amdgcn_cvt_pk_fp8_f32(a[2], a[3], w0, true);
                        int w1 = __builtin_amdgcn_cvt_pk_fp8_f32(b[0], b[1], 0, false); w1 = __builtin_amdgcn_cvt_pk_fp8_f32(b[2], b[3], w1, true);
                        o.x = (unsigned)w0; o.y = (unsigned)w1; *(u32x2*)(O8 + off) = o; } }
        }
    }
};
struct D1Order {
    StaticOrder S; int n;
    __device__ __forceinline__ void init(int M, int N, int G, int c) { S.init(M, N, G, c); n = (S.nwg - c + G - 1) / G; if (n < 0) n = 0; }
    __device__ __forceinline__ bool next(int i, Unit& u) const { if (i >= 2 * n) return false; const int br = (i >= n) ? 1 : 0; S.next(i - br * n, u); u.pm += 512 * br; u.pn += 8 * br; return true; }
    __device__ __forceinline__ void a_ready(const Unit&) const {}
    __device__ __forceinline__ void done(const Unit&) const {}
};

struct EpiY {
    static constexpr bool PERM = false, AFTER_DRAIN = false;
    bf16_t* Y; const bf16_t* R;
    __device__ __forceinline__ void operator()(const f32x4 (&acc)[2][2][4][2], const Unit& u, int wr, int wc, int fr, int fq) const {
        const int row0 = u.pm * BM + wr * 64 + fr, col0 = u.pn * BM + wc * 32 + 4 * fq;
#pragma unroll
        for (int ai = 0; ai < 2; ++ai)
#pragma unroll
            for (int mp = 0; mp < 2; ++mp) {
                u32x2 r[2][2][2];
#pragma unroll
                for (int mm = 0; mm < 2; ++mm)
#pragma unroll
                    for (int bj = 0; bj < 2; ++bj)
#pragma unroll
                        for (int n = 0; n < 2; ++n) r[mm][bj][n] = *(const u32x2*)(R + (size_t)(row0 + ai * HALF + (2 * mp + mm) * 16) * DM + col0 + bj * HALF + n * 16);
#pragma unroll
                for (int mm = 0; mm < 2; ++mm)
#pragma unroll
                    for (int bj = 0; bj < 2; ++bj)
#pragma unroll
                        for (int n = 0; n < 2; ++n) { const u32x2 w = r[mm][bj][n]; f32x4 rv;
                            rv[0] = bf2f(w.x & 0xffffu); rv[1] = __uint_as_float(w.x & 0xffff0000u); rv[2] = bf2f(w.y & 0xffffu); rv[3] = __uint_as_float(w.y & 0xffff0000u);
                            const f32x4 o = rv * ALPHA + acc[ai][bj][2 * mp + mm][n]; u32x2 ob; ob.x = cvt2(o[0], o[1]); ob.y = cvt2(o[2], o[3]);
                            *(u32x2*)(Y + (size_t)(row0 + ai * HALF + (2 * mp + mm) * 16) * DM + col0 + bj * HALF + n * 16) = ob; }
            }
    }
};
struct EpiYF8 : EpiY { static constexpr bool DEQ = true; const float* sw; };
struct EpiY8 : EpiY { static constexpr bool DEQ = true; const float* sa; const float* sw; __device__ __forceinline__ const float* sa_of(const Unit&) const { return sa; } };

struct EpiSwiglu {
    static constexpr bool PERM = true, AFTER_DRAIN = false;
    bf16_t* H; int nc;
    __device__ __forceinline__ void operator()(const f32x4 (&acc)[2][2][4][2], const Unit& u, int wr, int wc, int fr, int fq) const {
        const int row0 = u.pm * BM + wr * 64 + fr, col0 = (u.pn % nc) * HALF + wc * 32 + 8 * fq;
#pragma unroll
        for (int ai = 0; ai < 2; ++ai)
#pragma unroll
            for (int m = 0; m < 4; ++m) { f32x4 a, b;
#pragma unroll
                for (int i = 0; i < 4; ++i) { const float g0 = acc[ai][0][m][0][i], g1 = acc[ai][0][m][1][i];
#ifdef SWIGLU_PROBE
                    float t0 = g0, t1 = g1; asm volatile("" : "+v"(t0), "+v"(t1));
                    a[i] = g0 * (0.5f * (sigmoidf_fast(g0) + sigmoidf_fast(t0))) * acc[ai][1][m][0][i]; b[i] = g1 * (0.5f * (sigmoidf_fast(g1) + sigmoidf_fast(t1))) * acc[ai][1][m][1][i]; }
#else
                    a[i] = g0 * sigmoidf_fast(g0) * acc[ai][1][m][0][i]; b[i] = g1 * sigmoidf_fast(g1) * acc[ai][1][m][1][i]; }
#endif
                *(u32x4*)(H + (size_t)(row0 + ai * HALF + m * 16) * DFF + col0) = pack8(a, b); }
    }
};

struct EpiSwigluQ {
    static constexpr bool PERM = true, AFTER_DRAIN = false;
    unsigned char* H; int nc;
    __device__ __forceinline__ void operator()(const f32x4 (&acc)[2][2][4][2], const Unit& u, int wr, int wc, int fr, int fq) const {
        const int row0 = u.pm * BM + wr * 64 + fr, col0 = (u.pn % nc) * HALF + wc * 32 + 8 * fq;
#pragma unroll
        for (int ai = 0; ai < 2; ++ai)
#pragma unroll
            for (int m = 0; m < 4; ++m) { f32x4 a, b;
#pragma unroll
                for (int i = 0; i < 4; ++i) { const float g0 = acc[ai][0][m][0][i], g1 = acc[ai][0][m][1][i];
                    a[i] = g0 * sigmoidf_fast(g0) * acc[ai][1][m][0][i]; b[i] = g1 * sigmoidf_fast(g1) * acc[ai][1][m][1][i]; }
#pragma unroll
                for (int i = 0; i < 4; ++i) { a[i] = __builtin_amdgcn_fmed3f(a[i], -F8MAX, F8MAX); b[i] = __builtin_amdgcn_fmed3f(b[i], -F8MAX, F8MAX); }
                u32x2 o; int w0 = __builtin_amdgcn_cvt_pk_fp8_f32(a[0], a[1], 0, false); w0 = __builtin_amdgcn_cvt_pk_fp8_f32(a[2], a[3], w0, true);
                int w1 = __builtin_amdgcn_cvt_pk_fp8_f32(b[0], b[1], 0, false); w1 = __builtin_amdgcn_cvt_pk_fp8_f32(b[2], b[3], w1, true);
                o.x = (unsigned)w0; o.y = (unsigned)w1;
                *(u32x2*)(H + (size_t)(row0 + ai * HALF + m * 16) * DFF + col0) = o; }
    }
};
struct EpiSwiglu8 : EpiSwigluQ {
    static constexpr bool DEQ = true;
    const float* sa; const float* sw; int gbase;
    __device__ __forceinline__ const float* sa_of(const Unit& u) const { return sa + (size_t)((u.pm >= 128) ? 128 : gbase) * BM; }
};

struct EpiDownMoe {
    static constexpr bool PERM = true, AFTER_DRAIN = false;
    bf16_t* YB; const float* gate; int gbase;
    __device__ __forceinline__ void operator()(const f32x4 (&acc)[2][2][4][2], const Unit& u, int wr, int wc, int fr, int fq) const {
        const int gt = u.pm + ((u.pm >= 128) ? 128 : gbase);
        const int row0 = gt * BM + wr * 64 + fr, col0 = (u.pn & 3) * BM + wc * 32 + 8 * fq;
#pragma unroll
        for (int ai = 0; ai < 2; ++ai)
#pragma unroll
            for (int m = 0; m < 4; ++m) { const int row = row0 + ai * HALF + m * 16; const float gt_ = gate[row]; bf16_t* rp = YB + (size_t)row * DM + col0;
#pragma unroll
                for (int bj = 0; bj < 2; ++bj) *(u32x4*)(rp + bj * HALF) = pack8(acc[ai][bj][m][0] * gt_, acc[ai][bj][m][1] * gt_); }
    }
};
struct EpiDownMoeF8 : EpiDownMoe { static constexpr bool DEQ = true; const float* sw; };
struct EpiDownMoe8 : EpiDownMoe { static constexpr bool DEQ = true; const float* sa; const float* sw; __device__ __forceinline__ const float* sa_of(const Unit&) const { return sa; } };

struct MoeOrder {
    int cum[8]; int nc, G, c; const int* slot_tok; int mode, nrows, nmain, gbase, ut, y;
    __device__ __forceinline__ int gtile(int l) const { return l + ((l >= 128) ? 128 : gbase); }
    __device__ __forceinline__ bool next(int i, Unit& u) const {
        int l, pn;
        if (mode == 0) { if (nrows <= 0) return false;
            StaticOrder S; S.nM = nrows; S.nN = nc; S.nwg = nrows * nc; S.G = G; S.c = c; Unit v; if (!S.next(i, v)) return false;
            l = (v.pm < nmain) ? v.pm : 128 + (v.pm - nmain); pn = v.pn;
        } else if (mode == 1) { const int pool = nrows * nc; int L;
            if (c < ut) { if (i >= y) return false; L = c * y + i; } else L = y * ut + (c - ut) + i * (G - ut);
            if (L >= pool) return false; l = L / nc; pn = L - l * nc;
        } else { if (i != 0 || c >= ut) return false; l = 128 + (c >> 2); pn = c & 3; }
        const int tg = gtile(l); int e = 0;
#pragma unroll
        for (int j = 0; j < 7; ++j) e += (tg >= cum[j]) ? 1 : 0;
        u.pm = l; u.pn = e * nc + pn; return true;
    }
    __device__ __forceinline__ int arow(const Unit& u, int r) const { return slot_tok[gtile(u.pm) * BM + r]; }
    __device__ __forceinline__ void a_ready(const Unit&) const {}
    __device__ __forceinline__ void done(const Unit&) const {}
};
}

namespace attn_body {
using bf16 = unsigned short;
using bf16x8 = __attribute__((ext_vector_type(8))) short;
using s16x4 = __attribute__((ext_vector_type(4))) short;
using f32x16 = __attribute__((ext_vector_type(16))) float;
using f32x4a = __attribute__((ext_vector_type(4))) float;
using u32x4 = __attribute__((ext_vector_type(4))) unsigned;
using u32x2 = __attribute__((ext_vector_type(2))) unsigned;
#define ALAS __attribute__((address_space(3)))
constexpr int NW = 8, QBLK = 32, QB = QBLK * NW, KVBLK = 64;
constexpr int NSLOT = 3, SLOTB = 8192;
constexpr int LDS_K = 0, LDS_V = NSLOT * SLOTB, LDS_WS = 2 * NSLOT * SLOTB, LDS_OST = LDS_WS + NW * 64 * 4, LDS_BIAS = LDS_OST + NW * 4096, LDS_M = LDS_BIAS + 16384, LDS_BYTES = LDS_M + NW * 1024;
__device__ __forceinline__ int crow(int r, int hi) { return (r & 3) + 8 * (r >> 2) + 4 * hi; }
#define SBAR() __builtin_amdgcn_sched_barrier(0)
__device__ __forceinline__ void cmask(f32x16& p0, f32x16& p1, int jb, int qrel, int hi) {
    const float NEG = -INFINITY; const int kb = 64 * jb + 4 * hi;
#pragma unroll
    for (int r = 0; r < 16; ++r) { const int kv = kb + (r & 3) + 8 * (r >> 2); if (kv > qrel) p0[r] = NEG; if (kv + 32 > qrel) p1[r] = NEG; }
}
__device__ __forceinline__ void glds16(const void* gsrc, unsigned lds_dst) { unsigned keep;
    asm volatile("s_mov_b32 %0, m0\n\ts_mov_b32 m0, %2\n\ts_nop 0\n\tglobal_load_lds_dwordx4 %1, off\n\ts_mov_b32 m0, %0" : "=&s"(keep) : "v"(gsrc), "s"(lds_dst) : "memory"); }
__device__ __forceinline__ void glds4(const void* gsrc, unsigned lds_dst) { unsigned keep;
    asm volatile("s_mov_b32 %0, m0\n\ts_mov_b32 m0, %2\n\ts_nop 0\n\tglobal_load_lds_dword %1, off\n\ts_mov_b32 m0, %0" : "=&s"(keep) : "v"(gsrc), "s"(lds_dst) : "memory"); }
typedef float f32x2_t __attribute__((ext_vector_type(2))); typedef __bf16 bf16x2_t __attribute__((ext_vector_type(2)));
__device__ __forceinline__ unsigned cvtpk_s(float lo, float hi) { f32x2_t v = {lo, hi}; bf16x2_t b = __builtin_convertvector(v, bf16x2_t); return __builtin_bit_cast(unsigned, b); }
template <int N> __device__ __forceinline__ void wait_bar() {
    static_assert(N >= 0 && N <= 4, "wait_bar");
    if constexpr (N == 0) asm volatile("s_waitcnt vmcnt(0) lgkmcnt(0)\n\ts_barrier" ::: "memory");
    else if constexpr (N == 1) asm volatile("s_waitcnt vmcnt(1) lgkmcnt(0)\n\ts_barrier" ::: "memory");
    else if constexpr (N == 2) asm volatile("s_waitcnt vmcnt(2) lgkmcnt(0)\n\ts_barrier" ::: "memory");
    else if constexpr (N == 3) asm volatile("s_waitcnt vmcnt(3) lgkmcnt(0)\n\ts_barrier" ::: "memory");
    else asm volatile("s_waitcnt vmcnt(4) lgkmcnt(0)\n\ts_barrier" ::: "memory");
}
typedef __attribute__((address_space(3))) const char* lds_cptr;
typedef short v4i16_t __attribute__((ext_vector_type(4)));
__device__ __forceinline__ void kload8(bf16x8* kf, lds_cptr kp) {
    kf[0] = *(const ALAS bf16x8*)(kp);        kf[1] = *(const ALAS bf16x8*)(kp + 512);
    kf[2] = *(const ALAS bf16x8*)(kp + 2048); kf[3] = *(const ALAS bf16x8*)(kp + 2560);
    kf[4] = *(const ALAS bf16x8*)(kp + 4096); kf[5] = *(const ALAS bf16x8*)(kp + 4608);
    kf[6] = *(const ALAS bf16x8*)(kp + 6144); kf[7] = *(const ALAS bf16x8*)(kp + 6656);
}
__device__ __forceinline__ void kload2(bf16x8* kf, lds_cptr kp, int j) { kf[2 * j] = *(const ALAS bf16x8*)(kp + j * 2048); kf[2 * j + 1] = *(const ALAS bf16x8*)(kp + j * 2048 + 512); }
__device__ __forceinline__ s16x4 vtr(lds_cptr p) { return __builtin_bit_cast(s16x4, __builtin_amdgcn_ds_read_tr16_b64_v4i16((ALAS v4i16_t*)p)); }
__device__ __forceinline__ void pv(f32x16* o, int vb, bf16x8 pa0, bf16x8 pa1, bf16x8 pa2, bf16x8 pa3) {
#pragma unroll
    for (int d0 = 0; d0 < 2; ++d0) { s16x4 lo[4], hi[4];
#pragma unroll
        for (int ks = 0; ks < 4; ++ks) {
            asm volatile("ds_read_b64_tr_b16 %0,%1 offset:%c2" : "=&v"(lo[ks]) : "v"(vb), "i"(d0 * 4096 + ks * 1024) : "memory");
            asm volatile("ds_read_b64_tr_b16 %0,%1 offset:%c2" : "=&v"(hi[ks]) : "v"(vb), "i"(d0 * 4096 + ks * 1024 + 512) : "memory"); }
        asm volatile("s_waitcnt lgkmcnt(0)" ::: "memory"); SBAR();
#define PK(k) (bf16x8){lo[k][0], lo[k][1], lo[k][2], lo[k][3], hi[k][0], hi[k][1], hi[k][2], hi[k][3]}
        o[d0] = __builtin_amdgcn_mfma_f32_32x32x16_bf16(pa0, PK(0), o[d0], 0, 0, 0);
        o[d0] = __builtin_amdgcn_mfma_f32_32x32x16_bf16(pa1, PK(1), o[d0], 0, 0, 0);
        o[d0] = __builtin_amdgcn_mfma_f32_32x32x16_bf16(pa2, PK(2), o[d0], 0, 0, 0);
        o[d0] = __builtin_amdgcn_mfma_f32_32x32x16_bf16(pa3, PK(3), o[d0], 0, 0, 0);
#undef PK
    }
}
template <int KIND>
__device__ __forceinline__ void cload(f32x16& C0, f32x16& C1, unsigned& mw0, unsigned& mw1, const ALAS float* bl_t  , const ALAS unsigned* mw  ) {
    if constexpr (KIND == 1) {
#pragma unroll
        for (int g = 0; g < 4; ++g) { const f32x4a a = *(const ALAS f32x4a*)(bl_t + 8 * g), b = *(const ALAS f32x4a*)(bl_t + 32 + 8 * g);
            C0[4 * g] = a[0]; C0[4 * g + 1] = a[1]; C0[4 * g + 2] = a[2]; C0[4 * g + 3] = a[3];
            C1[4 * g] = b[0]; C1[4 * g + 1] = b[1]; C1[4 * g + 2] = b[2]; C1[4 * g + 3] = b[3]; }
    } else { mw0 = mw[0]; mw1 = mw[32]; }
}
template <int KIND>
__device__ __forceinline__ void cfin(f32x16& C0, f32x16& C1, unsigned mw0, unsigned mw1, int hi, float negmh) {
    if constexpr (KIND == 1) {
#pragma unroll
        for (int r = 0; r < 16; ++r) { C0[r] += negmh; C1[r] += negmh; }
    } else {
        const unsigned w0 = mw0 >> (4 * hi), w1 = mw1 >> (4 * hi); const unsigned ninf = 0xff800000u, nm = __float_as_uint(negmh);
#pragma unroll
        for (int r = 0; r < 16; ++r) { const int sh = (r & 3) + 8 * (r >> 2);
            const unsigned m0 = (unsigned)__builtin_amdgcn_sbfe((int)w0, sh, 1), m1 = (unsigned)__builtin_amdgcn_sbfe((int)w1, sh, 1);
            unsigned c0, c1;
            asm("v_bfi_b32 %0, %1, %2, %3" : "=v"(c0) : "v"(m0), "v"(nm), "v"(ninf));
            asm("v_bfi_b32 %0, %1, %2, %3" : "=v"(c1) : "v"(m1), "v"(nm), "v"(ninf));
            C0[r] = __uint_as_float(c0); C1[r] = __uint_as_float(c1); }
    }
}

template <int KIND, int THRL>
__device__ __forceinline__ void attn_unit(int b, int h, int qb, const bf16* Q, const bf16* __restrict__ K, const bf16* __restrict__ V, bf16* O,
                                          const unsigned* __restrict__ MASK, const float* __restrict__ CB, ALAS char* shm, float smax, unsigned* qctr, unsigned& pend, unsigned p_old, volatile ALAS int* qs, int wave_) {
    int tid_ = wave_ * 64 + mk_lane(); asm volatile("" : "+v"(tid_));
    const int tid = tid_, lane = tid & 63, r32 = lane & 31, hi = lane >> 5; const int wid = __builtin_amdgcn_readfirstlane(tid >> 6);
    constexpr int MX = (KIND == 0) ? 1 : 0;
    const long rowbase = (long)b * SEQ; const int q0 = qb * QB;
    const bf16* Qw = Q + (rowbase + q0 + wid * QBLK) * AW + h * 64;
    const float* cbh = CB + (size_t)(b * NH + h) * SEQ;
    int ts = 0;
    if constexpr (KIND == 1) {
        const int NT0 = (q0 + QB) / KVBLK;
        const float b0 = cbh[q0], be = cbh[64 * (lane < NT0 ? lane : NT0 - 1) + 63];
        const unsigned long long need = __ballot(lane >= NT0 || smax + be - b0 >= -165.f);
        ts = (int)__builtin_ctzll(need) & ~1; if (ts > NT0 - 4) ts = NT0 - 4;
        ts = __builtin_amdgcn_readfirstlane(ts);
    }
    const bf16* Kh = K + (rowbase + ts * KVBLK) * AW + h * 64, *Vh = V + (rowbase + ts * KVBLK) * AW + h * 64;
    const unsigned lds0 = (unsigned)(uintptr_t)shm;
    ALAS float* wsf = (ALAS float*)(shm + LDS_WS) + wid * 64;
    const bf16* ksrc = Kh + (long)lane * AW + wid * 8;
    const bf16* vsrc = Vh + (long)(16 * (wid & 3) + (lane >> 2)) * AW + (wid >> 2) * 32 + (lane & 3) * 8;
    const unsigned kdst = lds0 + LDS_K + wid * 1024, vdst = lds0 + LDS_V + wid * 1024;
#define DMA_K(t, slot) glds16(ksrc + (long)(t) * KVBLK * AW, (unsigned)__builtin_amdgcn_readfirstlane(kdst + (slot)))
#define DMA_V(t, slot) glds16(vsrc + (long)(t) * KVBLK * AW, (unsigned)__builtin_amdgcn_readfirstlane(vdst + (slot)))
    const int qrel = wid * QBLK + r32;
    const unsigned* msrc = MASK + (size_t)(rowbase + q0 + qrel) * 128 + hi;
    const unsigned mdst = lds0 + LDS_M + wid * 1024;
#define DMA_M(t) glds4(msrc + 2 * (t), (unsigned)__builtin_amdgcn_readfirstlane(mdst + (((t) & 3) << 8)))
    const ALAS unsigned* mwb = (const ALAS unsigned*)(shm + LDS_M + wid * 1024) + r32;
    const ALAS float* blb = (const ALAS float*)(shm + LDS_BIAS) + 4 * hi + 64 * ts;
    const int vb0 = (int)(lds0 + LDS_V) + ((lane >> 4) & 1) * 32 + (lane & 3) * 8 + (4 * hi + ((lane & 15) >> 2)) * 64;
    bf16x8 kf[8];
    const lds_cptr shm3 = (lds_cptr)shm; const lds_cptr kp0 = shm3 + LDS_K + hi * 1024 + r32 * 16; const lds_cptr vp0 = shm3 + LDS_V + ((lane >> 4) & 1) * 32 + (lane & 3) * 8 + (4 * hi + ((lane & 15) >> 2)) * 64;
    const int NT = (q0 + QB) / KVBLK - ts;
    if constexpr (KIND == 1) {
#pragma unroll
        for (int j = 0; j < 2; ++j) { const int piece = 2 * wid + j; if (piece * 256 < q0 + QB) glds16(cbh + piece * 256 + lane * 4, (unsigned)__builtin_amdgcn_readfirstlane(lds0 + LDS_BIAS + piece * 1024)); }
    } else { DMA_M(0); DMA_M(1); DMA_M(2); }
    DMA_K(0, 0); DMA_V(0, 0); DMA_K(1, SLOTB);
    bf16x8 qr[4];
#pragma unroll
    for (int d0 = 0; d0 < 4; ++d0) qr[d0] = *reinterpret_cast<const bf16x8*>(&Qw[(long)r32 * AW + d0 * 16 + hi * 8]);
    float mhat = 0.f; if constexpr (KIND == 1) mhat = cbh[q0 + qrel];
    float l_reg = 0.f; f32x16 o[2]; o[0] = f32x16{}; o[1] = f32x16{};
#define CMASK(P0, P1, t) do { if constexpr (KIND == 1) { int jb_ = (t) - (NT - 4); if (jb_ >= 0) cmask(P0, P1, jb_, qrel, hi); } } while (0)
    bool resc = false;
#define RESC() do { if (resc) { asm volatile("s_waitcnt lgkmcnt(0)" ::: "memory"); \
      _Pragma("unroll") for (int d_ = 0; d_ < 2; ++d_) _Pragma("unroll") for (int r = 0; r < 16; ++r) o[d_][r] *= wsf[crow(r, hi)]; } } while (0)
    f32x16 pA0, pA1, pB0, pB1;
    int sl_prev = 0, sl_cur = 0, sl_next = SLOTB;
#define ROT() do { sl_prev = sl_cur; sl_cur = sl_next; sl_next = (sl_next == (NSLOT - 1) * SLOTB) ? 0 : sl_next + SLOTB; } while (0)
    DMA_K(2, 2 * SLOTB);
    wait_bar<3>();
    unsigned mwn0 = 0u, mwn1 = 0u;
    cload<KIND>(pA0, pA1, mwn0, mwn1, blb, mwb); cfin<KIND>(pA0, pA1, mwn0, mwn1, hi, -mhat);
    { const lds_cptr kb = kp0;
#pragma unroll
      for (int d0 = 0; d0 < 4; ++d0) { const bf16x8 b0 = *(const ALAS bf16x8*)(kb + d0 * 2048), b1 = *(const ALAS bf16x8*)(kb + d0 * 2048 + 512);
          pA0 = __builtin_amdgcn_mfma_f32_32x32x16_bf16(b0, qr[d0], pA0, 0, 0, 0); pA1 = __builtin_amdgcn_mfma_f32_32x32x16_bf16(b1, qr[d0], pA1, 0, 0, 0); } }
    asm volatile("s_nop 15\n\ts_nop 7" : "+v"(pA0), "+v"(pA1)); CMASK(pA0, pA1, 0);
    { float rm = __builtin_fmaxf(pA0[0], pA1[0]);
#pragma unroll
      for (int r = 1; r < 16; ++r) rm = __builtin_fmaxf(rm, __builtin_fmaxf(pA0[r], pA1[r]));
      { auto rr = __builtin_amdgcn_permlane32_swap(__float_as_uint(rm), __float_as_uint(rm), false, false); rm = __builtin_fmaxf(__uint_as_float(rr[0]), __uint_as_float(rr[1])); }
      if (__any(rm > (float)THRL)) { const float dl = __builtin_fmaxf(rm, 0.f); mhat += dl;
#pragma unroll
          for (int r = 0; r < 16; ++r) { pA0[r] -= dl; pA1[r] -= dl; } } }
#pragma unroll
    for (int r = 0; r < 16; ++r) { pA0[r] = __builtin_amdgcn_exp2f(pA0[r]); pA1[r] = __builtin_amdgcn_exp2f(pA1[r]); }
    cload<KIND>(pB0, pB1, mwn0, mwn1, blb + 64, mwb + 64);
    wait_bar<0>();
    DMA_K(3, 0); DMA_V(1, SLOTB); if constexpr (MX) DMA_M(3);
    ROT();
    kload8(kf, kp0 + sl_cur);
    wait_bar<2 + MX>();
    s16x4 vlo[8], vhi[8]; u32x4 pw0, pw1, pw2, pw3;
#define PKW(P, B) cvtpk_s(P[B], P[B + 1])
#define PAF(k) __builtin_bit_cast(bf16x8, pw##k)
#define VFR(i) (bf16x8){vlo[i][0], vlo[i][1], vlo[i][2], vlo[i][3], vhi[i][0], vhi[i][1], vhi[i][2], vhi[i][3]}
#define PIN(x) asm volatile("" : "+v"(x))
#define MX3(a, b, c) __builtin_fmaxf(__builtin_fmaxf((a), (b)), (c))
#define GAPA(MF, A0, A1, A2, A3, W0, W1, PW) do { MF; sacc += A0; sacc += A1; sacc += A2; sacc += A3; PIN(sacc); W0; W1; PIN(PW); SBAR(); } while (0)
#define EX(v) __builtin_amdgcn_exp2f(v)
#define GAPB(MF, X, B) do { MF; X[B] = EX(X[B]); X[B + 1] = EX(X[B + 1]); X[B + 2] = EX(X[B + 2]); X[B + 3] = EX(X[B + 3]); PIN(X); SBAR(); } while (0)
#define VRD(i) do { vlo[i] = vtr(vp_ + (((i) >> 2) * 4096 + ((i) & 3) * 1024)); vhi[i] = vtr(vp_ + (((i) >> 2) * 4096 + ((i) & 3) * 1024 + 512)); } while (0)
#define KRD(G, j) do { if (G) { kload2(kf, kp0 + sl_next, j); SBAR(); } } while (0)
#define STEP(C0, C1, P0, P1, t, GK, GV, GL, GM) do { SBAR(); \
    cfin<KIND>(C0, C1, mwn0, mwn1, hi, -mhat); PIN(C0); PIN(C1); SBAR(); \
    const lds_cptr vp_ = vp0 + sl_prev; \
    VRD(0); SBAR(); float sacc = (P0[0] + P0[1]); \
    GAPA(C0 = __builtin_amdgcn_mfma_f32_32x32x16_bf16(kf[0], qr[0], C0, 0, 0, 0), P0[2], P0[3], P0[4], P0[5],     pw0[0] = PKW(P0, 0), pw0[1] = PKW(P0, 2), pw0); \
    VRD(4); SBAR(); GAPA(C1 = __builtin_amdgcn_mfma_f32_32x32x16_bf16(kf[1], qr[0], C1, 0, 0, 0), P0[6], P0[7], P0[8], P0[9],     pw0[2] = PKW(P0, 4), pw0[3] = PKW(P0, 6), pw0); \
    VRD(1); SBAR(); GAPA(C0 = __builtin_amdgcn_mfma_f32_32x32x16_bf16(kf[2], qr[1], C0, 0, 0, 0),   P0[10], P0[11], P0[12], P0[13], pw1[0] = PKW(P0, 8), pw1[1] = PKW(P0, 10), pw1); \
    VRD(5); SBAR(); GAPA(C1 = __builtin_amdgcn_mfma_f32_32x32x16_bf16(kf[3], qr[1], C1, 0, 0, 0),   P0[14], P0[15], P1[0], P1[1],   pw1[2] = PKW(P0, 12), pw1[3] = PKW(P0, 14), pw1); \
    VRD(2); SBAR(); GAPA(C0 = __builtin_amdgcn_mfma_f32_32x32x16_bf16(kf[4], qr[2], C0, 0, 0, 0),   P1[2], P1[3], P1[4], P1[5],     pw2[0] = PKW(P1, 0), pw2[1] = PKW(P1, 2), pw2); \
    VRD(6); SBAR(); GAPA(C1 = __builtin_amdgcn_mfma_f32_32x32x16_bf16(kf[5], qr[2], C1, 0, 0, 0),   P1[6], P1[7], P1[8], P1[9],     pw2[2] = PKW(P1, 4), pw2[3] = PKW(P1, 6), pw2); \
    VRD(3); SBAR(); GAPA(C0 = __builtin_amdgcn_mfma_f32_32x32x16_bf16(kf[6], qr[3], C0, 0, 0, 0),   P1[10], P1[11], P1[12], P1[13], pw3[0] = PKW(P1, 8), pw3[1] = PKW(P1, 10), pw3); \
    VRD(7); SBAR(); GAPA(C1 = __builtin_amdgcn_mfma_f32_32x32x16_bf16(kf[7], qr[3], C1, 0, 0, 0),   P1[14], P1[15], 0.f, 0.f,       pw3[2] = PKW(P1, 12), pw3[3] = PKW(P1, 14), pw3); \
    l_reg += sacc; \
    cload<KIND>(P0, P1, mwn0, mwn1, blb + 64 * ((t) + 1), mwb + ((((t) + 1) & 3) << 6)); SBAR();     \
    if (GK) { DMA_K((t) + 3, sl_cur); } if (GV) { DMA_V((t) + 1, sl_next); } if constexpr (MX) { if (GM) { DMA_M((t) + 3); } } \
    CMASK(C0, C1, t); \
    { float a = MX3(C0[0], C0[1], C1[0]), b = MX3(C0[2], C0[3], C1[1]); a = MX3(a, C1[2], C1[3]); \
      _Pragma("unroll") for (int r = 4; r < 16; r += 4) { a = MX3(a, C0[r], C0[r + 1]); b = MX3(b, C0[r + 2], C0[r + 3]); a = MX3(a, C1[r], C1[r + 1]); b = MX3(b, C1[r + 2], C1[r + 3]); } \
      float rm = __builtin_fmaxf(a, b); { auto rr = __builtin_amdgcn_permlane32_swap(__float_as_uint(rm), __float_as_uint(rm), false, false); rm = __builtin_fmaxf(__uint_as_float(rr[0]), __uint_as_float(rr[1])); } \
      resc = false; \
      if (__builtin_expect(__any(rm > (float)THRL), 0)) { const float dl = __builtin_fmaxf(rm, 0.f); mhat += dl; \
        _Pragma("unroll") for (int r = 0; r < 16; ++r) { C0[r] -= dl; C1[r] -= dl; } \
        const float f = __builtin_amdgcn_exp2f(-dl); l_reg *= f; if (hi == 0) wsf[r32] = f; resc = true; } } \
    SBAR(); \
    GAPB(o[0] = __builtin_amdgcn_mfma_f32_32x32x16_bf16(PAF(0), VFR(0), o[0], 0, 0, 0), C0, 0); \
    GAPB(o[1] = __builtin_amdgcn_mfma_f32_32x32x16_bf16(PAF(0), VFR(4), o[1], 0, 0, 0), C0, 4); \
    KRD(GL, 0); GAPB(o[0] = __builtin_amdgcn_mfma_f32_32x32x16_bf16(PAF(1), VFR(1), o[0], 0, 0, 0), C0, 8); \
    KRD(GL, 1); GAPB(o[1] = __builtin_amdgcn_mfma_f32_32x32x16_bf16(PAF(1), VFR(5), o[1], 0, 0, 0), C0, 12); \
    KRD(GL, 2); GAPB(o[0] = __builtin_amdgcn_mfma_f32_32x32x16_bf16(PAF(2), VFR(2), o[0], 0, 0, 0), C1, 0); \
    KRD(GL, 3); GAPB(o[1] = __builtin_amdgcn_mfma_f32_32x32x16_bf16(PAF(2), VFR(6), o[1], 0, 0, 0), C1, 4); \
    GAPB(o[0] = __builtin_amdgcn_mfma_f32_32x32x16_bf16(PAF(3), VFR(3), o[0], 0, 0, 0), C1, 8); \
    GAPB(o[1] = __builtin_amdgcn_mfma_f32_32x32x16_bf16(PAF(3), VFR(7), o[1], 0, 0, 0), C1, 12); \
    } while (0)
    int t = 1;
#undef CMASK
#define CMASK(P0, P1, t) do { } while (0)
    for (; t + 5 < NT; t += 2) {
        STEP(pB0, pB1, pA0, pA1, t, true, true, true, true);     wait_bar<2 + MX>(); RESC(); ROT();
        STEP(pA0, pA1, pB0, pB1, t + 1, true, true, true, true); wait_bar<2 + MX>(); RESC(); ROT();
    }
#undef CMASK
#define CMASK(P0, P1, t) do { if constexpr (KIND == 1) { int jb_ = (t) - (NT - 4); if (jb_ >= 0) cmask(P0, P1, jb_, qrel, hi); } } while (0)
#define ENDW(tt) do { if ((tt) + 3 < NT) { wait_bar<2 + MX>(); } else if ((tt) + 2 < NT) { wait_bar<1>(); } else { wait_bar<0>(); } } while (0)
    for (; t + 1 < NT; t += 2) {
        STEP(pB0, pB1, pA0, pA1, t, (t + 3 < NT), (t + 1 < NT), (t + 1 < NT), (t + 3 < NT));       ENDW(t);     RESC(); ROT();
        STEP(pA0, pA1, pB0, pB1, t + 1, (t + 4 < NT), (t + 2 < NT), (t + 2 < NT), (t + 4 < NT));   ENDW(t + 1); RESC(); ROT();
    }
    STEP(pB0, pB1, pA0, pA1, NT - 1, false, false, false, false); RESC();
    { float sacc = pB0[0] + pB0[1];
#pragma unroll
      for (int r = 2; r < 16; ++r) sacc += pB0[r];
#pragma unroll
      for (int r = 0; r < 16; ++r) sacc += pB1[r];
      l_reg += sacc;
      pw0 = (u32x4){PKW(pB0, 0), PKW(pB0, 2), PKW(pB0, 4), PKW(pB0, 6)}; pw1 = (u32x4){PKW(pB0, 8), PKW(pB0, 10), PKW(pB0, 12), PKW(pB0, 14)};
      pw2 = (u32x4){PKW(pB1, 0), PKW(pB1, 2), PKW(pB1, 4), PKW(pB1, 6)}; pw3 = (u32x4){PKW(pB1, 8), PKW(pB1, 10), PKW(pB1, 12), PKW(pB1, 14)};
      SBAR(); pv(o, vb0 + sl_cur, PAF(0), PAF(1), PAF(2), PAF(3)); }
#undef PKW
#undef PAF
#undef VFR
#undef PIN
#undef MX3
#undef GAPA
#undef GAPB
#undef EX
#undef VRD
#undef KRD
#undef STEP
#undef ENDW
    { auto rr = __builtin_amdgcn_permlane32_swap(__float_as_uint(l_reg), __float_as_uint(l_reg), false, false); l_reg = __uint_as_float(rr[0]) + __uint_as_float(rr[1]); }
    if (hi == 0) wsf[32 + r32] = l_reg;
    asm volatile("s_waitcnt lgkmcnt(0)" ::: "memory");
    float rli[16];
#pragma unroll
    for (int r = 0; r < 16; ++r) rli[r] = __builtin_amdgcn_rcpf(wsf[32 + crow(r, hi)]);
    if (tid == 0) pend = __hip_atomic_fetch_add(qctr, 1u, __ATOMIC_RELAXED, __HIP_MEMORY_SCOPE_AGENT);
    unsigned char* Ow = (unsigned char*)O + (rowbase + q0 + wid * QBLK) * AW + h * 64;
    { ALAS unsigned char* stg = (ALAS unsigned char*)(shm + LDS_OST) + wid * 4096;
#pragma unroll
      for (int r = 0; r < 16; ++r) { const int orow = crow(r, hi); const float sc_ = rli[r] * pg8::OSC;
#pragma unroll
          for (int d0 = 0; d0 < 2; ++d0) { const float x = __builtin_amdgcn_fmed3f(o[d0][r] * sc_, -pg8::F8MAX, pg8::F8MAX);
              stg[orow * 64 + d0 * 32 + r32] = (unsigned char)(__builtin_amdgcn_cvt_pk_fp8_f32(x, x, 0, false) & 255); } }
      asm volatile("s_waitcnt lgkmcnt(0)" ::: "memory");
#pragma unroll
      for (int i = 0; i < 2; ++i) { const int row = i * 16 + (lane >> 2), ch = lane & 3; const u32x4 v = *(const ALAS u32x4*)(stg + row * 64 + ch * 16); *(u32x4*)(Ow + (long)row * AW + ch * 16) = v; } }
    if (tid == 0) qs[0] = (int)p_old;
    asm volatile("s_waitcnt lgkmcnt(0)\n\ts_barrier" ::: "memory");
#undef DMA_K
#undef DMA_V
#undef DMA_M
#undef CMASK
#undef RESC
#undef ROT
}
#undef SBAR
#undef ALAS
}

static_assert(attn_body::LDS_BYTES <= RING_BYTES, "attention LDS");
#define XB_TMO      128
#define XB_XCNT(j)  (256  + 64 * (j))
#define XB_XSUB(j)  (1280 + 64 * (j))
#define XB_XGEN(j)  (2304 + 64 * (j))
#define XB_TOP      3328
#define XB_TOPGEN   3392
#define XCD_BAR_WORDS 3456
#define XB_SPIN_CAP (1u << 18)

__device__ __forceinline__ unsigned xb_ld(unsigned* p)              { return __hip_atomic_load(p, __ATOMIC_RELAXED, __HIP_MEMORY_SCOPE_AGENT); }
__device__ __forceinline__ unsigned xb_add(unsigned* p, unsigned v) { return __hip_atomic_fetch_add(p, v, __ATOMIC_RELAXED, __HIP_MEMORY_SCOPE_AGENT); }
__device__ __forceinline__ unsigned xb_xcc_id() { return (unsigned)__builtin_amdgcn_s_getreg((3 << 11) | 20) & 0xFu; }
#define XB_SPIN(cond, bar) do { unsigned _sp = 0; while (cond) { __builtin_amdgcn_s_sleep(1); \
    if ((++_sp & 255u) == 0u) { if (xb_ld(&(bar)[XB_TMO])) break; if (_sp > XB_SPIN_CAP) { atomicAdd(&(bar)[XB_TMO], 1u); break; } } } } while (0)

struct XcdBarrier {
    unsigned* bar; unsigned x; int wv;
    volatile LAS unsigned* st;
};

__device__ __forceinline__ XcdBarrier xcd_barrier_post(unsigned* bar, volatile LAS unsigned* st, int wv) {
    XcdBarrier b; b.bar = bar; b.x = xb_xcc_id(); b.st = st; b.wv = wv;
    if (wv == 0 && mk_lane() == 0) (void)xb_add(&bar[XB_XCNT(b.x)], 1u);
    return b;
}
__device__ __forceinline__ void xcd_barrier_complete(unsigned* bar, unsigned x, unsigned& nloc, unsigned& nx) {
    const unsigned G = gridDim.x * gridDim.y * gridDim.z;
    unsigned sum, cnt, mine, sp = 0u;
    for (;;) {
        sum = 0u; cnt = 0u; mine = 0u;
#pragma unroll
        for (unsigned j = 0; j < 16; ++j) { const unsigned c = xb_ld(&bar[XB_XCNT(j)]); sum += c; cnt += (c > 0u) ? 1u : 0u; mine = (j == x) ? c : mine; }
        if (sum == G) break;
        __builtin_amdgcn_s_sleep(1);
        if ((++sp & 255u) == 0u) { if (xb_ld(&bar[XB_TMO])) break; if (sp > XB_SPIN_CAP) { atomicAdd(&bar[XB_TMO], 1u); break; } }
    }
    nloc = mine > 0u ? mine : 1u; nx = cnt > 0u ? cnt : 1u;
}

__device__ __forceinline__ void xcd_barrier(const XcdBarrier& b) {
    asm volatile("s_waitcnt vmcnt(0)" ::: "memory");
    __syncthreads();
    if (b.wv == 0 && mk_lane() == 0) {
        unsigned* bar = b.bar; unsigned bx = b.x;
        asm volatile("" : "+s"(bar), "+s"(bx));
        __builtin_amdgcn_s_waitcnt(0);
        unsigned nloc = b.st[0], nx = b.st[1];
        if (nloc == 0u) { xcd_barrier_complete(bar, bx, nloc, nx); b.st[0] = nloc; b.st[1] = nx; }
        const unsigned old = xb_add(&bar[XB_XSUB(bx)], 1u);
        const unsigned gen = old / nloc;
        if (old + 1u == (gen + 1u) * nloc) {
            __builtin_amdgcn_fence(__ATOMIC_RELEASE, "agent");
            asm volatile("s_waitcnt vmcnt(0)" ::: "memory");
            const unsigned og = xb_add(&bar[XB_TOP], 1u);
            const unsigned tg = og / nx;
            if (og + 1u == (tg + 1u) * nx) xb_add(&bar[XB_TOPGEN], 1u);
            else XB_SPIN(xb_ld(&bar[XB_TOPGEN]) == tg, bar);
            __builtin_amdgcn_fence(__ATOMIC_ACQUIRE, "agent");
            xb_add(&bar[XB_XGEN(bx)], 1u);
            asm volatile("s_waitcnt vmcnt(0)" ::: "memory");
        } else {
            XB_SPIN(xb_ld(&bar[XB_XGEN(bx)]) == gen, bar);
            __builtin_amdgcn_fence(__ATOMIC_ACQUIRE, "agent");
            asm volatile("s_waitcnt vmcnt(0)" ::: "memory");
        }
    }
    __syncthreads();
}
struct Frame {
    LAS unsigned char* lds;
    volatile LAS unsigned* MISC;
    gu32* ctl;
    int tid, lane, wave, G, bid;
    unsigned char* ws; float* out;
};
__device__ __forceinline__ float wave_sum(float v) {
#define DPP_F(x, ctrl) __int_as_float(__builtin_amdgcn_update_dpp(0, __float_as_int(x), (ctrl), 0xf, 0xf, true))
    v += DPP_F(v, 0xB1); v += DPP_F(v, 0x4E); v += DPP_F(v, 0x141); v += DPP_F(v, 0x140);
#undef DPP_F
    const float a = __int_as_float(__builtin_amdgcn_readlane(__float_as_int(v), 0)), b = __int_as_float(__builtin_amdgcn_readlane(__float_as_int(v), 16));
    const float c = __int_as_float(__builtin_amdgcn_readlane(__float_as_int(v), 32)), d = __int_as_float(__builtin_amdgcn_readlane(__float_as_int(v), 48));
    return (a + b) + (c + d);
}

__device__ __forceinline__ float wave_max(float v) {
#define DPP_F(x, ctrl) __int_as_float(__builtin_amdgcn_update_dpp(0, __float_as_int(x), (ctrl), 0xf, 0xf, true))
    v = fmaxf(v, DPP_F(v, 0xB1)); v = fmaxf(v, DPP_F(v, 0x4E)); v = fmaxf(v, DPP_F(v, 0x141)); v = fmaxf(v, DPP_F(v, 0x140));
#undef DPP_F
    const float a = __int_as_float(__builtin_amdgcn_readlane(__float_as_int(v), 0)), b = __int_as_float(__builtin_amdgcn_readlane(__float_as_int(v), 16));
    const float c = __int_as_float(__builtin_amdgcn_readlane(__float_as_int(v), 32)), d = __int_as_float(__builtin_amdgcn_readlane(__float_as_int(v), 48));
    return fmaxf(fmaxf(a, b), fmaxf(c, d));
}
__device__ __forceinline__ unsigned q4(const f32x4 v, float inv) {
    const int a = (int)rintf(v[0] * inv), b = (int)rintf(v[1] * inv), c = (int)rintf(v[2] * inv), d = (int)rintf(v[3] * inv);
    return ((unsigned)a & 255u) | (((unsigned)b & 255u) << 8) | (((unsigned)c & 255u) << 16) | ((unsigned)d << 24);
}

__device__ __forceinline__ int win_colmap(int dr) {
    const int tile = dr >> 8, j = dr & 255;
    if (tile < 4 || tile == 6 || tile == 7) { const int base = (tile < 2) ? 0 : (tile < 4 ? 512 : 1536); return base + 256 * (tile & 1) + 64 * ((j & 127) >> 5) + 32 * (j >> 7) + (j & 31); }
    if (tile < 6) return 1024 + 256 * (tile - 4) + j;
    if (tile < 14) return 2120 + 256 * (tile - 8) + j;
    if (tile < 22) return 3664 + 256 * (tile - 14) + j;
    if (j < 32) return 2048 + j;
    if (j < 40) return 2112 + (j - 32);
    if (j >= 64 && j < 72) return 3656 + (j - 64);
    if (j >= 128 && j < 160) return 2080 + (j - 128);
    return -1;
}
template <int KIND>
__device__ __forceinline__ void conv_item(const float* s0, const float* s1, int K, int Nsrc, int ndst, bf16* dst, int item, LAS unsigned char* scr, int lane) {
    const int nb = ndst >> 6, kb = item / nb, dg = item - kb * nb, k0 = kb << 6, d0 = dg << 6;
    const int nq = lane & 15, dr = d0 + 4 * nq;
    const float* sp = s0; int col;
    if (KIND == 0) col = dr;
    else if (KIND == 1) col = win_colmap(dr);
    else { const int tile = dr >> 8, j = dr & 255; col = 128 * tile + (j & 127); if (j >= 128) sp = s1; }
    f32x4 vv[16];
#pragma unroll
    for (int i = 0; i < 16; ++i) { const int k = 4 * i + (lane >> 4); vv[i] = (f32x4){0.f, 0.f, 0.f, 0.f}; if (col >= 0) vv[i] = *(const f32x4*)(sp + (size_t)(k0 + k) * Nsrc + col); }
#pragma unroll
    for (int i = 0; i < 16; ++i) {
        const int k = 4 * i + (lane >> 4); const f32x4 v = vv[i];
        LAS unsigned short* w = (LAS unsigned short*)(scr + (4 * nq) * 144 + k * 2);
        w[0] = (unsigned short)f2bf(v[0]); w[72] = (unsigned short)f2bf(v[1]); w[144] = (unsigned short)f2bf(v[2]); w[216] = (unsigned short)f2bf(v[3]);
    }
    asm volatile("s_waitcnt lgkmcnt(0)" ::: "memory");
#pragma unroll
    for (int i = 0; i < 8; ++i) { const int n = 8 * i + (lane >> 3), ch = lane & 7;
        const v4u o = *(const LAS v4u*)(scr + n * 144 + ch * 16);
        *(v4u*)(dst + (size_t)(d0 + n) * K + k0 + 8 * ch) = o; }
    asm volatile("s_waitcnt lgkmcnt(0)" ::: "memory");
}
template <int KIND>
__device__ __forceinline__ void conv_matrix(Frame& F, const float* s0, const float* s1, int K, int Nsrc, int ndst, bf16* dst) {
    LAS unsigned char* scr = F.lds + RING_OFF + F.wave * 9216;
    const int gw = F.bid * NWAVES + F.wave, NGW = F.G * NWAVES, nitems = (K >> 6) * (ndst >> 6);
    for (int it = gw; it < nitems; it += NGW) conv_item<KIND>(s0, s1, K, Nsrc, ndst, dst, it, scr, F.lane);
}
template <int KIND>
__device__ __forceinline__ void colmax_item(const float* s0, const float* s1, int K, int Nsrc, int ndst, unsigned* cmax, int item, LAS unsigned char* scr, int lane) {
    const int nb = ndst >> 6, kb = item / nb, dg = item - kb * nb, k0 = kb << 6, d0 = dg << 6;
    const int nq = lane & 15, dr = d0 + 4 * nq;
    const float* sp = s0; int col;
    if (KIND == 0) col = dr;
    else if (KIND == 1) col = win_colmap(dr);
    else { const int tile = dr >> 8, j = dr & 255; col = 128 * tile + (j & 127); if (j >= 128) sp = s1; }
    f32x4 vv[16];
#pragma unroll
    for (int i = 0; i < 16; ++i) { const int k = 4 * i + (lane >> 4); vv[i] = (f32x4){0.f, 0.f, 0.f, 0.f}; if (col >= 0) vv[i] = *(const f32x4*)(sp + (size_t)(k0 + k) * Nsrc + col); }
    f32x4 mx = {0.f, 0.f, 0.f, 0.f};
#pragma unroll
    for (int i = 0; i < 16; ++i) { mx[0] = fmaxf(mx[0], fabsf(vv[i][0])); mx[1] = fmaxf(mx[1], fabsf(vv[i][1])); mx[2] = fmaxf(mx[2], fabsf(vv[i][2])); mx[3] = fmaxf(mx[3], fabsf(vv[i][3])); }
    *(LAS f32x4*)(scr + (lane >> 4) * 256 + nq * 16) = mx;
    asm volatile("s_waitcnt lgkmcnt(0)" ::: "memory");
    const LAS float* sf = (const LAS float*)scr;
    const float m = fmaxf(fmaxf(sf[lane], sf[64 + lane]), fmaxf(sf[128 + lane], sf[192 + lane]));
    asm volatile("s_waitcnt lgkmcnt(0)" ::: "memory");
    __hip_atomic_fetch_max(cmax + d0 + lane, __float_as_uint(m), __ATOMIC_RELAXED, __HIP_MEMORY_SCOPE_AGENT);
}
template <int KIND>
__device__ __forceinline__ void conv8_item(const float* s0, const float* s1, int K, int Nsrc, int ndst, unsigned char* dst, float* scale, const unsigned* cmax, int item, LAS unsigned char* scr, int lane) {
    const int nb = ndst >> 6, kb = item / nb, dg = item - kb * nb, k0 = kb << 6, d0 = dg << 6;
    const int nq = lane & 15, dr = d0 + 4 * nq;
    const float* sp = s0; int col;
    if (KIND == 0) col = dr;
    else if (KIND == 1) col = win_colmap(dr);
    else { const int tile = dr >> 8, j = dr & 255; col = 128 * tile + (j & 127); if (j >= 128) sp = s1; }
    f32x4 vv[16];
#pragma unroll
    for (int i = 0; i < 16; ++i) { const int k = 4 * i + (lane >> 4); vv[i] = (f32x4){0.f, 0.f, 0.f, 0.f}; if (col >= 0) vv[i] = *(const f32x4*)(sp + (size_t)(k0 + k) * Nsrc + col); }
    const v4u cm = *(const v4u*)(cmax + dr);
    float inv[4];
#pragma unroll
    for (int c = 0; c < 4; ++c) { const float a = __uint_as_float(cm[c]); inv[c] = a > 0.f ? 127.f / a : 0.f; }
    if (kb == 0) { const float a = __uint_as_float(cmax[d0 + lane]); scale[d0 + lane] = a * (1.f / 127.f); }
#pragma unroll
    for (int i = 0; i < 16; ++i) {
        const int k = 4 * i + (lane >> 4); const f32x4 v = vv[i];
        LAS unsigned char* w = (LAS unsigned char*)(scr + (4 * nq) * 80 + k);
        w[0] = (unsigned char)(int)rintf(v[0] * inv[0]); w[80] = (unsigned char)(int)rintf(v[1] * inv[1]); w[160] = (unsigned char)(int)rintf(v[2] * inv[2]); w[240] = (unsigned char)(int)rintf(v[3] * inv[3]);
    }
    asm volatile("s_waitcnt lgkmcnt(0)" ::: "memory");
#pragma unroll
    for (int i = 0; i < 4; ++i) { const int n = 16 * i + (lane >> 2), ch = lane & 3;
        const v4u o = *(const LAS v4u*)(scr + n * 80 + ch * 16);
        *(v4u*)(dst + (size_t)(d0 + n) * K + k0 + 16 * ch) = o; }
    asm volatile("s_waitcnt lgkmcnt(0)" ::: "memory");
}
template <int KIND>
__device__ __forceinline__ void conv8_strip_k(Frame& F, const float* s0, const float* s1, int Nsrc, unsigned char* dst, float* scale, int dg) {
    LAS unsigned char* scr = F.lds + RING_OFF + F.wave * 9216; LAS float* red = (LAS float*)(F.lds + RING_OFF + 8 * 9216);
    const int lane = F.lane, nq = lane & 15, d0 = dg << 6, dr = d0 + 4 * nq; int col;
    if (KIND == 1) col = win_colmap(dr);
    else { const int tile = dr >> 8, j = dr & 255; col = 128 * tile + (j & 127); if (j >= 128) s0 = s1; }
    f32x4 mx = {0.f, 0.f, 0.f, 0.f};
    for (int h = 0; h < 2; ++h) { const int k0 = (2 * F.wave + h) << 6;
        f32x4 vv[16];
#pragma unroll
        for (int i = 0; i < 16; ++i) { const int k = 4 * i + (lane >> 4); vv[i] = (f32x4){0.f, 0.f, 0.f, 0.f}; if (col >= 0) vv[i] = *(const f32x4*)(s0 + (size_t)(k0 + k) * Nsrc + col); }
#pragma unroll
        for (int i = 0; i < 16; ++i) { mx[0] = fmaxf(mx[0], fabsf(vv[i][0])); mx[1] = fmaxf(mx[1], fabsf(vv[i][1])); mx[2] = fmaxf(mx[2], fabsf(vv[i][2])); mx[3] = fmaxf(mx[3], fabsf(vv[i][3])); } }
    *(LAS f32x4*)(red + (F.wave * 4 + (lane >> 4)) * 64 + 4 * nq) = mx;
    __syncthreads();
    f32x4 m4 = {0.f, 0.f, 0.f, 0.f};
    for (int j = 0; j < 32; ++j) { const f32x4 t = *(const LAS f32x4*)(red + j * 64 + 4 * nq); m4[0] = fmaxf(m4[0], t[0]); m4[1] = fmaxf(m4[1], t[1]); m4[2] = fmaxf(m4[2], t[2]); m4[3] = fmaxf(m4[3], t[3]); }
    float inv[4];
#pragma unroll
    for (int c = 0; c < 4; ++c) inv[c] = m4[c] > 0.f ? 127.f / m4[c] : 0.f;
    if (F.wave == 0 && lane < 16) *(f32x4*)(scale + dr) = m4 * ((KIND == 2 && (dr & 255) >= 128) ? pg8::HSC / 127.f : (KIND == 1 && dr >= 14 * 256 && dr < 22 * 256) ? -1.4426950408889634f / 127.f : 1.f / 127.f);
    for (int h = 0; h < 2; ++h) { const int k0 = (2 * F.wave + h) << 6;
        f32x4 vv[16];
#pragma unroll
        for (int i = 0; i < 16; ++i) { const int k = 4 * i + (lane >> 4); vv[i] = (f32x4){0.f, 0.f, 0.f, 0.f}; if (col >= 0) vv[i] = *(const f32x4*)(s0 + (size_t)(k0 + k) * Nsrc + col); }
#pragma unroll
        for (int i = 0; i < 16; ++i) { const int k = 4 * i + (lane >> 4); const f32x4 v = vv[i];
            LAS unsigned char* w = (LAS unsigned char*)(scr + (4 * nq) * 80 + k);
            w[0] = (unsigned char)(int)rintf(v[0] * inv[0]); w[80] = (unsigned char)(int)rintf(v[1] * inv[1]); w[160] = (unsigned char)(int)rintf(v[2] * inv[2]); w[240] = (unsigned char)(int)rintf(v[3] * inv[3]); }
        asm volatile("s_waitcnt lgkmcnt(0)" ::: "memory");
#pragma unroll
        for (int i = 0; i < 4; ++i) { const int n = 16 * i + (lane >> 2), ch = lane & 3;
            const v4u o = *(const LAS v4u*)(scr + n * 80 + ch * 16);
            *(v4u*)(dst + (size_t)(d0 + n) * DM + k0 + 16 * ch) = o; }
        asm volatile("s_waitcnt lgkmcnt(0)" ::: "memory"); }
    __syncthreads();
}
template <int NKB, bool F8 = false>
__device__ __forceinline__ void conv8_strip(Frame& F, const float* s0, int Nsrc, unsigned char* dst, float* scale, int dg, float presc = pg8::HSC) {
    constexpr int K = NKB * 64;
    LAS unsigned char* scr = F.lds + RING_OFF + F.wave * 9216; LAS float* red = (LAS float*)(F.lds + RING_OFF + 8 * 9216);
    const int lane = F.lane, nq = lane & 15, d0 = dg << 6, dr = d0 + 4 * nq;
    f32x4 mx = {0.f, 0.f, 0.f, 0.f};
    for (int kb = F.wave; kb < NKB; kb += NWAVES) { const int k0 = kb << 6;
        f32x4 vv[16];
#pragma unroll
        for (int i = 0; i < 16; ++i) { const int k = 4 * i + (lane >> 4); vv[i] = *(const f32x4*)(s0 + (size_t)(k0 + k) * Nsrc + dr); }
#pragma unroll
        for (int i = 0; i < 16; ++i) { mx[0] = fmaxf(mx[0], fabsf(vv[i][0])); mx[1] = fmaxf(mx[1], fabsf(vv[i][1])); mx[2] = fmaxf(mx[2], fabsf(vv[i][2])); mx[3] = fmaxf(mx[3], fabsf(vv[i][3])); } }
    *(LAS f32x4*)(red + (F.wave * 4 + (lane >> 4)) * 64 + 4 * nq) = mx;
    __syncthreads();
    f32x4 m4 = {0.f, 0.f, 0.f, 0.f};
    for (int j = 0; j < 32; ++j) { const f32x4 t = *(const LAS f32x4*)(red + j * 64 + 4 * nq); m4[0] = fmaxf(m4[0], t[0]); m4[1] = fmaxf(m4[1], t[1]); m4[2] = fmaxf(m4[2], t[2]); m4[3] = fmaxf(m4[3], t[3]); }
    float inv[4];
#pragma unroll
    for (int c = 0; c < 4; ++c) inv[c] = m4[c] > 0.f ? (F8 ? 256.f : 127.f) / m4[c] : 0.f;
    if (F.wave == 0 && lane < 16) *(f32x4*)(scale + dr) = m4 * (F8 ? 1.f / (256.f * presc) : 1.f / 127.f);
    for (int kb = F.wave; kb < NKB; kb += NWAVES) { const int k0 = kb << 6;
        f32x4 vv[16];
#pragma unroll
        for (int i = 0; i < 16; ++i) { const int k = 4 * i + (lane >> 4); vv[i] = *(const f32x4*)(s0 + (size_t)(k0 + k) * Nsrc + dr); }
#pragma unroll
        for (int i = 0; i < 16; ++i) { const int k = 4 * i + (lane >> 4); const f32x4 v = vv[i];
            LAS unsigned char* w = (LAS unsigned char*)(scr + (4 * nq) * 80 + k);
            if (F8) { const int p0 = __builtin_amdgcn_cvt_pk_fp8_f32(v[0] * inv[0], v[1] * inv[1], 0, false), p1 = __builtin_amdgcn_cvt_pk_fp8_f32(v[2] * inv[2], v[3] * inv[3], 0, false);
                w[0] = (unsigned char)(p0 & 255); w[80] = (unsigned char)((p0 >> 8) & 255); w[160] = (unsigned char)(p1 & 255); w[240] = (unsigned char)((p1 >> 8) & 255); }
            else { w[0] = (unsigned char)(int)rintf(v[0] * inv[0]); w[80] = (unsigned char)(int)rintf(v[1] * inv[1]); w[160] = (unsigned char)(int)rintf(v[2] * inv[2]); w[240] = (unsigned char)(int)rintf(v[3] * inv[3]); } }
        asm volatile("s_waitcnt lgkmcnt(0)" ::: "memory");
#pragma unroll
        for (int i = 0; i < 4; ++i) { const int n = 16 * i + (lane >> 2), ch = lane & 3;
            const v4u o = *(const LAS v4u*)(scr + n * 80 + ch * 16);
            *(v4u*)(dst + (size_t)(d0 + n) * K + k0 + 16 * ch) = o; }
        asm volatile("s_waitcnt lgkmcnt(0)" ::: "memory"); }
    __syncthreads();
}
template <int W>
__device__ __forceinline__ void quant_rows(Frame& F, unsigned char* base, size_t pitch, int nrows, float* scale) {
    constexpr int NC = W / 512;
    static_assert(W % 512 == 0, "row width");
    const int gw = F.bid * NWAVES + F.wave, NGW = F.G * NWAVES;
    if (gw >= nrows) return;
    v4u vn[NC];
#pragma unroll
    for (int j = 0; j < NC; ++j) vn[j] = *(const v4u*)(base + (size_t)gw * pitch + 16 * (F.lane + 64 * j));
    for (int row = gw; row < nrows; row += NGW) {
        v4u v[NC];
#pragma unroll
        for (int j = 0; j < NC; ++j) v[j] = vn[j];
        const int rn = (row + NGW < nrows) ? row + NGW : row;
#pragma unroll
        for (int j = 0; j < NC; ++j) vn[j] = *(const v4u*)(base + (size_t)rn * pitch + 16 * (F.lane + 64 * j));
        float am = 0.f;
#pragma unroll
        for (int j = 0; j < NC; ++j)
#pragma unroll
            for (int c = 0; c < 4; ++c) am = fmaxf(am, fmaxf(fabsf(__uint_as_float(v[j][c] << 16)), fabsf(__uint_as_float(v[j][c] & 0xffff0000u))));
        am = wave_max(am);
        const float inv = am > 0.f ? 127.f / am : 0.f;
#pragma unroll
        for (int j = 0; j < NC; ++j) { v2u o;
            { const f32x4 a = {__uint_as_float(v[j][0] << 16), __uint_as_float(v[j][0] & 0xffff0000u), __uint_as_float(v[j][1] << 16), __uint_as_float(v[j][1] & 0xffff0000u)}; o.x = q4(a, inv); }
            { const f32x4 a = {__uint_as_float(v[j][2] << 16), __uint_as_float(v[j][2] & 0xffff0000u), __uint_as_float(v[j][3] << 16), __uint_as_float(v[j][3] & 0xffff0000u)}; o.y = q4(a, inv); }
            *(v2u*)(base + (size_t)row * pitch + 8 * (F.lane + 64 * j)) = o; }
        if (F.lane == 0) scale[row] = am * (1.f / 127.f);
    }
}
template <int KIND>
__device__ __forceinline__ void colmax_matrix(Frame& F, const float* s0, const float* s1, int K, int Nsrc, int ndst, unsigned* cmax) {
    LAS unsigned char* scr = F.lds + RING_OFF + F.wave * 9216;
    const int gw = F.bid * NWAVES + F.wave, NGW = F.G * NWAVES, nitems = (K >> 6) * (ndst >> 6);
    for (int it = gw; it < nitems; it += NGW) colmax_item<KIND>(s0, s1, K, Nsrc, ndst, cmax, it, scr, F.lane);
}
template <int KIND>
__device__ __forceinline__ void conv8_matrix(Frame& F, const float* s0, const float* s1, int K, int Nsrc, int ndst, unsigned char* dst, float* scale, const unsigned* cmax) {
    LAS unsigned char* scr = F.lds + RING_OFF + F.wave * 9216;
    const int gw = F.bid * NWAVES + F.wave, NGW = F.G * NWAVES, nitems = (K >> 6) * (ndst >> 6);
    for (int it = gw; it < nitems; it += NGW) conv8_item<KIND>(s0, s1, K, Nsrc, ndst, dst, scale, cmax, it, scr, F.lane);
}
__device__ __forceinline__ void sincos_rev(double r, float& s, float& c) {
    const double k = rint(4.0 * r);
    const double y = (r - 0.25 * k) * 6.283185307179586;
    const double y2 = y * y;
    const double sy = y * (1.0 + y2 * (-1.0 / 6 + y2 * (1.0 / 120 + y2 * (-1.0 / 5040 + y2 * (1.0 / 362880 + y2 * (-1.0 / 39916800 + y2 * (1.0 / 6227020800.0)))))));
    const double cy = 1.0 + y2 * (-0.5 + y2 * (1.0 / 24 + y2 * (-1.0 / 720 + y2 * (1.0 / 40320 + y2 * (-1.0 / 3628800 + y2 * (1.0 / 479001600.0))))));
    const int q = ((int)k) & 3;
    const double sv = (q == 0) ? sy : (q == 1) ? cy : (q == 2) ? -sy : -cy;
    const double cv = (q == 0) ? cy : (q == 1) ? -sy : (q == 2) ? -cy : sy;
    s = (float)sv; c = (float)cv;
}
__device__ __forceinline__ void p0_prologue(Frame& F, const float* x_in, const int* pos, const float* w_in, const float* w_a, const float* w_b, const float* w_o, const float* f_g, const float* f_u, const float* f_d) {
    unsigned char* ws = F.ws;
    for (int st = F.bid; st < 2 * (PROJ_PAD >> 6); st += F.G) { const int l = st / (PROJ_PAD >> 6), dg = st - l * (PROJ_PAD >> 6);
        conv8_strip_k<1>(F, w_in + (size_t)l * DM * PROJ_TOTAL, nullptr, PROJ_TOTAL, ws + OPQ(WS_WIN) + l * WIN_STRIDE, (float*)(ws + OPQ(WS_WINSC) + l * WIN_STRIDE), dg); }
    for (int st = F.G - 1 - F.bid; st < (2 * DFF >> 6); st += F.G)
        conv8_strip_k<2>(F, f_g, f_u, DFF, ws + OPQ(WS_FGU), (float*)(ws + OPQ(WS_FGUSC)), st);
    for (int l = 0; l < 2; ++l) {
    }
    for (int st = F.bid - 48; st >= 0 && st < 4 * (DM >> 6); st += F.G) { const int l = st >> 5, br = (st >> 4) & 1, dg = st & 15;
        conv8_strip<AW / 64, true>(F, (br ? w_b : w_a) + (size_t)l * AW * DM, DM, ws + OPQ(WS_WA) + (size_t)br * MiB + (size_t)l * (DM * AW), (float*)(ws + OPQ(WS_WABSC)) + l * 4096 + br * 2048, dg, pg8::OSC); }
    for (int st = F.bid - 16; st >= 0 && st < 2 * (DM >> 6); st += F.G) { const int l = st / (DM >> 6), dg = st - l * (DM >> 6);
        conv8_strip<DM / 64, true>(F, w_o + (size_t)l * DM * DM, DM, ws + OPQ(WS_WOUT) + (size_t)l * DM * DM, (float*)(ws + OPQ(WS_WOSC)) + l * DM, dg, pg8::MSC); }
    for (int st = F.bid; st < (DM >> 6); st += F.G) conv8_strip<DFF / 64, true>(F, f_d, DM, ws + OPQ(WS_FD), (float*)(ws + OPQ(WS_FDSC)), st);
    const int gt = F.bid * (NWAVES * 64) + F.tid, NGT = F.G * NWAVES * 64;
    const int RSK = (F.G >= 64) ? 16 : 0;
    if (F.bid >= RSK) { const int gw = (F.bid - RSK) * NWAVES + F.wave, NGW = (F.G - RSK) * NWAVES;
      f32x4 vn[4];
#pragma unroll
      for (int j = 0; j < 4; ++j) vn[j] = *(const f32x4*)(x_in + (size_t)gw * DM + 4 * F.lane + 256 * j);
      for (int row = gw; row < NTOK; row += NGW) {
          f32x4 v[4];
#pragma unroll
          for (int j = 0; j < 4; ++j) v[j] = vn[j];
          const int rn = (row + NGW < NTOK) ? row + NGW : row;
#pragma unroll
          for (int j = 0; j < 4; ++j) vn[j] = *(const f32x4*)(x_in + (size_t)rn * DM + 4 * F.lane + 256 * j);
          float am = 0.f;
#pragma unroll
          for (int j = 0; j < 4; ++j) am = fmaxf(fmaxf(am, fmaxf(fabsf(v[j][0]), fabsf(v[j][1]))), fmaxf(fabsf(v[j][2]), fabsf(v[j][3])));
          am = wave_max(am);
          const float inv = am > 0.f ? 127.f / am : 0.f;
          unsigned* x8 = (unsigned*)(ws + OPQ(WS_XS8)) + (size_t)row * (DM / 4) + F.lane;
#pragma unroll
          for (int j = 0; j < 4; ++j) { v2u o; o.x = pk2(v[j][0], v[j][1]); o.y = pk2(v[j][2], v[j][3]); *(v2u*)((bf16*)(ws + OPQ(WS_XS)) + (size_t)row * DM + 4 * F.lane + 256 * j) = o; x8[64 * j] = q4(v[j], inv); }
          if (F.lane == 0) ((float*)(ws + OPQ(WS_XSCALE)))[row] = am * (1.f / 127.f);
      } }
    { float* cs = (float*)(ws + OPQ(WS_CS));
      for (int i = gt; i < NTOK * 32; i += NGT) { const int tok = i >> 5, fi = i & 31;
          const float invf = (float)exp2(-(double)fi * (13.287712379549449 / 32.0));
          const float ang = (float)pos[tok] * invf;
          double rev = (double)ang * 0.15915494309189535; rev -= floor(rev);
          float s, c; sincos_rev(rev, s, c); cs[2 * i] = c; cs[2 * i + 1] = s; } }
}
__device__ __forceinline__ void moe_convert(Frame& F, const float* wg, const float* wu, const float* wd) {
    unsigned char* gu = (unsigned char*)F.out; float* gsc = (float*)(F.ws + OPQ(WS_MGUSC));
    constexpr int SPE = 2 * DFF >> 6;
    for (int st = F.bid; st < NEXP * SPE; st += F.G) { const int e = st / SPE, dg = st - e * SPE;
        conv8_strip_k<2>(F, wg + (size_t)e * DM * DFF, wu + (size_t)e * DM * DFF, DFF, gu + (size_t)e * 2 * DFF * DM, gsc + e * 2 * DFF, dg); }
    unsigned char* dn = (unsigned char*)(F.ws + OPQ(WS_MWD)); float* dsc = (float*)(F.ws + OPQ(WS_MWDSC));
    for (int st = F.G - 1 - F.bid; st < NEXP * (DM >> 6); st += F.G) { const int e = st / (DM >> 6), dg = st - e * (DM >> 6);
        conv8_strip<DFF / 64, true>(F, wd + (size_t)e * DFF * DM, DM, dn + (size_t)e * DM * DFF, dsc + e * DM, dg); }
}

typedef float f32x4i __attribute__((ext_vector_type(4)));
typedef short s16x2v __attribute__((ext_vector_type(2)));
__device__ __forceinline__ unsigned sortkey16x2(float a, float b) {
    const unsigned p = __builtin_amdgcn_perm(__float_as_uint(b), __float_as_uint(a), 0x07060302u);
    const s16x2v m = __builtin_bit_cast(s16x2v, p) >> (s16x2v){15, 15};
    return p ^ (__builtin_bit_cast(unsigned, m) | 0x80008000u);
}
__device__ __forceinline__ unsigned sortkey16(float f) { const unsigned u = __float_as_uint(f); return (u ^ ((u >> 31) ? 0xffffffffu : 0x80000000u)) >> 16; }
#define DPP_I(v, ctrl) __builtin_amdgcn_update_dpp(0, (v), (ctrl), 0xf, 0xf, true)
__device__ __forceinline__ int wave_suffix_sum(int x, int lane) {
    x += DPP_I(x, 0x101); x += DPP_I(x, 0x102); x += DPP_I(x, 0x104); x += DPP_I(x, 0x108);
    const int t1 = __builtin_amdgcn_readlane(x, 16), t2 = __builtin_amdgcn_readlane(x, 32), t3 = __builtin_amdgcn_readlane(x, 48);
    const int row = lane >> 4;
    return x + (row == 0 ? t1 + t2 + t3 : row == 1 ? t2 + t3 : row == 2 ? t3 : 0);
}
__device__ __forceinline__ int wave_sum_i(int v) {
    v += __builtin_amdgcn_update_dpp(0, v, 0xB1, 0xf, 0xf, false);
    v += __builtin_amdgcn_update_dpp(0, v, 0x4E, 0xf, 0xf, false);
    v += __builtin_amdgcn_update_dpp(0, v, 0x141, 0xf, 0xf, false);
    v += __builtin_amdgcn_update_dpp(0, v, 0x140, 0xf, 0xf, false);
    return __builtin_amdgcn_readlane(v, 0) + __builtin_amdgcn_readlane(v, 16) + __builtin_amdgcn_readlane(v, 32) + __builtin_amdgcn_readlane(v, 48);
}
__device__ __forceinline__ int hist_select(const LAS unsigned* hist, int K, int lane, int& gt) {
    const v4u c = *(const LAS v4u*)(hist + 4 * lane);
    const int s = (int)(c.x + c.y + c.z + c.w);
    const int above = wave_suffix_sum(s, lane) - s;
    int bin = -1, g = 0;
    int a3 = above, a2 = above + (int)c.w, a1 = a2 + (int)c.z, a0 = a1 + (int)c.y;
    if (a3 < K && K <= a3 + (int)c.w) { bin = 4 * lane + 3; g = a3; }
    else if (a2 < K && K <= a2 + (int)c.z) { bin = 4 * lane + 2; g = a2; }
    else if (a1 < K && K <= a1 + (int)c.y) { bin = 4 * lane + 1; g = a1; }
    else if (a0 < K && K <= a0 + (int)c.x) { bin = 4 * lane + 0; g = a0; }
    const unsigned long long bal = __ballot(bin >= 0);
    const int src = bal ? (int)__builtin_ctzll(bal) : 0;
    gt = __builtin_amdgcn_readlane(g, src); return __builtin_amdgcn_readlane(bin, src);
}
__device__ __forceinline__ int wave_prefix_sum(int x, int lane) {
    x += DPP_I(x, 0x111); x += DPP_I(x, 0x112); x += DPP_I(x, 0x114); x += DPP_I(x, 0x118);
    const int t0 = __builtin_amdgcn_readlane(x, 15), t1 = __builtin_amdgcn_readlane(x, 31), t2 = __builtin_amdgcn_readlane(x, 47);
    const int row = lane >> 4;
    return x + (row == 0 ? 0 : row == 1 ? t0 : row == 2 ? t0 + t1 : t0 + t1 + t2);
}
template <int S>
__device__ __forceinline__ unsigned bt_stage(unsigned x, unsigned t, bool upper) {
    constexpr unsigned M = S == 16 ? 0x0000ffffu : S == 8 ? 0x00ff00ffu : S == 4 ? 0x0f0f0f0fu : S == 2 ? 0x33333333u : 0x55555555u;
    const unsigned keep = upper ? ~M : M, sh = upper ? (t >> S) : (t << S);
    return (x & keep) | (sh & ~keep);
}
__device__ __forceinline__ void idx_unit(Frame& F, int b, int qg, const bf16* IQ, const bf16* IK, const float* IW, unsigned* MASK) {
    const int lane = F.lane, wave = F.wave;
    const int t0 = 16 * qg, limit = 64 * (t0 / 64 + 1); const size_t row0 = (size_t)b * SEQ + t0;
    const int nwords = ((limit + 255) >> 8) << 3;
    if (limit <= 256) {
        for (int qq = 0; qq < 2; ++qq) { const int q = 2 * wave + qq; if (lane < nwords) MASK[(row0 + q) * 128 + lane] = (lane < (limit >> 5)) ? 0xffffffffu : 0u; }
        return;
    }
    LAS unsigned char* keys = F.lds;
    LAS unsigned* hist = (LAS unsigned*)(F.lds + IDX_HIST_OFF) + wave * 256;
#ifndef IDX_REP_SCORE
#define IDX_REP_SCORE 1
#endif
#ifndef IDX_REP_SEL
#define IDX_REP_SEL 1
#endif
    for (int rs_ = 0; rs_ < IDX_REP_SCORE; ++rs_)
    {
        const int qc = lane & 15, kq = lane >> 4;
        bf16x8 bq[8][2]; float w[8];
#pragma unroll
        for (int h = 0; h < 8; ++h) { const bf16* p = IQ + (row0 + qc) * AW + h * 64 + 8 * kq; bq[h][0] = *(const bf16x8*)p; bq[h][1] = *(const bf16x8*)(p + 32); }
        { const f32x4 w0 = *(const f32x4*)(IW + (row0 + qc) * 8), w1 = *(const f32x4*)(IW + (row0 + qc) * 8 + 4);
          w[0] = w0[0]; w[1] = w0[1]; w[2] = w0[2]; w[3] = w0[3]; w[4] = w1[0]; w[5] = w1[1]; w[6] = w1[2]; w[7] = w1[3]; }
        const bf16* ikb = IK + ((size_t)b * SEQ + qc) * 64 + 8 * kq;
        const int nkb = limit >> 4;
#define IDX_BLOCK(KB, A0, A1) do { f32x4i sc = {0.f, 0.f, 0.f, 0.f}; f32x4i ac8[8]; \
              \
            _Pragma("unroll") for (int h = 0; h < 8; ++h) ac8[h] = __builtin_amdgcn_mfma_f32_16x16x32_bf16(A0, bq[h][0], (f32x4i){0.f, 0.f, 0.f, 0.f}, 0, 0, 0); \
            _Pragma("unroll") for (int h = 0; h < 8; ++h) ac8[h] = __builtin_amdgcn_mfma_f32_16x16x32_bf16(A1, bq[h][1], ac8[h], 0, 0, 0); \
            _Pragma("unroll") for (int h = 0; h < 8; ++h) { \
                _Pragma("unroll") for (int r = 0; r < 4; ++r) sc[r] = __builtin_fmaf(w[h], __builtin_amdgcn_fmed3f(ac8[h][r], 0.f, 3.0e38f), sc[r]); } \
            v2u pk; pk.x = sortkey16x2(sc[0], sc[1]); pk.y = sortkey16x2(sc[2], sc[3]); \
            *(LAS v2u*)(keys + qc * IDX_ROWB + ((KB) * 16 + 4 * kq) * 2) = pk; } while (0)
        const int kbB0 = (wave + 8 < nkb) ? wave + 8 : wave;
        bf16x8 a0 = *(const bf16x8*)(ikb + (size_t)wave * 1024), a1 = *(const bf16x8*)(ikb + (size_t)wave * 1024 + 32);
        bf16x8 b0 = *(const bf16x8*)(ikb + (size_t)kbB0 * 1024), b1 = *(const bf16x8*)(ikb + (size_t)kbB0 * 1024 + 32);
        for (int kb = wave; kb < nkb; kb += 32) {
            bf16x8 n0, n1, m0, m1;
            { const int kbB = (kb + 8 < nkb) ? kb + 8 : kb;
              const int kn = (kb + 16 < nkb) ? kb + 16 : kb, km = (kb + 24 < nkb) ? kb + 24 : kn;
              n0 = *(const bf16x8*)(ikb + (size_t)kn * 1024); n1 = *(const bf16x8*)(ikb + (size_t)kn * 1024 + 32);
              m0 = *(const bf16x8*)(ikb + (size_t)km * 1024); m1 = *(const bf16x8*)(ikb + (size_t)km * 1024 + 32);
              IDX_BLOCK(kb, a0, a1);
              IDX_BLOCK(kbB, b0, b1); }
            const int k2 = kb + 16;
            if (k2 >= nkb) break;
            { const int kbB = (k2 + 8 < nkb) ? k2 + 8 : k2;
              const int kn = (k2 + 16 < nkb) ? k2 + 16 : k2, km = (k2 + 24 < nkb) ? k2 + 24 : kn;
              a0 = *(const bf16x8*)(ikb + (size_t)kn * 1024); a1 = *(const bf16x8*)(ikb + (size_t)kn * 1024 + 32);
              b0 = *(const bf16x8*)(ikb + (size_t)km * 1024); b1 = *(const bf16x8*)(ikb + (size_t)km * 1024 + 32);
              IDX_BLOCK(k2, n0, n1);
              IDX_BLOCK(kbB, m0, m1); }
        }
#undef IDX_BLOCK
    }
    {
        const int tail = ((limit + 511) & ~511) - limit;
        for (int i = F.tid; i < 16 * (tail >> 1); i += NWAVES * 64) { const int row = i / (tail >> 1), k2 = i - row * (tail >> 1);
            *(LAS unsigned*)(keys + row * IDX_ROWB + (limit + 2 * k2) * 2) = 0u; }
    }
    __syncthreads();
    for (int rq_ = 0; rq_ < IDX_REP_SEL; ++rq_)
    for (int qq = 0; qq < 2; ++qq) {
        const int q = 2 * wave + qq; const LAS unsigned short* rowk = (const LAS unsigned short*)(keys + q * IDX_ROWB);
        const int nj = limit >> 6;
        unsigned kj[64];
#pragma unroll
        for (int g = 0; g < 8; ++g) {
            if (8 * g < nj) {
#pragma unroll
                for (int jj = 0; jj < 8; ++jj) kj[8 * g + jj] = rowk[64 * (8 * g + jj) + lane];
            } else {
#pragma unroll
                for (int jj = 0; jj < 8; ++jj) kj[8 * g + jj] = 0u;
            }
        }
#define IDX_COUNT(COND, OUT) do { int c_ = 0; \
            _Pragma("unroll") for (int g = 0; g < 8; ++g) if (8 * g < nj) { _Pragma("unroll") for (int jj = 0; jj < 8; ++jj) { const unsigned kv_ = kj[8 * g + jj]; c_ += (COND) ? 1 : 0; } } \
            OUT = wave_sum_i(c_); } while (0)
#ifndef SEL_REP_A
#define SEL_REP_A 1
#define SEL_REP_B 1
#define SEL_REP_C 1
#endif
        unsigned T = 0u; int gt8 = 0; bool hb_ok = false;
        for (int ra_ = 0; ra_ < SEL_REP_A; ++ra_)
        {   constexpr int HB0 = 0xB4;
            LAS unsigned* pc = hist + lane;
            { unsigned z_ = 0u; asm volatile("" : "+v"(z_)); pc[0] = z_; pc[64] = z_; pc[128] = z_; pc[192] = z_; }
#pragma unroll
            for (int g = 0; g < 8; ++g) if (8 * g < nj) {
#pragma unroll
                for (int jj = 0; jj < 8; ++jj) { int ix = (int)(kj[8 * g + jj] >> 8) - HB0; ix = ix < 0 ? 0 : (ix > 15 ? 15 : ix);
                    __hip_atomic_fetch_add(pc + ((ix >> 2) << 6), 1u << ((ix & 3) << 3), __ATOMIC_RELAXED, __HIP_MEMORY_SCOPE_WORKGROUP); } }
            asm volatile("s_waitcnt lgkmcnt(0)" ::: "memory");
            int cb[16];
#pragma unroll
            for (int w = 0; w < 4; ++w) { const unsigned x = pc[64 * w];
                const int e = wave_sum_i((int)(x & 0x00ff00ffu)), o = wave_sum_i((int)((x >> 8) & 0x00ff00ffu));
                cb[4 * w] = e & 0xffff; cb[4 * w + 2] = (e >> 16) & 0xffff; cb[4 * w + 1] = o & 0xffff; cb[4 * w + 3] = (o >> 16) & 0xffff; }
            int cum = 0, bin = -1, above = 0;
#pragma unroll
            for (int bi = 15; bi >= 0; --bi) { if (bin < 0) { if (cum + cb[bi] >= DSA_TOPK) { bin = bi; above = cum; } cum += cb[bi]; } }
            if (bin >= 1 && bin <= 14) { T = (unsigned)(HB0 + bin) << 8; gt8 = above; hb_ok = true; }
        }
        if (!hb_ok) {
            T = 0u;
            for (int bit = 15; bit >= 8; --bit) { const unsigned cand = T | (1u << bit); int cnt; IDX_COUNT(kv_ >= cand, cnt); if (cnt >= DSA_TOPK) T = cand; }
            const unsigned nxt = T + 256u; IDX_COUNT(kv_ >= nxt, gt8);
        }
        int gt2 = 0, lo8 = 0;
        for (int rb_ = 0; rb_ < SEL_REP_B; ++rb_) {
        { unsigned z_ = 0u; asm volatile("" : "+v"(z_)); *(LAS v4u*)(hist + 4 * lane) = (v4u){z_, z_, z_, z_}; }
        { const unsigned p8 = T >> 8;
#pragma unroll
          for (int g = 0; g < 8; ++g) if (8 * g < nj) {
#pragma unroll
              for (int jj = 0; jj < 8; ++jj) { const unsigned kv_ = kj[8 * g + jj]; if ((kv_ >> 8) == p8) __hip_atomic_fetch_add(hist + (kv_ & 255u), 1u, __ATOMIC_RELAXED, __HIP_MEMORY_SCOPE_WORKGROUP); } } }
        asm volatile("s_waitcnt lgkmcnt(0)" ::: "memory");
        lo8 = hist_select(hist, DSA_TOPK - gt8, lane, gt2); }
        T |= (unsigned)lo8; const int gt = gt8 + gt2;
#undef IDX_COUNT
        const int need = DSA_TOPK - gt;
        unsigned glo = 0u, ghi = 0u, elo = 0u, ehi = 0u;
#pragma unroll
        for (int g = 0; g < 8; ++g) if (8 * g < nj) {
#pragma unroll
            for (int jj = 0; jj < 8; ++jj) { const int j = 8 * g + jj; const unsigned kv_ = kj[j], bit = 1u << (j & 31);
                if (j < 32) { glo |= (kv_ > T) ? bit : 0u; elo |= (kv_ == T) ? bit : 0u; } else { ghi |= (kv_ > T) ? bit : 0u; ehi |= (kv_ == T) ? bit : 0u; } } }
        { const int cnt = __popc(elo) + __popc(ehi); const int nL = need - (wave_prefix_sum(cnt, lane) - cnt);
          if (nL <= 0) { elo = 0u; ehi = 0u; }
          else if (nL < cnt) { unsigned long long e = ((unsigned long long)ehi << 32) | elo;
              for (int rem = cnt - nL; rem > 0; --rem) e &= ~(1ull << (63 - __builtin_clzll(e)));
              elo = (unsigned)e; ehi = (unsigned)(e >> 32); } }
        unsigned mine_lo = glo | elo, mine_hi = ghi | ehi;
        { auto sw = __builtin_amdgcn_permlane32_swap(mine_lo, mine_hi, false, false); mine_lo = sw[0]; mine_hi = sw[1]; }
        { const int l5 = mk_lane();
          { const bool up = (l5 & 16) != 0;
            mine_lo = bt_stage<16>(mine_lo, (unsigned)__builtin_amdgcn_ds_swizzle((int)mine_lo, (16 << 10) | 0x1f), up); mine_hi = bt_stage<16>(mine_hi, (unsigned)__builtin_amdgcn_ds_swizzle((int)mine_hi, (16 << 10) | 0x1f), up); }
          { const bool up = (l5 & 8) != 0;
            mine_lo = bt_stage<8>(mine_lo, (unsigned)__builtin_amdgcn_update_dpp(0, (int)mine_lo, 0x128, 0xf, 0xf, false), up); mine_hi = bt_stage<8>(mine_hi, (unsigned)__builtin_amdgcn_update_dpp(0, (int)mine_hi, 0x128, 0xf, 0xf, false), up); }
          { const bool up = (l5 & 4) != 0;
            const unsigned tl = (unsigned)__builtin_amdgcn_update_dpp(0, __builtin_amdgcn_update_dpp(0, (int)mine_lo, 0x141, 0xf, 0xf, false), 0x1B, 0xf, 0xf, false);
            const unsigned th = (unsigned)__builtin_amdgcn_update_dpp(0, __builtin_amdgcn_update_dpp(0, (int)mine_hi, 0x141, 0xf, 0xf, false), 0x1B, 0xf, 0xf, false);
            mine_lo = bt_stage<4>(mine_lo, tl, up); mine_hi = bt_stage<4>(mine_hi, th, up); }
          { const bool up = (l5 & 2) != 0;
            mine_lo = bt_stage<2>(mine_lo, (unsigned)__builtin_amdgcn_update_dpp(0, (int)mine_lo, 0x4E, 0xf, 0xf, false), up); mine_hi = bt_stage<2>(mine_hi, (unsigned)__builtin_amdgcn_update_dpp(0, (int)mine_hi, 0x4E, 0xf, 0xf, false), up); }
          { const bool up = (l5 & 1) != 0;
            mine_lo = bt_stage<1>(mine_lo, (unsigned)__builtin_amdgcn_update_dpp(0, (int)mine_lo, 0xB1, 0xf, 0xf, false), up); mine_hi = bt_stage<1>(mine_hi, (unsigned)__builtin_amdgcn_update_dpp(0, (int)mine_hi, 0xB1, 0xf, 0xf, false), up); } }
        if (lane < (nwords >> 1)) *(v2u*)(MASK + (row0 + q) * 128 + 2 * lane) = (v2u){mine_lo, mine_hi};
    }
    __syncthreads();
}
__device__ __forceinline__ void idx_phase(Frame& F, const bf16* IQ, const bf16* IK, const float* IW, const float* LOGF, float* CB, unsigned* MASK, const bf16* FQ, const bf16* FK, unsigned* norms) {
    {
        const int tpb = NTOK / F.G, r0 = F.bid * tpb, rpw = tpb / NWAVES; float mq = 0.f, mk = 0.f;
        constexpr int RPW = 16;
        for (int base = 0; base < rpw; base += RPW) {
            v4u qa[RPW], ka[RPW];
#pragma unroll
            for (int i = 0; i < RPW; ++i) { const size_t row = (size_t)(r0 + F.wave * rpw + (base + i < rpw ? base + i : base)); qa[i] = *(const v4u*)(FQ + row * AW + 8 * F.lane); ka[i] = *(const v4u*)(FK + row * AW + 8 * F.lane); }
#pragma unroll
            for (int i = 0; i < RPW; ++i) {
                const v4u q8 = qa[i], k8 = ka[i]; float sq = 0.f, sk = 0.f;
#pragma unroll
                for (int j = 0; j < 4; ++j) { const float a = __uint_as_float(q8[j] << 16), b2 = __uint_as_float(q8[j] & 0xffff0000u), c = __uint_as_float(k8[j] << 16), d = __uint_as_float(k8[j] & 0xffff0000u);
                    sq += a * a + b2 * b2; sk += c * c + d * d; }
#define DPP_F(x, ctrl) __int_as_float(__builtin_amdgcn_update_dpp(0, __float_as_int(x), (ctrl), 0xf, 0xf, true))
                sq += DPP_F(sq, 0xB1); sq += DPP_F(sq, 0x4E); sq += DPP_F(sq, 0x141); sk += DPP_F(sk, 0xB1); sk += DPP_F(sk, 0x4E); sk += DPP_F(sk, 0x141);
#undef DPP_F
                mq = fmaxf(mq, sq); mk = fmaxf(mk, sk); } }
        LAS float* nl = (LAS float*)(F.lds + IDX_HIST_OFF);
        if ((F.lane & 7) == 0) { nl[F.wave * 16 + (F.lane >> 3)] = mq; nl[F.wave * 16 + 8 + (F.lane >> 3)] = mk; }
        __syncthreads();
        if (F.tid < 16) { float m = 0.f;
#pragma unroll
            for (int w = 0; w < NWAVES; ++w) m = fmaxf(m, nl[w * 16 + F.tid]);
            __hip_atomic_fetch_max(norms + ((r0 / SEQ) * NH + (F.tid & 7)) * 2 + (F.tid >> 3), __float_as_uint(m), __ATOMIC_RELAXED, __HIP_MEMORY_SCOPE_AGENT); }
        __syncthreads();
    }
    const int gw = F.bid * NWAVES + F.wave;
    if (gw < BATCH * NH) {
        const float* src = LOGF + (size_t)gw * SEQ; float* dst = CB + (size_t)gw * SEQ; float carry = 0.f;
        float vals[64];
#pragma unroll
        for (int i = 0; i < 64; ++i) vals[i] = src[64 * i + F.lane];
#pragma unroll
        for (int i = 0; i < 64; ++i) {
            float v = vals[i];
            v += __int_as_float(DPP_I(__float_as_int(v), 0x111)); v += __int_as_float(DPP_I(__float_as_int(v), 0x112));
            v += __int_as_float(DPP_I(__float_as_int(v), 0x114)); v += __int_as_float(DPP_I(__float_as_int(v), 0x118));
            { const float r0 = __int_as_float(__builtin_amdgcn_readlane(__float_as_int(v), 15)), r1 = __int_as_float(__builtin_amdgcn_readlane(__float_as_int(v), 31)),
                          r2 = __int_as_float(__builtin_amdgcn_readlane(__float_as_int(v), 47)); const int row = F.lane >> 4;
              v += (row == 0 ? 0.f : row == 1 ? r0 : row == 2 ? r0 + r1 : (r0 + r1) + r2); }
            const float c = carry + v;
            dst[64 * i + F.lane] = -c * LOG2E;
            carry = __int_as_float(__builtin_amdgcn_readlane(__float_as_int(c), 63));
        }
    }
    for (int k = F.bid; k < BATCH * (SEQ / 16); k += F.G) {
        const int round = k >> 8, pos = k & 255, i = (round << 8) + ((round & 1) ? 255 - pos : pos);
        idx_unit(F, i & 7, 255 - (i >> 3), IQ, IK, IW, MASK);
    }
}

__device__ __forceinline__ void attn_phase(Frame& F, const bf16* DQ, const bf16* DK, const bf16* DV, const bf16* FQ, const bf16* FK, const bf16* FV, const unsigned* MASK, const float* CB, bf16* OA, bf16* OB,
                                           unsigned* qctr, const unsigned* norms) {
    constexpr int NUNITS = 2 * BATCH * NH * (SEQ / 256);
    volatile LAS int* qs = (volatile LAS int*)(F.lds + MISC_OFF + 64);
    unsigned p_old = 0u, p_new = 0u;
    if (F.tid == 0) { qs[0] = (int)__hip_atomic_fetch_add(qctr, 1u, __ATOMIC_RELAXED, __HIP_MEMORY_SCOPE_AGENT); qs[1] = (int)__hip_atomic_fetch_add(qctr, 1u, __ATOMIC_RELAXED, __HIP_MEMORY_SCOPE_AGENT);
                      p_old = __hip_atomic_fetch_add(qctr, 1u, __ATOMIC_RELAXED, __HIP_MEMORY_SCOPE_AGENT); }
    __syncthreads();
    int cur = qs[0], nxt = qs[1];
    __syncthreads();
    while (cur < NUNITS) {
        const int qb = 15 - (cur >> 7), r = cur & 127, kind = r >> 6, b = (r >> 3) & 7, h = r & 7;
        if (kind == 0) attn_body::attn_unit<0, 8>(b, h, qb, DQ, DK, DV, OA, MASK, CB, (LAS char*)F.lds, 0.f, qctr, p_new, p_old, qs, F.wave);
        else { const float q2 = __uint_as_float(__hip_atomic_load(norms + (b * NH + h) * 2, __ATOMIC_RELAXED, __HIP_MEMORY_SCOPE_AGENT)), k2 = __uint_as_float(__hip_atomic_load(norms + (b * NH + h) * 2 + 1, __ATOMIC_RELAXED, __HIP_MEMORY_SCOPE_AGENT));
            attn_body::attn_unit<1, 8>(b, h, qb, FQ, FK, FV, OB, MASK, CB, (LAS char*)F.lds, sqrtf(q2 * k2) * 1.02f + 2.f, qctr, p_new, p_old, qs, F.wave); }
        cur = nxt; nxt = qs[0]; p_old = p_new;
    }
}

template <int MODE, bool Q8 = false>
__device__ __forceinline__ void ln_phase(Frame& F, const float* gam, const float* bet, const float* router, size_t x8off = 0, size_t xscoff = 0) {
    const bf16* Y = (const bf16*)F.out; bf16* XS = (bf16*)(F.ws + OPQ(WS_XS));
    const int tpb = NTOK / F.G, r_lo = F.bid * tpb;
    LAS unsigned* cnt = (LAS unsigned*)(F.lds + RING_OFF);
    if (MODE == 1) { if (F.tid < 8) cnt[F.tid] = 0u; __syncthreads(); }
    f32x4 g4[4], b4[4];
#pragma unroll
    for (int j = 0; j < 4; ++j) { g4[j] = *(const f32x4*)(gam + 4 * F.lane + 256 * j); b4[j] = *(const f32x4*)(bet + 4 * F.lane + 256 * j); }
    f32x4 rw[4][4][2];
    if (MODE == 1) {
#pragma unroll
        for (int j = 0; j < 4; ++j)
#pragma unroll
            for (int c = 0; c < 4; ++c) { const float* rp = router + (size_t)(4 * F.lane + 256 * j + c) * 8; rw[j][c][0] = *(const f32x4*)rp; rw[j][c][1] = *(const f32x4*)(rp + 4); }
    }
    v2u vn[4];
    if (MODE != 3) {
#pragma unroll
        for (int j = 0; j < 4; ++j) vn[j] = *(const v2u*)(Y + (size_t)(r_lo + F.wave) * DM + 4 * F.lane + 256 * j);
    }
    v2u xn[4], y0n[4], y1n[4]; int sn0 = 0, sn1 = 0;
    if (MODE == 3) {
        const int* tsb = (const int*)(F.ws + OPQ(MOE_TOKSLOT)); const bf16* yb = (const bf16*)(F.ws + OPQ(WS_YB));
        const int r0_ = r_lo + F.wave; const int a0 = tsb[2 * r0_], a1 = tsb[2 * r0_ + 1];
#pragma unroll
        for (int j = 0; j < 4; ++j) { const int c = 4 * F.lane + 256 * j; xn[j] = *(const v2u*)(XS + (size_t)r0_ * DM + c); y0n[j] = *(const v2u*)(yb + (size_t)a0 * DM + c); y1n[j] = *(const v2u*)(yb + (size_t)a1 * DM + c); }
        const int r1_ = (F.wave + NWAVES < tpb) ? r0_ + NWAVES : r0_; sn0 = tsb[2 * r1_]; sn1 = tsb[2 * r1_ + 1];
    }
    for (int rr = F.wave; rr < tpb; rr += NWAVES) {
        const int row = r_lo + rr;
        f32x4 v[4]; float s = 0.f;
        if (MODE == 3) {
            const int* tsb = (const int*)(F.ws + OPQ(MOE_TOKSLOT)); const bf16* yb = (const bf16*)(F.ws + OPQ(WS_YB));
            v2u xc[4], y0c[4], y1c[4];
#pragma unroll
            for (int j = 0; j < 4; ++j) { xc[j] = xn[j]; y0c[j] = y0n[j]; y1c[j] = y1n[j]; }
            const int rn = (rr + NWAVES < tpb) ? row + NWAVES : row, rn2 = (rr + 2 * NWAVES < tpb) ? row + 2 * NWAVES : rn;
#pragma unroll
            for (int j = 0; j < 4; ++j) { const int c = 4 * F.lane + 256 * j; xn[j] = *(const v2u*)(XS + (size_t)rn * DM + c); y0n[j] = *(const v2u*)(yb + (size_t)sn0 * DM + c); y1n[j] = *(const v2u*)(yb + (size_t)sn1 * DM + c); }
            sn0 = tsb[2 * rn2]; sn1 = tsb[2 * rn2 + 1];
#pragma unroll
            for (int j = 0; j < 4; ++j) {
                const v2u xr = xc[j], y0 = y0c[j], y1 = y1c[j];
                v[j][0] = ALPHA * pg8::bf2f(xr.x & 0xffffu) + (pg8::bf2f(y0.x & 0xffffu) + pg8::bf2f(y1.x & 0xffffu));
                v[j][1] = ALPHA * __uint_as_float(xr.x & 0xffff0000u) + (__uint_as_float(y0.x & 0xffff0000u) + __uint_as_float(y1.x & 0xffff0000u));
                v[j][2] = ALPHA * pg8::bf2f(xr.y & 0xffffu) + (pg8::bf2f(y0.y & 0xffffu) + pg8::bf2f(y1.y & 0xffffu));
                v[j][3] = ALPHA * __uint_as_float(xr.y & 0xffff0000u) + (__uint_as_float(y0.y & 0xffff0000u) + __uint_as_float(y1.y & 0xffff0000u)); }
        } else {
#pragma unroll
            for (int j = 0; j < 4; ++j) { v[j][0] = __uint_as_float(vn[j].x << 16); v[j][1] = __uint_as_float(vn[j].x & 0xffff0000u); v[j][2] = __uint_as_float(vn[j].y << 16); v[j][3] = __uint_as_float(vn[j].y & 0xffff0000u); }
            const int rn = (rr + NWAVES < tpb) ? row + NWAVES : row;
#pragma unroll
            for (int j = 0; j < 4; ++j) vn[j] = *(const v2u*)(Y + (size_t)rn * DM + 4 * F.lane + 256 * j);
        }
#pragma unroll
        for (int j = 0; j < 4; ++j) s += (v[j][0] + v[j][1]) + (v[j][2] + v[j][3]);
        const float mean = wave_sum(s) * (1.f / DM); float s2 = 0.f;
#pragma unroll
        for (int j = 0; j < 4; ++j) { v[j] = v[j] - mean; s2 += (v[j][0] * v[j][0] + v[j][1] * v[j][1]) + (v[j][2] * v[j][2] + v[j][3] * v[j][3]); }
        const float rstd = 1.f / sqrtf(wave_sum(s2) * (1.f / DM) + LN_EPS);
#pragma unroll
        for (int j = 0; j < 4; ++j) v[j] = v[j] * rstd * g4[j] + b4[j];
        if (MODE == 2 || MODE == 3) {
#pragma unroll
            for (int j = 0; j < 4; ++j) *(f32x4*)(F.out + (size_t)row * DM + 4 * F.lane + 256 * j) = v[j];
        }
        if (MODE == 0 || MODE == 1) {
#pragma unroll
            for (int j = 0; j < 4; ++j) { v2u o; o.x = pk2(v[j][0], v[j][1]); o.y = pk2(v[j][2], v[j][3]); *(v2u*)(XS + (size_t)row * DM + 4 * F.lane + 256 * j) = o; }
        }
        if ((MODE == 0 || MODE == 1) && Q8) {
            float am = 0.f;
#pragma unroll
            for (int j = 0; j < 4; ++j) am = fmaxf(fmaxf(am, fmaxf(fabsf(v[j][0]), fabsf(v[j][1]))), fmaxf(fabsf(v[j][2]), fabsf(v[j][3])));
            am = wave_max(am);
            const float inv = am > 0.f ? 127.f / am : 0.f;
            unsigned* x8 = (unsigned*)(F.ws + x8off) + (size_t)row * (DM / 4) + F.lane;
#pragma unroll
            for (int j = 0; j < 4; ++j) x8[64 * j] = q4(v[j], inv);
            if (F.lane == 0) ((float*)(F.ws + xscoff))[row] = am * (1.f / 127.f);
        }
        if (MODE == 1) {
            float lg[8];
#pragma unroll
            for (int e = 0; e < 8; ++e) lg[e] = 0.f;
#pragma unroll
            for (int j = 0; j < 4; ++j)
#pragma unroll
                for (int c = 0; c < 4; ++c) { const f32x4 r0 = rw[j][c][0], r1 = rw[j][c][1]; const float x = v[j][c];
                    lg[0] += x * r0[0]; lg[1] += x * r0[1]; lg[2] += x * r0[2]; lg[3] += x * r0[3]; lg[4] += x * r1[0]; lg[5] += x * r1[1]; lg[6] += x * r1[2]; lg[7] += x * r1[3]; }
#pragma unroll
            for (int e = 0; e < 8; ++e) lg[e] = wave_sum(lg[e]);
            float bv = lg[0]; int bi = 0;
#pragma unroll
            for (int e = 1; e < 8; ++e) if (lg[e] > bv) { bv = lg[e]; bi = e; }
            float sv = -INFINITY; int si = 0;
#pragma unroll
            for (int e = 0; e < 8; ++e) if (e != bi && lg[e] > sv) { sv = lg[e]; si = e; }
            if (F.lane == 0) {
                const float g0 = 1.f / (1.f + __expf(sv - bv));
                ((unsigned*)(F.ws + OPQ(MOE_TOPE)))[row] = (unsigned)bi | ((unsigned)si << 8);
                float* tg = (float*)(F.ws + OPQ(MOE_TOPG)) + 2 * row; tg[0] = g0; tg[1] = 1.f - g0;
                __hip_atomic_fetch_add(cnt + bi, 1u, __ATOMIC_RELAXED, __HIP_MEMORY_SCOPE_WORKGROUP); __hip_atomic_fetch_add(cnt + si, 1u, __ATOMIC_RELAXED, __HIP_MEMORY_SCOPE_WORKGROUP);
            }
        }
    }
    if (MODE == 1) { __syncthreads(); if (F.tid < 8) ((unsigned*)(F.ws + OPQ(MOE_CNT)))[F.bid * 8 + F.tid] = cnt[F.tid]; }
}

__device__ __forceinline__ void moe_assign(Frame& F) {
    const unsigned* CNT = (const unsigned*)(F.ws + OPQ(MOE_CNT));
    LAS int* part = (LAS int*)(F.lds + RING_OFF);
    LAS int* tot = part + 512;
    LAS int* base = tot + 8; LAS int* pst = tot + 16; LAS int* wcnt = tot + 24;
    const int G = F.G, tpb = NTOK / G, j = F.bid;
    __syncthreads();
    { const int e = F.tid & 7, grp = F.tid >> 3; int s = 0;
      const int gsz = (G + 63) / 64;
      for (int jj = grp * gsz; jj < (grp + 1) * gsz && jj < G; ++jj) s += (int)CNT[jj * 8 + e];
      part[grp * 8 + e] = s; }
    __syncthreads();
    if (F.tid < 8) { const int e = F.tid, gsz = (G + 63) / 64, myg = j / gsz; int t = 0, bs = 0;
        for (int g = 0; g < 64; ++g) { const int s = part[g * 8 + e]; if (g < myg) bs += s; t += s; }
        for (int jj = myg * gsz; jj < j; ++jj) bs += (int)CNT[jj * 8 + e];
        tot[e] = t; base[e] = bs; if (j == 0) ((int*)(F.ws + OPQ(MOE_TOT)))[e] = t; }
    __syncthreads();
    if (F.tid == 0) { int ps = 0; for (int e = 0; e < 8; ++e) { pst[e] = ps; ps += ((tot[e] + 255) >> 8) << 8; } }
    const unsigned* TOPE = (const unsigned*)(F.ws + OPQ(MOE_TOPE)); const float* TOPG = (const float*)(F.ws + OPQ(MOE_TOPG));
    int* SLOTTOK = (int*)(F.ws + OPQ(MOE_SLOTTOK)); float* SLOTGATE = (float*)(F.ws + OPQ(MOE_SLOTGATE)); int* TOKSLOT = (int*)(F.ws + OPQ(MOE_TOKSLOT)); float* SLOTSCALE = (float*)(F.ws + OPQ(MOE_SLOTSCALE)); const float* XSCM = (const float*)(F.ws + OPQ(WS_XSCALEM));
    const int na = 2 * tpb;
    int done_before[8];
#pragma unroll
    for (int e = 0; e < 8; ++e) done_before[e] = 0;
    for (int a0 = 0; a0 < na; a0 += NWAVES * 64) {
        const int a = a0 + F.tid; const bool valid = a < na;
        const int tok = j * tpb + (a >> 1), k = a & 1;
        int e = -1; if (valid) { const unsigned te = TOPE[tok]; e = (int)((te >> (8 * k)) & 255u); }
        int rank = 0;
#pragma unroll
        for (int x = 0; x < 8; ++x) { const unsigned long long bm = __ballot(e == x); if (e == x) rank = __popcll(bm & ((1ull << F.lane) - 1ull)); if (F.lane == 0) wcnt[F.wave * 8 + x] = __popcll(bm); }
        __syncthreads();
        if (valid) { int pre = 0, all = 0;
#pragma unroll
            for (int x = 0; x < 8; ++x) { int ps = 0, al = 0;
#pragma unroll
                for (int w = 0; w < NWAVES; ++w) { const int c = wcnt[w * 8 + x]; if (w < F.wave) ps += c; al += c; }
                if (e == x) { pre = ps + done_before[x]; } all = al; done_before[x] += all; }
            const int slot = pst[e] + base[e] + pre + rank;
            SLOTTOK[slot] = tok; SLOTGATE[slot] = TOPG[2 * tok + k]; TOKSLOT[2 * tok + k] = slot; SLOTSCALE[slot] = XSCM[tok];
        } else {
#pragma unroll
            for (int x = 0; x < 8; ++x) { int al = 0;
#pragma unroll
                for (int w = 0; w < NWAVES; ++w) al += wcnt[w * 8 + x];
                done_before[x] += al; }
        }
        __syncthreads();
    }
    if (j < 8) { const int e = j, t = tot[e], padded = ((t + 255) >> 8) << 8; for (int s = t + F.tid; s < padded; s += NWAVES * 64) { SLOTTOK[pst[e] + s] = 0; SLOTGATE[pst[e] + s] = 0.f; SLOTSCALE[pst[e] + s] = 0.f; } }
    __syncthreads();
}

constexpr int NPHASE = 27;
__device__ __forceinline__ const void* kin_load(const __attribute__((address_space(4))) char* ka, int i) {
    int z; asm volatile("s_mov_b32 %0, 0" : "=s"(z));
    return *(const void* const __attribute__((address_space(4)))*)(ka + 8 * (i + z));
}
struct Args { const void* in[18]; float* out; unsigned char* ws; int ph_lo, ph_hi; };
__global__ void __launch_bounds__(NWAVES * 64, 2) mk_fwd(Args args) {
    extern __shared__ __attribute__((aligned(16))) unsigned char lds[];
    Frame F;
    F.lds = (LAS unsigned char*)lds;
    F.MISC = (volatile LAS unsigned*)(F.lds + MISC_OFF);
    const int wave0_ = __builtin_amdgcn_readfirstlane((int)threadIdx.x >> 6);
    F.wave = wave0_; F.lane = mk_lane(); F.tid = wave0_ * 64 + F.lane;
    F.G = gridDim.x; F.bid = blockIdx.x;
    F.ws = args.ws; F.out = args.out; F.ctl = (gu32*)(args.ws + OPQ(WS_CTL));
    const __attribute__((address_space(4))) char* KA = (const __attribute__((address_space(4))) char*)__builtin_amdgcn_kernarg_segment_ptr();
#define KIN(T, i) ((T)kin_load(KA, (i)))
    for (int u = F.tid; u < (LDS_BYTES - MISC_OFF) / 4; u += NWAVES * 64) ((LAS unsigned*)(F.lds + MISC_OFF))[u] = 0u;
    __syncthreads();
    const int lo = args.ph_lo, hi = args.ph_hi;
    XcdBarrier bar; bar.bar = (unsigned*)(F.ctl + CW_BAR); bar.x = 0; bar.st = nullptr; bar.wv = wave0_;
    if (hi - lo > 1) bar = xcd_barrier_post((unsigned*)(F.ctl + CW_BAR), F.MISC + 8, wave0_);
#ifndef PHS
#define PHS(s) 1
#endif
#ifndef DUP_SLOT
#define DUP_SLOT -1
#endif
#ifdef DUP_MASK
#define NREP(s) ((((s) < 32) && ((DUP_MASK >> (s)) & 1)) ? 2 : 1)
#else
#define NREP(s) (((s) == (DUP_SLOT)) ? 2 : 1)
#endif
#define IN(k) (lo <= (k) && (k) < hi)
#define PHASE_BEGIN() do { int w_ = wave0_; asm volatile("" : "+s"(w_)); const int l_ = mk_lane(); F.wave = w_; F.lane = l_; F.tid = w_ * 64 + l_; } while (0)
#define INS(s) (PHS(s) && IN(pb + (s)))
#define INM(s) (PHS((s) + 20) && IN(pb + (s)))
#define SEAM(k) do { if (IN((k) + 1)) xcd_barrier(bar); } while (0)
    unsigned char* ws = args.ws;
#define XS ((bf16*)(ws + OPQ(WS_XS)))
#define DQ ((bf16*)(ws + OPQ(WS_DQ)))
#define DK ((bf16*)(ws + OPQ(WS_DK)))
#define DV ((bf16*)(ws + OPQ(WS_DV)))
#define IQ ((bf16*)(ws + OPQ(WS_IQ)))
#define FQ ((bf16*)(ws + OPQ(WS_FQ)))
#define FK ((bf16*)(ws + OPQ(WS_FK)))
#define FV ((bf16*)(ws + OPQ(WS_FV)))
#define GA ((bf16*)(ws + OPQ(WS_GA)))
#define GB ((bf16*)(ws + OPQ(WS_GB)))
#define IK ((bf16*)(ws + OPQ(WS_IK)))
#define MERGED ((bf16*)(ws + OPQ(WS_MERGED)))
#define IW ((float*)(ws + OPQ(WS_IW)))
#define LOGF ((float*)(ws + OPQ(WS_LOGF)))
#define CB ((float*)(ws + OPQ(WS_CB)))
#define MASK ((unsigned*)(ws + OPQ(WS_MASK)))

    if (PHS(100) && IN(0)) { for (int rep_ = 0; rep_ < NREP(100); ++rep_) { PHASE_BEGIN(); p0_prologue(F, KIN(const float*, 0), KIN(const int*, 1), KIN(const float*, 2), KIN(const float*, 4), KIN(const float*, 5), KIN(const float*, 6), KIN(const float*, 11), KIN(const float*, 12), KIN(const float*, 13)); if (rep_ + 1 < NREP(100)) xcd_barrier(bar); } SEAM(0); }

#ifdef BAR_PROBE_N
    for (int i_ = 0; i_ < BAR_PROBE_N; ++i_) xcd_barrier(bar);
#endif
#ifdef IDLE_PROBE_US
    { const unsigned long long t0_ = __builtin_amdgcn_s_memrealtime(); while (__builtin_amdgcn_s_memrealtime() - t0_ < (unsigned long long)IDLE_PROBE_US * 100ull) __builtin_amdgcn_s_sleep(64); }
#endif
    for (int layer = 0; layer < 2; ++layer) {
        const int pb = 1 + 13 * layer; const bool moe = (layer & 1) != 0;
        if (INS(0)) { for (int rep_ = 0; rep_ < NREP(0); ++rep_) { PHASE_BEGIN();
            pg8::Gemm g{(const bf16*)(ws + OPQ(WS_XS8)), (const bf16*)(ws + OPQ(WS_WIN) + layer * WIN_STRIDE), NTOK, PROJ_PAD, DM / 2}; g.wave = F.wave; pg8::StaticOrder S; S.init(NTOK, PROJ_PAD, F.G, F.bid);
            pg8::EpiProj8 E{{ws, KIN(const float*, 3) + layer * NH}, (const float*)(ws + OPQ(WS_XSCALE)), (const float*)(ws + OPQ(WS_WINSC) + layer * WIN_STRIDE)};
            pg8::gemm_phase<pg8::EpiProj8, pg8::StaticOrder, true, true, false, true>(F.lds + RING_OFF, g, S, E);
            if (rep_ + 1 < NREP(0)) xcd_barrier(bar); } SEAM(pb + 0);
        }
        if (INS(1)) { for (int rep_ = 0; rep_ < NREP(1); ++rep_) { PHASE_BEGIN(); idx_phase(F, IQ, IK, IW, LOGF, CB, MASK, FQ, FK, (unsigned*)(F.ctl + CW_NORMS + 256 * layer)); if (rep_ + 1 < NREP(1)) xcd_barrier(bar); } SEAM(pb + 1); }
        if (INS(2)) { for (int rep_ = 0; rep_ < NREP(2); ++rep_) { PHASE_BEGIN();
            attn_phase(F, DQ, DK, DV, FQ, FK, FV, MASK, CB, (bf16*)(ws + OPQ(WS_OA8)), (bf16*)(ws + OPQ(WS_OB8)), (unsigned*)(F.ctl + CW_QCTR + 64 * layer + 16 * rep_), (const unsigned*)(F.ctl + CW_NORMS + 256 * layer)); if (rep_ + 1 < NREP(2)) xcd_barrier(bar); } SEAM(pb + 2); }
        if (INS(3)) { for (int rep_ = 0; rep_ < NREP(3); ++rep_) { PHASE_BEGIN();
            static_assert((WS_OB8 - WS_OA8) == (size_t)512 * 256 * AW && MiB == (size_t)8 * 256 * AW, "branch B = branch A + 512 row tiles / + 8 column tiles (fp8 bytes)");
            pg8::Gemm g{(const bf16*)(ws + OPQ(WS_OA8)), (const bf16*)(ws + OPQ(WS_WA) + (size_t)layer * DM * AW), NTOK, DM, AW / 2}; g.wave = F.wave; pg8::D1Order S; S.init(NTOK, DM, F.G, F.bid);
            pg8::EpiGate2 E{MERGED, GA, GB, ws + OPQ(WS_IQ), (const float*)(ws + OPQ(WS_WABSC)) + layer * 4096};
            pg8::gemm_phase<pg8::EpiGate2, pg8::D1Order, false, true, false, false, true>(F.lds + RING_OFF, g, S, E);
            if (rep_ + 1 < NREP(3)) xcd_barrier(bar); } SEAM(pb + 3);
        }
        if (INS(5)) { for (int rep_ = 0; rep_ < NREP(5); ++rep_) { PHASE_BEGIN();
            pg8::Gemm g{(const bf16*)(ws + OPQ(WS_IQ)), (const bf16*)(ws + OPQ(WS_WOUT) + (size_t)layer * DM * DM), NTOK, DM, DM / 2}; g.wave = F.wave; pg8::StaticOrder S; S.init(NTOK, DM, F.G, F.bid);
            pg8::EpiYF8 E{{(bf16*)F.out, XS}, (const float*)(ws + OPQ(WS_WOSC)) + layer * DM};
            pg8::gemm_phase<pg8::EpiYF8, pg8::StaticOrder, false, true, false, false, true>(F.lds + RING_OFF, g, S, E);
            if (rep_ + 1 < NREP(5)) xcd_barrier(bar); } SEAM(pb + 5);
        }
        if (INS(6)) { for (int rep_ = 0; rep_ < NREP(6); ++rep_) { PHASE_BEGIN();
            if (moe) { ln_phase<1, true>(F, KIN(const float*, 7) + layer * DM, KIN(const float*, 8) + layer * DM, KIN(const float*, 14) + (size_t)(layer >> 1) * DM * NEXP, WS_XS8M, WS_XSCALEM); }
            else { ln_phase<0, true>(F, KIN(const float*, 7) + layer * DM, KIN(const float*, 8) + layer * DM, nullptr, WS_XS8, WS_XSCALE); }
            if (rep_ + 1 < NREP(6)) xcd_barrier(bar); } SEAM(pb + 6);
        }
        if (!moe) {
            if (INS(8)) { for (int rep_ = 0; rep_ < NREP(8); ++rep_) { PHASE_BEGIN();
                pg8::Gemm g{(const bf16*)(ws + OPQ(WS_XS8)), (const bf16*)(ws + OPQ(WS_FGU)), NTOK, 2 * DFF, DM / 2}; g.wave = F.wave; pg8::StaticOrder S; S.init(NTOK, 2 * DFF, F.G, F.bid);
                pg8::EpiSwiglu8 E{{ws + OPQ(WS_H), 28}, (const float*)(ws + OPQ(WS_XSCALE)), (const float*)(ws + OPQ(WS_FGUSC)), 0};
                pg8::gemm_phase<pg8::EpiSwiglu8, pg8::StaticOrder, true, true, false, true>(F.lds + RING_OFF, g, S, E);
                if (rep_ + 1 < NREP(8)) xcd_barrier(bar); } SEAM(pb + 8);
            }
            if (INS(9)) { for (int rep_ = 0; rep_ < NREP(9); ++rep_) { PHASE_BEGIN();
                pg8::Gemm g{(const bf16*)(ws + OPQ(WS_H)), (const bf16*)(ws + OPQ(WS_FD)), NTOK, DM, DFF / 2}; g.wave = F.wave; pg8::StaticOrder S; S.init(NTOK, DM, F.G, F.bid);
                pg8::EpiYF8 E{{(bf16*)F.out, XS}, (const float*)(ws + OPQ(WS_FDSC))};
                pg8::gemm_phase<pg8::EpiYF8, pg8::StaticOrder, false, true, false, false, true>(F.lds + RING_OFF, g, S, E);
                if (rep_ + 1 < NREP(9)) xcd_barrier(bar); } SEAM(pb + 9);
            }
            if (INS(12)) { for (int rep_ = 0; rep_ < NREP(12); ++rep_) { PHASE_BEGIN();
                ln_phase<0, true>(F, KIN(const float*, 9) + layer * DM, KIN(const float*, 10) + layer * DM, nullptr, WS_XS8, WS_XSCALE);
                if (rep_ + 1 < NREP(12)) xcd_barrier(bar); } SEAM(pb + 12);
            }
        } else {
            if (INS(7)) { for (int rep_ = 0; rep_ < NREP(7); ++rep_) { PHASE_BEGIN(); moe_convert(F, KIN(const float*, 15), KIN(const float*, 16), KIN(const float*, 17)); moe_assign(F); if (rep_ + 1 < NREP(7)) xcd_barrier(bar); } SEAM(pb + 7); }
            pg8::MoeOrder MO; MO.G = F.G; MO.c = F.bid; MO.slot_tok = (const int*)(ws + OPQ(MOE_SLOTTOK));
            if (INM(8) || INM(9) || INM(10) || INM(11)) {
                const int* tot = (const int*)(ws + OPQ(MOE_TOT)); int cs = 0;
#pragma unroll
                for (int e = 0; e < 8; ++e) { cs += (tot[e] + 255) >> 8; MO.cum[e] = cs; }
            } else {
#pragma unroll
                for (int e = 0; e < 8; ++e) MO.cum[e] = 0;
            }
            const int ntile = MO.cum[7], nA = ntile < 128 ? ntile : 128, nT = ntile > 256 ? (ntile - 256 > 8 ? 8 : ntile - 256) : 0, nB = ntile > 128 ? (ntile - 128 > 128 ? 128 : ntile - 128) : 0;
            MO.nmain = nA; MO.gbase = 0; MO.ut = 4 * nT; MO.y = 4;
            if (INM(8)) { PHASE_BEGIN();
                MO.mode = 0; MO.nrows = nA + nT; MO.nmain = nA; MO.gbase = 0; MO.nc = 28;
                pg8::Gemm g{(const bf16*)(ws + OPQ(WS_XS8M)), (const bf16*)F.out, NTOK, NEXP * 2 * DFF, DM / 2}; g.wave = F.wave;
                pg8::EpiSwiglu8 E{{ws + OPQ(WS_H2), 28}, (const float*)(ws + OPQ(MOE_SLOTSCALE)), (const float*)(ws + OPQ(WS_MGUSC)), 0};
                pg8::gemm_phase<pg8::EpiSwiglu8, pg8::MoeOrder, true, true, true, true>(F.lds + RING_OFF, g, MO, E);
                SEAM(pb + 8);
            }
            if (INM(9)) { PHASE_BEGIN();
                MO.mode = 0; MO.nrows = nA; MO.nmain = nA; MO.gbase = 0; MO.nc = 4;
                pg8::Gemm g{(const bf16*)(ws + OPQ(WS_H2)), (const bf16*)(ws + OPQ(WS_MWD)), MOE_H2_TILES * 256, NEXP * DM, DFF / 2}; g.wave = F.wave;
                pg8::EpiDownMoeF8 E{{(bf16*)(ws + OPQ(WS_YB)), (const float*)(ws + OPQ(MOE_SLOTGATE)), 0}, (const float*)(ws + OPQ(WS_MWDSC))};
                pg8::gemm_phase<pg8::EpiDownMoeF8, pg8::MoeOrder, true, true, false, false, true>(F.lds + RING_OFF, g, MO, E);
                SEAM(pb + 9);
            }
            if (INM(10)) { PHASE_BEGIN();
                { MO.mode = 2; MO.gbase = 0; MO.nc = 4;
                  pg8::Gemm g{(const bf16*)(ws + OPQ(WS_H2)), (const bf16*)(ws + OPQ(WS_MWD)), MOE_H2_TILES * 256, NEXP * DM, DFF / 2}; g.wave = F.wave;
                  pg8::EpiDownMoeF8 E{{(bf16*)(ws + OPQ(WS_YB)), (const float*)(ws + OPQ(MOE_SLOTGATE)), 0}, (const float*)(ws + OPQ(WS_MWDSC))};
                  pg8::gemm_phase<pg8::EpiDownMoeF8, pg8::MoeOrder, true, true, false, false, true>(F.lds + RING_OFF, g, MO, E); }
                PHASE_BEGIN();
                { MO.mode = 1; MO.nrows = nB; MO.gbase = 128; MO.nc = 28;
                  pg8::Gemm g{(const bf16*)(ws + OPQ(WS_XS8M)), (const bf16*)F.out, NTOK, NEXP * 2 * DFF, DM / 2}; g.wave = F.wave;
                  pg8::EpiSwiglu8 E{{ws + OPQ(WS_H2), 28}, (const float*)(ws + OPQ(MOE_SLOTSCALE)), (const float*)(ws + OPQ(WS_MGUSC)), 128};
                  pg8::gemm_phase<pg8::EpiSwiglu8, pg8::MoeOrder, true, true, true, true>(F.lds + RING_OFF, g, MO, E); }
                SEAM(pb + 10);
            }
            if (INM(11)) { PHASE_BEGIN();
                MO.mode = 0; MO.nrows = nB; MO.nmain = nB; MO.gbase = 128; MO.nc = 4;
                pg8::Gemm g{(const bf16*)(ws + OPQ(WS_H2)), (const bf16*)(ws + OPQ(WS_MWD)), MOE_H2_TILES * 256, NEXP * DM, DFF / 2}; g.wave = F.wave;
                pg8::EpiDownMoeF8 E{{(bf16*)(ws + OPQ(WS_YB)), (const float*)(ws + OPQ(MOE_SLOTGATE)), 128}, (const float*)(ws + OPQ(WS_MWDSC))};
                pg8::gemm_phase<pg8::EpiDownMoeF8, pg8::MoeOrder, true, true, false, false, true>(F.lds + RING_OFF, g, MO, E);
                SEAM(pb + 11);
            }
            if (INS(12)) { for (int rep_ = 0; rep_ < NREP(12); ++rep_) { PHASE_BEGIN(); ln_phase<3>(F, KIN(const float*, 9) + layer * DM, KIN(const float*, 10) + layer * DM, nullptr); if (rep_ + 1 < NREP(12)) xcd_barrier(bar); } SEAM(pb + 12); }
        }
    }
#undef IN
#undef INS
#undef SEAM
}


#if MK_MULTI && defined(MK_DUMP)
__global__ void dump_kernel(unsigned char* ws, float* out, int mode) {
    const size_t n = (size_t)NTOK * DM;
    for (size_t i = (size_t)blockIdx.x * blockDim.x + threadIdx.x; i < n; i += (size_t)gridDim.x * blockDim.x) {
        const size_t row = i >> 10; const int c = (int)(i & 1023);
        float v = 0.f;
        auto B = [&](size_t off, int pitch, int col) { return pg8::bf2f(((const bf16*)(ws + off))[row * pitch + col]); };
        if (mode == 1) { if (c < 512) v = B(WS_DQ, 512, c) + 2.f * B(WS_DK, 512, c) + 4.f * B(WS_DV, 512, c) + 8.f * B(WS_IQ, 512, c);
                         else v = B(WS_FQ, 512, c - 512) + 2.f * B(WS_FK, 512, c - 512) + 4.f * B(WS_FV, 512, c - 512) + 8.f * B(WS_IK, 64, c & 63) + ((const float*)(ws + OPQ(WS_IW)))[row * 8 + (c & 7)] + ((const float*)(ws + OPQ(WS_LOGF)))[row * 8 + (c & 7)]; }
        else if (mode == 2) v = B(WS_GA, 1024, c) + 2.f * B(WS_GB, 1024, c);
        else if (mode == 3) { const unsigned w = ((const unsigned*)(ws + OPQ(WS_MASK)))[row * 128 + (c & 127)]; const int qb = (int)((row & 4095) >> 8); v = ((c & 127) < 8 * (qb + 1)) ? (float)((w >> (4 * (c >> 7))) & 0xffffu) : 0.f; }
        else if (mode == 4) v = ((const float*)(ws + OPQ(WS_CB)))[(row >> 12) * 8 * 4096 + (size_t)(c & 7) * 4096 + (row & 4095)];
        else if (mode == 5) v = c < 512 ? B(WS_DQ, 512, c) : B(WS_FQ, 512, c - 512);
        else if (mode == 6) v = B(WS_MERGED, 1024, c);
        else if (mode == 7) v = B(WS_XS, 1024, c);
        out[i] = v;
    }
}
#endif
extern "C" void kernel_launch(void* const* d_in, const int* in_sizes, int n_in, void* d_out, int out_size, void* d_ws, size_t ws_size, hipStream_t stream) {
    static int grid = 0;
    if (grid == 0) {
        if (n_in != 18 || in_sizes[0] != NTOK * DM || out_size != NTOK * DM || ws_size < WS_END) {
            fprintf(stderr, "kernel_launch: unexpected shapes: n_in %d in0 %d out %d ws %zu (need %zu); nothing launched\n", n_in, n_in > 0 ? in_sizes[0] : -1, out_size, ws_size, (size_t)WS_END); grid = -1; return; }
        int dev = 0, cus = 0, per_cu = 0;
        if (hipGetDevice(&dev) != hipSuccess || hipDeviceGetAttribute(&cus, hipDeviceAttributeMultiprocessorCount, dev) != hipSuccess) { fprintf(stderr, "kernel_launch: device query failed\n"); grid = -1; return; }
        if (hipFuncSetAttribute((const void*)mk_fwd, hipFuncAttributeMaxDynamicSharedMemorySize, LDS_BYTES) != hipSuccess) { fprintf(stderr, "kernel_launch: hipFuncSetAttribute failed\n"); grid = -1; return; }
        if (hipOccupancyMaxActiveBlocksPerMultiprocessor(&per_cu, (const void*)mk_fwd, NWAVES * 64, LDS_BYTES) != hipSuccess || per_cu < 1)
            fprintf(stderr, "kernel_launch: note: occupancy query reports %d workgroups per CU\n", per_cu);
        (void)hipGetLastError();
        grid = cus;
        if (grid != 256) fprintf(stderr, "kernel_launch: note: %d CUs (built for 256)\n", grid);
    }
    if (grid < 0) return;
    if (hipMemsetAsync((char*)d_ws + WS_CTL, 0, CTL_ZERO_BYTES, stream) != hipSuccess) { fprintf(stderr, "kernel_launch: memset failed\n"); return; }
    Args a{};
    for (int i = 0; i < 18; ++i) a.in[i] = d_in[i];
    a.out = (float*)d_out; a.ws = (unsigned char*)d_ws;
#if MK_MULTI
#ifndef MK_MAXPH
#define MK_MAXPH NPHASE
#endif
    for (int k = 0; k < MK_MAXPH; ++k) {
        if (k >= 1) { const int layer = (k - 1) / 13, s = (k - 1) % 13; const bool moe = layer & 1;
            if (s == 4 || (!moe && (s == 7 || s == 10 || s == 11))) continue; }
        a.ph_lo = k; a.ph_hi = k + 1;
        hipLaunchKernelGGL(mk_fwd, dim3(grid), dim3(NWAVES * 64), LDS_BYTES, stream, a);
    }
#ifdef MK_DUMP
    hipLaunchKernelGGL(dump_kernel, dim3(2048), dim3(256), 0, stream, (unsigned char*)d_ws, (float*)d_out, MK_DUMP);
#endif
#else
    a.ph_lo = 0; a.ph_hi = NPHASE;
    hipLaunchKernelGGL(mk_fwd, dim3(grid), dim3(NWAVES * 64), LDS_BYTES, stream, a);
#endif
    const hipError_t le = hipPeekAtLastError();
    if (le != hipSuccess) fprintf(stderr, "kernel_launch: launch failed: %s\n", hipGetErrorName(le));
}
```
